# Optimizing an MI355X kernel written in HIP

```python
import jax, jax.numpy as jnp
from jax import lax
import numpy as np

D_MODEL = 2048
BATCH = 16
SEQ = 256
DEPTH = 2
DEC_BATCH = 4
DEC_SEQ = 1024
PAST_LEN = 256

GRID_W = 64
D_MIX = D_MODEL
HEAD_DIM = 128
N_HEADS = (D_MIX // 2) // HEAD_DIM
N_KV_HEADS = 2
GROUP = N_HEADS // N_KV_HEADS
D_ATTN = N_HEADS * HEAD_DIM
D_KV = N_KV_HEADS * HEAD_DIM
ROPE_THETA = 10000.0
Q_BLOCK = 128
D_CONV = D_MIX // 4
CONV_WIDTH = 3
D_RWKV = D_MIX // 4
RWKV_HEAD = 64
RWKV_HEADS = D_RWKV // RWKV_HEAD
DECAY_RANK = 32
A_RANK = 32
GATE_RANK = 96
D_RWKV_IN = 3 * D_RWKV + DECAY_RANK + A_RANK + GATE_RANK
D_IN = D_ATTN + 2 * D_KV + 3 * D_CONV + D_RWKV_IN
SPLIT_IN = [D_ATTN, D_ATTN + D_KV, D_ATTN + 2 * D_KV, D_ATTN + 2 * D_KV + D_CONV,
            D_ATTN + 2 * D_KV + 2 * D_CONV, D_ATTN + 2 * D_KV + 3 * D_CONV]
SPLIT_RWKV = [D_RWKV, 2 * D_RWKV, 3 * D_RWKV, 3 * D_RWKV + DECAY_RANK,
              3 * D_RWKV + DECAY_RANK + A_RANK]
D_FF = -(-(8 * D_MODEL) // (3 * 256)) * 256
N_MOD = 6
EPS = 1e-6
GN_EPS = 64e-5

kernel_name = 'hybrid_dit_parallel_heads_step'


def rmsnorm(x, g):
    xf = x.astype(jnp.float32)
    y = xf * lax.rsqrt(jnp.mean(xf * xf, axis=-1, keepdims=True) + EPS)
    return (y * g.astype(jnp.float32)).astype(x.dtype)


def axial_rope(n):
    rows = n // GRID_W
    row = jnp.repeat(jnp.arange(rows), GRID_W).astype(jnp.float32)
    col = jnp.tile(jnp.arange(GRID_W), rows).astype(jnp.float32)
    half = HEAD_DIM // 2
    inv = 1.0 / (ROPE_THETA ** (jnp.arange(0, half, 2, dtype=jnp.float32) / half))
    ar = row[:, None] * inv
    ac = col[:, None] * inv
    ang = jnp.concatenate([ar, ar, ac, ac], axis=-1)
    return jnp.cos(ang), jnp.sin(ang)


def apply_rope(x, cos, sin):
    x1, x2, x3, x4 = jnp.split(x, 4, axis=-1)
    rot = jnp.concatenate([-x2, x1, -x4, x3], axis=-1)
    cos = cos[None, :, None, :].astype(x.dtype)
    sin = sin[None, :, None, :].astype(x.dtype)
    return x * cos + rot * sin


def shift_prev(u):
    return jnp.pad(u, ((0, 0), (1, 0), (0, 0)))[:, :-1]


def shift_next(u):
    return jnp.pad(u, ((0, 0), (0, 1), (0, 0)))[:, 1:]


def short_conv(u, w):
    return shift_prev(u) * w[0] + u * w[1] + shift_next(u) * w[2]


def attention(q, k, v):
    b, n = q.shape[:2]
    nb = n // Q_BLOCK
    qb = q.reshape(b, nb, Q_BLOCK, N_KV_HEADS, GROUP, HEAD_DIM).swapaxes(0, 1)
    scale = HEAD_DIM ** -0.5

    def block(qi):
        s = jnp.einsum('bqkgd,bskd->bkgqs', qi, k).astype(jnp.float32) * scale
        p = jax.nn.softmax(s, axis=-1).astype(v.dtype)
        return jnp.einsum('bkgqs,bskd->bqkgd', p, v)

    o = lax.map(block, qb)
    return o.swapaxes(0, 1).reshape(b, n, D_ATTN)


def rwkv_scan(r, w, k, v, kk, a, s0, reverse):
    xs = tuple(t.swapaxes(0, 1) for t in (r, w, k, v, kk, a))

    def step(S, inp):
        r_t, w_t, k_t, v_t, kk_t, a_t = inp
        sa = jnp.einsum('bhij,bhj->bhi', S, -kk_t)
        S = (S * w_t[:, :, None, :] + sa[..., None] * (kk_t * a_t)[:, :, None, :]
             + v_t[..., None] * k_t[:, :, None, :])
        return S, jnp.einsum('bhij,bhj->bhi', S, r_t)

    S, y = lax.scan(step, s0, xs, reverse=reverse)
    return y.swapaxes(0, 1), S


def rwkv_mixer(u, s0, P, l):
    dt = u.dtype
    b, n = u.shape[:2]
    u = u + P['rwkv_mu'][l] * (0.5 * (shift_prev(u) + shift_next(u)) - u)
    u = u.astype(jnp.float32)
    r, k, v, xw, xa, xg = jnp.split(u, SPLIT_RWKV, axis=-1)

    def hs(t):
        return t.reshape(b, n, RWKV_HEADS, RWKV_HEAD)

    def f(name):
        return P[name][l].astype(jnp.float32)

    g = jax.nn.sigmoid(xg) @ f('rwkv_g_up')
    kk = hs(k * f('rwkv_k_k'))
    kk = kk * lax.rsqrt(jnp.sum(kk * kk, axis=-1, keepdims=True) + 1e-12)
    rh, vh = hs(r), hs(v)
    r_k = f('rwkv_r_k')
    s0 = s0.astype(jnp.float32)
    ys, bonuses, states = [], [], []
    for d in range(2):
        w = -jax.nn.softplus(-(f('rwkv_w0')[d] + jnp.tanh(xw) @ f('rwkv_w_up')[d])) - 0.5
        decay = jnp.exp(-jnp.exp(w))
        a = jax.nn.sigmoid(f('rwkv_a0')[d] + xa @ f('rwkv_a_up')[d])
        kd = hs(k * (1.0 + (a - 1.0) * f('rwkv_k_a')))
        yd, Sd = rwkv_scan(rh, hs(decay), kd, vh, kk, hs(a), s0[:, d], reverse=(d == 1))
        ys.append(yd)
        bonuses.append(jnp.sum(rh * kd * r_k, axis=-1, keepdims=True) * vh)
        states.append(Sd)
    y = ys[0] + ys[1]
    mean = jnp.mean(y, axis=-1, keepdims=True)
    var = jnp.mean(jnp.square(y - mean), axis=-1, keepdims=True)
    yn = ((y - mean) * lax.rsqrt(var + GN_EPS)).reshape(b, n, D_RWKV) * f('rwkv_ln_g') + f('rwkv_ln_b')
    out = (yn + (bonuses[0] + bonuses[1]).reshape(b, n, D_RWKV)) * g
    return out.astype(dt), jnp.stack(states, axis=1)


def layer(x, mod, P, l, rope, ctx_k, ctx_v, s0):
    b, n = x.shape[:2]
    sh_a, sc_a, g_a, sh_f, sc_f, g_f = jnp.split(mod, N_MOD, axis=-1)
    ng = P['norm_g'][l]
    h = rmsnorm(x, ng[0]) * (1 + sc_a) + sh_a
    proj = h @ P['w_in'][l]
    q, k, v, cb, cc, ch, ur = jnp.split(proj, SPLIT_IN, axis=-1)
    q = rmsnorm(q.reshape(b, n, N_HEADS, HEAD_DIM), P['q_norm'][l])
    k = rmsnorm(k.reshape(b, n, N_KV_HEADS, HEAD_DIM), P['k_norm'][l])
    v = v.reshape(b, n, N_KV_HEADS, HEAD_DIM)
    if rope is None:
        keys, vals = k, v
    else:
        q = apply_rope(q, rope[0], rope[1])
        k = apply_rope(k, rope[0], rope[1])
        keys = jnp.concatenate([k, ctx_k], axis=1)
        vals = jnp.concatenate([v, ctx_v], axis=1)
    attn = attention(q.reshape(b, n, N_KV_HEADS, GROUP, HEAD_DIM), keys, vals)
    conv = cb * short_conv(cc * ch, P['conv_w'][l])
    rw, S = rwkv_mixer(ur, s0, P, l)
    o = jnp.concatenate([attn, conv, rw], axis=-1) @ P['w_out'][l]
    x = x + g_a * rmsnorm(o, ng[1])
    h = rmsnorm(x, ng[2]) * (1 + sc_f) + sh_f
    ff = (jax.nn.silu(h @ P['w_gate'][l]) * (h @ P['w_up'][l])) @ P['w_down'][l]
    x = x + g_f * rmsnorm(ff, ng[3])
    return x, k, v, S


def setup_inputs(seed: int = 0) -> dict:
    key = jax.random.key(seed)
    ks = jax.random.split(key, 32)

    def nrm(i, shape, scale):
        return jax.random.normal(ks[i], shape, jnp.float32) * scale

    L, D = DEPTH, D_MODEL
    return {
        'x_prompt': nrm(0, (BATCH, SEQ, D), 1.0),
        'x_sample': nrm(1, (DEC_BATCH, DEC_SEQ, D), 1.0),
        'cache_k': nrm(2, (DEC_BATCH, L, PAST_LEN, N_KV_HEADS, HEAD_DIM), 1.0),
        'cache_v': nrm(3, (DEC_BATCH, L, PAST_LEN, N_KV_HEADS, HEAD_DIM), 1.0),
        'state_rwkv': nrm(4, (DEC_BATCH, L, 2, RWKV_HEADS, RWKV_HEAD, RWKV_HEAD), 0.1),
        'c': nrm(5, (DEC_BATCH, D), 1.0),
        'c_ctx': nrm(6, (D,), 1.0),
        'w_ada': nrm(7, (L, D, N_MOD * D), D ** -0.5),
        'b_ada': nrm(8, (L, N_MOD * D), 0.01),
        'norm_g': 1.0 + nrm(9, (L, 4, D), 0.05),
        'w_in': nrm(10, (L, D, D_IN), D ** -0.5),
        'q_norm': 1.0 + nrm(11, (L, HEAD_DIM), 0.05),
        'k_norm': 1.0 + nrm(12, (L, HEAD_DIM), 0.05),
        'conv_w': nrm(13, (L, CONV_WIDTH, D_CONV), CONV_WIDTH ** -0.5),
        'rwkv_mu': 0.5 + nrm(14, (L, D_RWKV_IN), 0.1),
        'rwkv_w0': nrm(15, (L, 2, D_RWKV), 1.0),
        'rwkv_w_up': nrm(16, (L, 2, DECAY_RANK, D_RWKV), 0.1),
        'rwkv_a0': nrm(17, (L, 2, D_RWKV), 0.1),
        'rwkv_a_up': nrm(18, (L, 2, A_RANK, D_RWKV), 0.1),
        'rwkv_g_up': nrm(19, (L, GATE_RANK, D_RWKV), GATE_RANK ** -0.5),
        'rwkv_k_k': 0.85 + nrm(20, (L, D_RWKV), 0.02),
        'rwkv_k_a': 1.0 + nrm(21, (L, D_RWKV), 0.02),
        'rwkv_r_k': nrm(22, (L, RWKV_HEADS, RWKV_HEAD), 0.1),
        'rwkv_ln_g': 1.0 + nrm(23, (L, D_RWKV), 0.05),
        'rwkv_ln_b': nrm(24, (L, D_RWKV), 0.01),
        'w_out': nrm(25, (L, D_MIX, D), D_MIX ** -0.5),
        'w_gate': nrm(26, (L, D, D_FF), D ** -0.5),
        'w_up': nrm(27, (L, D, D_FF), D ** -0.5),
        'w_down': nrm(28, (L, D_FF, D), D_FF ** -0.5),
    }


def reference(x_prompt, x_sample, cache_k, cache_v, state_rwkv, c, c_ctx, w_ada, b_ada, norm_g,
              w_in, q_norm, k_norm, conv_w, rwkv_mu, rwkv_w0, rwkv_w_up, rwkv_a0, rwkv_a_up,
              rwkv_g_up, rwkv_k_k, rwkv_k_a, rwkv_r_k, rwkv_ln_g, rwkv_ln_b, w_out, w_gate, w_up,
              w_down):
    P = {'norm_g': norm_g, 'w_in': w_in, 'q_norm': q_norm, 'k_norm': k_norm, 'conv_w': conv_w,
         'rwkv_mu': rwkv_mu, 'rwkv_w0': rwkv_w0, 'rwkv_w_up': rwkv_w_up, 'rwkv_a0': rwkv_a0,
         'rwkv_a_up': rwkv_a_up, 'rwkv_g_up': rwkv_g_up, 'rwkv_k_k': rwkv_k_k,
         'rwkv_k_a': rwkv_k_a, 'rwkv_r_k': rwkv_r_k, 'rwkv_ln_g': rwkv_ln_g,
         'rwkv_ln_b': rwkv_ln_b, 'w_out': w_out, 'w_gate': w_gate, 'w_up': w_up,
         'w_down': w_down}

    xp = x_prompt
    s_zero = jnp.zeros((xp.shape[0], 2, RWKV_HEADS, RWKV_HEAD, RWKV_HEAD), jnp.float32)
    ks, vs, ss = [], [], []
    for l in range(DEPTH):
        mod = (jax.nn.silu(c_ctx) @ w_ada[l] + b_ada[l])[None, None, :]
        xp, k_l, v_l, s_l = layer(xp, mod, P, l, None, None, None, s_zero)
        ks.append(k_l)
        vs.append(v_l)
        ss.append(s_l.astype(x_prompt.dtype))
    new_k = jnp.stack(ks, axis=1)
    new_v = jnp.stack(vs, axis=1)
    new_rwkv = jnp.stack(ss, axis=1)

    rope = axial_rope(x_sample.shape[1])
    xs = x_sample
    for l in range(DEPTH):
        mod = (jax.nn.silu(c) @ w_ada[l] + b_ada[l])[:, None, :]
        xs, _, _, _ = layer(xs, mod, P, l, rope, cache_k[:, l], cache_v[:, l], state_rwkv[:, l])

    return (xp, xs, new_k, new_v, new_rwkv)
```

```cpp
#include <hip/hip_runtime.h>
#include <hip/hip_bf16.h>
#include <hip/hip_cooperative_groups.h>
#include <cstdio>
#include <cstdint>
#include <cmath>
namespace cg = cooperative_groups;
#ifndef ONE_LAUNCH
#define ONE_LAUNCH 0
#endif
namespace pg8 {
#define PG8_LAS __attribute__((address_space(3)))
typedef unsigned short bf16_t;
typedef short bf16x8 __attribute__((ext_vector_type(8)));
typedef float f32x4 __attribute__((ext_vector_type(4)));
typedef unsigned u32x4 __attribute__((ext_vector_type(4)));
constexpr int BM = 256, BK = 64, HALF = 128, HTB = HALF * BK * 2  , STAGE_BYTES = 8 * HTB, NXCD = 8, WGM = 8;

__host__ __device__ __forceinline__ int lds_byte(int r, int c) { const int st = (r >> 4) * 2 + (c >> 5), rr = r & 15, cc = c & 31, ob = rr * 64 + cc * 2; return st * 1024 + (ob ^ (((ob >> 9) & 1) << 5)); }
__host__ __device__ __forceinline__ void stage_rc(int b, int& R, int& C) { const int st = b / 1024, sb = b % 1024, swz = sb ^ (((sb >> 9) & 1) << 5); R = (st >> 1) * 16 + swz / 64; C = (st & 1) * 32 + (swz % 64) / 2; }
__host__ __device__ __forceinline__ int perm32(int rho) { const int n = rho >> 4, i = rho & 15; return 8 * (i >> 2) + 4 * n + (i & 3); }

struct Unit { int pm, pn; };
struct Gemm { const bf16_t* A; const bf16_t* Bt; int M, N, K; };

struct StaticOrder {
    int nM, nN, nwg, G, c;
    __host__ __device__ void init(int M, int N, int G_, int c_) { nM = M / BM; nN = N / BM; nwg = nM * nN; G = G_; c = c_; }
    __host__ __device__ bool next(int i, Unit& u) const {
        const long L = (long)i * G + c; if (L >= nwg) return false;
        int wgid = (int)L; { const int q = nwg / NXCD, r = nwg % NXCD, xcd = wgid % NXCD, off = wgid / NXCD; wgid = (xcd < r ? xcd * (q + 1) : r * (q + 1) + (xcd - r) * q) + off; }
        const int nig = WGM * nN, gid = wgid / nig, fm = gid * WGM, gsz = (nM - fm) < WGM ? (nM - fm) : WGM;
        u.pm = fm + ((wgid % nig) % gsz); u.pn = (wgid % nig) / gsz; return true;
    }
    __device__ __forceinline__ void a_ready(const Unit&) const {}
    __device__ __forceinline__ void done(const Unit&) const {}
};

__device__ __forceinline__ unsigned cvt_pk_bf16(float lo, float hi) { unsigned r; asm volatile("v_cvt_pk_bf16_f32 %0, %1, %2" : "=v"(r) : "v"(lo), "v"(hi)); return r; }
struct EpiBf16 {
    static constexpr bool PERM = true, AFTER_DRAIN = false;
    bf16_t* O; int ldc;
    __device__ __forceinline__ void operator()(const f32x4 (&acc)[2][2][4][2], const Unit& u, int wr, int wc, int fr, int fq) const {
        const int row0 = u.pm * BM + wr * 64 + fr; const int col0 = u.pn * BM + wc * 32 + 8 * fq;
#pragma unroll
        for (int ai = 0; ai < 2; ++ai)
#pragma unroll
            for (int m = 0; m < 4; ++m) { bf16_t* rowp = O + (size_t)(row0 + ai * HALF + m * 16) * ldc + col0;
#pragma unroll
                for (int bj = 0; bj < 2; ++bj) { const f32x4 v0 = acc[ai][bj][m][0], v1 = acc[ai][bj][m][1];
                    u32x4 w; w.x = cvt_pk_bf16(v0[0], v0[1]); w.y = cvt_pk_bf16(v0[2], v0[3]); w.z = cvt_pk_bf16(v1[0], v1[1]); w.w = cvt_pk_bf16(v1[2], v1[3]);
                    *(u32x4*)(rowp + bj * HALF) = w; } }
    }
};
struct EpiF32 {
    static constexpr bool PERM = false, AFTER_DRAIN = false;
    float* O; int ldc;
    __device__ __forceinline__ void operator()(const f32x4 (&acc)[2][2][4][2], const Unit& u, int wr, int wc, int fr, int fq) const {
        const int row0 = u.pm * BM + wr * 64 + fr; const int col0 = u.pn * BM + wc * 32 + 4 * fq;
#pragma unroll
        for (int ai = 0; ai < 2; ++ai)
#pragma unroll
            for (int m = 0; m < 4; ++m) { float* rowp = O + (size_t)(row0 + ai * HALF + m * 16) * ldc + col0;
#pragma unroll
                for (int bj = 0; bj < 2; ++bj)
#pragma unroll
                    for (int n = 0; n < 2; ++n) *(f32x4*)(rowp + bj * HALF + n * 16) = acc[ai][bj][m][n]; }
    }
};
__device__ __forceinline__ float silu_mul(float g, float u) { return g * __builtin_amdgcn_rcpf(1.0f + __expf(-g)) * u; }
struct EpiSwiGLU {
    static constexpr bool PERM = true, AFTER_DRAIN = false;
    bf16_t* O; int ldc;
    __device__ __forceinline__ void operator()(const f32x4 (&acc)[2][2][4][2], const Unit& u, int wr, int wc, int fr, int fq) const {
        const int row0 = u.pm * BM + wr * 64 + fr; const int col0 = u.pn * HALF + wc * 32 + 8 * fq;
#pragma unroll
        for (int ai = 0; ai < 2; ++ai)
#pragma unroll
            for (int m = 0; m < 4; ++m) { bf16_t* rowp = O + (size_t)(row0 + ai * HALF + m * 16) * ldc + col0;
                const f32x4 g0 = acc[ai][0][m][0], g1 = acc[ai][0][m][1], u0 = acc[ai][1][m][0], u1 = acc[ai][1][m][1];
                u32x4 w; w.x = cvt_pk_bf16(silu_mul(g0[0], u0[0]), silu_mul(g0[1], u0[1])); w.y = cvt_pk_bf16(silu_mul(g0[2], u0[2]), silu_mul(g0[3], u0[3]));
                w.z = cvt_pk_bf16(silu_mul(g1[0], u1[0]), silu_mul(g1[1], u1[1])); w.w = cvt_pk_bf16(silu_mul(g1[2], u1[2]), silu_mul(g1[3], u1[3]));
                *(u32x4*)rowp = w; }
    }
};
template <class Epi, class Sched, bool ALIGN_EPI = false, bool SP2 = false>
__device__ __forceinline__ void gemm_phase(PG8_LAS unsigned char* lds, const Gemm g, const Sched& S, const Epi& E) {
    const int tid = threadIdx.x, wid = __builtin_amdgcn_readfirstlane(tid >> 6), lane = tid & 63, wr = wid >> 2, wc = wid & 3, fr = lane & 15, fq = lane >> 4;
    const int K = g.K, nt = K / BK;
    unsigned voffA[2], voffB[2];
#pragma unroll
    for (int i = 0; i < 2; ++i) { int R, C; stage_rc(tid * 16 + i * 8192, R, C); const int Rb = Epi::PERM ? ((R & ~31) + perm32(R & 31)) : R;
        voffA[i] = (unsigned)(R * K + C) * 2u; voffB[i] = (unsigned)(Rb * K + C) * 2u; }
    const size_t kstep = (size_t)(BK * 2);
    const size_t hstep = (size_t)HALF * K * 2;
    const size_t tstep = 2 * hstep;
    const unsigned ldsw = (unsigned)wid * 1024u;
    const int aoff = lds_byte(wr * 64 + fr, fq * 8), boff = lds_byte(wc * 32 + fr, fq * 8);
#define PG8_SA(b, h) (((b) * 2 + (h)) * HTB)
#define PG8_SB(b, h) ((4 + (b) * 2 + (h)) * HTB)
#define PG8_STAGE(bufoff, gbase, voff) do { _Pragma("unroll") for (int _i = 0; _i < 2; ++_i) \
        __builtin_amdgcn_global_load_lds((const unsigned*)((const char*)(gbase) + (voff)[_i]), (PG8_LAS unsigned*)(lds + (bufoff) + ldsw + _i * 8192), 16, 0, 0); } while (0)
#define PG8_LDA(dst, b, h) do { _Pragma("unroll") for (int m = 0; m < 4; ++m) _Pragma("unroll") for (int k = 0; k < 2; ++k) dst[m][k] = *(const PG8_LAS bf16x8*)(lds + PG8_SA(b, h) + aoff + m * 2048 + k * 1024); } while (0)
#define PG8_LDB(dst, b, h) do { _Pragma("unroll") for (int n = 0; n < 2; ++n) _Pragma("unroll") for (int k = 0; k < 2; ++k) dst[n][k] = *(const PG8_LAS bf16x8*)(lds + PG8_SB(b, h) + boff + n * 2048 + k * 1024); } while (0)
#define PG8_MMA(ai, bj, At, Bt) do { __builtin_amdgcn_s_setprio(1); _Pragma("unroll") for (int m = 0; m < 4; ++m) _Pragma("unroll") for (int n = 0; n < 2; ++n) _Pragma("unroll") for (int k = 0; k < 2; ++k) \
        acc[ai][bj][m][n] = __builtin_amdgcn_mfma_f32_16x16x32_bf16(Bt[n][k], At[m][k], acc[ai][bj][m][n], 0, 0, 0); __builtin_amdgcn_s_setprio(0); } while (0)
#define PG8_WAIT_V(n) asm volatile("s_waitcnt vmcnt(" #n ")" ::: "memory")
#define PG8_WAIT_L(n) asm volatile("s_waitcnt lgkmcnt(" #n ")" ::: "memory")
#define PG8_BAR __builtin_amdgcn_s_barrier()
#define PG8_SCHED __builtin_amdgcn_sched_barrier(0)
    Unit cur, nxt; int ui = 0;
    if (!S.next(0, cur)) return;
    f32x4 acc[2][2][4][2];
#pragma unroll
    for (int a = 0; a < 2; ++a)
#pragma unroll
        for (int b = 0; b < 2; ++b)
#pragma unroll
            for (int m = 0; m < 4; ++m)
#pragma unroll
                for (int n = 0; n < 2; ++n) acc[a][b][m][n] = (f32x4){0.f, 0.f, 0.f, 0.f};
    bf16x8 At[4][2], B0[2][2], B1[2][2];
    const char* cA = (const char*)g.A + (size_t)cur.pm * tstep; const char* cB = (const char*)g.Bt + (size_t)cur.pn * tstep;
    S.a_ready(cur);
    if constexpr (SP2) {
        PG8_STAGE(PG8_SB(0, 0), cB, voffB); PG8_STAGE(PG8_SB(0, 1), cB + hstep, voffB); PG8_STAGE(PG8_SA(0, 0), cA, voffA); PG8_STAGE(PG8_SA(0, 1), cA + hstep, voffA);
        if (wr == 1) PG8_BAR;
        PG8_WAIT_V(2); PG8_BAR;
        PG8_STAGE(PG8_SB(1, 0), cB + kstep, voffB); PG8_STAGE(PG8_SA(1, 0), cA + kstep, voffA); PG8_STAGE(PG8_SB(1, 1), cB + hstep + kstep, voffB);
        PG8_WAIT_V(6); PG8_BAR;
    } else {
        PG8_STAGE(PG8_SB(0, 0), cB, voffB); PG8_STAGE(PG8_SA(0, 0), cA, voffA); PG8_STAGE(PG8_SB(0, 1), cB + hstep, voffB); PG8_STAGE(PG8_SA(0, 1), cA + hstep, voffA);
        if (wr == 1) PG8_BAR;
        PG8_WAIT_V(4); PG8_BAR;
        PG8_STAGE(PG8_SB(1, 0), cB + kstep, voffB); PG8_STAGE(PG8_SA(1, 0), cA + kstep, voffA); PG8_STAGE(PG8_SB(1, 1), cB + hstep + kstep, voffB);
        PG8_WAIT_V(6); PG8_BAR;
    }
    for (;;) {
        const bool has_next = S.next(ui + 1, nxt);
        const char* nA = has_next ? (const char*)g.A + (size_t)nxt.pm * tstep : cA; const char* nB = has_next ? (const char*)g.Bt + (size_t)nxt.pn * tstep : cB;
        for (int t = 0; t < nt; t += 2) {
            const bool last = (t == nt - 2);
            const char* a1 = cA + (size_t)(t + 1) * kstep;
            const char* a2 = last ? nA : cA + (size_t)(t + 2) * kstep; const char* b2 = last ? nB : cB + (size_t)(t + 2) * kstep;
            const char* a3 = a2 + kstep; const char* b3 = b2 + kstep;
            if (last && has_next) S.a_ready(nxt);
            if constexpr (SP2) {
            PG8_LDB(B0, 0, 0); PG8_LDB(B1, 0, 1); PG8_SCHED; PG8_LDA(At, 0, 0); PG8_STAGE(PG8_SA(1, 1), a1 + hstep, voffA);
            PG8_WAIT_V(8); PG8_WAIT_L(0); PG8_BAR; PG8_MMA(0, 0, At, B0); PG8_MMA(0, 1, At, B1); PG8_BAR; PG8_SCHED;
            PG8_LDA(At, 0, 1); PG8_STAGE(PG8_SB(0, 0), b2, voffB); PG8_STAGE(PG8_SB(0, 1), b2 + hstep, voffB); PG8_STAGE(PG8_SA(0, 0), a2, voffA);
            PG8_WAIT_V(8); PG8_WAIT_L(0); PG8_BAR; PG8_MMA(1, 0, At, B0); PG8_MMA(1, 1, At, B1); PG8_BAR; PG8_SCHED;
            PG8_LDB(B0, 1, 0); PG8_LDB(B1, 1, 1); PG8_SCHED; PG8_LDA(At, 1, 0); PG8_STAGE(PG8_SA(0, 1), a2 + hstep, voffA);
            PG8_WAIT_V(8); PG8_WAIT_L(0); PG8_BAR; PG8_MMA(0, 0, At, B0); PG8_MMA(0, 1, At, B1); PG8_BAR; PG8_SCHED;
            PG8_LDA(At, 1, 1); PG8_STAGE(PG8_SB(1, 0), b3, voffB); PG8_STAGE(PG8_SB(1, 1), b3 + hstep, voffB); PG8_STAGE(PG8_SA(1, 0), a3, voffA);
            PG8_WAIT_V(8); PG8_WAIT_L(0); PG8_BAR; PG8_MMA(1, 0, At, B0); PG8_MMA(1, 1, At, B1); PG8_BAR; PG8_SCHED;
            } else {
            PG8_LDB(B0, 0, 0); PG8_SCHED; PG8_LDA(At, 0, 0); PG8_STAGE(PG8_SA(1, 1), a1 + hstep, voffA);
            PG8_WAIT_L(8); PG8_BAR; PG8_WAIT_L(0); PG8_MMA(0, 0, At, B0); PG8_BAR; PG8_SCHED;
            PG8_LDB(B1, 0, 1); PG8_STAGE(PG8_SB(0, 0), b2, voffB);
            PG8_BAR; PG8_WAIT_L(0); PG8_MMA(0, 1, At, B1); PG8_BAR;
            PG8_LDA(At, 0, 1); PG8_STAGE(PG8_SA(0, 0), a2, voffA);
            PG8_BAR; PG8_WAIT_L(0); PG8_MMA(1, 0, At, B0); PG8_BAR; PG8_SCHED;
            PG8_STAGE(PG8_SB(0, 1), b2 + hstep, voffB);
            PG8_WAIT_V(6); PG8_BAR; PG8_MMA(1, 1, At, B1); PG8_BAR;
            PG8_LDB(B0, 1, 0); PG8_SCHED; PG8_LDA(At, 1, 0); PG8_STAGE(PG8_SA(0, 1), a2 + hstep, voffA);
            PG8_WAIT_L(8); PG8_BAR; PG8_WAIT_L(0); PG8_MMA(0, 0, At, B0); PG8_BAR; PG8_SCHED;
            PG8_LDB(B1, 1, 1); PG8_STAGE(PG8_SB(1, 0), b3, voffB);
            PG8_BAR; PG8_WAIT_L(0); PG8_MMA(0, 1, At, B1); PG8_BAR;
            PG8_LDA(At, 1, 1); PG8_STAGE(PG8_SA(1, 0), a3, voffA);
            PG8_BAR; PG8_WAIT_L(0); PG8_MMA(1, 0, At, B0); PG8_BAR; PG8_SCHED;
            PG8_STAGE(PG8_SB(1, 1), b3 + hstep, voffB);
            PG8_WAIT_V(6); PG8_BAR; PG8_MMA(1, 1, At, B1); PG8_BAR;
            }
        }
        if constexpr (ALIGN_EPI) { if (wr == 0) PG8_BAR; }
        if constexpr (!Epi::AFTER_DRAIN) { E(acc, cur, wr, wc, fr, fq); S.done(cur); }
        if (!has_next) break;
#pragma unroll
        for (int a = 0; a < 2; ++a)
#pragma unroll
            for (int b = 0; b < 2; ++b)
#pragma unroll
                for (int m = 0; m < 4; ++m)
#pragma unroll
                    for (int n = 0; n < 2; ++n) acc[a][b][m][n] = (f32x4){0.f, 0.f, 0.f, 0.f};
        cur = nxt; cA = nA; cB = nB; ++ui;
        if constexpr (ALIGN_EPI) { if (wr == 1) PG8_BAR; }
    }
    PG8_WAIT_V(0);
    if constexpr (!ALIGN_EPI) { if (wr == 0) PG8_BAR; }
    PG8_BAR;
    if constexpr (Epi::AFTER_DRAIN) { E.fused(acc, cur, wr, wc, fr, fq, lds, wid, lane); S.done(cur); }
#undef PG8_SA
#undef PG8_SB
#undef PG8_STAGE
#undef PG8_LDA
#undef PG8_LDB
#undef PG8_MMA
#undef PG8_WAIT_V
#undef PG8_WAIT_L
#undef PG8_BAR
#undef PG8_SCHED
}
}
namespace attn {
using bf16 = __hip_bfloat16;
constexpr int   D = 128, NW = 8, QBLK = 32, KVBLK = 64;
constexpr float SCALE = 0.088388347648318440f;
constexpr float THR = 8.f;
constexpr int SDEPTH = 2;
constexpr int LDQ = 1024, LDK = 256, LDO = 2048;
constexpr size_t SHM_V = KVBLK * D * 2, SHM_K = KVBLK * D * 2, SHM_ATTN = 2 * SHM_V + 2 * SHM_K + NW * 64 * 4;
__device__ __forceinline__ unsigned short f2bf_rne(float f) { unsigned u = __builtin_bit_cast(unsigned, f); return (unsigned short)((u + 0x7fffu + ((u >> 16) & 1u)) >> 16); }
using bf16x8 = __attribute__((ext_vector_type(8))) short;
using s16x4  = __attribute__((ext_vector_type(4))) short;
using f32x16 = __attribute__((ext_vector_type(16))) float;
using f32x8  = __attribute__((ext_vector_type(8))) float;
using u32x4  = __attribute__((ext_vector_type(4))) unsigned;
#define KSWZ(row, colB) ((row) * 256 + ((colB) ^ (((row) & 7) << 4)))
#define SBAR() __builtin_amdgcn_sched_barrier(0)
__device__ __forceinline__ int crow(int r, int hi) { return (r & 3) + 8 * (r >> 2) + 4 * hi; }
__device__ __forceinline__ unsigned cvtpk(float lo, float hi) {
  unsigned r; asm volatile("v_cvt_pk_bf16_f32 %0, %1, %2" : "=v"(r) : "v"(lo), "v"(hi)); return r;
}
template <typename TIn> struct Stage;
template <> struct Stage<bf16>  { using T = bf16x8;
  __device__ static __forceinline__ T ld8(const bf16* p) { return *reinterpret_cast<const bf16x8*>(p); }
  __device__ static __forceinline__ bf16x8 tobf(T x) { return x; } };
template <> struct Stage<float> { using T = f32x8;
  __device__ static __forceinline__ T ld8(const float* p) { return *reinterpret_cast<const f32x8*>(p); }
  __device__ static __forceinline__ bf16x8 tobf(T x) {
    u32x4 w = {cvtpk(x[0], x[1]), cvtpk(x[2], x[3]), cvtpk(x[4], x[5]), cvtpk(x[6], x[7])}; return *reinterpret_cast<bf16x8*>(&w); } };

__device__ __forceinline__ void partialSM(f32x16& p0, f32x16& p1, float& m_reg, float& mn, float& alpha) {
  constexpr float C = SCALE * 1.4426950408889634f;
  float pmax = p0[0]; for (int r = 1; r < 16; ++r) pmax = fmaxf(pmax, p0[r]); for (int r = 0; r < 16; ++r) pmax = fmaxf(pmax, p1[r]);
  { auto rr = __builtin_amdgcn_permlane32_swap(__float_as_uint(pmax), __float_as_uint(pmax), false, false);
    pmax = fmaxf(__uint_as_float(rr[0]), __uint_as_float(rr[1])); }
  if (__builtin_expect(__all(pmax - m_reg <= THR / SCALE), 1)) { mn = m_reg; alpha = 1.f; }
  else { mn = fmaxf(m_reg, pmax); alpha = __builtin_amdgcn_exp2f((m_reg - mn) * C); m_reg = mn; }
  float mnC = -mn * C;
  for (int r = 0; r < 16; ++r) p0[r] = fmaf(p0[r], C, mnC); for (int r = 0; r < 16; ++r) p1[r] = fmaf(p1[r], C, mnC);
  for (int r = 0; r < 16; ++r) p0[r] = __builtin_amdgcn_exp2f(p0[r]);
}
__device__ __forceinline__ void finishSM(f32x16& p0, f32x16& p1, float alpha, float& l_reg, bf16x8& pa0, bf16x8& pa1, bf16x8& pa2, bf16x8& pa3) {
  for (int r = 0; r < 16; ++r) p1[r] = __builtin_amdgcn_exp2f(p1[r]);
  float ps = 0; for (int r = 0; r < 16; ++r) ps += p0[r]; for (int r = 0; r < 16; ++r) ps += p1[r];
  { auto rr = __builtin_amdgcn_permlane32_swap(__float_as_uint(ps), __float_as_uint(ps), false, false);
    ps = __uint_as_float(rr[0]) + __uint_as_float(rr[1]); }
  l_reg = l_reg * alpha + ps;
#define PK4(P, BASE, OUT) do { unsigned a0 = cvtpk(P[BASE + 0], P[BASE + 1]), a1 = cvtpk(P[BASE + 2], P[BASE + 3]);   \
    unsigned b0 = cvtpk(P[BASE + 4], P[BASE + 5]), b1 = cvtpk(P[BASE + 6], P[BASE + 7]);                              \
    auto r0 = __builtin_amdgcn_permlane32_swap(a0, b0, false, false); auto r1 = __builtin_amdgcn_permlane32_swap(a1, b1, false, false); \
    u32x4 w = {r0[0], r1[0], r0[1], r1[1]}; OUT = *reinterpret_cast<bf16x8*>(&w); } while (0)
  PK4(p0, 0, pa0); PK4(p0, 8, pa1); PK4(p1, 0, pa2); PK4(p1, 8, pa3);
#undef PK4
}
__device__ __forceinline__ void qkt(f32x16& p0, f32x16& p1, const bf16* Ks, const bf16x8* qr, int r32, int hi) {
  p0 = f32x16{}; p1 = f32x16{};
  for (int d0 = 0; d0 < 8; ++d0) { int cb = (d0 * 16 + hi * 8) * 2;
    bf16x8 b0 = *reinterpret_cast<const bf16x8*>((const char*)Ks + KSWZ(r32, cb));
    bf16x8 b1 = *reinterpret_cast<const bf16x8*>((const char*)Ks + KSWZ(32 + r32, cb));
    p0 = __builtin_amdgcn_mfma_f32_32x32x16_bf16(b0, qr[d0], p0, 0, 0, 0);
    p1 = __builtin_amdgcn_mfma_f32_32x32x16_bf16(b1, qr[d0], p1, 0, 0, 0); }
}
__device__ __forceinline__ int v_st(int k, int c) { const int kk = (k & ~0xC) | ((k & 4) << 1) | ((k & 8) >> 1); return ((kk >> 3) * 4 + (c >> 5)) * 512 + ((kk & 7) * 32 + (c & 31)) * 2; }
__device__ __forceinline__ int v_rd_base(int lane) { return ((lane & 3) << 3) | (((lane >> 2) & 3) << 6) | (((lane >> 4) & 1) << 5) | (((lane >> 5) & 1) << 8); }
constexpr int v_rd_off(int d0, int ks, int half) { return d0 * 512 + ks * 4096 + half * 2048; }
template <int OFF> __device__ __forceinline__ s16x4 tr_read(int vb) {
  s16x4 r; asm volatile("ds_read_b64_tr_b16 %0, %1 offset:%2" : "=&v"(r) : "v"(vb), "i"(OFF) : "memory"); return r;
}
template <int D0> __device__ __forceinline__ void pv_one(f32x16& od, int vb, bf16x8 pa0, bf16x8 pa1, bf16x8 pa2, bf16x8 pa3) {
  const s16x4 l0 = tr_read<v_rd_off(D0, 0, 0)>(vb), h0 = tr_read<v_rd_off(D0, 0, 1)>(vb), l1 = tr_read<v_rd_off(D0, 1, 0)>(vb), h1 = tr_read<v_rd_off(D0, 1, 1)>(vb);
  const s16x4 l2 = tr_read<v_rd_off(D0, 2, 0)>(vb), h2 = tr_read<v_rd_off(D0, 2, 1)>(vb), l3 = tr_read<v_rd_off(D0, 3, 0)>(vb), h3 = tr_read<v_rd_off(D0, 3, 1)>(vb);
  asm volatile("s_waitcnt lgkmcnt(0)" ::: "memory"); SBAR();
#define PK(L, H) (bf16x8){L[0], L[1], L[2], L[3], H[0], H[1], H[2], H[3]}
  od = __builtin_amdgcn_mfma_f32_32x32x16_bf16(pa0, PK(l0, h0), od, 0, 0, 0);
  od = __builtin_amdgcn_mfma_f32_32x32x16_bf16(pa1, PK(l1, h1), od, 0, 0, 0);
  od = __builtin_amdgcn_mfma_f32_32x32x16_bf16(pa2, PK(l2, h2), od, 0, 0, 0);
  od = __builtin_amdgcn_mfma_f32_32x32x16_bf16(pa3, PK(l3, h3), od, 0, 0, 0);
#undef PK
}
__device__ __forceinline__ void pv_d0(f32x16* o, int vb, bf16x8 pa0, bf16x8 pa1, bf16x8 pa2, bf16x8 pa3) {
  pv_one<0>(o[0], vb, pa0, pa1, pa2, pa3); pv_one<1>(o[1], vb, pa0, pa1, pa2, pa3); pv_one<2>(o[2], vb, pa0, pa1, pa2, pa3); pv_one<3>(o[3], vb, pa0, pa1, pa2, pa3);
}
template <typename TQ>
__device__ __forceinline__ void attn_dense_body(const TQ* __restrict__ Qb, const bf16* __restrict__ Kh, const bf16* __restrict__ Vh,
                                                unsigned short* __restrict__ Ob, int seq, char* lds) {
  using St = Stage<bf16>; using SQ = Stage<TQ>;
  const int tid = threadIdx.x, wid = tid >> 6, lane = tid & 63, r32 = lane & 31, hi = lane >> 5;
  bf16* V_lds = (bf16*)lds; bf16* K_lds = (bf16*)(lds + 2 * SHM_V);
  float* ws = (float*)(lds + 2 * SHM_V + 2 * SHM_K) + wid * 64; float* li_l = ws; float* al_l = ws + 32;
  float m_reg = -1e30f, l_reg = 0; f32x16 o[4] = {}; bf16x8 qr[8];
  const TQ* Qw = Qb + (long)(wid * QBLK + r32) * LDQ + hi * 8;
#pragma unroll
  for (int d0 = 0; d0 < 8; ++d0) qr[d0] = SQ::tobf(SQ::ld8(Qw + d0 * 16));
  const int sr = tid >> 4, sc = (tid & 15) * 8, vst0 = v_st(sr, sc), vst1 = v_st(32 + sr, sc);
  const int vb0 = (int)(uintptr_t)V_lds + v_rd_base(lane);
  struct { typename St::T vs0, vs1, ks0, ks1; } sr_[SDEPTH];
#define SLOAD(i, k0) do { sr_[i].vs0 = St::ld8(&Vh[(long)((k0) + sr) * LDK + sc]); sr_[i].vs1 = St::ld8(&Vh[(long)((k0) + 32 + sr) * LDK + sc]); \
    sr_[i].ks0 = St::ld8(&Kh[(long)((k0) + sr) * LDK + sc]); sr_[i].ks1 = St::ld8(&Kh[(long)((k0) + 32 + sr) * LDK + sc]); } while (0)
#define SWRITE(b, i) do { *(bf16x8*)((char*)V_lds + (b) * SHM_V + vst0) = St::tobf(sr_[i].vs0);          \
    *(bf16x8*)((char*)V_lds + (b) * SHM_V + vst1) = St::tobf(sr_[i].vs1); int kc = sc * 2;               \
    *(bf16x8*)((char*)K_lds + (b) * SHM_K + KSWZ(sr, kc)) = St::tobf(sr_[i].ks0);                       \
    *(bf16x8*)((char*)K_lds + (b) * SHM_K + KSWZ(32 + sr, kc)) = St::tobf(sr_[i].ks1); } while (0)
#define SWAIT() do { if constexpr (SDEPTH == 2) asm volatile("s_waitcnt vmcnt(4)" ::: "memory"); else asm volatile("s_waitcnt vmcnt(0)" ::: "memory"); } while (0)
#define RESC(a) do { if (__any((a) < 1.f)) { if (hi == 0) al_l[r32] = (a); asm volatile("s_waitcnt lgkmcnt(0)" ::: "memory"); \
    for (int d = 0; d < 4; ++d) for (int r = 0; r < 16; ++r) o[d][r] *= al_l[crow(r, hi)]; } } while (0)
  f32x16 pA0, pA1, pB0, pB1; float mnA, mnB, alA, alB; bf16x8 pa0, pa1, pa2, pa3; const int NT = seq / KVBLK;
  constexpr int SE = 0, SO = SDEPTH - 1;
  SLOAD(SE, 0); asm volatile("s_waitcnt vmcnt(0)" ::: "memory"); SWRITE(0, SE); __syncthreads();
  qkt(pA0, pA1, K_lds, qr, r32, hi); partialSM(pA0, pA1, m_reg, mnA, alA);
  SLOAD(SO, KVBLK); if constexpr (SDEPTH == 2) { if (2 < NT) SLOAD(SE, 2 * KVBLK); }
  SWAIT(); SWRITE(1, SO); __syncthreads();
  for (int j = 1; j + 1 < NT; j += 2) {
    SBAR(); qkt(pB0, pB1, (bf16*)((char*)K_lds + SHM_K), qr, r32, hi);
    finishSM(pA0, pA1, alA, l_reg, pa0, pa1, pa2, pa3); SBAR();
    SLOAD(SO, (j + SDEPTH) * KVBLK); SBAR();
    pv_d0(o, vb0, pa0, pa1, pa2, pa3); partialSM(pB0, pB1, m_reg, mnB, alB);
    __syncthreads(); SWAIT(); SWRITE(0, SE);
    RESC(alB); __syncthreads();
    SBAR(); qkt(pA0, pA1, K_lds, qr, r32, hi);
    finishSM(pB0, pB1, alB, l_reg, pa0, pa1, pa2, pa3); SBAR();
    if (SDEPTH == 1 || j + 3 < NT) SLOAD(SE, (j + 1 + SDEPTH) * KVBLK); SBAR();
    pv_d0(o, vb0 + (int)SHM_V, pa0, pa1, pa2, pa3); partialSM(pA0, pA1, m_reg, mnA, alA);
    __syncthreads(); SWAIT(); SWRITE(1, SO);
    RESC(alA); __syncthreads();
  }
  SBAR(); qkt(pB0, pB1, (bf16*)((char*)K_lds + SHM_K), qr, r32, hi);
  finishSM(pA0, pA1, alA, l_reg, pa0, pa1, pa2, pa3); SBAR();
  pv_d0(o, vb0, pa0, pa1, pa2, pa3); partialSM(pB0, pB1, m_reg, mnB, alB);
  __syncthreads(); RESC(alB);
  finishSM(pB0, pB1, alB, l_reg, pa0, pa1, pa2, pa3); SBAR();
  pv_d0(o, vb0 + (int)SHM_V, pa0, pa1, pa2, pa3);
  if (hi == 0) li_l[r32] = l_reg; asm volatile("s_waitcnt lgkmcnt(0)" ::: "memory");
  float rli[16];
#pragma unroll
  for (int r = 0; r < 16; ++r) rli[r] = __builtin_amdgcn_rcpf(li_l[crow(r, hi)]);
  unsigned short* Ow = Ob + (long)(wid * QBLK) * LDO;
#pragma unroll
  for (int r = 0; r < 16; ++r) { int orow = crow(r, hi);
    for (int d0 = 0; d0 < 4; ++d0) Ow[(long)orow * LDO + d0 * 32 + r32] = f2bf_rne(o[d0][r] * rli[r]); }
#undef SLOAD
#undef SWRITE
#undef SWAIT
#undef RESC
}
}
#ifndef PP_MASK
#define PP_MASK 31
#endif
#define GAS __attribute__((address_space(1)))
#define LAS __attribute__((address_space(3)))
typedef unsigned short bf16_t;
typedef float f32x4 __attribute__((ext_vector_type(4)));
typedef float f32x2 __attribute__((ext_vector_type(2)));
typedef unsigned u32x4 __attribute__((ext_vector_type(4)));
typedef unsigned u32x2 __attribute__((ext_vector_type(2)));
typedef __bf16 bf16x2_t __attribute__((ext_vector_type(2)));

constexpr int DM = 2048, MC = 4096, MS = 4096, MT = MC + MS, DEPTH = 2;
constexpr int DIN = 4768, DINP = 4864, DFF = 5632;
constexpr int O_K = 1024, O_V = 1280, O_CB = 1536, O_CC = 2048, O_CH = 2560, O_UR = 3072;
constexpr int KVROWS = 4096 + 4 * 1280;
constexpr float EPS = 1e-6f, GN_EPS = 64e-5f;
constexpr int NWAVES = 8, NTHREADS = 512;
enum { I_XP = 0, I_XS, I_CK, I_CV, I_ST, I_C, I_CCTX, I_WADA, I_BADA, I_NG, I_WIN, I_QN, I_KN, I_CONVW, I_MU, I_W0, I_WUP, I_A0, I_AUP, I_GUP, I_KK, I_KA, I_RK, I_LNG, I_LNB, I_WOUT, I_WGATE, I_WUPF, I_WDOWN, N_IN };
constexpr size_t OUT_Y = 0, OUT_NK = (size_t)MT * DM, OUT_NV = OUT_NK + 2097152, OUT_ST = OUT_NV + 2097152, OUT_TOTAL = OUT_ST + 2097152;
constexpr size_t MiB = 1u << 20;
constexpr size_t WS_CTL = 0, CTL_BYTES = 1 * MiB;
constexpr size_t WS_WIN = 1 * MiB, SZ_WIN = 19 * MiB;
constexpr size_t WS_WOUT = WS_WIN + 2 * SZ_WIN, SZ_WOUT = 8 * MiB;
constexpr size_t WS_WGU = WS_WOUT + 2 * SZ_WOUT, SZ_WGU = 44 * MiB;
constexpr size_t WS_WDN = WS_WGU + 2 * SZ_WGU, SZ_WDN = 22 * MiB;
constexpr size_t WS_MOD = WS_WDN + 2 * SZ_WDN;
constexpr size_t WS_HB = WS_MOD + 1 * MiB;
constexpr size_t WS_MIX = WS_HB + 32 * MiB;
constexpr size_t WS_XB = WS_MIX + 32 * MiB;
constexpr size_t WS_R1 = WS_XB + 64 * MiB;
constexpr size_t WS_PROJ = WS_R1;
constexpr size_t WS_QB = WS_R1 + 76 * MiB;
constexpr size_t WS_KB = WS_R1 + 92 * MiB;
constexpr size_t WS_VB = WS_R1 + 97 * MiB;
constexpr size_t WS_SCAN = WS_R1 + 102 * MiB;
constexpr size_t WS_GB = WS_R1 + 246 * MiB;
constexpr size_t WS_BON = WS_R1 + 262 * MiB;
constexpr size_t WS_YB = WS_R1 + 278 * MiB;
constexpr size_t WS_OB = WS_R1;
constexpr size_t WS_HID = WS_R1 + 64 * MiB;
constexpr size_t WS_END = WS_R1 + 310 * MiB;
constexpr int CW_QUEUE = 64;
constexpr int RING_BYTES = 131072, MISC_OFF = RING_BYTES + 320, LDS_BYTES = 147456;

__device__ __forceinline__ float bf2f(bf16_t h) { return __uint_as_float((unsigned)h << 16); }
__device__ __forceinline__ unsigned pk2(float lo, float hi) { f32x2 v = {lo, hi}; bf16x2_t b = __builtin_convertvector(v, bf16x2_t); return __builtin_bit_cast(unsigned, b); }
__device__ __forceinline__ bf16_t f2bf(float f) { return (bf16_t)(pk2(f, 0.f) & 0xffffu); }
__device__ __forceinline__ float wave_sum(float v) {
#pragma unroll
    for (int o = 1; o < 64; o <<= 1) v += __shfl_xor(v, o);
    return v;
}
template <int CTRL> __device__ __forceinline__ float dpp_add(float x) {
    const int y = __builtin_amdgcn_update_dpp(0, __float_as_int(x), CTRL, 0xf, 0xf, false);
    return x + __int_as_float(y);
}
__device__ __forceinline__ float row16_sum(float x) {
    x = dpp_add<0x128>(x); x = dpp_add<0x124>(x); x = dpp_add<0x122>(x); x = dpp_add<0x121>(x); return x;
}
__device__ __forceinline__ float sigmoidf_(float x) { return 1.0f / (1.0f + __expf(-x)); }

struct Args { const float* in[N_IN]; float* out; unsigned char* ws; int ph_lo, ph_hi; };
struct Frame {
    LAS unsigned char* lds; unsigned char* ldsg;
    const float* const* in; float* out; unsigned char* ws;
    int tid, lane, wave, G;
};
#define LDS_WAIT() asm volatile("s_waitcnt lgkmcnt(0)" ::: "memory")

__device__ __forceinline__ void p0_transpose_item(const float* W, int K, int N, bf16_t* WT, int kb, int nb, int rowbase, LAS float* scr, int lane) {
    const int k0 = 64 * kb, n0 = 32 * nb;
#pragma unroll 8
    for (int i = 0; i < 32; ++i) { const int kk = 2 * i + (lane >> 5); scr[kk * 33 + (lane & 31)] = W[(size_t)(k0 + kk) * N + n0 + (lane & 31)]; }
    LDS_WAIT(); asm volatile("" ::: "memory");
    const int c = lane & 7;
#pragma unroll
    for (int j = 0; j < 4; ++j) { const int n = (lane >> 3) + 8 * j; const LAS float* s = scr + (8 * c) * 33 + n;
        u32x4 o; o.x = pk2(s[0 * 33], s[1 * 33]); o.y = pk2(s[2 * 33], s[3 * 33]); o.z = pk2(s[4 * 33], s[5 * 33]); o.w = pk2(s[6 * 33], s[7 * 33]);
        *(u32x4*)(WT + (size_t)(rowbase + n) * K + k0 + 8 * c) = o; }
    LDS_WAIT(); asm volatile("" ::: "memory");
}
__device__ __forceinline__ void p0_prologue(Frame& F) {
    {
        LAS float* sc = (LAS float*)F.lds;
        LAS float* red = sc + 5 * 2048;
        for (int i = F.tid; i < 5 * 2048; i += NTHREADS) { const int v = i >> 11, k = i & 2047; const float x = v == 0 ? F.in[I_CCTX][k] : F.in[I_C][(v - 1) * 2048 + k]; sc[i] = x * sigmoidf_(x); }
        __syncthreads();
        for (int it = blockIdx.x; it < 2 * 192; it += F.G) {
            const int l = it / 192, cg_ = it % 192, col = cg_ * 64 + F.lane;
            const float* W = F.in[I_WADA] + (size_t)l * 2048 * 12288 + col;
            float acc[5] = {0.f, 0.f, 0.f, 0.f, 0.f};
            const int kbeg = F.wave * 256;
#pragma unroll 2
            for (int k = kbeg; k < kbeg + 256; k += 4) {
                const float w0 = W[(size_t)(k + 0) * 12288], w1 = W[(size_t)(k + 1) * 12288], w2 = W[(size_t)(k + 2) * 12288], w3 = W[(size_t)(k + 3) * 12288];
#pragma unroll
                for (int v = 0; v < 5; ++v) { const f32x4 s = *(const LAS f32x4*)(sc + v * 2048 + k); acc[v] += s.x * w0 + s.y * w1 + s.z * w2 + s.w * w3; }
            }
#pragma unroll
            for (int v = 0; v < 5; ++v) red[(F.wave * 5 + v) * 64 + F.lane] = acc[v];
            __syncthreads();
            if (F.tid < 320) { const int v = F.tid >> 6, c = F.tid & 63; float s = 0.f;
#pragma unroll
                for (int w = 0; w < 8; ++w) s += red[(w * 5 + v) * 64 + c];
                const int cc = cg_ * 64 + c;
                ((float*)(F.ws + WS_MOD))[(size_t)(l * 5 + v) * 12288 + cc] = s + F.in[I_BADA][l * 12288 + cc]; }
            __syncthreads();
        }
    }
    __syncthreads();
    {
        const int gt = blockIdx.x * NTHREADS + F.tid, GT = F.G * NTHREADS;
        for (int i = gt; i < 2 * 24576; i += GT) { const int l = i / 24576, r = i % 24576;
            *(u32x4*)(F.ws + WS_WIN + (size_t)l * SZ_WIN + (size_t)4768 * 2048 * 2 + (size_t)r * 16) = (u32x4){0u, 0u, 0u, 0u}; }
    }
    {
        LAS float* scr = (LAS float*)(F.lds + F.wave * 16384);
        const int gw = blockIdx.x * NWAVES + F.wave, NGW = F.G * NWAVES;
        constexpr int I_IN = 32 * 149, I_OUT = 32 * 64, I_G = 32 * 176, I_DN = 88 * 64, PER_L = I_IN + I_OUT + 2 * I_G + I_DN;
        for (int it = gw; it < 2 * PER_L; it += NGW) {
            const int l = it / PER_L; int r = it % PER_L;
            if (r < I_IN) { const int kb = r / 149, nb = r % 149;
                p0_transpose_item(F.in[I_WIN] + (size_t)l * 2048 * DIN, 2048, DIN, (bf16_t*)(F.ws + WS_WIN + l * SZ_WIN), kb, nb, 32 * nb, scr, F.lane); continue; }
            r -= I_IN;
            if (r < I_OUT) { const int kb = r / 64, nb = r % 64;
                p0_transpose_item(F.in[I_WOUT] + (size_t)l * 2048 * 2048, 2048, 2048, (bf16_t*)(F.ws + WS_WOUT + l * SZ_WOUT), kb, nb, 32 * nb, scr, F.lane); continue; }
            r -= I_OUT;
            if (r < 2 * I_G) { const int up = r >= I_G; if (up) r -= I_G; const int kb = r / 176, nb = r % 176, n0 = 32 * nb;
                p0_transpose_item(F.in[up ? I_WUPF : I_WGATE] + (size_t)l * 2048 * DFF, 2048, DFF, (bf16_t*)(F.ws + WS_WGU + l * SZ_WGU), kb, nb, (n0 >> 7) * 256 + (up ? 128 : 0) + (n0 & 127), scr, F.lane); continue; }
            r -= 2 * I_G;
            { const int kb = r / 64, nb = r % 64;
                p0_transpose_item(F.in[I_WDOWN] + (size_t)l * DFF * 2048, DFF, 2048, (bf16_t*)(F.ws + WS_WDN + l * SZ_WDN), kb, nb, 32 * nb, scr, F.lane); }
        }
    }
}

__device__ __forceinline__ const float* mod_vec(const Frame& F, int l, int m, int which) {
    const int v = m < MC ? 0 : 1 + ((m - MC) >> 10);
    return (const float*)(F.ws + WS_MOD) + (size_t)(l * 5 + v) * 12288 + which * 2048;
}
__device__ __forceinline__ const float* x_in_row(const Frame& F, int m) { return m < MC ? F.in[I_XP] + (size_t)m * DM : F.in[I_XS] + (size_t)(m - MC) * DM; }
__device__ __forceinline__ float row_ss(const f32x4 (&v)[8]) {
    float s = 0.f;
#pragma unroll
    for (int j = 0; j < 8; ++j) s += (v[j].x * v[j].x + v[j].y * v[j].y) + (v[j].z * v[j].z + v[j].w * v[j].w);
    return wave_sum(s);
}
__device__ __forceinline__ void write_h(const Frame& F, const f32x4 (&x)[8], float rs, const float* ng, const float* sc, const float* sh, bf16_t* hrow) {
#pragma unroll
    for (int j = 0; j < 8; ++j) { const int o = F.lane + 64 * j;
        const f32x4 g = ((const f32x4*)ng)[o], s = ((const f32x4*)sc)[o], b = ((const f32x4*)sh)[o];
        const f32x4 h = x[j] * rs * g * (1.0f + s) + b;
        u32x2 w; w.x = pk2(h.x, h.y); w.y = pk2(h.z, h.w); ((u32x2*)hrow)[o] = w; }
}
__device__ __forceinline__ void rowpass0(Frame& F) {
    const int gw = blockIdx.x * NWAVES + F.wave, NGW = F.G * NWAVES;
    for (int m = gw; m < MT; m += NGW) {
        const f32x4* xr = (const f32x4*)x_in_row(F, m); f32x4 x[8];
#pragma unroll
        for (int j = 0; j < 8; ++j) x[j] = xr[F.lane + 64 * j];
        const float rs = rsqrtf(row_ss(x) * (1.0f / DM) + EPS);
        write_h(F, x, rs, F.in[I_NG] + 0, mod_vec(F, 0, m, 1), mod_vec(F, 0, m, 0), (bf16_t*)(F.ws + WS_HB) + (size_t)m * DM);
    }
}
__device__ __forceinline__ void rowpassA(Frame& F, int l) {
    const int gw = blockIdx.x * NWAVES + F.wave, NGW = F.G * NWAVES;
    const float* ng = F.in[I_NG] + (size_t)l * 4 * DM;
    for (int m = gw; m < MT; m += NGW) {
        const f32x4* orow = (const f32x4*)(F.ws + WS_OB) + (size_t)m * (DM / 4);
        const f32x4* xr = l == 0 ? (const f32x4*)x_in_row(F, m) : (const f32x4*)(F.ws + WS_XB) + (size_t)m * (DM / 4);
        f32x4 o[8], x[8];
#pragma unroll
        for (int j = 0; j < 8; ++j) { o[j] = orow[F.lane + 64 * j]; x[j] = xr[F.lane + 64 * j]; }
        const float r1 = rsqrtf(row_ss(o) * (1.0f / DM) + EPS);
        const float* ga = mod_vec(F, l, m, 2);
        f32x4* xo = (f32x4*)(F.ws + WS_XB) + (size_t)m * (DM / 4);
#pragma unroll
        for (int j = 0; j < 8; ++j) { const int q = F.lane + 64 * j; x[j] = x[j] + ((const f32x4*)ga)[q] * (o[j] * r1 * ((const f32x4*)(ng + DM))[q]); xo[q] = x[j]; }
        const float r2 = rsqrtf(row_ss(x) * (1.0f / DM) + EPS);
        write_h(F, x, r2, ng + 2 * DM, mod_vec(F, l, m, 4), mod_vec(F, l, m, 3), (bf16_t*)(F.ws + WS_HB) + (size_t)m * DM);
    }
}
__device__ __forceinline__ void rowpassB(Frame& F, int l) {
    const int gw = blockIdx.x * NWAVES + F.wave, NGW = F.G * NWAVES;
    const float* ng = F.in[I_NG] + (size_t)l * 4 * DM;
    for (int m = gw; m < MT; m += NGW) {
        const f32x4* orow = (const f32x4*)(F.ws + WS_OB) + (size_t)m * (DM / 4);
        const f32x4* xr = (const f32x4*)(F.ws + WS_XB) + (size_t)m * (DM / 4);
        f32x4 o[8], x[8];
#pragma unroll
        for (int j = 0; j < 8; ++j) { o[j] = orow[F.lane + 64 * j]; x[j] = xr[F.lane + 64 * j]; }
        const float r1 = rsqrtf(row_ss(o) * (1.0f / DM) + EPS);
        const float* gf = mod_vec(F, l, m, 5);
        f32x4* xo = (l == DEPTH - 1) ? (f32x4*)(F.out + OUT_Y) + (size_t)m * (DM / 4) : (f32x4*)(F.ws + WS_XB) + (size_t)m * (DM / 4);
#pragma unroll
        for (int j = 0; j < 8; ++j) { const int q = F.lane + 64 * j; x[j] = x[j] + ((const f32x4*)gf)[q] * (o[j] * r1 * ((const f32x4*)(ng + 3 * DM))[q]); xo[q] = x[j]; }
        if (l < DEPTH - 1) {
            const float r2 = rsqrtf(row_ss(x) * (1.0f / DM) + EPS);
            write_h(F, x, r2, ng + 4 * DM, mod_vec(F, l + 1, m, 1), mod_vec(F, l + 1, m, 0), (bf16_t*)(F.ws + WS_HB) + (size_t)m * DM);
        }
    }
}

__device__ __forceinline__ void p2_prepass(Frame& F, int l) {
    const bf16_t* PROJ = (const bf16_t*)(F.ws + WS_PROJ);
    bf16_t* QB = (bf16_t*)(F.ws + WS_QB); bf16_t* KB = (bf16_t*)(F.ws + WS_KB); bf16_t* VB = (bf16_t*)(F.ws + WS_VB); bf16_t* MIX = (bf16_t*)(F.ws + WS_MIX);
    float* SCAN = (float*)(F.ws + WS_SCAN); float* GB = (float*)(F.ws + WS_GB); float* BON = (float*)(F.ws + WS_BON);
    for (int pi = blockIdx.x * NTHREADS + F.tid; pi < 131072; pi += F.G * NTHREADS) {
        const int e = 2 * pi, b = e >> 16, rem = e & 65535, p = rem >> 8, col = rem & 255;
        const size_t src = ((size_t)(b * 2 + l) * 256 + p) * 256 + col, dst = (size_t)(MC + b * 1280 + 1024 + p) * 256 + col;
        const f32x2 kv = *(const f32x2*)(F.in[I_CK] + src), vv = *(const f32x2*)(F.in[I_CV] + src);
        *(unsigned*)(KB + dst) = pk2(kv.x, kv.y); *(unsigned*)(VB + dst) = pk2(vv.x, vv.y);
    }
    for (int item = blockIdx.x; item < MT / 32; item += F.G) {
        asm volatile("" ::: "memory");
        int tid = F.tid; asm volatile("" : "+v"(tid)); const int lane = tid & 63;
        const int m0 = item * 32; const bool smp = m0 >= MC;
        const int sb = smp ? (m0 - MC) >> 10 : m0 >> 8, t0 = smp ? (m0 - MC) & 1023 : m0 & 255, seqlen = smp ? 1024 : 256;
#if PP_MASK & 1
        for (int wi = F.wave; wi < 32 * 12; wi += NWAVES) {
            const int tok = wi / 12, j = wi % 12, m = m0 + tok, t = t0 + tok;
            const bf16_t* prow = PROJ + (size_t)m * DINP;
            const size_t krow = smp ? (size_t)(MC + sb * 1280 + t) : (size_t)m;
            if (j < 10) {
                const int col0 = j < 8 ? j * 128 : O_K + (j - 8) * 128;
                const float* g = (j < 8 ? F.in[I_QN] : F.in[I_KN]) + l * 128;
                const int e1 = lane < 32 ? lane : lane + 32, e2 = e1 + 32;
                const float x1 = bf2f(prow[col0 + e1]), x2 = bf2f(prow[col0 + e2]);
                const float rs = rsqrtf(wave_sum(x1 * x1 + x2 * x2) * (1.0f / 128.0f) + EPS);
                float y1 = x1 * rs * g[e1], y2 = x2 * rs * g[e2];
                if (!smp && j >= 8) { float* nk = F.out + OUT_NK + ((size_t)(sb * 2 + l) * 256 + t) * 256 + (j - 8) * 128; nk[e1] = y1; nk[e2] = y2; }
                if (smp) {
                    const float pos = (float)(lane < 32 ? (t >> 6) : (t & 63));
                    const float inv = exp2f(-(float)(2 * (lane & 31)) * (13.287712379549449f / 64.0f));
                    const float ang = pos * inv; float rev = ang * 0.15915494309189535f; rev = rev - floorf(rev);
                    const float s = __builtin_amdgcn_sinf(rev), c = __builtin_amdgcn_cosf(rev);
                    const float o1 = y1 * c - y2 * s, o2 = y2 * c + y1 * s; y1 = o1; y2 = o2;
                }
                bf16_t* dst = j < 8 ? QB + (size_t)m * 1024 + j * 128 : KB + krow * 256 + (j - 8) * 128;
                dst[e1] = f2bf(y1); dst[e2] = f2bf(y2);
            } else {
                const int kvh = j - 10; const unsigned u = *(const unsigned*)(prow + O_V + kvh * 128 + 2 * lane);
                *(unsigned*)(VB + krow * 256 + kvh * 128 + 2 * lane) = u;
                if (!smp) { float* nv = F.out + OUT_NV + ((size_t)(sb * 2 + l) * 256 + t) * 256 + kvh * 128 + 2 * lane; nv[0] = __uint_as_float(u << 16); nv[1] = __uint_as_float(u & 0xffff0000u); }
            }
        }
#endif
#if PP_MASK & 2
        {
            const int c = tid; const float* cw = F.in[I_CONVW] + (size_t)l * 3 * 512;
            const float w0 = cw[c], w1 = cw[512 + c], w2 = cw[1024 + c];
            const bf16_t* pr = PROJ + (size_t)m0 * DINP;
            float prev = t0 > 0 ? bf2f(pr[-DINP + O_CC + c]) * bf2f(pr[-DINP + O_CH + c]) : 0.f;
            float cur = bf2f(pr[O_CC + c]) * bf2f(pr[O_CH + c]);
#pragma unroll 1
            for (int tok = 0; tok < 32; ++tok) {
                const bf16_t* p = pr + (size_t)tok * DINP;
                const float nxt = (t0 + tok + 1 < seqlen) ? bf2f(p[DINP + O_CC + c]) * bf2f(p[DINP + O_CH + c]) : 0.f;
                const float o = bf2f(p[O_CB + c]) * (w0 * prev + w1 * cur + w2 * nxt);
                MIX[(size_t)(m0 + tok) * DM + 1024 + c] = f2bf(o);
                prev = cur; cur = nxt;
            }
        }
#endif
        LAS float* sm = (LAS float*)F.lds;
        const float* mu = F.in[I_MU] + (size_t)l * 1696;
        __syncthreads();
        for (int idx = tid; idx < 32 * 160; idx += NTHREADS) {
            const int tok = idx / 160, k = idx % 160, col = 1536 + k, t = t0 + tok;
            const bf16_t* p = PROJ + (size_t)(m0 + tok) * DINP + O_UR + col;
            const float u = bf2f(p[0]), up = t > 0 ? bf2f(p[-DINP]) : 0.f, un = t + 1 < seqlen ? bf2f(p[DINP]) : 0.f;
            const float us = u + mu[col] * (0.5f * (up + un) - u);
            sm[idx] = k < 32 ? tanhf(us) : (k < 64 ? us : sigmoidf_(us));
        }
        __syncthreads();
        const int c = tid, h = F.wave, i = lane;
#if PP_MASK & 4
        {
            asm volatile("" ::: "memory");
            float wa0[32], wa1[32];
            const float* au = F.in[I_AUP] + (size_t)l * 2 * 32 * 512 + c;
#pragma unroll
            for (int k = 0; k < 32; ++k) { wa0[k] = au[0]; wa1[k] = au[32 * 512]; au += 512; asm volatile("" : "+v"(au)); }
            const float a0b0 = F.in[I_A0][(l * 2 + 0) * 512 + c], a0b1 = F.in[I_A0][(l * 2 + 1) * 512 + c];
            const float kkc = F.in[I_KK][l * 512 + c], kac = F.in[I_KA][l * 512 + c], rkc = F.in[I_RK][l * 512 + c];
            const float mur = mu[c], muk = mu[512 + c], muv = mu[1024 + c];
            const bf16_t* pr = PROJ + (size_t)m0 * DINP + O_UR + c;
            float pr_r = 0.f, pr_k = 0.f, pr_v = 0.f;
            if (t0 > 0) { pr_r = bf2f(pr[-DINP]); pr_k = bf2f(pr[-DINP + 512]); pr_v = bf2f(pr[-DINP + 1024]); }
            float cu_r = bf2f(pr[0]), cu_k = bf2f(pr[512]), cu_v = bf2f(pr[1024]);
#pragma unroll 1
            for (int tok = 0; tok < 32; ++tok) {
                const bf16_t* p = pr + (size_t)tok * DINP; const int m = m0 + tok;
                float nx_r = 0.f, nx_k = 0.f, nx_v = 0.f;
                if (t0 + tok + 1 < seqlen) { nx_r = bf2f(p[DINP]); nx_k = bf2f(p[DINP + 512]); nx_v = bf2f(p[DINP + 1024]); }
                const float r = cu_r + mur * (0.5f * (pr_r + nx_r) - cu_r), k = cu_k + muk * (0.5f * (pr_k + nx_k) - cu_k), v = cu_v + muv * (0.5f * (pr_v + nx_v) - cu_v);
                pr_r = cu_r; pr_k = cu_k; pr_v = cu_v; cu_r = nx_r; cu_k = nx_k; cu_v = nx_v;
                const float kkr = k * kkc; const float kk = kkr * rsqrtf(wave_sum(kkr * kkr) + 1e-12f);
                float za0 = a0b0, za1 = a0b1; const LAS float* xa = sm + tok * 160 + 32;
#pragma unroll
                for (int q = 0; q < 8; ++q) { const f32x4 s = *(const LAS f32x4*)(xa + 4 * q);
                    za0 += s.x * wa0[4 * q] + s.y * wa0[4 * q + 1] + s.z * wa0[4 * q + 2] + s.w * wa0[4 * q + 3];
                    za1 += s.x * wa1[4 * q] + s.y * wa1[4 * q + 1] + s.z * wa1[4 * q + 2] + s.w * wa1[4 * q + 3]; }
                const float a0 = sigmoidf_(za0), a1 = sigmoidf_(za1);
                const float kd0 = k * (1.0f + (a0 - 1.0f) * kac), kd1 = k * (1.0f + (a1 - 1.0f) * kac);
                const float bs = wave_sum(r * (kd0 + kd1) * rkc);
                float* base = SCAN + ((size_t)m * 8 + h) * 576 + i;
                base[0] = r; base[64] = v; base[128] = kk; base[256] = kd0; base[320] = kk * a0; base[448] = kd1; base[512] = kk * a1;
                BON[(size_t)m * 512 + c] = bs * v;
            }
        }
#endif
#if PP_MASK & 8
        {
            asm volatile("" ::: "memory");
            float ww0[32], ww1[32];
            const float* wu = F.in[I_WUP] + (size_t)l * 2 * 32 * 512 + c;
#pragma unroll
            for (int k = 0; k < 32; ++k) { ww0[k] = wu[0]; ww1[k] = wu[32 * 512]; wu += 512; asm volatile("" : "+v"(wu)); }
            const float b0 = F.in[I_W0][(l * 2 + 0) * 512 + c], b1 = F.in[I_W0][(l * 2 + 1) * 512 + c];
#pragma unroll 1
            for (int tok = 0; tok < 32; ++tok) {
                float z0 = b0, z1 = b1; const LAS float* xw = sm + tok * 160;
#pragma unroll
                for (int q = 0; q < 8; ++q) { const f32x4 s = *(const LAS f32x4*)(xw + 4 * q);
                    z0 += s.x * ww0[4 * q] + s.y * ww0[4 * q + 1] + s.z * ww0[4 * q + 2] + s.w * ww0[4 * q + 3];
                    z1 += s.x * ww1[4 * q] + s.y * ww1[4 * q + 1] + s.z * ww1[4 * q + 2] + s.w * ww1[4 * q + 3]; }
                const float sp0 = fmaxf(-z0, 0.f) + log1pf(__expf(-fabsf(z0))), sp1 = fmaxf(-z1, 0.f) + log1pf(__expf(-fabsf(z1)));
                float* base = SCAN + ((size_t)(m0 + tok) * 8 + h) * 576 + i;
                base[192] = __expf(-__expf(-sp0 - 0.5f)); base[384] = __expf(-__expf(-sp1 - 0.5f));
            }
        }
#endif
#if PP_MASK & 16
        {
            asm volatile("" ::: "memory");
            float wg[96];
            const float* gu = F.in[I_GUP] + (size_t)l * 96 * 512 + c;
#pragma unroll
            for (int k = 0; k < 96; ++k) { wg[k] = gu[0]; gu += 512; asm volatile("" : "+v"(gu)); }
#pragma unroll 1
            for (int tok = 0; tok < 32; ++tok) {
                float g = 0.f; const LAS float* xg = sm + tok * 160 + 64;
#pragma unroll
                for (int q = 0; q < 24; ++q) { const f32x4 s = *(const LAS f32x4*)(xg + 4 * q); g += s.x * wg[4 * q] + s.y * wg[4 * q + 1] + s.z * wg[4 * q + 2] + s.w * wg[4 * q + 3]; }
                GB[(size_t)(m0 + tok) * 512 + c] = g;
            }
        }
#endif
        __syncthreads();
    }
}

__device__ __forceinline__ void scan_item(Frame& F, int l, bool smp, int b, int h, int d) {
    int tid = F.tid; asm volatile("" : "+v"(tid));
    const int seqlen = smp ? 1024 : 256, seq_base = smp ? MC + b * 1024 : b * 256, nch = seqlen / 16;
    const int p = tid >> 4, c = tid & 15, i0 = p, i1 = p + 32;
    f32x4 s0 = {0.f, 0.f, 0.f, 0.f}, s1 = {0.f, 0.f, 0.f, 0.f};
    if (smp) { const float* S0 = F.in[I_ST] + ((((size_t)b * 2 + l) * 2 + d) * 8 + h) * 4096; s0 = *(const f32x4*)(S0 + i0 * 64 + 4 * c); s1 = *(const f32x4*)(S0 + i1 * 64 + 4 * c); }
    LAS float* opb = (LAS float*)F.lds;
    LAS float* yb = opb + 2 * 6144;
    const float* SCAN = (const float*)(F.ws + WS_SCAN); float* YB = (float*)(F.ws + WS_YB) + (size_t)d * MT * 512;
    int sst[3], soff[3];
#pragma unroll
    for (int j = 0; j < 3; ++j) { const int e4 = tid + 512 * j, s = e4 / 96, rem = e4 % 96, vec = rem >> 4, q4 = rem & 15; sst[j] = s; soff[j] = (vec < 3 ? vec : 3 + 3 * d + (vec - 3)) * 64 + 4 * q4; }
    f32x4 stg[3];
#define SCAN_TOK(ci, s) (d ? seqlen - 1 - ((ci) * 16 + (s)) : (ci) * 16 + (s))
#define SCAN_LOAD(ci) do { _Pragma("unroll") for (int j = 0; j < 3; ++j) stg[j] = *(const f32x4*)(SCAN + ((size_t)(seq_base + SCAN_TOK(ci, sst[j])) * 8 + h) * 576 + soff[j]); } while (0)
#define SCAN_STORE(buf) do { _Pragma("unroll") for (int j = 0; j < 3; ++j) *(LAS f32x4*)(opb + (buf) * 6144 + (tid + 512 * j) * 4) = stg[j]; } while (0)
    __syncthreads();
    SCAN_LOAD(0); SCAN_STORE(0);
    __syncthreads();
    for (int ci = 0; ci < nch; ++ci) {
        if (ci + 1 < nch) SCAN_LOAD(ci + 1);
        const LAS float* ob = opb + (ci & 1) * 6144;
#pragma unroll 4
        for (int s = 0; s < 16; ++s) {
            const LAS float* o = ob + s * 384;
            const f32x4 r4 = *(const LAS f32x4*)(o + 4 * c), kk4 = *(const LAS f32x4*)(o + 128 + 4 * c), w4 = *(const LAS f32x4*)(o + 192 + 4 * c);
            const f32x4 kd4 = *(const LAS f32x4*)(o + 256 + 4 * c), ka4 = *(const LAS f32x4*)(o + 320 + 4 * c);
            const float v0 = o[64 + i0], v1 = o[64 + i1];
            float d0 = (s0.x * kk4.x + s0.y * kk4.y) + (s0.z * kk4.z + s0.w * kk4.w), d1 = (s1.x * kk4.x + s1.y * kk4.y) + (s1.z * kk4.z + s1.w * kk4.w);
            d0 = row16_sum(d0); d1 = row16_sum(d1);
            s0 = s0 * w4 + (ka4 * (-d0) + kd4 * v0);
            s1 = s1 * w4 + (ka4 * (-d1) + kd4 * v1);
            float y0 = (s0.x * r4.x + s0.y * r4.y) + (s0.z * r4.z + s0.w * r4.w), y1 = (s1.x * r4.x + s1.y * r4.y) + (s1.z * r4.z + s1.w * r4.w);
            y0 = row16_sum(y0); y1 = row16_sum(y1);
            if (c == 0) { yb[s * 64 + i0] = y0; yb[s * 64 + i1] = y1; }
        }
        __syncthreads();
        if (tid < 256) { const int s = tid >> 4, i4 = tid & 15; const f32x4 v = *(const LAS f32x4*)(yb + s * 64 + 4 * i4);
            *(f32x4*)(YB + (size_t)(seq_base + SCAN_TOK(ci, s)) * 512 + h * 64 + 4 * i4) = v; }
        if (ci + 1 < nch) SCAN_STORE((ci + 1) & 1);
        __syncthreads();
    }
    if (!smp) { float* O = F.out + OUT_ST + ((((size_t)b * 2 + l) * 2 + d) * 8 + h) * 4096; *(f32x4*)(O + i0 * 64 + 4 * c) = s0; *(f32x4*)(O + i1 * 64 + 4 * c) = s1; }
#undef SCAN_TOK
#undef SCAN_LOAD
#undef SCAN_STORE
}

__device__ __forceinline__ void mixer_phase(Frame& F, int l) {
    unsigned* head = (unsigned*)(F.ws + WS_CTL) + CW_QUEUE + 64 * l;
    volatile LAS unsigned* slot = (volatile LAS unsigned*)(F.lds + MISC_OFF);
    const bf16_t* QB = (const bf16_t*)(F.ws + WS_QB); const bf16_t* KB = (const bf16_t*)(F.ws + WS_KB); const bf16_t* VB = (const bf16_t*)(F.ws + WS_VB); bf16_t* MIX = (bf16_t*)(F.ws + WS_MIX);
    for (;;) {
        __syncthreads();
        if (F.tid == 0) slot[0] = atomicAdd(head, 1u);
        __syncthreads();
        const int item = (int)slot[0];
        if (item >= 576) break;
        const bool is_scan = item < 64 || (item >= 192 && item < 448);
        if (is_scan) { const bool smp = item < 64; const int u = smp ? item : item - 192; scan_item(F, l, smp, u >> 4, (u >> 1) & 7, u & 1); }
        else {
            size_t row0, kr0; int hq, seq;
            if (item < 192) { const int u = item - 64, b = u >> 5, qb = u & 3; hq = (u >> 2) & 7; row0 = (size_t)MC + b * 1024 + qb * 256; kr0 = (size_t)MC + b * 1280; seq = 1280; }
            else { const int u = item - 448, b = u >> 3; hq = u & 7; row0 = (size_t)b * 256; kr0 = row0; seq = 256; }
            attn::attn_dense_body<attn::bf16>((const attn::bf16*)(QB + row0 * 1024 + hq * 128), (const attn::bf16*)(KB + kr0 * 256 + (hq >> 2) * 128), (const attn::bf16*)(VB + kr0 * 256 + (hq >> 2) * 128), MIX + row0 * DM + hq * 128, seq, (char*)F.ldsg);
        }
    }
}
__device__ __forceinline__ void rwkv_combine(Frame& F, int l) {
    const float* Y0 = (const float*)(F.ws + WS_YB); const float* Y1 = Y0 + (size_t)MT * 512;
    const float* GB = (const float*)(F.ws + WS_GB); const float* BON = (const float*)(F.ws + WS_BON); bf16_t* MIX = (bf16_t*)(F.ws + WS_MIX);
    const int c = F.tid; const float lg = F.in[I_LNG][l * 512 + c], lb = F.in[I_LNB][l * 512 + c];
    for (int item = blockIdx.x; item < MT / 32; item += F.G)
        for (int tok = 0; tok < 32; ++tok) { const size_t m = (size_t)item * 32 + tok;
            const float y = Y0[m * 512 + c] + Y1[m * 512 + c];
            const float mean = wave_sum(y) * (1.0f / 64.0f), dl = y - mean, var = wave_sum(dl * dl) * (1.0f / 64.0f);
            const float yn = dl * rsqrtf(var + GN_EPS) * lg + lb;
            MIX[m * DM + 1536 + c] = f2bf((yn + BON[m * 512 + c]) * GB[m * 512 + c]); }
}

constexpr int NPHASE = 2 + 9 * DEPTH;
#ifndef PH_MASK
#define PH_MASK 0xffff
#endif
#if ONE_LAUNCH
#define GRID_BAR() cg::this_grid().sync()
#else
#define GRID_BAR() do {} while (0)
#endif
#define IN(k) (lo <= (k) && (k) < hi)
#define SEAM(k) do { if (IN(k) && IN((k) + 1)) GRID_BAR(); } while (0)
template <int L> __device__ __forceinline__ void layer_phases(Frame& F, const int lo, const int hi) {
    constexpr int l = L, pb = 2 + 9 * L;
    if (IN(pb + 0) && (PH_MASK & 4)) {
        pg8::Gemm g{(const bf16_t*)(F.ws + WS_HB), (const bf16_t*)(F.ws + WS_WIN + l * SZ_WIN), MT, DINP, DM}; pg8::StaticOrder S; S.init(MT, DINP, F.G, (int)blockIdx.x);
        pg8::EpiBf16 E{(bf16_t*)(F.ws + WS_PROJ), DINP};
        pg8::gemm_phase<pg8::EpiBf16, pg8::StaticOrder, true, true>(F.lds, g, S, E);
    } SEAM(pb + 0);
    if (IN(pb + 1) && (PH_MASK & 8)) { p2_prepass(F, l); } SEAM(pb + 1);
    if (IN(pb + 2) && (PH_MASK & 16)) { mixer_phase(F, l); } SEAM(pb + 2);
    if (IN(pb + 3) && (PH_MASK & 32)) { rwkv_combine(F, l); } SEAM(pb + 3);
    if (IN(pb + 4) && (PH_MASK & 64)) {
        pg8::Gemm g{(const bf16_t*)(F.ws + WS_MIX), (const bf16_t*)(F.ws + WS_WOUT + l * SZ_WOUT), MT, DM, DM}; pg8::StaticOrder S; S.init(MT, DM, F.G, (int)blockIdx.x);
        pg8::EpiF32 E{(float*)(F.ws + WS_OB), DM};
        pg8::gemm_phase<pg8::EpiF32, pg8::StaticOrder, true, true>(F.lds, g, S, E);
    } SEAM(pb + 4);
    if (IN(pb + 5) && (PH_MASK & 128)) { rowpassA(F, l); } SEAM(pb + 5);
    if (IN(pb + 6) && (PH_MASK & 256)) {
        pg8::Gemm g{(const bf16_t*)(F.ws + WS_HB), (const bf16_t*)(F.ws + WS_WGU + l * SZ_WGU), MT, 2 * DFF, DM}; pg8::StaticOrder S; S.init(MT, 2 * DFF, F.G, (int)blockIdx.x);
        pg8::EpiSwiGLU E{(bf16_t*)(F.ws + WS_HID), DFF};
        pg8::gemm_phase<pg8::EpiSwiGLU, pg8::StaticOrder, true, true>(F.lds, g, S, E);
    } SEAM(pb + 6);
    if (IN(pb + 7) && (PH_MASK & 512)) {
        pg8::Gemm g{(const bf16_t*)(F.ws + WS_HID), (const bf16_t*)(F.ws + WS_WDN + l * SZ_WDN), MT, DM, DFF}; pg8::StaticOrder S; S.init(MT, DM, F.G, (int)blockIdx.x);
        pg8::EpiF32 E{(float*)(F.ws + WS_OB), DM};
        pg8::gemm_phase<pg8::EpiF32, pg8::StaticOrder, true, true>(F.lds, g, S, E);
    } SEAM(pb + 7);
    if (IN(pb + 8) && (PH_MASK & 1024)) { rowpassB(F, l); } SEAM(pb + 8);
}
__global__ void __launch_bounds__(NTHREADS, 2) hybrid_fwd(Args args) {
    extern __shared__ __attribute__((aligned(16))) unsigned char lds[];
    Frame F;
    F.lds = (LAS unsigned char*)lds; F.ldsg = lds; F.in = args.in; F.out = args.out; F.ws = args.ws;
    F.tid = threadIdx.x; F.lane = F.tid & 63; F.wave = __builtin_amdgcn_readfirstlane(F.tid >> 6); F.G = gridDim.x;
    const int lo = args.ph_lo, hi = args.ph_hi;
    if (IN(0) && (PH_MASK & 1)) { p0_prologue(F); } SEAM(0);
    if (IN(1) && (PH_MASK & 2)) { rowpass0(F); } SEAM(1);
    layer_phases<0>(F, lo, hi);
    layer_phases<1>(F, lo, hi);
}
#undef IN
#undef SEAM

extern "C" void kernel_launch(void* const* d_in, const int* in_sizes, int n_in, void* d_out, int out_size, void* d_ws, size_t ws_size, hipStream_t stream) {
    static int grid = 0;
    if (grid == 0) {
        if (n_in != N_IN || (size_t)out_size != OUT_TOTAL || ws_size < WS_END) { fprintf(stderr, "kernel_launch: unexpected shapes: n_in %d out %d ws %zu (need %zu)\n", n_in, out_size, ws_size, (size_t)WS_END); grid = -1; return; }
        int dev = 0, cus = 0, per_cu = 0;
        if (hipGetDevice(&dev) != hipSuccess || hipDeviceGetAttribute(&cus, hipDeviceAttributeMultiprocessorCount, dev) != hipSuccess) { grid = -1; return; }
        if (hipFuncSetAttribute((const void*)hybrid_fwd, hipFuncAttributeMaxDynamicSharedMemorySize, LDS_BYTES) != hipSuccess) { fprintf(stderr, "kernel_launch: hipFuncSetAttribute failed\n"); grid = -1; return; }
        if (hipOccupancyMaxActiveBlocksPerMultiprocessor(&per_cu, (const void*)hybrid_fwd, NTHREADS, LDS_BYTES) != hipSuccess || per_cu < 1) { fprintf(stderr, "kernel_launch: occupancy query says %d blocks per CU\n", per_cu); (void)hipGetLastError(); grid = -1; return; }
        grid = cus;
    }
    if (grid < 0) return;
    (void)hipMemsetAsync((char*)d_ws + WS_CTL, 0, CTL_BYTES, stream);
    Args a{};
    for (int i = 0; i < N_IN; ++i) a.in[i] = (const float*)d_in[i];
    a.out = (float*)d_out; a.ws = (unsigned char*)d_ws;
#if ONE_LAUNCH
    a.ph_lo = 0; a.ph_hi = NPHASE;
    void* kargs[] = {&a};
    const hipError_t e = hipLaunchCooperativeKernel((const void*)hybrid_fwd, dim3(grid), dim3(NTHREADS), kargs, LDS_BYTES, stream);
    if (e != hipSuccess) fprintf(stderr, "kernel_launch: cooperative launch failed: %s (grid %d)\n", hipGetErrorString(e), grid);
#else
    for (int ph = 0; ph < NPHASE; ++ph) {
        a.ph_lo = ph; a.ph_hi = ph + 1;
        hipLaunchKernelGGL(hybrid_fwd, dim3(grid), dim3(NTHREADS), LDS_BYTES, stream, a);
    }
    const hipError_t le = hipPeekAtLastError();
    if (le != hipSuccess) fprintf(stderr, "kernel_launch: launch failed: %s\n", hipGetErrorName(le));
#endif
}
```

```cpp
#include <hip/hip_runtime.h>
#include <hip/hip_bf16.h>
#include <hip/hip_cooperative_groups.h>
#include <cstdio>
#include <cstdint>
#include <cmath>
namespace cg = cooperative_groups;
#ifndef ONE_LAUNCH
#define ONE_LAUNCH 1
#endif
namespace pg8 {
#define PG8_LAS __attribute__((address_space(3)))
typedef unsigned short bf16_t;
typedef short bf16x8 __attribute__((ext_vector_type(8)));
typedef float f32x4 __attribute__((ext_vector_type(4)));
typedef unsigned u32x4 __attribute__((ext_vector_type(4)));
constexpr int BM = 256, BK = 64, HALF = 128, HTB = HALF * BK * 2  , STAGE_BYTES = 8 * HTB, NXCD = 8, WGM = 8;

__host__ __device__ __forceinline__ int lds_byte(int r, int c) { const int st = (r >> 4) * 2 + (c >> 5), rr = r & 15, cc = c & 31, ob = rr * 64 + cc * 2; return st * 1024 + (ob ^ (((ob >> 9) & 1) << 5)); }
__host__ __device__ __forceinline__ void stage_rc(int b, int& R, int& C) { const int st = b / 1024, sb = b % 1024, swz = sb ^ (((sb >> 9) & 1) << 5); R = (st >> 1) * 16 + swz / 64; C = (st & 1) * 32 + (swz % 64) / 2; }
__host__ __device__ __forceinline__ int perm32(int rho) { const int n = rho >> 4, i = rho & 15; return 8 * (i >> 2) + 4 * n + (i & 3); }

struct Unit { int pm, pn; };
struct Gemm { const bf16_t* A; const bf16_t* Bt; int M, N, K; };

struct StaticOrder {
    int nM, nN, nwg, G, c;
    __host__ __device__ void init(int M, int N, int G_, int c_) { nM = M / BM; nN = N / BM; nwg = nM * nN; G = G_; c = c_; }
    __host__ __device__ bool next(int i, Unit& u) const {
        const long L = (long)i * G + c; if (L >= nwg) return false;
        int wgid = (int)L; { const int q = nwg / NXCD, r = nwg % NXCD, xcd = wgid % NXCD, off = wgid / NXCD; wgid = (xcd < r ? xcd * (q + 1) : r * (q + 1) + (xcd - r) * q) + off; }
        const int nig = WGM * nN, gid = wgid / nig, fm = gid * WGM, gsz = (nM - fm) < WGM ? (nM - fm) : WGM;
        u.pm = fm + ((wgid % nig) % gsz); u.pn = (wgid % nig) / gsz; return true;
    }
    __device__ __forceinline__ void a_ready(const Unit&) const {}
    __device__ __forceinline__ void done(const Unit&) const {}
};

__device__ __forceinline__ unsigned cvt_pk_bf16(float lo, float hi) { unsigned r; asm volatile("v_cvt_pk_bf16_f32 %0, %1, %2" : "=v"(r) : "v"(lo), "v"(hi)); return r; }
struct EpiBf16 {
    static constexpr bool PERM = true, AFTER_DRAIN = false;
    bf16_t* O; int ldc;
    __device__ __forceinline__ void operator()(const f32x4 (&acc)[2][2][4][2], const Unit& u, int wr, int wc, int fr, int fq) const {
        const int row0 = u.pm * BM + wr * 64 + fr; const int col0 = u.pn * BM + wc * 32 + 8 * fq;
#pragma unroll
        for (int ai = 0; ai < 2; ++ai)
#pragma unroll
            for (int m = 0; m < 4; ++m) { bf16_t* rowp = O + (size_t)(row0 + ai * HALF + m * 16) * ldc + col0;
#pragma unroll
                for (int bj = 0; bj < 2; ++bj) { const f32x4 v0 = acc[ai][bj][m][0], v1 = acc[ai][bj][m][1];
                    u32x4 w; w.x = cvt_pk_bf16(v0[0], v0[1]); w.y = cvt_pk_bf16(v0[2], v0[3]); w.z = cvt_pk_bf16(v1[0], v1[1]); w.w = cvt_pk_bf16(v1[2], v1[3]);
                    *(u32x4*)(rowp + bj * HALF) = w; } }
    }
};
struct EpiF32 {
    static constexpr bool PERM = false, AFTER_DRAIN = false;
    float* O; int ldc;
    __device__ __forceinline__ void operator()(const f32x4 (&acc)[2][2][4][2], const Unit& u, int wr, int wc, int fr, int fq) const {
        const int row0 = u.pm * BM + wr * 64 + fr; const int col0 = u.pn * BM + wc * 32 + 4 * fq;
#pragma unroll
        for (int ai = 0; ai < 2; ++ai)
#pragma unroll
            for (int m = 0; m < 4; ++m) { float* rowp = O + (size_t)(row0 + ai * HALF + m * 16) * ldc + col0;
#pragma unroll
                for (int bj = 0; bj < 2; ++bj)
#pragma unroll
                    for (int n = 0; n < 2; ++n) *(f32x4*)(rowp + bj * HALF + n * 16) = acc[ai][bj][m][n]; }
    }
};
__device__ __forceinline__ float silu_mul(float g, float u) { return g * __builtin_amdgcn_rcpf(1.0f + __expf(-g)) * u; }
struct EpiSwiGLU {
    static constexpr bool PERM = true, AFTER_DRAIN = false;
    bf16_t* O; int ldc;
    __device__ __forceinline__ void operator()(const f32x4 (&acc)[2][2][4][2], const Unit& u, int wr, int wc, int fr, int fq) const {
        const int row0 = u.pm * BM + wr * 64 + fr; const int col0 = u.pn * HALF + wc * 32 + 8 * fq;
#pragma unroll
        for (int ai = 0; ai < 2; ++ai)
#pragma unroll
            for (int m = 0; m < 4; ++m) { bf16_t* rowp = O + (size_t)(row0 + ai * HALF + m * 16) * ldc + col0;
                const f32x4 g0 = acc[ai][0][m][0], g1 = acc[ai][0][m][1], u0 = acc[ai][1][m][0], u1 = acc[ai][1][m][1];
                u32x4 w; w.x = cvt_pk_bf16(silu_mul(g0[0], u0[0]), silu_mul(g0[1], u0[1])); w.y = cvt_pk_bf16(silu_mul(g0[2], u0[2]), silu_mul(g0[3], u0[3]));
                w.z = cvt_pk_bf16(silu_mul(g1[0], u1[0]), silu_mul(g1[1], u1[1])); w.w = cvt_pk_bf16(silu_mul(g1[2], u1[2]), silu_mul(g1[3], u1[3]));
                *(u32x4*)rowp = w; }
    }
};
template <class Epi, class Sched, bool ALIGN_EPI = false, bool SP2 = false>
__device__ __forceinline__ void gemm_phase(PG8_LAS unsigned char* lds, const Gemm g, const Sched& S, const Epi& E) {
    const int tid = threadIdx.x, wid = __builtin_amdgcn_readfirstlane(tid >> 6), lane = tid & 63, wr = wid >> 2, wc = wid & 3, fr = lane & 15, fq = lane >> 4;
    const int K = g.K, nt = K / BK;
    unsigned voffA[2], voffB[2];
#pragma unroll
    for (int i = 0; i < 2; ++i) { int R, C; stage_rc(tid * 16 + i * 8192, R, C); const int Rb = Epi::PERM ? ((R & ~31) + perm32(R & 31)) : R;
        voffA[i] = (unsigned)(R * K + C) * 2u; voffB[i] = (unsigned)(Rb * K + C) * 2u; }
    const size_t kstep = (size_t)(BK * 2);
    const size_t hstep = (size_t)HALF * K * 2;
    const size_t tstep = 2 * hstep;
    const unsigned ldsw = (unsigned)wid * 1024u;
    const int aoff = lds_byte(wr * 64 + fr, fq * 8), boff = lds_byte(wc * 32 + fr, fq * 8);
#define PG8_SA(b, h) (((b) * 2 + (h)) * HTB)
#define PG8_SB(b, h) ((4 + (b) * 2 + (h)) * HTB)
#define PG8_STAGE(bufoff, gbase, voff) do { _Pragma("unroll") for (int _i = 0; _i < 2; ++_i) \
        __builtin_amdgcn_global_load_lds((const unsigned*)((const char*)(gbase) + (voff)[_i]), (PG8_LAS unsigned*)(lds + (bufoff) + ldsw + _i * 8192), 16, 0, 0); } while (0)
#define PG8_LDA(dst, b, h) do { _Pragma("unroll") for (int m = 0; m < 4; ++m) _Pragma("unroll") for (int k = 0; k < 2; ++k) dst[m][k] = *(const PG8_LAS bf16x8*)(lds + PG8_SA(b, h) + aoff + m * 2048 + k * 1024); } while (0)
#define PG8_LDB(dst, b, h) do { _Pragma("unroll") for (int n = 0; n < 2; ++n) _Pragma("unroll") for (int k = 0; k < 2; ++k) dst[n][k] = *(const PG8_LAS bf16x8*)(lds + PG8_SB(b, h) + boff + n * 2048 + k * 1024); } while (0)
#define PG8_MMA(ai, bj, At, Bt) do { __builtin_amdgcn_s_setprio(1); _Pragma("unroll") for (int m = 0; m < 4; ++m) _Pragma("unroll") for (int n = 0; n < 2; ++n) _Pragma("unroll") for (int k = 0; k < 2; ++k) \
        acc[ai][bj][m][n] = __builtin_amdgcn_mfma_f32_16x16x32_bf16(Bt[n][k], At[m][k], acc[ai][bj][m][n], 0, 0, 0); __builtin_amdgcn_s_setprio(0); } while (0)
#define PG8_WAIT_V(n) asm volatile("s_waitcnt vmcnt(" #n ")" ::: "memory")
#define PG8_WAIT_L(n) asm volatile("s_waitcnt lgkmcnt(" #n ")" ::: "memory")
#define PG8_BAR __builtin_amdgcn_s_barrier()
#define PG8_SCHED __builtin_amdgcn_sched_barrier(0)
    Unit cur, nxt; int ui = 0;
    if (!S.next(0, cur)) return;
    f32x4 acc[2][2][4][2];
#pragma unroll
    for (int a = 0; a < 2; ++a)
#pragma unroll
        for (int b = 0; b < 2; ++b)
#pragma unroll
            for (int m = 0; m < 4; ++m)
#pragma unroll
                for (int n = 0; n < 2; ++n) acc[a][b][m][n] = (f32x4){0.f, 0.f, 0.f, 0.f};
    bf16x8 At[4][2], B0[2][2], B1[2][2];
    const char* cA = (const char*)g.A + (size_t)cur.pm * tstep; const char* cB = (const char*)g.Bt + (size_t)cur.pn * tstep;
    S.a_ready(cur);
    if constexpr (SP2) {
        PG8_STAGE(PG8_SB(0, 0), cB, voffB); PG8_STAGE(PG8_SB(0, 1), cB + hstep, voffB); PG8_STAGE(PG8_SA(0, 0), cA, voffA); PG8_STAGE(PG8_SA(0, 1), cA + hstep, voffA);
        if (wr == 1) PG8_BAR;
        PG8_WAIT_V(2); PG8_BAR;
        PG8_STAGE(PG8_SB(1, 0), cB + kstep, voffB); PG8_STAGE(PG8_SA(1, 0), cA + kstep, voffA); PG8_STAGE(PG8_SB(1, 1), cB + hstep + kstep, voffB);
        PG8_WAIT_V(6); PG8_BAR;
    } else {
        PG8_STAGE(PG8_SB(0, 0), cB, voffB); PG8_STAGE(PG8_SA(0, 0), cA, voffA); PG8_STAGE(PG8_SB(0, 1), cB + hstep, voffB); PG8_STAGE(PG8_SA(0, 1), cA + hstep, voffA);
        if (wr == 1) PG8_BAR;
        PG8_WAIT_V(4); PG8_BAR;
        PG8_STAGE(PG8_SB(1, 0), cB + kstep, voffB); PG8_STAGE(PG8_SA(1, 0), cA + kstep, voffA); PG8_STAGE(PG8_SB(1, 1), cB + hstep + kstep, voffB);
        PG8_WAIT_V(6); PG8_BAR;
    }
    for (;;) {
        const bool has_next = S.next(ui + 1, nxt);
        const char* nA = has_next ? (const char*)g.A + (size_t)nxt.pm * tstep : cA; const char* nB = has_next ? (const char*)g.Bt + (size_t)nxt.pn * tstep : cB;
        for (int t = 0; t < nt; t += 2) {
            const bool last = (t == nt - 2);
            const char* a1 = cA + (size_t)(t + 1) * kstep;
            const char* a2 = last ? nA : cA + (size_t)(t + 2) * kstep; const char* b2 = last ? nB : cB + (size_t)(t + 2) * kstep;
            const char* a3 = a2 + kstep; const char* b3 = b2 + kstep;
            if (last && has_next) S.a_ready(nxt);
            if constexpr (SP2) {
            PG8_LDB(B0, 0, 0); PG8_LDB(B1, 0, 1); PG8_SCHED; PG8_LDA(At, 0, 0); PG8_STAGE(PG8_SA(1, 1), a1 + hstep, voffA);
            PG8_WAIT_V(8); PG8_WAIT_L(0); PG8_BAR; PG8_MMA(0, 0, At, B0); PG8_MMA(0, 1, At, B1); PG8_BAR; PG8_SCHED;
            PG8_LDA(At, 0, 1); PG8_STAGE(PG8_SB(0, 0), b2, voffB); PG8_STAGE(PG8_SB(0, 1), b2 + hstep, voffB); PG8_STAGE(PG8_SA(0, 0), a2, voffA);
            PG8_WAIT_V(8); PG8_WAIT_L(0); PG8_BAR; PG8_MMA(1, 0, At, B0); PG8_MMA(1, 1, At, B1); PG8_BAR; PG8_SCHED;
            PG8_LDB(B0, 1, 0); PG8_LDB(B1, 1, 1); PG8_SCHED; PG8_LDA(At, 1, 0); PG8_STAGE(PG8_SA(0, 1), a2 + hstep, voffA);
            PG8_WAIT_V(8); PG8_WAIT_L(0); PG8_BAR; PG8_MMA(0, 0, At, B0); PG8_MMA(0, 1, At, B1); PG8_BAR; PG8_SCHED;
            PG8_LDA(At, 1, 1); PG8_STAGE(PG8_SB(1, 0), b3, voffB); PG8_STAGE(PG8_SB(1, 1), b3 + hstep, voffB); PG8_STAGE(PG8_SA(1, 0), a3, voffA);
            PG8_WAIT_V(8); PG8_WAIT_L(0); PG8_BAR; PG8_MMA(1, 0, At, B0); PG8_MMA(1, 1, At, B1); PG8_BAR; PG8_SCHED;
            } else {
            PG8_LDB(B0, 0, 0); PG8_SCHED; PG8_LDA(At, 0, 0); PG8_STAGE(PG8_SA(1, 1), a1 + hstep, voffA);
            PG8_WAIT_L(8); PG8_BAR; PG8_WAIT_L(0); PG8_MMA(0, 0, At, B0); PG8_BAR; PG8_SCHED;
            PG8_LDB(B1, 0, 1); PG8_STAGE(PG8_SB(0, 0), b2, voffB);
            PG8_BAR; PG8_WAIT_L(0); PG8_MMA(0, 1, At, B1); PG8_BAR;
            PG8_LDA(At, 0, 1); PG8_STAGE(PG8_SA(0, 0), a2, voffA);
            PG8_BAR; PG8_WAIT_L(0); PG8_MMA(1, 0, At, B0); PG8_BAR; PG8_SCHED;
            PG8_STAGE(PG8_SB(0, 1), b2 + hstep, voffB);
            PG8_WAIT_V(6); PG8_BAR; PG8_MMA(1, 1, At, B1); PG8_BAR;
            PG8_LDB(B0, 1, 0); PG8_SCHED; PG8_LDA(At, 1, 0); PG8_STAGE(PG8_SA(0, 1), a2 + hstep, voffA);
            PG8_WAIT_L(8); PG8_BAR; PG8_WAIT_L(0); PG8_MMA(0, 0, At, B0); PG8_BAR; PG8_SCHED;
            PG8_LDB(B1, 1, 1); PG8_STAGE(PG8_SB(1, 0), b3, voffB);
            PG8_BAR; PG8_WAIT_L(0); PG8_MMA(0, 1, At, B1); PG8_BAR;
            PG8_LDA(At, 1, 1); PG8_STAGE(PG8_SA(1, 0), a3, voffA);
            PG8_BAR; PG8_WAIT_L(0); PG8_MMA(1, 0, At, B0); PG8_BAR; PG8_SCHED;
            PG8_STAGE(PG8_SB(1, 1), b3 + hstep, voffB);
            PG8_WAIT_V(6); PG8_BAR; PG8_MMA(1, 1, At, B1); PG8_BAR;
            }
        }
        if constexpr (ALIGN_EPI) { if (wr == 0) PG8_BAR; }
        if constexpr (!Epi::AFTER_DRAIN) { E(acc, cur, wr, wc, fr, fq); S.done(cur); }
        if (!has_next) break;
#pragma unroll
        for (int a = 0; a < 2; ++a)
#pragma unroll
            for (int b = 0; b < 2; ++b)
#pragma unroll
                for (int m = 0; m < 4; ++m)
#pragma unroll
                    for (int n = 0; n < 2; ++n) acc[a][b][m][n] = (f32x4){0.f, 0.f, 0.f, 0.f};
        cur = nxt; cA = nA; cB = nB; ++ui;
        if constexpr (ALIGN_EPI) { if (wr == 1) PG8_BAR; }
    }
    PG8_WAIT_V(0);
    if constexpr (!ALIGN_EPI) { if (wr == 0) PG8_BAR; }
    PG8_BAR;
    if constexpr (Epi::AFTER_DRAIN) { E.fused(acc, cur, wr, wc, fr, fq, lds, wid, lane); S.done(cur); }
#undef PG8_SA
#undef PG8_SB
#undef PG8_STAGE
#undef PG8_LDA
#undef PG8_LDB
#undef PG8_MMA
#undef PG8_WAIT_V
#undef PG8_WAIT_L
#undef PG8_BAR
#undef PG8_SCHED
}
}
namespace attn {
using bf16 = __hip_bfloat16;
constexpr int   D = 128, NW = 8, QBLK = 32, KVBLK = 64;
constexpr float SCALE = 0.088388347648318440f;
constexpr float THR = 8.f;
constexpr int SDEPTH = 2;
constexpr int LDQ = 1024, LDK = 256, LDO = 2048;
constexpr size_t SHM_V = KVBLK * D * 2, SHM_K = KVBLK * D * 2, SHM_ATTN = 2 * SHM_V + 2 * SHM_K + NW * 64 * 4;
__device__ __forceinline__ unsigned short f2bf_rne(float f) { unsigned u = __builtin_bit_cast(unsigned, f); return (unsigned short)((u + 0x7fffu + ((u >> 16) & 1u)) >> 16); }
using bf16x8 = __attribute__((ext_vector_type(8))) short;
using s16x4  = __attribute__((ext_vector_type(4))) short;
using f32x16 = __attribute__((ext_vector_type(16))) float;
using f32x8  = __attribute__((ext_vector_type(8))) float;
using u32x4  = __attribute__((ext_vector_type(4))) unsigned;
#define KSWZ(row, colB) ((row) * 256 + ((colB) ^ (((row) & 7) << 4)))
#define SBAR() __builtin_amdgcn_sched_barrier(0)
__device__ __forceinline__ int crow(int r, int hi) { return (r & 3) + 8 * (r >> 2) + 4 * hi; }
__device__ __forceinline__ unsigned cvtpk(float lo, float hi) {
  unsigned r; asm volatile("v_cvt_pk_bf16_f32 %0, %1, %2" : "=v"(r) : "v"(lo), "v"(hi)); return r;
}
template <typename TIn> struct Stage;
template <> struct Stage<bf16>  { using T = bf16x8;
  __device__ static __forceinline__ T ld8(const bf16* p) { return *reinterpret_cast<const bf16x8*>(p); }
  __device__ static __forceinline__ bf16x8 tobf(T x) { return x; } };
template <> struct Stage<float> { using T = f32x8;
  __device__ static __forceinline__ T ld8(const float* p) { return *reinterpret_cast<const f32x8*>(p); }
  __device__ static __forceinline__ bf16x8 tobf(T x) {
    u32x4 w = {cvtpk(x[0], x[1]), cvtpk(x[2], x[3]), cvtpk(x[4], x[5]), cvtpk(x[6], x[7])}; return *reinterpret_cast<bf16x8*>(&w); } };

__device__ __forceinline__ void partialSM(f32x16& p0, f32x16& p1, float& m_reg, float& mn, float& alpha) {
  constexpr float C = SCALE * 1.4426950408889634f;
  float pmax = p0[0]; for (int r = 1; r < 16; ++r) pmax = fmaxf(pmax, p0[r]); for (int r = 0; r < 16; ++r) pmax = fmaxf(pmax, p1[r]);
  { auto rr = __builtin_amdgcn_permlane32_swap(__float_as_uint(pmax), __float_as_uint(pmax), false, false);
    pmax = fmaxf(__uint_as_float(rr[0]), __uint_as_float(rr[1])); }
  if (__builtin_expect(__all(pmax - m_reg <= THR / SCALE), 1)) { mn = m_reg; alpha = 1.f; }
  else { mn = fmaxf(m_reg, pmax); alpha = __builtin_amdgcn_exp2f((m_reg - mn) * C); m_reg = mn; }
  float mnC = -mn * C;
  for (int r = 0; r < 16; ++r) p0[r] = fmaf(p0[r], C, mnC); for (int r = 0; r < 16; ++r) p1[r] = fmaf(p1[r], C, mnC);
  for (int r = 0; r < 16; ++r) p0[r] = __builtin_amdgcn_exp2f(p0[r]);
}
__device__ __forceinline__ void finishSM(f32x16& p0, f32x16& p1, float alpha, float& l_reg, bf16x8& pa0, bf16x8& pa1, bf16x8& pa2, bf16x8& pa3) {
  for (int r = 0; r < 16; ++r) p1[r] = __builtin_amdgcn_exp2f(p1[r]);
  float ps = 0; for (int r = 0; r < 16; ++r) ps += p0[r]; for (int r = 0; r < 16; ++r) ps += p1[r];
  { auto rr = __builtin_amdgcn_permlane32_swap(__float_as_uint(ps), __float_as_uint(ps), false, false);
    ps = __uint_as_float(rr[0]) + __uint_as_float(rr[1]); }
  l_reg = l_reg * alpha + ps;
#define PK4(P, BASE, OUT) do { unsigned a0 = cvtpk(P[BASE + 0], P[BASE + 1]), a1 = cvtpk(P[BASE + 2], P[BASE + 3]);   \
    unsigned b0 = cvtpk(P[BASE + 4], P[BASE + 5]), b1 = cvtpk(P[BASE + 6], P[BASE + 7]);                              \
    auto r0 = __builtin_amdgcn_permlane32_swap(a0, b0, false, false); auto r1 = __builtin_amdgcn_permlane32_swap(a1, b1, false, false); \
    u32x4 w = {r0[0], r1[0], r0[1], r1[1]}; OUT = *reinterpret_cast<bf16x8*>(&w); } while (0)
  PK4(p0, 0, pa0); PK4(p0, 8, pa1); PK4(p1, 0, pa2); PK4(p1, 8, pa3);
#undef PK4
}
__device__ __forceinline__ void qkt(f32x16& p0, f32x16& p1, const bf16* Ks, const bf16x8* qr, int r32, int hi) {
  p0 = f32x16{}; p1 = f32x16{};
  for (int d0 = 0; d0 < 8; ++d0) { int cb = (d0 * 16 + hi * 8) * 2;
    bf16x8 b0 = *reinterpret_cast<const bf16x8*>((const char*)Ks + KSWZ(r32, cb));
    bf16x8 b1 = *reinterpret_cast<const bf16x8*>((const char*)Ks + KSWZ(32 + r32, cb));
    p0 = __builtin_amdgcn_mfma_f32_32x32x16_bf16(b0, qr[d0], p0, 0, 0, 0);
    p1 = __builtin_amdgcn_mfma_f32_32x32x16_bf16(b1, qr[d0], p1, 0, 0, 0); }
}
__device__ __forceinline__ int v_st(int k, int c) { const int kk = (k & ~0xC) | ((k & 4) << 1) | ((k & 8) >> 1); return ((kk >> 3) * 4 + (c >> 5)) * 512 + ((kk & 7) * 32 + (c & 31)) * 2; }
__device__ __forceinline__ int v_rd_base(int lane) { return ((lane & 3) << 3) | (((lane >> 2) & 3) << 6) | (((lane >> 4) & 1) << 5) | (((lane >> 5) & 1) << 8); }
constexpr int v_rd_off(int d0, int ks, int half) { return d0 * 512 + ks * 4096 + half * 2048; }
template <int OFF> __device__ __forceinline__ s16x4 tr_read(int vb) {
  s16x4 r; asm volatile("ds_read_b64_tr_b16 %0, %1 offset:%2" : "=&v"(r) : "v"(vb), "i"(OFF) : "memory"); return r;
}
template <int D0> __device__ __forceinline__ void pv_one(f32x16& od, int vb, bf16x8 pa0, bf16x8 pa1, bf16x8 pa2, bf16x8 pa3) {
  const s16x4 l0 = tr_read<v_rd_off(D0, 0, 0)>(vb), h0 = tr_read<v_rd_off(D0, 0, 1)>(vb), l1 = tr_read<v_rd_off(D0, 1, 0)>(vb), h1 = tr_read<v_rd_off(D0, 1, 1)>(vb);
  const s16x4 l2 = tr_read<v_rd_off(D0, 2, 0)>(vb), h2 = tr_read<v_rd_off(D0, 2, 1)>(vb), l3 = tr_read<v_rd_off(D0, 3, 0)>(vb), h3 = tr_read<v_rd_off(D0, 3, 1)>(vb);
  asm volatile("s_waitcnt lgkmcnt(0)" ::: "memory"); SBAR();
#define PK(L, H) (bf16x8){L[0], L[1], L[2], L[3], H[0], H[1], H[2], H[3]}
  od = __builtin_amdgcn_mfma_f32_32x32x16_bf16(pa0, PK(l0, h0), od, 0, 0, 0);
  od = __builtin_amdgcn_mfma_f32_32x32x16_bf16(pa1, PK(l1, h1), od, 0, 0, 0);
  od = __builtin_amdgcn_mfma_f32_32x32x16_bf16(pa2, PK(l2, h2), od, 0, 0, 0);
  od = __builtin_amdgcn_mfma_f32_32x32x16_bf16(pa3, PK(l3, h3), od, 0, 0, 0);
#undef PK
}
__device__ __forceinline__ void pv_d0(f32x16* o, int vb, bf16x8 pa0, bf16x8 pa1, bf16x8 pa2, bf16x8 pa3) {
  pv_one<0>(o[0], vb, pa0, pa1, pa2, pa3); pv_one<1>(o[1], vb, pa0, pa1, pa2, pa3); pv_one<2>(o[2], vb, pa0, pa1, pa2, pa3); pv_one<3>(o[3], vb, pa0, pa1, pa2, pa3);
}
template <typename TQ>
__device__ __forceinline__ void attn_dense_body(const TQ* __restrict__ Qb, const bf16* __restrict__ Kh, const bf16* __restrict__ Vh,
                                                unsigned short* __restrict__ Ob, int seq, char* lds) {
  using St = Stage<bf16>; using SQ = Stage<TQ>;
  const int tid = threadIdx.x, wid = tid >> 6, lane = tid & 63, r32 = lane & 31, hi = lane >> 5;
  bf16* V_lds = (bf16*)lds; bf16* K_lds = (bf16*)(lds + 2 * SHM_V);
  float* ws = (float*)(lds + 2 * SHM_V + 2 * SHM_K) + wid * 64; float* li_l = ws; float* al_l = ws + 32;
  float m_reg = -1e30f, l_reg = 0; f32x16 o[4] = {}; bf16x8 qr[8];
  const TQ* Qw = Qb + (long)(wid * QBLK + r32) * LDQ + hi * 8;
#pragma unroll
  for (int d0 = 0; d0 < 8; ++d0) qr[d0] = SQ::tobf(SQ::ld8(Qw + d0 * 16));
  const int sr = tid >> 4, sc = (tid & 15) * 8, vst0 = v_st(sr, sc), vst1 = v_st(32 + sr, sc);
  const int vb0 = (int)(uintptr_t)V_lds + v_rd_base(lane);
  struct { typename St::T vs0, vs1, ks0, ks1; } sr_[SDEPTH];
#define SLOAD(i, k0) do { sr_[i].vs0 = St::ld8(&Vh[(long)((k0) + sr) * LDK + sc]); sr_[i].vs1 = St::ld8(&Vh[(long)((k0) + 32 + sr) * LDK + sc]); \
    sr_[i].ks0 = St::ld8(&Kh[(long)((k0) + sr) * LDK + sc]); sr_[i].ks1 = St::ld8(&Kh[(long)((k0) + 32 + sr) * LDK + sc]); } while (0)
#define SWRITE(b, i) do { *(bf16x8*)((char*)V_lds + (b) * SHM_V + vst0) = St::tobf(sr_[i].vs0);          \
    *(bf16x8*)((char*)V_lds + (b) * SHM_V + vst1) = St::tobf(sr_[i].vs1); int kc = sc * 2;               \
    *(bf16x8*)((char*)K_lds + (b) * SHM_K + KSWZ(sr, kc)) = St::tobf(sr_[i].ks0);                       \
    *(bf16x8*)((char*)K_lds + (b) * SHM_K + KSWZ(32 + sr, kc)) = St::tobf(sr_[i].ks1); } while (0)
#define SWAIT() do { if constexpr (SDEPTH == 2) asm volatile("s_waitcnt vmcnt(4)" ::: "memory"); else asm volatile("s_waitcnt vmcnt(0)" ::: "memory"); } while (0)
#define RESC(a) do { if (__any((a) < 1.f)) { if (hi == 0) al_l[r32] = (a); asm volatile("s_waitcnt lgkmcnt(0)" ::: "memory"); \
    for (int d = 0; d < 4; ++d) for (int r = 0; r < 16; ++r) o[d][r] *= al_l[crow(r, hi)]; } } while (0)
  f32x16 pA0, pA1, pB0, pB1; float mnA, mnB, alA, alB; bf16x8 pa0, pa1, pa2, pa3; const int NT = seq / KVBLK;
  constexpr int SE = 0, SO = SDEPTH - 1;
  SLOAD(SE, 0); asm volatile("s_waitcnt vmcnt(0)" ::: "memory"); SWRITE(0, SE); __syncthreads();
  qkt(pA0, pA1, K_lds, qr, r32, hi); partialSM(pA0, pA1, m_reg, mnA, alA);
  SLOAD(SO, KVBLK); if constexpr (SDEPTH == 2) { if (2 < NT) SLOAD(SE, 2 * KVBLK); }
  SWAIT(); SWRITE(1, SO); __syncthreads();
  for (int j = 1; j + 1 < NT; j += 2) {
    SBAR(); qkt(pB0, pB1, (bf16*)((char*)K_lds + SHM_K), qr, r32, hi);
    finishSM(pA0, pA1, alA, l_reg, pa0, pa1, pa2, pa3); SBAR();
    SLOAD(SO, (j + SDEPTH) * KVBLK); SBAR();
    pv_d0(o, vb0, pa0, pa1, pa2, pa3); partialSM(pB0, pB1, m_reg, mnB, alB);
    __syncthreads(); SWAIT(); SWRITE(0, SE);
    RESC(alB); __syncthreads();
    SBAR(); qkt(pA0, pA1, K_lds, qr, r32, hi);
    finishSM(pB0, pB1, alB, l_reg, pa0, pa1, pa2, pa3); SBAR();
    if (SDEPTH == 1 || j + 3 < NT) SLOAD(SE, (j + 1 + SDEPTH) * KVBLK); SBAR();
    pv_d0(o, vb0 + (int)SHM_V, pa0, pa1, pa2, pa3); partialSM(pA0, pA1, m_reg, mnA, alA);
    __syncthreads(); SWAIT(); SWRITE(1, SO);
    RESC(alA); __syncthreads();
  }
  SBAR(); qkt(pB0, pB1, (bf16*)((char*)K_lds + SHM_K), qr, r32, hi);
  finishSM(pA0, pA1, alA, l_reg, pa0, pa1, pa2, pa3); SBAR();
  pv_d0(o, vb0, pa0, pa1, pa2, pa3); partialSM(pB0, pB1, m_reg, mnB, alB);
  __syncthreads(); RESC(alB);
  finishSM(pB0, pB1, alB, l_reg, pa0, pa1, pa2, pa3); SBAR();
  pv_d0(o, vb0 + (int)SHM_V, pa0, pa1, pa2, pa3);
  if (hi == 0) li_l[r32] = l_reg; asm volatile("s_waitcnt lgkmcnt(0)" ::: "memory");
  float rli[16];
#pragma unroll
  for (int r = 0; r < 16; ++r) rli[r] = __builtin_amdgcn_rcpf(li_l[crow(r, hi)]);
  unsigned short* Ow = Ob + (long)(wid * QBLK) * LDO;
#pragma unroll
  for (int r = 0; r < 16; ++r) { int orow = crow(r, hi);
    for (int d0 = 0; d0 < 4; ++d0) Ow[(long)orow * LDO + d0 * 32 + r32] = f2bf_rne(o[d0][r] * rli[r]); }
#undef SLOAD
#undef SWRITE
#undef SWAIT
#undef RESC
}
}
#ifndef PP_MASK
#define PP_MASK 31
#endif
#define GAS __attribute__((address_space(1)))
#define LAS __attribute__((address_space(3)))
typedef unsigned short bf16_t;
typedef float f32x4 __attribute__((ext_vector_type(4)));
typedef float f32x2 __attribute__((ext_vector_type(2)));
typedef unsigned u32x4 __attribute__((ext_vector_type(4)));
typedef unsigned u32x2 __attribute__((ext_vector_type(2)));
typedef __bf16 bf16x2_t __attribute__((ext_vector_type(2)));

constexpr int DM = 2048, MC = 4096, MS = 4096, MT = MC + MS, DEPTH = 2;
constexpr int DIN = 4768, DINP = 4864, DFF = 5632;
constexpr int O_K = 1024, O_V = 1280, O_CB = 1536, O_CC = 2048, O_CH = 2560, O_UR = 3072;
constexpr int KVROWS = 4096 + 4 * 1280;
constexpr float EPS = 1e-6f, GN_EPS = 64e-5f;
constexpr int NWAVES = 8, NTHREADS = 512;
enum { I_XP = 0, I_XS, I_CK, I_CV, I_ST, I_C, I_CCTX, I_WADA, I_BADA, I_NG, I_WIN, I_QN, I_KN, I_CONVW, I_MU, I_W0, I_WUP, I_A0, I_AUP, I_GUP, I_KK, I_KA, I_RK, I_LNG, I_LNB, I_WOUT, I_WGATE, I_WUPF, I_WDOWN, N_IN };
constexpr size_t OUT_Y = 0, OUT_NK = (size_t)MT * DM, OUT_NV = OUT_NK + 2097152, OUT_ST = OUT_NV + 2097152, OUT_TOTAL = OUT_ST + 2097152;
constexpr size_t MiB = 1u << 20;
constexpr size_t WS_CTL = 0, CTL_BYTES = 1 * MiB;
constexpr size_t WS_WIN = 1 * MiB, SZ_WIN = 19 * MiB;
constexpr size_t WS_WOUT = WS_WIN + 2 * SZ_WIN, SZ_WOUT = 8 * MiB;
constexpr size_t WS_WGU = WS_WOUT + 2 * SZ_WOUT, SZ_WGU = 44 * MiB;
constexpr size_t WS_WDN = WS_WGU + 2 * SZ_WGU, SZ_WDN = 22 * MiB;
constexpr size_t WS_MOD = WS_WDN + 2 * SZ_WDN;
constexpr size_t WS_HB = WS_MOD + 1 * MiB;
constexpr size_t WS_MIX = WS_HB + 32 * MiB;
constexpr size_t WS_XB = WS_MIX + 32 * MiB;
constexpr size_t WS_R1 = WS_XB + 64 * MiB;
constexpr size_t WS_PROJ = WS_R1;
constexpr size_t WS_QB = WS_R1 + 76 * MiB;
constexpr size_t WS_KB = WS_R1 + 92 * MiB;
constexpr size_t WS_VB = WS_R1 + 97 * MiB;
constexpr size_t WS_SCAN = WS_R1 + 102 * MiB;
constexpr size_t WS_GB = WS_R1 + 246 * MiB;
constexpr size_t WS_BON = WS_R1 + 262 * MiB;
constexpr size_t WS_YB = WS_R1 + 278 * MiB;
constexpr size_t WS_OB = WS_R1;
constexpr size_t WS_HID = WS_R1 + 64 * MiB;
constexpr size_t WS_END = WS_R1 + 310 * MiB;
constexpr int CW_QUEUE = 64;
constexpr int RING_BYTES = 131072, MISC_OFF = RING_BYTES + 320, LDS_BYTES = 147456;

__device__ __forceinline__ float bf2f(bf16_t h) { return __uint_as_float((unsigned)h << 16); }
__device__ __forceinline__ unsigned pk2(float lo, float hi) { f32x2 v = {lo, hi}; bf16x2_t b = __builtin_convertvector(v, bf16x2_t); return __builtin_bit_cast(unsigned, b); }
__device__ __forceinline__ bf16_t f2bf(float f) { return (bf16_t)(pk2(f, 0.f) & 0xffffu); }
__device__ __forceinline__ float wave_sum(float v) {
#pragma unroll
    for (int o = 1; o < 64; o <<= 1) v += __shfl_xor(v, o);
    return v;
}
template <int CTRL> __device__ __forceinline__ float dpp_add(float x) {
    const int y = __builtin_amdgcn_update_dpp(0, __float_as_int(x), CTRL, 0xf, 0xf, false);
    return x + __int_as_float(y);
}
__device__ __forceinline__ float row16_sum(float x) {
    x = dpp_add<0x128>(x); x = dpp_add<0x124>(x); x = dpp_add<0x122>(x); x = dpp_add<0x121>(x); return x;
}
__device__ __forceinline__ float sigmoidf_(float x) { return 1.0f / (1.0f + __expf(-x)); }

struct Args { const float* in[N_IN]; float* out; unsigned char* ws; int ph_lo, ph_hi; };
struct Frame {
    LAS unsigned char* lds; unsigned char* ldsg;
    const float* const* in; float* out; unsigned char* ws;
    int tid, lane, wave, G;
};
#define LDS_WAIT() asm volatile("s_waitcnt lgkmcnt(0)" ::: "memory")

__device__ __forceinline__ void p0_transpose_item(const float* W, int K, int N, bf16_t* WT, int kb, int nb, int rowbase, LAS float* scr, int lane) {
    const int k0 = 64 * kb, n0 = 32 * nb;
#pragma unroll 8
    for (int i = 0; i < 32; ++i) { const int kk = 2 * i + (lane >> 5); scr[kk * 33 + (lane & 31)] = W[(size_t)(k0 + kk) * N + n0 + (lane & 31)]; }
    LDS_WAIT(); asm volatile("" ::: "memory");
    const int c = lane & 7;
#pragma unroll
    for (int j = 0; j < 4; ++j) { const int n = (lane >> 3) + 8 * j; const LAS float* s = scr + (8 * c) * 33 + n;
        u32x4 o; o.x = pk2(s[0 * 33], s[1 * 33]); o.y = pk2(s[2 * 33], s[3 * 33]); o.z = pk2(s[4 * 33], s[5 * 33]); o.w = pk2(s[6 * 33], s[7 * 33]);
        *(u32x4*)(WT + (size_t)(rowbase + n) * K + k0 + 8 * c) = o; }
    LDS_WAIT(); asm volatile("" ::: "memory");
}
__device__ __forceinline__ void p0_prologue(Frame& F) {
    {
        LAS float* sc = (LAS float*)F.lds;
        LAS float* red = sc + 5 * 2048;
        for (int i = F.tid; i < 5 * 2048; i += NTHREADS) { const int v = i >> 11, k = i & 2047; const float x = v == 0 ? F.in[I_CCTX][k] : F.in[I_C][(v - 1) * 2048 + k]; sc[i] = x * sigmoidf_(x); }
        __syncthreads();
        for (int it = blockIdx.x; it < 2 * 192; it += F.G) {
            const int l = it / 192, cg_ = it % 192, col = cg_ * 64 + F.lane;
            const float* W = F.in[I_WADA] + (size_t)l * 2048 * 12288 + col;
            float acc[5] = {0.f, 0.f, 0.f, 0.f, 0.f};
            const int kbeg = F.wave * 256;
#pragma unroll 2
            for (int k = kbeg; k < kbeg + 256; k += 4) {
                const float w0 = W[(size_t)(k + 0) * 12288], w1 = W[(size_t)(k + 1) * 12288], w2 = W[(size_t)(k + 2) * 12288], w3 = W[(size_t)(k + 3) * 12288];
#pragma unroll
                for (int v = 0; v < 5; ++v) { const f32x4 s = *(const LAS f32x4*)(sc + v * 2048 + k); acc[v] += s.x * w0 + s.y * w1 + s.z * w2 + s.w * w3; }
            }
#pragma unroll
            for (int v = 0; v < 5; ++v) red[(F.wave * 5 + v) * 64 + F.lane] = acc[v];
            __syncthreads();
            if (F.tid < 320) { const int v = F.tid >> 6, c = F.tid & 63; float s = 0.f;
#pragma unroll
                for (int w = 0; w < 8; ++w) s += red[(w * 5 + v) * 64 + c];
                const int cc = cg_ * 64 + c;
                ((float*)(F.ws + WS_MOD))[(size_t)(l * 5 + v) * 12288 + cc] = s + F.in[I_BADA][l * 12288 + cc]; }
            __syncthreads();
        }
    }
    __syncthreads();
    {
        const int gt = blockIdx.x * NTHREADS + F.tid, GT = F.G * NTHREADS;
        for (int i = gt; i < 2 * 24576; i += GT) { const int l = i / 24576, r = i % 24576;
            *(u32x4*)(F.ws + WS_WIN + (size_t)l * SZ_WIN + (size_t)4768 * 2048 * 2 + (size_t)r * 16) = (u32x4){0u, 0u, 0u, 0u}; }
    }
    {
        LAS float* scr = (LAS float*)(F.lds + F.wave * 16384);
        const int gw = blockIdx.x * NWAVES + F.wave, NGW = F.G * NWAVES;
        constexpr int I_IN = 32 * 149, I_OUT = 32 * 64, I_G = 32 * 176, I_DN = 88 * 64, PER_L = I_IN + I_OUT + 2 * I_G + I_DN;
        for (int it = gw; it < 2 * PER_L; it += NGW) {
            const int l = it / PER_L; int r = it % PER_L;
            if (r < I_IN) { const int kb = r / 149, nb = r % 149;
                p0_transpose_item(F.in[I_WIN] + (size_t)l * 2048 * DIN, 2048, DIN, (bf16_t*)(F.ws + WS_WIN + l * SZ_WIN), kb, nb, 32 * nb, scr, F.lane); continue; }
            r -= I_IN;
            if (r < I_OUT) { const int kb = r / 64, nb = r % 64;
                p0_transpose_item(F.in[I_WOUT] + (size_t)l * 2048 * 2048, 2048, 2048, (bf16_t*)(F.ws + WS_WOUT + l * SZ_WOUT), kb, nb, 32 * nb, scr, F.lane); continue; }
            r -= I_OUT;
            if (r < 2 * I_G) { const int up = r >= I_G; if (up) r -= I_G; const int kb = r / 176, nb = r % 176, n0 = 32 * nb;
                p0_transpose_item(F.in[up ? I_WUPF : I_WGATE] + (size_t)l * 2048 * DFF, 2048, DFF, (bf16_t*)(F.ws + WS_WGU + l * SZ_WGU), kb, nb, (n0 >> 7) * 256 + (up ? 128 : 0) + (n0 & 127), scr, F.lane); continue; }
            r -= 2 * I_G;
            { const int kb = r / 64, nb = r % 64;
                p0_transpose_item(F.in[I_WDOWN] + (size_t)l * DFF * 2048, DFF, 2048, (bf16_t*)(F.ws + WS_WDN + l * SZ_WDN), kb, nb, 32 * nb, scr, F.lane); }
        }
    }
}

__device__ __forceinline__ const float* mod_vec(const Frame& F, int l, int m, int which) {
    const int v = m < MC ? 0 : 1 + ((m - MC) >> 10);
    return (const float*)(F.ws + WS_MOD) + (size_t)(l * 5 + v) * 12288 + which * 2048;
}
__device__ __forceinline__ const float* x_in_row(const Frame& F, int m) { return m < MC ? F.in[I_XP] + (size_t)m * DM : F.in[I_XS] + (size_t)(m - MC) * DM; }
__device__ __forceinline__ float row_ss(const f32x4 (&v)[8]) {
    float s = 0.f;
#pragma unroll
    for (int j = 0; j < 8; ++j) s += (v[j].x * v[j].x + v[j].y * v[j].y) + (v[j].z * v[j].z + v[j].w * v[j].w);
    return wave_sum(s);
}
__device__ __forceinline__ void write_h(const Frame& F, const f32x4 (&x)[8], float rs, const float* ng, const float* sc, const float* sh, bf16_t* hrow) {
#pragma unroll
    for (int j = 0; j < 8; ++j) { const int o = F.lane + 64 * j;
        const f32x4 g = ((const f32x4*)ng)[o], s = ((const f32x4*)sc)[o], b = ((const f32x4*)sh)[o];
        const f32x4 h = x[j] * rs * g * (1.0f + s) + b;
        u32x2 w; w.x = pk2(h.x, h.y); w.y = pk2(h.z, h.w); ((u32x2*)hrow)[o] = w; }
}
__device__ __forceinline__ void rowpass0(Frame& F) {
    const int gw = blockIdx.x * NWAVES + F.wave, NGW = F.G * NWAVES;
    for (int m = gw; m < MT; m += NGW) {
        const f32x4* xr = (const f32x4*)x_in_row(F, m); f32x4 x[8];
#pragma unroll
        for (int j = 0; j < 8; ++j) x[j] = xr[F.lane + 64 * j];
        const float rs = rsqrtf(row_ss(x) * (1.0f / DM) + EPS);
        write_h(F, x, rs, F.in[I_NG] + 0, mod_vec(F, 0, m, 1), mod_vec(F, 0, m, 0), (bf16_t*)(F.ws + WS_HB) + (size_t)m * DM);
    }
}
__device__ __forceinline__ void rowpassA(Frame& F, int l) {
    const int gw = blockIdx.x * NWAVES + F.wave, NGW = F.G * NWAVES;
    const float* ng = F.in[I_NG] + (size_t)l * 4 * DM;
    for (int m = gw; m < MT; m += NGW) {
        const f32x4* orow = (const f32x4*)(F.ws + WS_OB) + (size_t)m * (DM / 4);
        const f32x4* xr = l == 0 ? (const f32x4*)x_in_row(F, m) : (const f32x4*)(F.ws + WS_XB) + (size_t)m * (DM / 4);
        f32x4 o[8], x[8];
#pragma unroll
        for (int j = 0; j < 8; ++j) { o[j] = orow[F.lane + 64 * j]; x[j] = xr[F.lane + 64 * j]; }
        const float r1 = rsqrtf(row_ss(o) * (1.0f / DM) + EPS);
        const float* ga = mod_vec(F, l, m, 2);
        f32x4* xo = (f32x4*)(F.ws + WS_XB) + (size_t)m * (DM / 4);
#pragma unroll
        for (int j = 0; j < 8; ++j) { const int q = F.lane + 64 * j; x[j] = x[j] + ((const f32x4*)ga)[q] * (o[j] * r1 * ((const f32x4*)(ng + DM))[q]); xo[q] = x[j]; }
        const float r2 = rsqrtf(row_ss(x) * (1.0f / DM) + EPS);
        write_h(F, x, r2, ng + 2 * DM, mod_vec(F, l, m, 4), mod_vec(F, l, m, 3), (bf16_t*)(F.ws + WS_HB) + (size_t)m * DM);
    }
}
__device__ __forceinline__ void rowpassB(Frame& F, int l) {
    const int gw = blockIdx.x * NWAVES + F.wave, NGW = F.G * NWAVES;
    const float* ng = F.in[I_NG] + (size_t)l * 4 * DM;
    for (int m = gw; m < MT; m += NGW) {
        const f32x4* orow = (const f32x4*)(F.ws + WS_OB) + (size_t)m * (DM / 4);
        const f32x4* xr = (const f32x4*)(F.ws + WS_XB) + (size_t)m * (DM / 4);
        f32x4 o[8], x[8];
#pragma unroll
        for (int j = 0; j < 8; ++j) { o[j] = orow[F.lane + 64 * j]; x[j] = xr[F.lane + 64 * j]; }
        const float r1 = rsqrtf(row_ss(o) * (1.0f / DM) + EPS);
        const float* gf = mod_vec(F, l, m, 5);
        f32x4* xo = (l == DEPTH - 1) ? (f32x4*)(F.out + OUT_Y) + (size_t)m * (DM / 4) : (f32x4*)(F.ws + WS_XB) + (size_t)m * (DM / 4);
#pragma unroll
        for (int j = 0; j < 8; ++j) { const int q = F.lane + 64 * j; x[j] = x[j] + ((const f32x4*)gf)[q] * (o[j] * r1 * ((const f32x4*)(ng + 3 * DM))[q]); xo[q] = x[j]; }
        if (l < DEPTH - 1) {
            const float r2 = rsqrtf(row_ss(x) * (1.0f / DM) + EPS);
            write_h(F, x, r2, ng + 4 * DM, mod_vec(F, l + 1, m, 1), mod_vec(F, l + 1, m, 0), (bf16_t*)(F.ws + WS_HB) + (size_t)m * DM);
        }
    }
}

__device__ __forceinline__ void p2_prepass(Frame& F, int l) {
    const bf16_t* PROJ = (const bf16_t*)(F.ws + WS_PROJ);
    bf16_t* QB = (bf16_t*)(F.ws + WS_QB); bf16_t* KB = (bf16_t*)(F.ws + WS_KB); bf16_t* VB = (bf16_t*)(F.ws + WS_VB); bf16_t* MIX = (bf16_t*)(F.ws + WS_MIX);
    float* SCAN = (float*)(F.ws + WS_SCAN); float* GB = (float*)(F.ws + WS_GB); float* BON = (float*)(F.ws + WS_BON);
    for (int pi = blockIdx.x * NTHREADS + F.tid; pi < 131072; pi += F.G * NTHREADS) {
        const int e = 2 * pi, b = e >> 16, rem = e & 65535, p = rem >> 8, col = rem & 255;
        const size_t src = ((size_t)(b * 2 + l) * 256 + p) * 256 + col, dst = (size_t)(MC + b * 1280 + 1024 + p) * 256 + col;
        const f32x2 kv = *(const f32x2*)(F.in[I_CK] + src), vv = *(const f32x2*)(F.in[I_CV] + src);
        *(unsigned*)(KB + dst) = pk2(kv.x, kv.y); *(unsigned*)(VB + dst) = pk2(vv.x, vv.y);
    }
    for (int item = blockIdx.x; item < MT / 32; item += F.G) {
        asm volatile("" ::: "memory");
        int tid = F.tid; asm volatile("" : "+v"(tid)); const int lane = tid & 63;
        const int m0 = item * 32; const bool smp = m0 >= MC;
        const int sb = smp ? (m0 - MC) >> 10 : m0 >> 8, t0 = smp ? (m0 - MC) & 1023 : m0 & 255, seqlen = smp ? 1024 : 256;
#if PP_MASK & 1
        for (int wi = F.wave; wi < 32 * 12; wi += NWAVES) {
            const int tok = wi / 12, j = wi % 12, m = m0 + tok, t = t0 + tok;
            const bf16_t* prow = PROJ + (size_t)m * DINP;
            const size_t krow = smp ? (size_t)(MC + sb * 1280 + t) : (size_t)m;
            if (j < 10) {
                const int col0 = j < 8 ? j * 128 : O_K + (j - 8) * 128;
                const float* g = (j < 8 ? F.in[I_QN] : F.in[I_KN]) + l * 128;
                const int e1 = lane < 32 ? lane : lane + 32, e2 = e1 + 32;
                const float x1 = bf2f(prow[col0 + e1]), x2 = bf2f(prow[col0 + e2]);
                const float rs = rsqrtf(wave_sum(x1 * x1 + x2 * x2) * (1.0f / 128.0f) + EPS);
                float y1 = x1 * rs * g[e1], y2 = x2 * rs * g[e2];
                if (!smp && j >= 8) { float* nk = F.out + OUT_NK + ((size_t)(sb * 2 + l) * 256 + t) * 256 + (j - 8) * 128; nk[e1] = y1; nk[e2] = y2; }
                if (smp) {
                    const float pos = (float)(lane < 32 ? (t >> 6) : (t & 63));
                    const float inv = exp2f(-(float)(2 * (lane & 31)) * (13.287712379549449f / 64.0f));
                    const float ang = pos * inv; float rev = ang * 0.15915494309189535f; rev = rev - floorf(rev);
                    const float s = __builtin_amdgcn_sinf(rev), c = __builtin_amdgcn_cosf(rev);
                    const float o1 = y1 * c - y2 * s, o2 = y2 * c + y1 * s; y1 = o1; y2 = o2;
                }
                bf16_t* dst = j < 8 ? QB + (size_t)m * 1024 + j * 128 : KB + krow * 256 + (j - 8) * 128;
                dst[e1] = f2bf(y1); dst[e2] = f2bf(y2);
            } else {
                const int kvh = j - 10; const unsigned u = *(const unsigned*)(prow + O_V + kvh * 128 + 2 * lane);
                *(unsigned*)(VB + krow * 256 + kvh * 128 + 2 * lane) = u;
                if (!smp) { float* nv = F.out + OUT_NV + ((size_t)(sb * 2 + l) * 256 + t) * 256 + kvh * 128 + 2 * lane; nv[0] = __uint_as_float(u << 16); nv[1] = __uint_as_float(u & 0xffff0000u); }
            }
        }
#endif
#if PP_MASK & 2
        {
            const int c = tid; const float* cw = F.in[I_CONVW] + (size_t)l * 3 * 512;
            const float w0 = cw[c], w1 = cw[512 + c], w2 = cw[1024 + c];
            const bf16_t* pr = PROJ + (size_t)m0 * DINP;
            float prev = t0 > 0 ? bf2f(pr[-DINP + O_CC + c]) * bf2f(pr[-DINP + O_CH + c]) : 0.f;
            float cur = bf2f(pr[O_CC + c]) * bf2f(pr[O_CH + c]);
#pragma unroll 1
            for (int tok = 0; tok < 32; ++tok) {
                const bf16_t* p = pr + (size_t)tok * DINP;
                const float nxt = (t0 + tok + 1 < seqlen) ? bf2f(p[DINP + O_CC + c]) * bf2f(p[DINP + O_CH + c]) : 0.f;
                const float o = bf2f(p[O_CB + c]) * (w0 * prev + w1 * cur + w2 * nxt);
                MIX[(size_t)(m0 + tok) * DM + 1024 + c] = f2bf(o);
                prev = cur; cur = nxt;
            }
        }
#endif
        LAS float* sm = (LAS float*)F.lds;
        const float* mu = F.in[I_MU] + (size_t)l * 1696;
        __syncthreads();
        for (int idx = tid; idx < 32 * 160; idx += NTHREADS) {
            const int tok = idx / 160, k = idx % 160, col = 1536 + k, t = t0 + tok;
            const bf16_t* p = PROJ + (size_t)(m0 + tok) * DINP + O_UR + col;
            const float u = bf2f(p[0]), up = t > 0 ? bf2f(p[-DINP]) : 0.f, un = t + 1 < seqlen ? bf2f(p[DINP]) : 0.f;
            const float us = u + mu[col] * (0.5f * (up + un) - u);
            sm[idx] = k < 32 ? tanhf(us) : (k < 64 ? us : sigmoidf_(us));
        }
        __syncthreads();
        const int c = tid, h = F.wave, i = lane;
#if PP_MASK & 4
        {
            asm volatile("" ::: "memory");
            float wa0[32], wa1[32];
            const float* au = F.in[I_AUP] + (size_t)l * 2 * 32 * 512 + c;
#pragma unroll
            for (int k = 0; k < 32; ++k) { wa0[k] = au[0]; wa1[k] = au[32 * 512]; au += 512; asm volatile("" : "+v"(au)); }
            const float a0b0 = F.in[I_A0][(l * 2 + 0) * 512 + c], a0b1 = F.in[I_A0][(l * 2 + 1) * 512 + c];
            const float kkc = F.in[I_KK][l * 512 + c], kac = F.in[I_KA][l * 512 + c], rkc = F.in[I_RK][l * 512 + c];
            const float mur = mu[c], muk = mu[512 + c], muv = mu[1024 + c];
            const bf16_t* pr = PROJ + (size_t)m0 * DINP + O_UR + c;
            float pr_r = 0.f, pr_k = 0.f, pr_v = 0.f;
            if (t0 > 0) { pr_r = bf2f(pr[-DINP]); pr_k = bf2f(pr[-DINP + 512]); pr_v = bf2f(pr[-DINP + 1024]); }
            float cu_r = bf2f(pr[0]), cu_k = bf2f(pr[512]), cu_v = bf2f(pr[1024]);
#pragma unroll 1
            for (int tok = 0; tok < 32; ++tok) {
                const bf16_t* p = pr + (size_t)tok * DINP; const int m = m0 + tok;
                float nx_r = 0.f, nx_k = 0.f, nx_v = 0.f;
                if (t0 + tok + 1 < seqlen) { nx_r = bf2f(p[DINP]); nx_k = bf2f(p[DINP + 512]); nx_v = bf2f(p[DINP + 1024]); }
                const float r = cu_r + mur * (0.5f * (pr_r + nx_r) - cu_r), k = cu_k + muk * (0.5f * (pr_k + nx_k) - cu_k), v = cu_v + muv * (0.5f * (pr_v + nx_v) - cu_v);
                pr_r = cu_r; pr_k = cu_k; pr_v = cu_v; cu_r = nx_r; cu_k = nx_k; cu_v = nx_v;
                const float kkr = k * kkc; const float kk = kkr * rsqrtf(wave_sum(kkr * kkr) + 1e-12f);
                float za0 = a0b0, za1 = a0b1; const LAS float* xa = sm + tok * 160 + 32;
#pragma unroll
                for (int q = 0; q < 8; ++q) { const f32x4 s = *(const LAS f32x4*)(xa + 4 * q);
                    za0 += s.x * wa0[4 * q] + s.y * wa0[4 * q + 1] + s.z * wa0[4 * q + 2] + s.w * wa0[4 * q + 3];
                    za1 += s.x * wa1[4 * q] + s.y * wa1[4 * q + 1] + s.z * wa1[4 * q + 2] + s.w * wa1[4 * q + 3]; }
                const float a0 = sigmoidf_(za0), a1 = sigmoidf_(za1);
                const float kd0 = k * (1.0f + (a0 - 1.0f) * kac), kd1 = k * (1.0f + (a1 - 1.0f) * kac);
                const float bs = wave_sum(r * (kd0 + kd1) * rkc);
                float* base = SCAN + ((size_t)m * 8 + h) * 576 + i;
                base[0] = r; base[64] = v; base[128] = kk; base[256] = kd0; base[320] = kk * a0; base[448] = kd1; base[512] = kk * a1;
                BON[(size_t)m * 512 + c] = bs * v;
            }
        }
#endif
#if PP_MASK & 8
        {
            asm volatile("" ::: "memory");
            float ww0[32], ww1[32];
            const float* wu = F.in[I_WUP] + (size_t)l * 2 * 32 * 512 + c;
#pragma unroll
            for (int k = 0; k < 32; ++k) { ww0[k] = wu[0]; ww1[k] = wu[32 * 512]; wu += 512; asm volatile("" : "+v"(wu)); }
            const float b0 = F.in[I_W0][(l * 2 + 0) * 512 + c], b1 = F.in[I_W0][(l * 2 + 1) * 512 + c];
#pragma unroll 1
            for (int tok = 0; tok < 32; ++tok) {
                float z0 = b0, z1 = b1; const LAS float* xw = sm + tok * 160;
#pragma unroll
                for (int q = 0; q < 8; ++q) { const f32x4 s = *(const LAS f32x4*)(xw + 4 * q);
                    z0 += s.x * ww0[4 * q] + s.y * ww0[4 * q + 1] + s.z * ww0[4 * q + 2] + s.w * ww0[4 * q + 3];
                    z1 += s.x * ww1[4 * q] + s.y * ww1[4 * q + 1] + s.z * ww1[4 * q + 2] + s.w * ww1[4 * q + 3]; }
                const float sp0 = fmaxf(-z0, 0.f) + log1pf(__expf(-fabsf(z0))), sp1 = fmaxf(-z1, 0.f) + log1pf(__expf(-fabsf(z1)));
                float* base = SCAN + ((size_t)(m0 + tok) * 8 + h) * 576 + i;
                base[192] = __expf(-__expf(-sp0 - 0.5f)); base[384] = __expf(-__expf(-sp1 - 0.5f));
            }
        }
#endif
#if PP_MASK & 16
        {
            asm volatile("" ::: "memory");
            float wg[96];
            const float* gu = F.in[I_GUP] + (size_t)l * 96 * 512 + c;
#pragma unroll
            for (int k = 0; k < 96; ++k) { wg[k] = gu[0]; gu += 512; asm volatile("" : "+v"(gu)); }
#pragma unroll 1
            for (int tok = 0; tok < 32; ++tok) {
                float g = 0.f; const LAS float* xg = sm + tok * 160 + 64;
#pragma unroll
                for (int q = 0; q < 24; ++q) { const f32x4 s = *(const LAS f32x4*)(xg + 4 * q); g += s.x * wg[4 * q] + s.y * wg[4 * q + 1] + s.z * wg[4 * q + 2] + s.w * wg[4 * q + 3]; }
                GB[(size_t)(m0 + tok) * 512 + c] = g;
            }
        }
#endif
        __syncthreads();
    }
}

__device__ __forceinline__ void scan_item(Frame& F, int l, bool smp, int b, int h, int d) {
    int tid = F.tid; asm volatile("" : "+v"(tid));
    const int seqlen = smp ? 1024 : 256, seq_base = smp ? MC + b * 1024 : b * 256, nch = seqlen / 16;
    const int p = tid >> 4, c = tid & 15, i0 = p, i1 = p + 32;
    f32x4 s0 = {0.f, 0.f, 0.f, 0.f}, s1 = {0.f, 0.f, 0.f, 0.f};
    if (smp) { const float* S0 = F.in[I_ST] + ((((size_t)b * 2 + l) * 2 + d) * 8 + h) * 4096; s0 = *(const f32x4*)(S0 + i0 * 64 + 4 * c); s1 = *(const f32x4*)(S0 + i1 * 64 + 4 * c); }
    LAS float* opb = (LAS float*)F.lds;
    LAS float* yb = opb + 2 * 6144;
    const float* SCAN = (const float*)(F.ws + WS_SCAN); float* YB = (float*)(F.ws + WS_YB) + (size_t)d * MT * 512;
    int sst[3], soff[3];
#pragma unroll
    for (int j = 0; j < 3; ++j) { const int e4 = tid + 512 * j, s = e4 / 96, rem = e4 % 96, vec = rem >> 4, q4 = rem & 15; sst[j] = s; soff[j] = (vec < 3 ? vec : 3 + 3 * d + (vec - 3)) * 64 + 4 * q4; }
    f32x4 stg[3];
#define SCAN_TOK(ci, s) (d ? seqlen - 1 - ((ci) * 16 + (s)) : (ci) * 16 + (s))
#define SCAN_LOAD(ci) do { _Pragma("unroll") for (int j = 0; j < 3; ++j) stg[j] = *(const f32x4*)(SCAN + ((size_t)(seq_base + SCAN_TOK(ci, sst[j])) * 8 + h) * 576 + soff[j]); } while (0)
#define SCAN_STORE(buf) do { _Pragma("unroll") for (int j = 0; j < 3; ++j) *(LAS f32x4*)(opb + (buf) * 6144 + (tid + 512 * j) * 4) = stg[j]; } while (0)
    __syncthreads();
    SCAN_LOAD(0); SCAN_STORE(0);
    __syncthreads();
    for (int ci = 0; ci < nch; ++ci) {
        if (ci + 1 < nch) SCAN_LOAD(ci + 1);
        const LAS float* ob = opb + (ci & 1) * 6144;
#pragma unroll 4
        for (int s = 0; s < 16; ++s) {
            const LAS float* o = ob + s * 384;
            const f32x4 r4 = *(const LAS f32x4*)(o + 4 * c), kk4 = *(const LAS f32x4*)(o + 128 + 4 * c), w4 = *(const LAS f32x4*)(o + 192 + 4 * c);
            const f32x4 kd4 = *(const LAS f32x4*)(o + 256 + 4 * c), ka4 = *(const LAS f32x4*)(o + 320 + 4 * c);
            const float v0 = o[64 + i0], v1 = o[64 + i1];
            float d0 = (s0.x * kk4.x + s0.y * kk4.y) + (s0.z * kk4.z + s0.w * kk4.w), d1 = (s1.x * kk4.x + s1.y * kk4.y) + (s1.z * kk4.z + s1.w * kk4.w);
            d0 = row16_sum(d0); d1 = row16_sum(d1);
            s0 = s0 * w4 + (ka4 * (-d0) + kd4 * v0);
            s1 = s1 * w4 + (ka4 * (-d1) + kd4 * v1);
            float y0 = (s0.x * r4.x + s0.y * r4.y) + (s0.z * r4.z + s0.w * r4.w), y1 = (s1.x * r4.x + s1.y * r4.y) + (s1.z * r4.z + s1.w * r4.w);
            y0 = row16_sum(y0); y1 = row16_sum(y1);
            if (c == 0) { yb[s * 64 + i0] = y0; yb[s * 64 + i1] = y1; }
        }
        __syncthreads();
        if (tid < 256) { const int s = tid >> 4, i4 = tid & 15; const f32x4 v = *(const LAS f32x4*)(yb + s * 64 + 4 * i4);
            *(f32x4*)(YB + (size_t)(seq_base + SCAN_TOK(ci, s)) * 512 + h * 64 + 4 * i4) = v; }
        if (ci + 1 < nch) SCAN_STORE((ci + 1) & 1);
        __syncthreads();
    }
    if (!smp) { float* O = F.out + OUT_ST + ((((size_t)b * 2 + l) * 2 + d) * 8 + h) * 4096; *(f32x4*)(O + i0 * 64 + 4 * c) = s0; *(f32x4*)(O + i1 * 64 + 4 * c) = s1; }
#undef SCAN_TOK
#undef SCAN_LOAD
#undef SCAN_STORE
}

__device__ __forceinline__ void mixer_phase(Frame& F, int l) {
    unsigned* head = (unsigned*)(F.ws + WS_CTL) + CW_QUEUE + 64 * l;
    volatile LAS unsigned* slot = (volatile LAS unsigned*)(F.lds + MISC_OFF);
    const bf16_t* QB = (const bf16_t*)(F.ws + WS_QB); const bf16_t* KB = (const bf16_t*)(F.ws + WS_KB); const bf16_t* VB = (const bf16_t*)(F.ws + WS_VB); bf16_t* MIX = (bf16_t*)(F.ws + WS_MIX);
    for (;;) {
        __syncthreads();
        if (F.tid == 0) slot[0] = atomicAdd(head, 1u);
        __syncthreads();
        const int item = (int)slot[0];
        if (item >= 576) break;
        const bool is_scan = item < 64 || (item >= 192 && item < 448);
        if (is_scan) { const bool smp = item < 64; const int u = smp ? item : item - 192; scan_item(F, l, smp, u >> 4, (u >> 1) & 7, u & 1); }
        else {
            size_t row0, kr0; int hq, seq;
            if (item < 192) { const int u = item - 64, b = u >> 5, qb = u & 3; hq = (u >> 2) & 7; row0 = (size_t)MC + b * 1024 + qb * 256; kr0 = (size_t)MC + b * 1280; seq = 1280; }
            else { const int u = item - 448, b = u >> 3; hq = u & 7; row0 = (size_t)b * 256; kr0 = row0; seq = 256; }
            attn::attn_dense_body<attn::bf16>((const attn::bf16*)(QB + row0 * 1024 + hq * 128), (const attn::bf16*)(KB + kr0 * 256 + (hq >> 2) * 128), (const attn::bf16*)(VB + kr0 * 256 + (hq >> 2) * 128), MIX + row0 * DM + hq * 128, seq, (char*)F.ldsg);
        }
    }
}
__device__ __forceinline__ void rwkv_combine(Frame& F, int l) {
    const float* Y0 = (const float*)(F.ws + WS_YB); const float* Y1 = Y0 + (size_t)MT * 512;
    const float* GB = (const float*)(F.ws + WS_GB); const float* BON = (const float*)(F.ws + WS_BON); bf16_t* MIX = (bf16_t*)(F.ws + WS_MIX);
    const int c = F.tid; const float lg = F.in[I_LNG][l * 512 + c], lb = F.in[I_LNB][l * 512 + c];
    for (int item = blockIdx.x; item < MT / 32; item += F.G)
        for (int tok = 0; tok < 32; ++tok) { const size_t m = (size_t)item * 32 + tok;
            const float y = Y0[m * 512 + c] + Y1[m * 512 + c];
            const float mean = wave_sum(y) * (1.0f / 64.0f), dl = y - mean, var = wave_sum(dl * dl) * (1.0f / 64.0f);
            const float yn = dl * rsqrtf(var + GN_EPS) * lg + lb;
            MIX[m * DM + 1536 + c] = f2bf((yn + BON[m * 512 + c]) * GB[m * 512 + c]); }
}

constexpr int NPHASE = 2 + 9 * DEPTH;
#ifndef PH_MASK
#define PH_MASK 0xffff
#endif
#if ONE_LAUNCH
#define GRID_BAR() cg::this_grid().sync()
#else
#define GRID_BAR() do {} while (0)
#endif
#define IN(k) (lo <= (k) && (k) < hi)
#define SEAM(k) do { if (IN(k) && IN((k) + 1)) GRID_BAR(); } while (0)
template <int L> __device__ __forceinline__ void layer_phases(Frame& F, const int lo, const int hi) {
    constexpr int l = L, pb = 2 + 9 * L;
    if (IN(pb + 0) && (PH_MASK & 4)) {
        pg8::Gemm g{(const bf16_t*)(F.ws + WS_HB), (const bf16_t*)(F.ws + WS_WIN + l * SZ_WIN), MT, DINP, DM}; pg8::StaticOrder S; S.init(MT, DINP, F.G, (int)blockIdx.x);
        pg8::EpiBf16 E{(bf16_t*)(F.ws + WS_PROJ), DINP};
        pg8::gemm_phase<pg8::EpiBf16, pg8::StaticOrder, true, true>(F.lds, g, S, E);
    } SEAM(pb + 0);
    if (IN(pb + 1) && (PH_MASK & 8)) { p2_prepass(F, l); } SEAM(pb + 1);
    if (IN(pb + 2) && (PH_MASK & 16)) { mixer_phase(F, l); } SEAM(pb + 2);
    if (IN(pb + 3) && (PH_MASK & 32)) { rwkv_combine(F, l); } SEAM(pb + 3);
    if (IN(pb + 4) && (PH_MASK & 64)) {
        pg8::Gemm g{(const bf16_t*)(F.ws + WS_MIX), (const bf16_t*)(F.ws + WS_WOUT + l * SZ_WOUT), MT, DM, DM}; pg8::StaticOrder S; S.init(MT, DM, F.G, (int)blockIdx.x);
        pg8::EpiF32 E{(float*)(F.ws + WS_OB), DM};
        pg8::gemm_phase<pg8::EpiF32, pg8::StaticOrder, true, true>(F.lds, g, S, E);
    } SEAM(pb + 4);
    if (IN(pb + 5) && (PH_MASK & 128)) { rowpassA(F, l); } SEAM(pb + 5);
    if (IN(pb + 6) && (PH_MASK & 256)) {
        pg8::Gemm g{(const bf16_t*)(F.ws + WS_HB), (const bf16_t*)(F.ws + WS_WGU + l * SZ_WGU), MT, 2 * DFF, DM}; pg8::StaticOrder S; S.init(MT, 2 * DFF, F.G, (int)blockIdx.x);
        pg8::EpiSwiGLU E{(bf16_t*)(F.ws + WS_HID), DFF};
        pg8::gemm_phase<pg8::EpiSwiGLU, pg8::StaticOrder, true, true>(F.lds, g, S, E);
    } SEAM(pb + 6);
    if (IN(pb + 7) && (PH_MASK & 512)) {
        pg8::Gemm g{(const bf16_t*)(F.ws + WS_HID), (const bf16_t*)(F.ws + WS_WDN + l * SZ_WDN), MT, DM, DFF}; pg8::StaticOrder S; S.init(MT, DM, F.G, (int)blockIdx.x);
        pg8::EpiF32 E{(float*)(F.ws + WS_OB), DM};
        pg8::gemm_phase<pg8::EpiF32, pg8::StaticOrder, true, true>(F.lds, g, S, E);
    } SEAM(pb + 7);
    if (IN(pb + 8) && (PH_MASK & 1024)) { rowpassB(F, l); } SEAM(pb + 8);
}
__global__ void __launch_bounds__(NTHREADS, 2) hybrid_fwd(Args args) {
    extern __shared__ __attribute__((aligned(16))) unsigned char lds[];
    Frame F;
    F.lds = (LAS unsigned char*)lds; F.ldsg = lds; F.in = args.in; F.out = args.out; F.ws = args.ws;
    F.tid = threadIdx.x; F.lane = F.tid & 63; F.wave = __builtin_amdgcn_readfirstlane(F.tid >> 6); F.G = gridDim.x;
    const int lo = args.ph_lo, hi = args.ph_hi;
    if (IN(0) && (PH_MASK & 1)) { p0_prologue(F); } SEAM(0);
    if (IN(1) && (PH_MASK & 2)) { rowpass0(F); } SEAM(1);
    layer_phases<0>(F, lo, hi);
    layer_phases<1>(F, lo, hi);
}
#undef IN
#undef SEAM

extern "C" void kernel_launch(void* const* d_in, const int* in_sizes, int n_in, void* d_out, int out_size, void* d_ws, size_t ws_size, hipStream_t stream) {
    static int grid = 0;
    if (grid == 0) {
        if (n_in != N_IN || (size_t)out_size != OUT_TOTAL || ws_size < WS_END) { fprintf(stderr, "kernel_launch: unexpected shapes: n_in %d out %d ws %zu (need %zu)\n", n_in, out_size, ws_size, (size_t)WS_END); grid = -1; return; }
        int dev = 0, cus = 0, per_cu = 0;
        if (hipGetDevice(&dev) != hipSuccess || hipDeviceGetAttribute(&cus, hipDeviceAttributeMultiprocessorCount, dev) != hipSuccess) { grid = -1; return; }
        if (hipFuncSetAttribute((const void*)hybrid_fwd, hipFuncAttributeMaxDynamicSharedMemorySize, LDS_BYTES) != hipSuccess) { fprintf(stderr, "kernel_launch: hipFuncSetAttribute failed\n"); grid = -1; return; }
        if (hipOccupancyMaxActiveBlocksPerMultiprocessor(&per_cu, (const void*)hybrid_fwd, NTHREADS, LDS_BYTES) != hipSuccess || per_cu < 1) { fprintf(stderr, "kernel_launch: occupancy query says %d blocks per CU\n", per_cu); (void)hipGetLastError(); grid = -1; return; }
        grid = cus;
    }
    if (grid < 0) return;
    (void)hipMemsetAsync((char*)d_ws + WS_CTL, 0, CTL_BYTES, stream);
    Args a{};
    for (int i = 0; i < N_IN; ++i) a.in[i] = (const float*)d_in[i];
    a.out = (float*)d_out; a.ws = (unsigned char*)d_ws;
#if ONE_LAUNCH
    a.ph_lo = 0; a.ph_hi = NPHASE;
    void* kargs[] = {&a};
    const hipError_t e = hipLaunchCooperativeKernel((const void*)hybrid_fwd, dim3(grid), dim3(NTHREADS), kargs, LDS_BYTES, stream);
    if (e != hipSuccess) fprintf(stderr, "kernel_launch: cooperative launch failed: %s (grid %d)\n", hipGetErrorString(e), grid);
#else
    for (int ph = 0; ph < NPHASE; ++ph) {
        a.ph_lo = ph; a.ph_hi = ph + 1;
        hipLaunchKernelGGL(hybrid_fwd, dim3(grid), dim3(NTHREADS), LDS_BYTES, stream, a);
    }
    const hipError_t le = hipPeekAtLastError();
    if (le != hipSuccess) fprintf(stderr, "kernel_launch: launch failed: %s\n", hipGetErrorName(le));
#endif
}
```

```cpp
#include <hip/hip_runtime.h>
#include <hip/hip_bf16.h>
#include <hip/hip_cooperative_groups.h>
#include <cstdio>
#include <cstdint>
#include <cmath>
namespace cg = cooperative_groups;
#ifndef ONE_LAUNCH
#define ONE_LAUNCH 1
#endif
namespace pg8 {
#define PG8_LAS __attribute__((address_space(3)))
typedef unsigned short bf16_t;
typedef short bf16x8 __attribute__((ext_vector_type(8)));
typedef float f32x4 __attribute__((ext_vector_type(4)));
typedef unsigned u32x4 __attribute__((ext_vector_type(4)));
constexpr int BM = 256, BK = 64, HALF = 128, HTB = HALF * BK * 2  , STAGE_BYTES = 8 * HTB, NXCD = 8, WGM = 8;

__host__ __device__ __forceinline__ int lds_byte(int r, int c) { const int st = (r >> 4) * 2 + (c >> 5), rr = r & 15, cc = c & 31, ob = rr * 64 + cc * 2; return st * 1024 + (ob ^ (((ob >> 9) & 1) << 5)); }
__host__ __device__ __forceinline__ void stage_rc(int b, int& R, int& C) { const int st = b / 1024, sb = b % 1024, swz = sb ^ (((sb >> 9) & 1) << 5); R = (st >> 1) * 16 + swz / 64; C = (st & 1) * 32 + (swz % 64) / 2; }
__host__ __device__ __forceinline__ int perm32(int rho) { const int n = rho >> 4, i = rho & 15; return 8 * (i >> 2) + 4 * n + (i & 3); }

struct Unit { int pm, pn; };
struct Gemm { const bf16_t* A; const bf16_t* Bt; int M, N, K; };

struct StaticOrder {
    int nM, nN, nwg, G, c;
    __host__ __device__ void init(int M, int N, int G_, int c_) { nM = M / BM; nN = N / BM; nwg = nM * nN; G = G_; c = c_; }
    __host__ __device__ bool next(int i, Unit& u) const {
        const long L = (long)i * G + c; if (L >= nwg) return false;
        int wgid = (int)L; { const int q = nwg / NXCD, r = nwg % NXCD, xcd = wgid % NXCD, off = wgid / NXCD; wgid = (xcd < r ? xcd * (q + 1) : r * (q + 1) + (xcd - r) * q) + off; }
        const int nig = WGM * nN, gid = wgid / nig, fm = gid * WGM, gsz = (nM - fm) < WGM ? (nM - fm) : WGM;
        u.pm = fm + ((wgid % nig) % gsz); u.pn = (wgid % nig) / gsz; return true;
    }
    __device__ __forceinline__ void a_ready(const Unit&) const {}
    __device__ __forceinline__ void done(const Unit&) const {}
};

__device__ __forceinline__ unsigned cvt_pk_bf16(float lo, float hi) { unsigned r; asm volatile("v_cvt_pk_bf16_f32 %0, %1, %2" : "=v"(r) : "v"(lo), "v"(hi)); return r; }
struct EpiBf16 {
    static constexpr bool PERM = true, AFTER_DRAIN = false;
    bf16_t* O; int ldc;
    __device__ __forceinline__ void operator()(const f32x4 (&acc)[2][2][4][2], const Unit& u, int wr, int wc, int fr, int fq) const {
        const int row0 = u.pm * BM + wr * 64 + fr; const int col0 = u.pn * BM + wc * 32 + 8 * fq;
#pragma unroll
        for (int ai = 0; ai < 2; ++ai)
#pragma unroll
            for (int m = 0; m < 4; ++m) { bf16_t* rowp = O + (size_t)(row0 + ai * HALF + m * 16) * ldc + col0;
#pragma unroll
                for (int bj = 0; bj < 2; ++bj) { const f32x4 v0 = acc[ai][bj][m][0], v1 = acc[ai][bj][m][1];
                    u32x4 w; w.x = cvt_pk_bf16(v0[0], v0[1]); w.y = cvt_pk_bf16(v0[2], v0[3]); w.z = cvt_pk_bf16(v1[0], v1[1]); w.w = cvt_pk_bf16(v1[2], v1[3]);
                    *(u32x4*)(rowp + bj * HALF) = w; } }
    }
};
struct EpiF32 {
    static constexpr bool PERM = false, AFTER_DRAIN = false;
    float* O; int ldc;
    __device__ __forceinline__ void operator()(const f32x4 (&acc)[2][2][4][2], const Unit& u, int wr, int wc, int fr, int fq) const {
        const int row0 = u.pm * BM + wr * 64 + fr; const int col0 = u.pn * BM + wc * 32 + 4 * fq;
#pragma unroll
        for (int ai = 0; ai < 2; ++ai)
#pragma unroll
            for (int m = 0; m < 4; ++m) { float* rowp = O + (size_t)(row0 + ai * HALF + m * 16) * ldc + col0;
#pragma unroll
                for (int bj = 0; bj < 2; ++bj)
#pragma unroll
                    for (int n = 0; n < 2; ++n) *(f32x4*)(rowp + bj * HALF + n * 16) = acc[ai][bj][m][n]; }
    }
};
__device__ __forceinline__ float silu_mul(float g, float u) { return g * __builtin_amdgcn_rcpf(1.0f + __expf(-g)) * u; }
struct EpiSwiGLU {
    static constexpr bool PERM = true, AFTER_DRAIN = false;
    bf16_t* O; int ldc;
    __device__ __forceinline__ void operator()(const f32x4 (&acc)[2][2][4][2], const Unit& u, int wr, int wc, int fr, int fq) const {
        const int row0 = u.pm * BM + wr * 64 + fr; const int col0 = u.pn * HALF + wc * 32 + 8 * fq;
#pragma unroll
        for (int ai = 0; ai < 2; ++ai)
#pragma unroll
            for (int m = 0; m < 4; ++m) { bf16_t* rowp = O + (size_t)(row0 + ai * HALF + m * 16) * ldc + col0;
                const f32x4 g0 = acc[ai][0][m][0], g1 = acc[ai][0][m][1], u0 = acc[ai][1][m][0], u1 = acc[ai][1][m][1];
                u32x4 w; w.x = cvt_pk_bf16(silu_mul(g0[0], u0[0]), silu_mul(g0[1], u0[1])); w.y = cvt_pk_bf16(silu_mul(g0[2], u0[2]), silu_mul(g0[3], u0[3]));
                w.z = cvt_pk_bf16(silu_mul(g1[0], u1[0]), silu_mul(g1[1], u1[1])); w.w = cvt_pk_bf16(silu_mul(g1[2], u1[2]), silu_mul(g1[3], u1[3]));
                *(u32x4*)rowp = w; }
    }
};
template <class Epi, class Sched, bool ALIGN_EPI = false, bool SP2 = false>
__device__ __forceinline__ void gemm_phase(PG8_LAS unsigned char* lds, const Gemm g, const Sched& S, const Epi& E) {
    const int tid = threadIdx.x, wid = __builtin_amdgcn_readfirstlane(tid >> 6), lane = tid & 63, wr = wid >> 2, wc = wid & 3, fr = lane & 15, fq = lane >> 4;
    const int K = g.K, nt = K / BK;
    unsigned voffA[2], voffB[2];
#pragma unroll
    for (int i = 0; i < 2; ++i) { int R, C; stage_rc(tid * 16 + i * 8192, R, C); const int Rb = Epi::PERM ? ((R & ~31) + perm32(R & 31)) : R;
        voffA[i] = (unsigned)(R * K + C) * 2u; voffB[i] = (unsigned)(Rb * K + C) * 2u; }
    const size_t kstep = (size_t)(BK * 2);
    const size_t hstep = (size_t)HALF * K * 2;
    const size_t tstep = 2 * hstep;
    const unsigned ldsw = (unsigned)wid * 1024u;
    const int aoff = lds_byte(wr * 64 + fr, fq * 8), boff = lds_byte(wc * 32 + fr, fq * 8);
#define PG8_SA(b, h) (((b) * 2 + (h)) * HTB)
#define PG8_SB(b, h) ((4 + (b) * 2 + (h)) * HTB)
#define PG8_STAGE(bufoff, gbase, voff) do { _Pragma("unroll") for (int _i = 0; _i < 2; ++_i) \
        __builtin_amdgcn_global_load_lds((const unsigned*)((const char*)(gbase) + (voff)[_i]), (PG8_LAS unsigned*)(lds + (bufoff) + ldsw + _i * 8192), 16, 0, 0); } while (0)
#define PG8_LDA(dst, b, h) do { _Pragma("unroll") for (int m = 0; m < 4; ++m) _Pragma("unroll") for (int k = 0; k < 2; ++k) dst[m][k] = *(const PG8_LAS bf16x8*)(lds + PG8_SA(b, h) + aoff + m * 2048 + k * 1024); } while (0)
#define PG8_LDB(dst, b, h) do { _Pragma("unroll") for (int n = 0; n < 2; ++n) _Pragma("unroll") for (int k = 0; k < 2; ++k) dst[n][k] = *(const PG8_LAS bf16x8*)(lds + PG8_SB(b, h) + boff + n * 2048 + k * 1024); } while (0)
#define PG8_MMA(ai, bj, At, Bt) do { __builtin_amdgcn_s_setprio(1); _Pragma("unroll") for (int m = 0; m < 4; ++m) _Pragma("unroll") for (int n = 0; n < 2; ++n) _Pragma("unroll") for (int k = 0; k < 2; ++k) \
        acc[ai][bj][m][n] = __builtin_amdgcn_mfma_f32_16x16x32_bf16(Bt[n][k], At[m][k], acc[ai][bj][m][n], 0, 0, 0); __builtin_amdgcn_s_setprio(0); } while (0)
#define PG8_WAIT_V(n) asm volatile("s_waitcnt vmcnt(" #n ")" ::: "memory")
#define PG8_WAIT_L(n) asm volatile("s_waitcnt lgkmcnt(" #n ")" ::: "memory")
#define PG8_BAR __builtin_amdgcn_s_barrier()
#define PG8_SCHED __builtin_amdgcn_sched_barrier(0)
    Unit cur, nxt; int ui = 0;
    if (!S.next(0, cur)) return;
    f32x4 acc[2][2][4][2];
#pragma unroll
    for (int a = 0; a < 2; ++a)
#pragma unroll
        for (int b = 0; b < 2; ++b)
#pragma unroll
            for (int m = 0; m < 4; ++m)
#pragma unroll
                for (int n = 0; n < 2; ++n) acc[a][b][m][n] = (f32x4){0.f, 0.f, 0.f, 0.f};
    bf16x8 At[4][2], B0[2][2], B1[2][2];
    const char* cA = (const char*)g.A + (size_t)cur.pm * tstep; const char* cB = (const char*)g.Bt + (size_t)cur.pn * tstep;
    S.a_ready(cur);
    if constexpr (SP2) {
        PG8_STAGE(PG8_SB(0, 0), cB, voffB); PG8_STAGE(PG8_SB(0, 1), cB + hstep, voffB); PG8_STAGE(PG8_SA(0, 0), cA, voffA); PG8_STAGE(PG8_SA(0, 1), cA + hstep, voffA);
        if (wr == 1) PG8_BAR;
        PG8_WAIT_V(2); PG8_BAR;
        PG8_STAGE(PG8_SB(1, 0), cB + kstep, voffB); PG8_STAGE(PG8_SA(1, 0), cA + kstep, voffA); PG8_STAGE(PG8_SB(1, 1), cB + hstep + kstep, voffB);
        PG8_WAIT_V(6); PG8_BAR;
    } else {
        PG8_STAGE(PG8_SB(0, 0), cB, voffB); PG8_STAGE(PG8_SA(0, 0), cA, voffA); PG8_STAGE(PG8_SB(0, 1), cB + hstep, voffB); PG8_STAGE(PG8_SA(0, 1), cA + hstep, voffA);
        if (wr == 1) PG8_BAR;
        PG8_WAIT_V(4); PG8_BAR;
        PG8_STAGE(PG8_SB(1, 0), cB + kstep, voffB); PG8_STAGE(PG8_SA(1, 0), cA + kstep, voffA); PG8_STAGE(PG8_SB(1, 1), cB + hstep + kstep, voffB);
        PG8_WAIT_V(6); PG8_BAR;
    }
    for (;;) {
        const bool has_next = S.next(ui + 1, nxt);
        const char* nA = has_next ? (const char*)g.A + (size_t)nxt.pm * tstep : cA; const char* nB = has_next ? (const char*)g.Bt + (size_t)nxt.pn * tstep : cB;
        for (int t = 0; t < nt; t += 2) {
            const bool last = (t == nt - 2);
            const char* a1 = cA + (size_t)(t + 1) * kstep;
            const char* a2 = last ? nA : cA + (size_t)(t + 2) * kstep; const char* b2 = last ? nB : cB + (size_t)(t + 2) * kstep;
            const char* a3 = a2 + kstep; const char* b3 = b2 + kstep;
            if (last && has_next) S.a_ready(nxt);
            if constexpr (SP2) {
            PG8_LDB(B0, 0, 0); PG8_LDB(B1, 0, 1); PG8_SCHED; PG8_LDA(At, 0, 0); PG8_STAGE(PG8_SA(1, 1), a1 + hstep, voffA);
            PG8_WAIT_V(8); PG8_WAIT_L(0); PG8_BAR; PG8_MMA(0, 0, At, B0); PG8_MMA(0, 1, At, B1); PG8_BAR; PG8_SCHED;
            PG8_LDA(At, 0, 1); PG8_STAGE(PG8_SB(0, 0), b2, voffB); PG8_STAGE(PG8_SB(0, 1), b2 + hstep, voffB); PG8_STAGE(PG8_SA(0, 0), a2, voffA);
            PG8_WAIT_V(8); PG8_WAIT_L(0); PG8_BAR; PG8_MMA(1, 0, At, B0); PG8_MMA(1, 1, At, B1); PG8_BAR; PG8_SCHED;
            PG8_LDB(B0, 1, 0); PG8_LDB(B1, 1, 1); PG8_SCHED; PG8_LDA(At, 1, 0); PG8_STAGE(PG8_SA(0, 1), a2 + hstep, voffA);
            PG8_WAIT_V(8); PG8_WAIT_L(0); PG8_BAR; PG8_MMA(0, 0, At, B0); PG8_MMA(0, 1, At, B1); PG8_BAR; PG8_SCHED;
            PG8_LDA(At, 1, 1); PG8_STAGE(PG8_SB(1, 0), b3, voffB); PG8_STAGE(PG8_SB(1, 1), b3 + hstep, voffB); PG8_STAGE(PG8_SA(1, 0), a3, voffA);
            PG8_WAIT_V(8); PG8_WAIT_L(0); PG8_BAR; PG8_MMA(1, 0, At, B0); PG8_MMA(1, 1, At, B1); PG8_BAR; PG8_SCHED;
            } else {
            PG8_LDB(B0, 0, 0); PG8_SCHED; PG8_LDA(At, 0, 0); PG8_STAGE(PG8_SA(1, 1), a1 + hstep, voffA);
            PG8_WAIT_L(8); PG8_BAR; PG8_WAIT_L(0); PG8_MMA(0, 0, At, B0); PG8_BAR; PG8_SCHED;
            PG8_LDB(B1, 0, 1); PG8_STAGE(PG8_SB(0, 0), b2, voffB);
            PG8_BAR; PG8_WAIT_L(0); PG8_MMA(0, 1, At, B1); PG8_BAR;
            PG8_LDA(At, 0, 1); PG8_STAGE(PG8_SA(0, 0), a2, voffA);
            PG8_BAR; PG8_WAIT_L(0); PG8_MMA(1, 0, At, B0); PG8_BAR; PG8_SCHED;
            PG8_STAGE(PG8_SB(0, 1), b2 + hstep, voffB);
            PG8_WAIT_V(6); PG8_BAR; PG8_MMA(1, 1, At, B1); PG8_BAR;
            PG8_LDB(B0, 1, 0); PG8_SCHED; PG8_LDA(At, 1, 0); PG8_STAGE(PG8_SA(0, 1), a2 + hstep, voffA);
            PG8_WAIT_L(8); PG8_BAR; PG8_WAIT_L(0); PG8_MMA(0, 0, At, B0); PG8_BAR; PG8_SCHED;
            PG8_LDB(B1, 1, 1); PG8_STAGE(PG8_SB(1, 0), b3, voffB);
            PG8_BAR; PG8_WAIT_L(0); PG8_MMA(0, 1, At, B1); PG8_BAR;
            PG8_LDA(At, 1, 1); PG8_STAGE(PG8_SA(1, 0), a3, voffA);
            PG8_BAR; PG8_WAIT_L(0); PG8_MMA(1, 0, At, B0); PG8_BAR; PG8_SCHED;
            PG8_STAGE(PG8_SB(1, 1), b3 + hstep, voffB);
            PG8_WAIT_V(6); PG8_BAR; PG8_MMA(1, 1, At, B1); PG8_BAR;
            }
        }
        if constexpr (ALIGN_EPI) { if (wr == 0) PG8_BAR; }
        if constexpr (!Epi::AFTER_DRAIN) { E(acc, cur, wr, wc, fr, fq); S.done(cur); }
        if (!has_next) break;
#pragma unroll
        for (int a = 0; a < 2; ++a)
#pragma unroll
            for (int b = 0; b < 2; ++b)
#pragma unroll
                for (int m = 0; m < 4; ++m)
#pragma unroll
                    for (int n = 0; n < 2; ++n) acc[a][b][m][n] = (f32x4){0.f, 0.f, 0.f, 0.f};
        cur = nxt; cA = nA; cB = nB; ++ui;
        if constexpr (ALIGN_EPI) { if (wr == 1) PG8_BAR; }
    }
    PG8_WAIT_V(0);
    if constexpr (!ALIGN_EPI) { if (wr == 0) PG8_BAR; }
    PG8_BAR;
    if constexpr (Epi::AFTER_DRAIN) { E.fused(acc, cur, wr, wc, fr, fq, lds, wid, lane); S.done(cur); }
#undef PG8_SA
#undef PG8_SB
#undef PG8_STAGE
#undef PG8_LDA
#undef PG8_LDB
#undef PG8_MMA
#undef PG8_WAIT_V
#undef PG8_WAIT_L
#undef PG8_BAR
#undef PG8_SCHED
}
}
namespace attn {
using bf16 = __hip_bfloat16;
constexpr int   D = 128, NW = 8, QBLK = 32, KVBLK = 64;
constexpr float SCALE = 0.088388347648318440f;
constexpr float THR = 8.f;
constexpr int SDEPTH = 2;
constexpr int LDQ = 1024, LDK = 256, LDO = 2048;
constexpr size_t SHM_V = KVBLK * D * 2, SHM_K = KVBLK * D * 2, SHM_ATTN = 2 * SHM_V + 2 * SHM_K + NW * 64 * 4;
__device__ __forceinline__ unsigned short f2bf_rne(float f) { unsigned u = __builtin_bit_cast(unsigned, f); return (unsigned short)((u + 0x7fffu + ((u >> 16) & 1u)) >> 16); }
using bf16x8 = __attribute__((ext_vector_type(8))) short;
using s16x4  = __attribute__((ext_vector_type(4))) short;
using f32x16 = __attribute__((ext_vector_type(16))) float;
using f32x8  = __attribute__((ext_vector_type(8))) float;
using u32x4  = __attribute__((ext_vector_type(4))) unsigned;
#define KSWZ(row, colB) ((row) * 256 + ((colB) ^ (((row) & 7) << 4)))
#define SBAR() __builtin_amdgcn_sched_barrier(0)
__device__ __forceinline__ int crow(int r, int hi) { return (r & 3) + 8 * (r >> 2) + 4 * hi; }
__device__ __forceinline__ unsigned cvtpk(float lo, float hi) {
  unsigned r; asm volatile("v_cvt_pk_bf16_f32 %0, %1, %2" : "=v"(r) : "v"(lo), "v"(hi)); return r;
}
template <typename TIn> struct Stage;
template <> struct Stage<bf16>  { using T = bf16x8;
  __device__ static __forceinline__ T ld8(const bf16* p) { return *reinterpret_cast<const bf16x8*>(p); }
  __device__ static __forceinline__ bf16x8 tobf(T x) { return x; } };
template <> struct Stage<float> { using T = f32x8;
  __device__ static __forceinline__ T ld8(const float* p) { return *reinterpret_cast<const f32x8*>(p); }
  __device__ static __forceinline__ bf16x8 tobf(T x) {
    u32x4 w = {cvtpk(x[0], x[1]), cvtpk(x[2], x[3]), cvtpk(x[4], x[5]), cvtpk(x[6], x[7])}; return *reinterpret_cast<bf16x8*>(&w); } };

__device__ __forceinline__ void partialSM(f32x16& p0, f32x16& p1, float& m_reg, float& mn, float& alpha) {
  constexpr float C = SCALE * 1.4426950408889634f;
  float pmax = p0[0]; for (int r = 1; r < 16; ++r) pmax = fmaxf(pmax, p0[r]); for (int r = 0; r < 16; ++r) pmax = fmaxf(pmax, p1[r]);
  { auto rr = __builtin_amdgcn_permlane32_swap(__float_as_uint(pmax), __float_as_uint(pmax), false, false);
    pmax = fmaxf(__uint_as_float(rr[0]), __uint_as_float(rr[1])); }
  if (__builtin_expect(__all(pmax - m_reg <= THR / SCALE), 1)) { mn = m_reg; alpha = 1.f; }
  else { mn = fmaxf(m_reg, pmax); alpha = __builtin_amdgcn_exp2f((m_reg - mn) * C); m_reg = mn; }
  float mnC = -mn * C;
  for (int r = 0; r < 16; ++r) p0[r] = fmaf(p0[r], C, mnC); for (int r = 0; r < 16; ++r) p1[r] = fmaf(p1[r], C, mnC);
  for (int r = 0; r < 16; ++r) p0[r] = __builtin_amdgcn_exp2f(p0[r]);
}
__device__ __forceinline__ void finishSM(f32x16& p0, f32x16& p1, float alpha, float& l_reg, bf16x8& pa0, bf16x8& pa1, bf16x8& pa2, bf16x8& pa3) {
  for (int r = 0; r < 16; ++r) p1[r] = __builtin_amdgcn_exp2f(p1[r]);
  float ps = 0; for (int r = 0; r < 16; ++r) ps += p0[r]; for (int r = 0; r < 16; ++r) ps += p1[r];
  { auto rr = __builtin_amdgcn_permlane32_swap(__float_as_uint(ps), __float_as_uint(ps), false, false);
    ps = __uint_as_float(rr[0]) + __uint_as_float(rr[1]); }
  l_reg = l_reg * alpha + ps;
#define PK4(P, BASE, OUT) do { unsigned a0 = cvtpk(P[BASE + 0], P[BASE + 1]), a1 = cvtpk(P[BASE + 2], P[BASE + 3]);   \
    unsigned b0 = cvtpk(P[BASE + 4], P[BASE + 5]), b1 = cvtpk(P[BASE + 6], P[BASE + 7]);                              \
    auto r0 = __builtin_amdgcn_permlane32_swap(a0, b0, false, false); auto r1 = __builtin_amdgcn_permlane32_swap(a1, b1, false, false); \
    u32x4 w = {r0[0], r1[0], r0[1], r1[1]}; OUT = *reinterpret_cast<bf16x8*>(&w); } while (0)
  PK4(p0, 0, pa0); PK4(p0, 8, pa1); PK4(p1, 0, pa2); PK4(p1, 8, pa3);
#undef PK4
}
__device__ __forceinline__ void qkt(f32x16& p0, f32x16& p1, const bf16* Ks, const bf16x8* qr, int r32, int hi) {
  p0 = f32x16{}; p1 = f32x16{};
  for (int d0 = 0; d0 < 8; ++d0) { int cb = (d0 * 16 + hi * 8) * 2;
    bf16x8 b0 = *reinterpret_cast<const bf16x8*>((const char*)Ks + KSWZ(r32, cb));
    bf16x8 b1 = *reinterpret_cast<const bf16x8*>((const char*)Ks + KSWZ(32 + r32, cb));
    p0 = __builtin_amdgcn_mfma_f32_32x32x16_bf16(b0, qr[d0], p0, 0, 0, 0);
    p1 = __builtin_amdgcn_mfma_f32_32x32x16_bf16(b1, qr[d0], p1, 0, 0, 0); }
}
__device__ __forceinline__ int v_st(int k, int c) { const int kk = (k & ~0xC) | ((k & 4) << 1) | ((k & 8) >> 1); return ((kk >> 3) * 4 + (c >> 5)) * 512 + ((kk & 7) * 32 + (c & 31)) * 2; }
__device__ __forceinline__ int v_rd_base(int lane) { return ((lane & 3) << 3) | (((lane >> 2) & 3) << 6) | (((lane >> 4) & 1) << 5) | (((lane >> 5) & 1) << 8); }
constexpr int v_rd_off(int d0, int ks, int half) { return d0 * 512 + ks * 4096 + half * 2048; }
template <int OFF> __device__ __forceinline__ s16x4 tr_read(int vb) {
  s16x4 r; asm volatile("ds_read_b64_tr_b16 %0, %1 offset:%2" : "=&v"(r) : "v"(vb), "i"(OFF) : "memory"); return r;
}
template <int D0> __device__ __forceinline__ void pv_one(f32x16& od, int vb, bf16x8 pa0, bf16x8 pa1, bf16x8 pa2, bf16x8 pa3) {
  const s16x4 l0 = tr_read<v_rd_off(D0, 0, 0)>(vb), h0 = tr_read<v_rd_off(D0, 0, 1)>(vb), l1 = tr_read<v_rd_off(D0, 1, 0)>(vb), h1 = tr_read<v_rd_off(D0, 1, 1)>(vb);
  const s16x4 l2 = tr_read<v_rd_off(D0, 2, 0)>(vb), h2 = tr_read<v_rd_off(D0, 2, 1)>(vb), l3 = tr_read<v_rd_off(D0, 3, 0)>(vb), h3 = tr_read<v_rd_off(D0, 3, 1)>(vb);
  asm volatile("s_waitcnt lgkmcnt(0)" ::: "memory"); SBAR();
#define PK(L, H) (bf16x8){L[0], L[1], L[2], L[3], H[0], H[1], H[2], H[3]}
  od = __builtin_amdgcn_mfma_f32_32x32x16_bf16(pa0, PK(l0, h0), od, 0, 0, 0);
  od = __builtin_amdgcn_mfma_f32_32x32x16_bf16(pa1, PK(l1, h1), od, 0, 0, 0);
  od = __builtin_amdgcn_mfma_f32_32x32x16_bf16(pa2, PK(l2, h2), od, 0, 0, 0);
  od = __builtin_amdgcn_mfma_f32_32x32x16_bf16(pa3, PK(l3, h3), od, 0, 0, 0);
#undef PK
}
__device__ __forceinline__ void pv_d0(f32x16* o, int vb, bf16x8 pa0, bf16x8 pa1, bf16x8 pa2, bf16x8 pa3) {
  pv_one<0>(o[0], vb, pa0, pa1, pa2, pa3); pv_one<1>(o[1], vb, pa0, pa1, pa2, pa3); pv_one<2>(o[2], vb, pa0, pa1, pa2, pa3); pv_one<3>(o[3], vb, pa0, pa1, pa2, pa3);
}
template <typename TQ>
__device__ __forceinline__ void attn_dense_body(const TQ* __restrict__ Qb, const bf16* __restrict__ Kh, const bf16* __restrict__ Vh,
                                                unsigned short* __restrict__ Ob, int seq, char* lds) {
  using St = Stage<bf16>; using SQ = Stage<TQ>;
  const int tid = threadIdx.x, wid = tid >> 6, lane = tid & 63, r32 = lane & 31, hi = lane >> 5;
  bf16* V_lds = (bf16*)lds; bf16* K_lds = (bf16*)(lds + 2 * SHM_V);
  float* ws = (float*)(lds + 2 * SHM_V + 2 * SHM_K) + wid * 64; float* li_l = ws; float* al_l = ws + 32;
  float m_reg = -1e30f, l_reg = 0; f32x16 o[4] = {}; bf16x8 qr[8];
  const TQ* Qw = Qb + (long)(wid * QBLK + r32) * LDQ + hi * 8;
#pragma unroll
  for (int d0 = 0; d0 < 8; ++d0) qr[d0] = SQ::tobf(SQ::ld8(Qw + d0 * 16));
  const int sr = tid >> 4, sc = (tid & 15) * 8, vst0 = v_st(sr, sc), vst1 = v_st(32 + sr, sc);
  const int vb0 = (int)(uintptr_t)V_lds + v_rd_base(lane);
  struct { typename St::T vs0, vs1, ks0, ks1; } sr_[SDEPTH];
#define SLOAD(i, k0) do { sr_[i].vs0 = St::ld8(&Vh[(long)((k0) + sr) * LDK + sc]); sr_[i].vs1 = St::ld8(&Vh[(long)((k0) + 32 + sr) * LDK + sc]); \
    sr_[i].ks0 = St::ld8(&Kh[(long)((k0) + sr) * LDK + sc]); sr_[i].ks1 = St::ld8(&Kh[(long)((k0) + 32 + sr) * LDK + sc]); } while (0)
#define SWRITE(b, i) do { *(bf16x8*)((char*)V_lds + (b) * SHM_V + vst0) = St::tobf(sr_[i].vs0);          \
    *(bf16x8*)((char*)V_lds + (b) * SHM_V + vst1) = St::tobf(sr_[i].vs1); int kc = sc * 2;               \
    *(bf16x8*)((char*)K_lds + (b) * SHM_K + KSWZ(sr, kc)) = St::tobf(sr_[i].ks0);                       \
    *(bf16x8*)((char*)K_lds + (b) * SHM_K + KSWZ(32 + sr, kc)) = St::tobf(sr_[i].ks1); } while (0)
#define SWAIT() do { if constexpr (SDEPTH == 2) asm volatile("s_waitcnt vmcnt(4)" ::: "memory"); else asm volatile("s_waitcnt vmcnt(0)" ::: "memory"); } while (0)
#define RESC(a) do { if (__any((a) < 1.f)) { if (hi == 0) al_l[r32] = (a); asm volatile("s_waitcnt lgkmcnt(0)" ::: "memory"); \
    for (int d = 0; d < 4; ++d) for (int r = 0; r < 16; ++r) o[d][r] *= al_l[crow(r, hi)]; } } while (0)
  f32x16 pA0, pA1, pB0, pB1; float mnA, mnB, alA, alB; bf16x8 pa0, pa1, pa2, pa3; const int NT = seq / KVBLK;
  constexpr int SE = 0, SO = SDEPTH - 1;
  SLOAD(SE, 0); asm volatile("s_waitcnt vmcnt(0)" ::: "memory"); SWRITE(0, SE); __syncthreads();
  qkt(pA0, pA1, K_lds, qr, r32, hi); partialSM(pA0, pA1, m_reg, mnA, alA);
  SLOAD(SO, KVBLK); if constexpr (SDEPTH == 2) { if (2 < NT) SLOAD(SE, 2 * KVBLK); }
  SWAIT(); SWRITE(1, SO); __syncthreads();
  for (int j = 1; j + 1 < NT; j += 2) {
    SBAR(); qkt(pB0, pB1, (bf16*)((char*)K_lds + SHM_K), qr, r32, hi);
    finishSM(pA0, pA1, alA, l_reg, pa0, pa1, pa2, pa3); SBAR();
    SLOAD(SO, (j + SDEPTH) * KVBLK); SBAR();
    pv_d0(o, vb0, pa0, pa1, pa2, pa3); partialSM(pB0, pB1, m_reg, mnB, alB);
    __syncthreads(); SWAIT(); SWRITE(0, SE);
    RESC(alB); __syncthreads();
    SBAR(); qkt(pA0, pA1, K_lds, qr, r32, hi);
    finishSM(pB0, pB1, alB, l_reg, pa0, pa1, pa2, pa3); SBAR();
    if (SDEPTH == 1 || j + 3 < NT) SLOAD(SE, (j + 1 + SDEPTH) * KVBLK); SBAR();
    pv_d0(o, vb0 + (int)SHM_V, pa0, pa1, pa2, pa3); partialSM(pA0, pA1, m_reg, mnA, alA);
    __syncthreads(); SWAIT(); SWRITE(1, SO);
    RESC(alA); __syncthreads();
  }
  SBAR(); qkt(pB0, pB1, (bf16*)((char*)K_lds + SHM_K), qr, r32, hi);
  finishSM(pA0, pA1, alA, l_reg, pa0, pa1, pa2, pa3); SBAR();
  pv_d0(o, vb0, pa0, pa1, pa2, pa3); partialSM(pB0, pB1, m_reg, mnB, alB);
  __syncthreads(); RESC(alB);
  finishSM(pB0, pB1, alB, l_reg, pa0, pa1, pa2, pa3); SBAR();
  pv_d0(o, vb0 + (int)SHM_V, pa0, pa1, pa2, pa3);
  if (hi == 0) li_l[r32] = l_reg; asm volatile("s_waitcnt lgkmcnt(0)" ::: "memory");
  float rli[16];
#pragma unroll
  for (int r = 0; r < 16; ++r) rli[r] = __builtin_amdgcn_rcpf(li_l[crow(r, hi)]);
  unsigned short* Ow = Ob + (long)(wid * QBLK) * LDO;
#pragma unroll
  for (int r = 0; r < 16; ++r) { int orow = crow(r, hi);
    for (int d0 = 0; d0 < 4; ++d0) Ow[(long)orow * LDO + d0 * 32 + r32] = f2bf_rne(o[d0][r] * rli[r]); }
#undef SLOAD
#undef SWRITE
#undef SWAIT
#undef RESC
}
}
#ifndef PP_MASK
#define PP_MASK 31
#endif
#define GAS __attribute__((address_space(1)))
#define LAS __attribute__((address_space(3)))
typedef unsigned short bf16_t;
typedef float f32x4 __attribute__((ext_vector_type(4)));
typedef float f32x2 __attribute__((ext_vector_type(2)));
typedef unsigned u32x4 __attribute__((ext_vector_type(4)));
typedef unsigned u32x2 __attribute__((ext_vector_type(2)));
typedef __bf16 bf16x2_t __attribute__((ext_vector_type(2)));

constexpr int DM = 2048, MC = 4096, MS = 4096, MT = MC + MS, DEPTH = 2;
constexpr int DIN = 4768, DINP = 4864, DFF = 5632;
constexpr int O_K = 1024, O_V = 1280, O_CB = 1536, O_CC = 2048, O_CH = 2560, O_UR = 3072;
constexpr int KVROWS = 4096 + 4 * 1280;
constexpr float EPS = 1e-6f, GN_EPS = 64e-5f;
constexpr int NWAVES = 8, NTHREADS = 512;
enum { I_XP = 0, I_XS, I_CK, I_CV, I_ST, I_C, I_CCTX, I_WADA, I_BADA, I_NG, I_WIN, I_QN, I_KN, I_CONVW, I_MU, I_W0, I_WUP, I_A0, I_AUP, I_GUP, I_KK, I_KA, I_RK, I_LNG, I_LNB, I_WOUT, I_WGATE, I_WUPF, I_WDOWN, N_IN };
constexpr size_t OUT_Y = 0, OUT_NK = (size_t)MT * DM, OUT_NV = OUT_NK + 2097152, OUT_ST = OUT_NV + 2097152, OUT_TOTAL = OUT_ST + 2097152;
constexpr size_t MiB = 1u << 20;
constexpr size_t WS_CTL = 0, CTL_BYTES = 1 * MiB;
constexpr size_t WS_WIN = 1 * MiB, SZ_WIN = 19 * MiB;
constexpr size_t WS_WOUT = WS_WIN + 2 * SZ_WIN, SZ_WOUT = 8 * MiB;
constexpr size_t WS_WGU = WS_WOUT + 2 * SZ_WOUT, SZ_WGU = 44 * MiB;
constexpr size_t WS_WDN = WS_WGU + 2 * SZ_WGU, SZ_WDN = 22 * MiB;
constexpr size_t WS_MOD = WS_WDN + 2 * SZ_WDN;
constexpr size_t WS_HB = WS_MOD + 1 * MiB;
constexpr size_t WS_MIX = WS_HB + 32 * MiB;
constexpr size_t WS_XB = WS_MIX + 32 * MiB;
constexpr size_t WS_R1 = WS_XB + 64 * MiB;
constexpr size_t WS_PROJ = WS_R1;
constexpr size_t WS_QB = WS_R1 + 76 * MiB;
constexpr size_t WS_KB = WS_R1 + 92 * MiB;
constexpr size_t WS_VB = WS_R1 + 97 * MiB;
constexpr size_t WS_SCAN = WS_R1 + 102 * MiB;
constexpr size_t WS_GB = WS_R1 + 246 * MiB;
constexpr size_t WS_BON = WS_R1 + 262 * MiB;
constexpr size_t WS_YB = WS_R1 + 278 * MiB;
constexpr size_t WS_OB = WS_R1;
constexpr size_t WS_HID = WS_R1 + 64 * MiB;
constexpr size_t WS_END = WS_R1 + 310 * MiB;
constexpr int CW_BAR = 4096;
constexpr int CW_QUEUE = 64;
constexpr int RING_BYTES = 131072, MISC_OFF = RING_BYTES + 320, LDS_BYTES = 147456;

__device__ __forceinline__ float bf2f(bf16_t h) { return __uint_as_float((unsigned)h << 16); }
__device__ __forceinline__ unsigned pk2(float lo, float hi) { f32x2 v = {lo, hi}; bf16x2_t b = __builtin_convertvector(v, bf16x2_t); return __builtin_bit_cast(unsigned, b); }
__device__ __forceinline__ bf16_t f2bf(float f) { return (bf16_t)(pk2(f, 0.f) & 0xffffu); }
__device__ __forceinline__ float wave_sum(float v) {
#pragma unroll
    for (int o = 1; o < 64; o <<= 1) v += __shfl_xor(v, o);
    return v;
}
template <int CTRL> __device__ __forceinline__ float dpp_add(float x) {
    const int y = __builtin_amdgcn_update_dpp(0, __float_as_int(x), CTRL, 0xf, 0xf, false);
    return x + __int_as_float(y);
}
__device__ __forceinline__ float row16_sum(float x) {
    x = dpp_add<0x128>(x); x = dpp_add<0x124>(x); x = dpp_add<0x122>(x); x = dpp_add<0x121>(x); return x;
}
__device__ __forceinline__ float sigmoidf_(float x) { return 1.0f / (1.0f + __expf(-x)); }

#define XB_TMO      128
#define XB_XCNT(j)  (256  + 64 * (j))
#define XB_XSUB(j)  (1280 + 64 * (j))
#define XB_XGEN(j)  (2304 + 64 * (j))
#define XB_TOP      3328
#define XB_TOPGEN   3392
#define XCD_BAR_WORDS 3456
#define XB_SPIN_CAP (1u << 18)

__device__ __forceinline__ unsigned xb_ld(unsigned* p)              { return __hip_atomic_load(p, __ATOMIC_RELAXED, __HIP_MEMORY_SCOPE_AGENT); }
__device__ __forceinline__ unsigned xb_add(unsigned* p, unsigned v) { return __hip_atomic_fetch_add(p, v, __ATOMIC_RELAXED, __HIP_MEMORY_SCOPE_AGENT); }
__device__ __forceinline__ unsigned xb_xcc_id() { return (unsigned)__builtin_amdgcn_s_getreg((3 << 11) | 20) & 0xFu; }
#define XB_SPIN(cond, bar) do { unsigned _sp = 0; while (cond) { __builtin_amdgcn_s_sleep(1); \
    if ((++_sp & 255u) == 0u) { if (xb_ld(&(bar)[XB_TMO])) break; if (_sp > XB_SPIN_CAP) { atomicAdd(&(bar)[XB_TMO], 1u); break; } } } } while (0)

struct XcdBarrier {
    unsigned* bar; unsigned x;
    volatile LAS unsigned* st;
};

__device__ __forceinline__ XcdBarrier xcd_barrier_post(unsigned* bar, volatile LAS unsigned* st) {
    XcdBarrier b; b.bar = bar; b.x = xb_xcc_id(); b.st = st;
    if (threadIdx.x == 0) (void)xb_add(&bar[XB_XCNT(b.x)], 1u);
    return b;
}
__device__ __forceinline__ void xcd_barrier_complete(unsigned* bar, unsigned x, unsigned& nloc, unsigned& nx) {
    const unsigned G = gridDim.x * gridDim.y * gridDim.z;
    unsigned sum, cnt, mine, sp = 0u;
    for (;;) {
        sum = 0u; cnt = 0u; mine = 0u;
#pragma unroll
        for (unsigned j = 0; j < 16; ++j) { const unsigned c = xb_ld(&bar[XB_XCNT(j)]); sum += c; cnt += (c > 0u) ? 1u : 0u; mine = (j == x) ? c : mine; }
        if (sum == G) break;
        __builtin_amdgcn_s_sleep(1);
        if ((++sp & 255u) == 0u) { if (xb_ld(&bar[XB_TMO])) break; if (sp > XB_SPIN_CAP) { atomicAdd(&bar[XB_TMO], 1u); break; } }
    }
    nloc = mine > 0u ? mine : 1u; nx = cnt > 0u ? cnt : 1u;
}

__device__ __forceinline__ void xcd_barrier(const XcdBarrier& b) {
    asm volatile("s_waitcnt vmcnt(0)" ::: "memory");
    __syncthreads();
    if (threadIdx.x == 0) {
        unsigned* bar = b.bar;
        __builtin_amdgcn_s_waitcnt(0);
        unsigned nloc = b.st[0], nx = b.st[1];
        if (nloc == 0u) { xcd_barrier_complete(bar, b.x, nloc, nx); b.st[0] = nloc; b.st[1] = nx; }
        const unsigned old = xb_add(&bar[XB_XSUB(b.x)], 1u);
        const unsigned gen = old / nloc;
        if (old + 1u == (gen + 1u) * nloc) {
            __builtin_amdgcn_fence(__ATOMIC_RELEASE, "agent");
            asm volatile("s_waitcnt vmcnt(0)" ::: "memory");
            const unsigned og = xb_add(&bar[XB_TOP], 1u);
            const unsigned tg = og / nx;
            if (og + 1u == (tg + 1u) * nx) xb_add(&bar[XB_TOPGEN], 1u);
            else XB_SPIN(xb_ld(&bar[XB_TOPGEN]) == tg, bar);
            __builtin_amdgcn_fence(__ATOMIC_ACQUIRE, "agent");
            xb_add(&bar[XB_XGEN(b.x)], 1u);
            asm volatile("s_waitcnt vmcnt(0)" ::: "memory");
        } else {
            XB_SPIN(xb_ld(&bar[XB_XGEN(b.x)]) == gen, bar);
            __builtin_amdgcn_fence(__ATOMIC_ACQUIRE, "agent");
            asm volatile("s_waitcnt vmcnt(0)" ::: "memory");
        }
    }
    __syncthreads();
}


struct Args { const float* in[N_IN]; float* out; unsigned char* ws; int ph_lo, ph_hi; };
struct Frame {
    LAS unsigned char* lds; unsigned char* ldsg;
    const float* const* in; float* out; unsigned char* ws;
    int tid, lane, wave, G;
    XcdBarrier bar;
};
#define LDS_WAIT() asm volatile("s_waitcnt lgkmcnt(0)" ::: "memory")

__device__ __forceinline__ void p0_transpose_item(const float* W, int K, int N, bf16_t* WT, int kb, int nb, int rowbase, LAS float* scr, int lane) {
    const int k0 = 64 * kb, n0 = 32 * nb;
#pragma unroll 8
    for (int i = 0; i < 32; ++i) { const int kk = 2 * i + (lane >> 5); scr[kk * 33 + (lane & 31)] = W[(size_t)(k0 + kk) * N + n0 + (lane & 31)]; }
    LDS_WAIT(); asm volatile("" ::: "memory");
    const int c = lane & 7;
#pragma unroll
    for (int j = 0; j < 4; ++j) { const int n = (lane >> 3) + 8 * j; const LAS float* s = scr + (8 * c) * 33 + n;
        u32x4 o; o.x = pk2(s[0 * 33], s[1 * 33]); o.y = pk2(s[2 * 33], s[3 * 33]); o.z = pk2(s[4 * 33], s[5 * 33]); o.w = pk2(s[6 * 33], s[7 * 33]);
        *(u32x4*)(WT + (size_t)(rowbase + n) * K + k0 + 8 * c) = o; }
    LDS_WAIT(); asm volatile("" ::: "memory");
}
__device__ __forceinline__ void p0_prologue(Frame& F) {
    {
        LAS float* sc = (LAS float*)F.lds;
        LAS float* red = sc + 5 * 2048;
        for (int i = F.tid; i < 5 * 2048; i += NTHREADS) { const int v = i >> 11, k = i & 2047; const float x = v == 0 ? F.in[I_CCTX][k] : F.in[I_C][(v - 1) * 2048 + k]; sc[i] = x * sigmoidf_(x); }
        __syncthreads();
        for (int it = blockIdx.x; it < 2 * 192; it += F.G) {
            const int l = it / 192, cg_ = it % 192, col = cg_ * 64 + F.lane;
            const float* W = F.in[I_WADA] + (size_t)l * 2048 * 12288 + col;
            float acc[5] = {0.f, 0.f, 0.f, 0.f, 0.f};
            const int kbeg = F.wave * 256;
#pragma unroll 2
            for (int k = kbeg; k < kbeg + 256; k += 4) {
                const float w0 = W[(size_t)(k + 0) * 12288], w1 = W[(size_t)(k + 1) * 12288], w2 = W[(size_t)(k + 2) * 12288], w3 = W[(size_t)(k + 3) * 12288];
#pragma unroll
                for (int v = 0; v < 5; ++v) { const f32x4 s = *(const LAS f32x4*)(sc + v * 2048 + k); acc[v] += s.x * w0 + s.y * w1 + s.z * w2 + s.w * w3; }
            }
#pragma unroll
            for (int v = 0; v < 5; ++v) red[(F.wave * 5 + v) * 64 + F.lane] = acc[v];
            __syncthreads();
            if (F.tid < 320) { const int v = F.tid >> 6, c = F.tid & 63; float s = 0.f;
#pragma unroll
                for (int w = 0; w < 8; ++w) s += red[(w * 5 + v) * 64 + c];
                const int cc = cg_ * 64 + c;
                ((float*)(F.ws + WS_MOD))[(size_t)(l * 5 + v) * 12288 + cc] = s + F.in[I_BADA][l * 12288 + cc]; }
            __syncthreads();
        }
    }
    __syncthreads();
    {
        const int gt = blockIdx.x * NTHREADS + F.tid, GT = F.G * NTHREADS;
        for (int i = gt; i < 2 * 24576; i += GT) { const int l = i / 24576, r = i % 24576;
            *(u32x4*)(F.ws + WS_WIN + (size_t)l * SZ_WIN + (size_t)4768 * 2048 * 2 + (size_t)r * 16) = (u32x4){0u, 0u, 0u, 0u}; }
    }
    {
        LAS float* scr = (LAS float*)(F.lds + F.wave * 16384);
        const int gw = blockIdx.x * NWAVES + F.wave, NGW = F.G * NWAVES;
        constexpr int I_IN = 32 * 149, I_OUT = 32 * 64, I_G = 32 * 176, I_DN = 88 * 64, PER_L = I_IN + I_OUT + 2 * I_G + I_DN;
        for (int it = gw; it < 2 * PER_L; it += NGW) {
            const int l = it / PER_L; int r = it % PER_L;
            if (r < I_IN) { const int kb = r / 149, nb = r % 149;
                p0_transpose_item(F.in[I_WIN] + (size_t)l * 2048 * DIN, 2048, DIN, (bf16_t*)(F.ws + WS_WIN + l * SZ_WIN), kb, nb, 32 * nb, scr, F.lane); continue; }
            r -= I_IN;
            if (r < I_OUT) { const int kb = r / 64, nb = r % 64;
                p0_transpose_item(F.in[I_WOUT] + (size_t)l * 2048 * 2048, 2048, 2048, (bf16_t*)(F.ws + WS_WOUT + l * SZ_WOUT), kb, nb, 32 * nb, scr, F.lane); continue; }
            r -= I_OUT;
            if (r < 2 * I_G) { const int up = r >= I_G; if (up) r -= I_G; const int kb = r / 176, nb = r % 176, n0 = 32 * nb;
                p0_transpose_item(F.in[up ? I_WUPF : I_WGATE] + (size_t)l * 2048 * DFF, 2048, DFF, (bf16_t*)(F.ws + WS_WGU + l * SZ_WGU), kb, nb, (n0 >> 7) * 256 + (up ? 128 : 0) + (n0 & 127), scr, F.lane); continue; }
            r -= 2 * I_G;
            { const int kb = r / 64, nb = r % 64;
                p0_transpose_item(F.in[I_WDOWN] + (size_t)l * DFF * 2048, DFF, 2048, (bf16_t*)(F.ws + WS_WDN + l * SZ_WDN), kb, nb, 32 * nb, scr, F.lane); }
        }
    }
}

__device__ __forceinline__ const float* mod_vec(const Frame& F, int l, int m, int which) {
    const int v = m < MC ? 0 : 1 + ((m - MC) >> 10);
    return (const float*)(F.ws + WS_MOD) + (size_t)(l * 5 + v) * 12288 + which * 2048;
}
__device__ __forceinline__ const float* x_in_row(const Frame& F, int m) { return m < MC ? F.in[I_XP] + (size_t)m * DM : F.in[I_XS] + (size_t)(m - MC) * DM; }
__device__ __forceinline__ float row_ss(const f32x4 (&v)[8]) {
    float s = 0.f;
#pragma unroll
    for (int j = 0; j < 8; ++j) s += (v[j].x * v[j].x + v[j].y * v[j].y) + (v[j].z * v[j].z + v[j].w * v[j].w);
    return wave_sum(s);
}
__device__ __forceinline__ void write_h(const Frame& F, const f32x4 (&x)[8], float rs, const float* ng, const float* sc, const float* sh, bf16_t* hrow) {
#pragma unroll
    for (int j = 0; j < 8; ++j) { const int o = F.lane + 64 * j;
        const f32x4 g = ((const f32x4*)ng)[o], s = ((const f32x4*)sc)[o], b = ((const f32x4*)sh)[o];
        const f32x4 h = x[j] * rs * g * (1.0f + s) + b;
        u32x2 w; w.x = pk2(h.x, h.y); w.y = pk2(h.z, h.w); ((u32x2*)hrow)[o] = w; }
}
__device__ __forceinline__ void rowpass0(Frame& F) {
    const int gw = blockIdx.x * NWAVES + F.wave, NGW = F.G * NWAVES;
    for (int m = gw; m < MT; m += NGW) {
        const f32x4* xr = (const f32x4*)x_in_row(F, m); f32x4 x[8];
#pragma unroll
        for (int j = 0; j < 8; ++j) x[j] = xr[F.lane + 64 * j];
        const float rs = rsqrtf(row_ss(x) * (1.0f / DM) + EPS);
        write_h(F, x, rs, F.in[I_NG] + 0, mod_vec(F, 0, m, 1), mod_vec(F, 0, m, 0), (bf16_t*)(F.ws + WS_HB) + (size_t)m * DM);
    }
}
__device__ __forceinline__ void rowpassA(Frame& F, int l) {
    const int gw = blockIdx.x * NWAVES + F.wave, NGW = F.G * NWAVES;
    const float* ng = F.in[I_NG] + (size_t)l * 4 * DM;
    for (int m = gw; m < MT; m += NGW) {
        const f32x4* orow = (const f32x4*)(F.ws + WS_OB) + (size_t)m * (DM / 4);
        const f32x4* xr = l == 0 ? (const f32x4*)x_in_row(F, m) : (const f32x4*)(F.ws + WS_XB) + (size_t)m * (DM / 4);
        f32x4 o[8], x[8];
#pragma unroll
        for (int j = 0; j < 8; ++j) { o[j] = orow[F.lane + 64 * j]; x[j] = xr[F.lane + 64 * j]; }
        const float r1 = rsqrtf(row_ss(o) * (1.0f / DM) + EPS);
        const float* ga = mod_vec(F, l, m, 2);
        f32x4* xo = (f32x4*)(F.ws + WS_XB) + (size_t)m * (DM / 4);
#pragma unroll
        for (int j = 0; j < 8; ++j) { const int q = F.lane + 64 * j; x[j] = x[j] + ((const f32x4*)ga)[q] * (o[j] * r1 * ((const f32x4*)(ng + DM))[q]); xo[q] = x[j]; }
        const float r2 = rsqrtf(row_ss(x) * (1.0f / DM) + EPS);
        write_h(F, x, r2, ng + 2 * DM, mod_vec(F, l, m, 4), mod_vec(F, l, m, 3), (bf16_t*)(F.ws + WS_HB) + (size_t)m * DM);
    }
}
__device__ __forceinline__ void rowpassB(Frame& F, int l) {
    const int gw = blockIdx.x * NWAVES + F.wave, NGW = F.G * NWAVES;
    const float* ng = F.in[I_NG] + (size_t)l * 4 * DM;
    for (int m = gw; m < MT; m += NGW) {
        const f32x4* orow = (const f32x4*)(F.ws + WS_OB) + (size_t)m * (DM / 4);
        const f32x4* xr = (const f32x4*)(F.ws + WS_XB) + (size_t)m * (DM / 4);
        f32x4 o[8], x[8];
#pragma unroll
        for (int j = 0; j < 8; ++j) { o[j] = orow[F.lane + 64 * j]; x[j] = xr[F.lane + 64 * j]; }
        const float r1 = rsqrtf(row_ss(o) * (1.0f / DM) + EPS);
        const float* gf = mod_vec(F, l, m, 5);
        f32x4* xo = (l == DEPTH - 1) ? (f32x4*)(F.out + OUT_Y) + (size_t)m * (DM / 4) : (f32x4*)(F.ws + WS_XB) + (size_t)m * (DM / 4);
#pragma unroll
        for (int j = 0; j < 8; ++j) { const int q = F.lane + 64 * j; x[j] = x[j] + ((const f32x4*)gf)[q] * (o[j] * r1 * ((const f32x4*)(ng + 3 * DM))[q]); xo[q] = x[j]; }
        if (l < DEPTH - 1) {
            const float r2 = rsqrtf(row_ss(x) * (1.0f / DM) + EPS);
            write_h(F, x, r2, ng + 4 * DM, mod_vec(F, l + 1, m, 1), mod_vec(F, l + 1, m, 0), (bf16_t*)(F.ws + WS_HB) + (size_t)m * DM);
        }
    }
}

__device__ __forceinline__ void p2_prepass(Frame& F, int l) {
    const bf16_t* PROJ = (const bf16_t*)(F.ws + WS_PROJ);
    bf16_t* QB = (bf16_t*)(F.ws + WS_QB); bf16_t* KB = (bf16_t*)(F.ws + WS_KB); bf16_t* VB = (bf16_t*)(F.ws + WS_VB); bf16_t* MIX = (bf16_t*)(F.ws + WS_MIX);
    float* SCAN = (float*)(F.ws + WS_SCAN); float* GB = (float*)(F.ws + WS_GB); float* BON = (float*)(F.ws + WS_BON);
    for (int pi = blockIdx.x * NTHREADS + F.tid; pi < 131072; pi += F.G * NTHREADS) {
        const int e = 2 * pi, b = e >> 16, rem = e & 65535, p = rem >> 8, col = rem & 255;
        const size_t src = ((size_t)(b * 2 + l) * 256 + p) * 256 + col, dst = (size_t)(MC + b * 1280 + 1024 + p) * 256 + col;
        const f32x2 kv = *(const f32x2*)(F.in[I_CK] + src), vv = *(const f32x2*)(F.in[I_CV] + src);
        *(unsigned*)(KB + dst) = pk2(kv.x, kv.y); *(unsigned*)(VB + dst) = pk2(vv.x, vv.y);
    }
    for (int item = blockIdx.x; item < MT / 32; item += F.G) {
        asm volatile("" ::: "memory");
        int tid = F.tid; asm volatile("" : "+v"(tid)); const int lane = tid & 63;
        const int m0 = item * 32; const bool smp = m0 >= MC;
        const int sb = smp ? (m0 - MC) >> 10 : m0 >> 8, t0 = smp ? (m0 - MC) & 1023 : m0 & 255, seqlen = smp ? 1024 : 256;
#if PP_MASK & 1
        for (int wi = F.wave; wi < 32 * 12; wi += NWAVES) {
            const int tok = wi / 12, j = wi % 12, m = m0 + tok, t = t0 + tok;
            const bf16_t* prow = PROJ + (size_t)m * DINP;
            const size_t krow = smp ? (size_t)(MC + sb * 1280 + t) : (size_t)m;
            if (j < 10) {
                const int col0 = j < 8 ? j * 128 : O_K + (j - 8) * 128;
                const float* g = (j < 8 ? F.in[I_QN] : F.in[I_KN]) + l * 128;
                const int e1 = lane < 32 ? lane : lane + 32, e2 = e1 + 32;
                const float x1 = bf2f(prow[col0 + e1]), x2 = bf2f(prow[col0 + e2]);
                const float rs = rsqrtf(wave_sum(x1 * x1 + x2 * x2) * (1.0f / 128.0f) + EPS);
                float y1 = x1 * rs * g[e1], y2 = x2 * rs * g[e2];
                if (!smp && j >= 8) { float* nk = F.out + OUT_NK + ((size_t)(sb * 2 + l) * 256 + t) * 256 + (j - 8) * 128; nk[e1] = y1; nk[e2] = y2; }
                if (smp) {
                    const float pos = (float)(lane < 32 ? (t >> 6) : (t & 63));
                    const float inv = exp2f(-(float)(2 * (lane & 31)) * (13.287712379549449f / 64.0f));
                    const float ang = pos * inv; float rev = ang * 0.15915494309189535f; rev = rev - floorf(rev);
                    const float s = __builtin_amdgcn_sinf(rev), c = __builtin_amdgcn_cosf(rev);
                    const float o1 = y1 * c - y2 * s, o2 = y2 * c + y1 * s; y1 = o1; y2 = o2;
                }
                bf16_t* dst = j < 8 ? QB + (size_t)m * 1024 + j * 128 : KB + krow * 256 + (j - 8) * 128;
                dst[e1] = f2bf(y1); dst[e2] = f2bf(y2);
            } else {
                const int kvh = j - 10; const unsigned u = *(const unsigned*)(prow + O_V + kvh * 128 + 2 * lane);
                *(unsigned*)(VB + krow * 256 + kvh * 128 + 2 * lane) = u;
                if (!smp) { float* nv = F.out + OUT_NV + ((size_t)(sb * 2 + l) * 256 + t) * 256 + kvh * 128 + 2 * lane; nv[0] = __uint_as_float(u << 16); nv[1] = __uint_as_float(u & 0xffff0000u); }
            }
        }
#endif
#if PP_MASK & 2
        {
            const int c = tid; const float* cw = F.in[I_CONVW] + (size_t)l * 3 * 512;
            const float w0 = cw[c], w1 = cw[512 + c], w2 = cw[1024 + c];
            const bf16_t* pr = PROJ + (size_t)m0 * DINP;
            float prev = t0 > 0 ? bf2f(pr[-DINP + O_CC + c]) * bf2f(pr[-DINP + O_CH + c]) : 0.f;
            float cur = bf2f(pr[O_CC + c]) * bf2f(pr[O_CH + c]);
#pragma unroll 1
            for (int tok = 0; tok < 32; ++tok) {
                const bf16_t* p = pr + (size_t)tok * DINP;
                const float nxt = (t0 + tok + 1 < seqlen) ? bf2f(p[DINP + O_CC + c]) * bf2f(p[DINP + O_CH + c]) : 0.f;
                const float o = bf2f(p[O_CB + c]) * (w0 * prev + w1 * cur + w2 * nxt);
                MIX[(size_t)(m0 + tok) * DM + 1024 + c] = f2bf(o);
                prev = cur; cur = nxt;
            }
        }
#endif
        LAS float* sm = (LAS float*)F.lds;
        const float* mu = F.in[I_MU] + (size_t)l * 1696;
        __syncthreads();
        for (int idx = tid; idx < 32 * 160; idx += NTHREADS) {
            const int tok = idx / 160, k = idx % 160, col = 1536 + k, t = t0 + tok;
            const bf16_t* p = PROJ + (size_t)(m0 + tok) * DINP + O_UR + col;
            const float u = bf2f(p[0]), up = t > 0 ? bf2f(p[-DINP]) : 0.f, un = t + 1 < seqlen ? bf2f(p[DINP]) : 0.f;
            const float us = u + mu[col] * (0.5f * (up + un) - u);
            sm[idx] = k < 32 ? tanhf(us) : (k < 64 ? us : sigmoidf_(us));
        }
        __syncthreads();
        const int c = tid, h = F.wave, i = lane;
#if PP_MASK & 4
        {
            asm volatile("" ::: "memory");
            float wa0[32], wa1[32];
            const float* au = F.in[I_AUP] + (size_t)l * 2 * 32 * 512 + c;
#pragma unroll
            for (int k = 0; k < 32; ++k) { wa0[k] = au[0]; wa1[k] = au[32 * 512]; au += 512; asm volatile("" : "+v"(au)); }
            const float a0b0 = F.in[I_A0][(l * 2 + 0) * 512 + c], a0b1 = F.in[I_A0][(l * 2 + 1) * 512 + c];
            const float kkc = F.in[I_KK][l * 512 + c], kac = F.in[I_KA][l * 512 + c], rkc = F.in[I_RK][l * 512 + c];
            const float mur = mu[c], muk = mu[512 + c], muv = mu[1024 + c];
            const bf16_t* pr = PROJ + (size_t)m0 * DINP + O_UR + c;
            float pr_r = 0.f, pr_k = 0.f, pr_v = 0.f;
            if (t0 > 0) { pr_r = bf2f(pr[-DINP]); pr_k = bf2f(pr[-DINP + 512]); pr_v = bf2f(pr[-DINP + 1024]); }
            float cu_r = bf2f(pr[0]), cu_k = bf2f(pr[512]), cu_v = bf2f(pr[1024]);
#pragma unroll 1
            for (int tok = 0; tok < 32; ++tok) {
                const bf16_t* p = pr + (size_t)tok * DINP; const int m = m0 + tok;
                float nx_r = 0.f, nx_k = 0.f, nx_v = 0.f;
                if (t0 + tok + 1 < seqlen) { nx_r = bf2f(p[DINP]); nx_k = bf2f(p[DINP + 512]); nx_v = bf2f(p[DINP + 1024]); }
                const float r = cu_r + mur * (0.5f * (pr_r + nx_r) - cu_r), k = cu_k + muk * (0.5f * (pr_k + nx_k) - cu_k), v = cu_v + muv * (0.5f * (pr_v + nx_v) - cu_v);
                pr_r = cu_r; pr_k = cu_k; pr_v = cu_v; cu_r = nx_r; cu_k = nx_k; cu_v = nx_v;
                const float kkr = k * kkc; const float kk = kkr * rsqrtf(wave_sum(kkr * kkr) + 1e-12f);
                float za0 = a0b0, za1 = a0b1; const LAS float* xa = sm + tok * 160 + 32;
#pragma unroll
                for (int q = 0; q < 8; ++q) { const f32x4 s = *(const LAS f32x4*)(xa + 4 * q);
                    za0 += s.x * wa0[4 * q] + s.y * wa0[4 * q + 1] + s.z * wa0[4 * q + 2] + s.w * wa0[4 * q + 3];
                    za1 += s.x * wa1[4 * q] + s.y * wa1[4 * q + 1] + s.z * wa1[4 * q + 2] + s.w * wa1[4 * q + 3]; }
                const float a0 = sigmoidf_(za0), a1 = sigmoidf_(za1);
                const float kd0 = k * (1.0f + (a0 - 1.0f) * kac), kd1 = k * (1.0f + (a1 - 1.0f) * kac);
                const float bs = wave_sum(r * (kd0 + kd1) * rkc);
                float* base = SCAN + ((size_t)m * 8 + h) * 576 + i;
                base[0] = r; base[64] = v; base[128] = kk; base[256] = kd0; base[320] = kk * a0; base[448] = kd1; base[512] = kk * a1;
                BON[(size_t)m * 512 + c] = bs * v;
            }
        }
#endif
#if PP_MASK & 8
        {
            asm volatile("" ::: "memory");
            float ww0[32], ww1[32];
            const float* wu = F.in[I_WUP] + (size_t)l * 2 * 32 * 512 + c;
#pragma unroll
            for (int k = 0; k < 32; ++k) { ww0[k] = wu[0]; ww1[k] = wu[32 * 512]; wu += 512; asm volatile("" : "+v"(wu)); }
            const float b0 = F.in[I_W0][(l * 2 + 0) * 512 + c], b1 = F.in[I_W0][(l * 2 + 1) * 512 + c];
#pragma unroll 1
            for (int tok = 0; tok < 32; ++tok) {
                float z0 = b0, z1 = b1; const LAS float* xw = sm + tok * 160;
#pragma unroll
                for (int q = 0; q < 8; ++q) { const f32x4 s = *(const LAS f32x4*)(xw + 4 * q);
                    z0 += s.x * ww0[4 * q] + s.y * ww0[4 * q + 1] + s.z * ww0[4 * q + 2] + s.w * ww0[4 * q + 3];
                    z1 += s.x * ww1[4 * q] + s.y * ww1[4 * q + 1] + s.z * ww1[4 * q + 2] + s.w * ww1[4 * q + 3]; }
                const float sp0 = fmaxf(-z0, 0.f) + log1pf(__expf(-fabsf(z0))), sp1 = fmaxf(-z1, 0.f) + log1pf(__expf(-fabsf(z1)));
                float* base = SCAN + ((size_t)(m0 + tok) * 8 + h) * 576 + i;
                base[192] = __expf(-__expf(-sp0 - 0.5f)); base[384] = __expf(-__expf(-sp1 - 0.5f));
            }
        }
#endif
#if PP_MASK & 16
        {
            asm volatile("" ::: "memory");
            float wg[96];
            const float* gu = F.in[I_GUP] + (size_t)l * 96 * 512 + c;
#pragma unroll
            for (int k = 0; k < 96; ++k) { wg[k] = gu[0]; gu += 512; asm volatile("" : "+v"(gu)); }
#pragma unroll 1
            for (int tok = 0; tok < 32; ++tok) {
                float g = 0.f; const LAS float* xg = sm + tok * 160 + 64;
#pragma unroll
                for (int q = 0; q < 24; ++q) { const f32x4 s = *(const LAS f32x4*)(xg + 4 * q); g += s.x * wg[4 * q] + s.y * wg[4 * q + 1] + s.z * wg[4 * q + 2] + s.w * wg[4 * q + 3]; }
                GB[(size_t)(m0 + tok) * 512 + c] = g;
            }
        }
#endif
        __syncthreads();
    }
}

__device__ __forceinline__ void scan_item(Frame& F, int l, bool smp, int b, int h, int d) {
    int tid = F.tid; asm volatile("" : "+v"(tid));
    const int seqlen = smp ? 1024 : 256, seq_base = smp ? MC + b * 1024 : b * 256, nch = seqlen / 16;
    const int p = tid >> 4, c = tid & 15, i0 = p, i1 = p + 32;
    f32x4 s0 = {0.f, 0.f, 0.f, 0.f}, s1 = {0.f, 0.f, 0.f, 0.f};
    if (smp) { const float* S0 = F.in[I_ST] + ((((size_t)b * 2 + l) * 2 + d) * 8 + h) * 4096; s0 = *(const f32x4*)(S0 + i0 * 64 + 4 * c); s1 = *(const f32x4*)(S0 + i1 * 64 + 4 * c); }
    LAS float* opb = (LAS float*)F.lds;
    LAS float* yb = opb + 2 * 6144;
    const float* SCAN = (const float*)(F.ws + WS_SCAN); float* YB = (float*)(F.ws + WS_YB) + (size_t)d * MT * 512;
    int sst[3], soff[3];
#pragma unroll
    for (int j = 0; j < 3; ++j) { const int e4 = tid + 512 * j, s = e4 / 96, rem = e4 % 96, vec = rem >> 4, q4 = rem & 15; sst[j] = s; soff[j] = (vec < 3 ? vec : 3 + 3 * d + (vec - 3)) * 64 + 4 * q4; }
    f32x4 stg[3];
#define SCAN_TOK(ci, s) (d ? seqlen - 1 - ((ci) * 16 + (s)) : (ci) * 16 + (s))
#define SCAN_LOAD(ci) do { _Pragma("unroll") for (int j = 0; j < 3; ++j) stg[j] = *(const f32x4*)(SCAN + ((size_t)(seq_base + SCAN_TOK(ci, sst[j])) * 8 + h) * 576 + soff[j]); } while (0)
#define SCAN_STORE(buf) do { _Pragma("unroll") for (int j = 0; j < 3; ++j) *(LAS f32x4*)(opb + (buf) * 6144 + (tid + 512 * j) * 4) = stg[j]; } while (0)
    __syncthreads();
    SCAN_LOAD(0); SCAN_STORE(0);
    __syncthreads();
    for (int ci = 0; ci < nch; ++ci) {
        if (ci + 1 < nch) SCAN_LOAD(ci + 1);
        const LAS float* ob = opb + (ci & 1) * 6144;
#pragma unroll 4
        for (int s = 0; s < 16; ++s) {
            const LAS float* o = ob + s * 384;
            const f32x4 r4 = *(const LAS f32x4*)(o + 4 * c), kk4 = *(const LAS f32x4*)(o + 128 + 4 * c), w4 = *(const LAS f32x4*)(o + 192 + 4 * c);
            const f32x4 kd4 = *(const LAS f32x4*)(o + 256 + 4 * c), ka4 = *(const LAS f32x4*)(o + 320 + 4 * c);
            const float v0 = o[64 + i0], v1 = o[64 + i1];
            float d0 = (s0.x * kk4.x + s0.y * kk4.y) + (s0.z * kk4.z + s0.w * kk4.w), d1 = (s1.x * kk4.x + s1.y * kk4.y) + (s1.z * kk4.z + s1.w * kk4.w);
            d0 = row16_sum(d0); d1 = row16_sum(d1);
            s0 = s0 * w4 + (ka4 * (-d0) + kd4 * v0);
            s1 = s1 * w4 + (ka4 * (-d1) + kd4 * v1);
            float y0 = (s0.x * r4.x + s0.y * r4.y) + (s0.z * r4.z + s0.w * r4.w), y1 = (s1.x * r4.x + s1.y * r4.y) + (s1.z * r4.z + s1.w * r4.w);
            y0 = row16_sum(y0); y1 = row16_sum(y1);
            if (c == 0) { yb[s * 64 + i0] = y0; yb[s * 64 + i1] = y1; }
        }
        __syncthreads();
        if (tid < 256) { const int s = tid >> 4, i4 = tid & 15; const f32x4 v = *(const LAS f32x4*)(yb + s * 64 + 4 * i4);
            *(f32x4*)(YB + (size_t)(seq_base + SCAN_TOK(ci, s)) * 512 + h * 64 + 4 * i4) = v; }
        if (ci + 1 < nch) SCAN_STORE((ci + 1) & 1);
        __syncthreads();
    }
    if (!smp) { float* O = F.out + OUT_ST + ((((size_t)b * 2 + l) * 2 + d) * 8 + h) * 4096; *(f32x4*)(O + i0 * 64 + 4 * c) = s0; *(f32x4*)(O + i1 * 64 + 4 * c) = s1; }
#undef SCAN_TOK
#undef SCAN_LOAD
#undef SCAN_STORE
}

__device__ __forceinline__ void mixer_phase(Frame& F, int l, int rep) {
    unsigned* head = (unsigned*)(F.ws + WS_CTL) + CW_QUEUE + 64 * (2 * l + rep);
    volatile LAS unsigned* slot = (volatile LAS unsigned*)(F.lds + MISC_OFF);
    const bf16_t* QB = (const bf16_t*)(F.ws + WS_QB); const bf16_t* KB = (const bf16_t*)(F.ws + WS_KB); const bf16_t* VB = (const bf16_t*)(F.ws + WS_VB); bf16_t* MIX = (bf16_t*)(F.ws + WS_MIX);
    for (;;) {
        __syncthreads();
        if (F.tid == 0) slot[0] = atomicAdd(head, 1u);
        __syncthreads();
        const int item = (int)slot[0];
        if (item >= 576) break;
        const bool is_scan = item < 64 || (item >= 192 && item < 448);
        if (is_scan) { const bool smp = item < 64; const int u = smp ? item : item - 192; scan_item(F, l, smp, u >> 4, (u >> 1) & 7, u & 1); }
        else {
            size_t row0, kr0; int hq, seq;
            if (item < 192) { const int u = item - 64, b = u >> 5, qb = u & 3; hq = (u >> 2) & 7; row0 = (size_t)MC + b * 1024 + qb * 256; kr0 = (size_t)MC + b * 1280; seq = 1280; }
            else { const int u = item - 448, b = u >> 3; hq = u & 7; row0 = (size_t)b * 256; kr0 = row0; seq = 256; }
            attn::attn_dense_body<attn::bf16>((const attn::bf16*)(QB + row0 * 1024 + hq * 128), (const attn::bf16*)(KB + kr0 * 256 + (hq >> 2) * 128), (const attn::bf16*)(VB + kr0 * 256 + (hq >> 2) * 128), MIX + row0 * DM + hq * 128, seq, (char*)F.ldsg);
        }
    }
}
__device__ __forceinline__ void rwkv_combine(Frame& F, int l) {
    const float* Y0 = (const float*)(F.ws + WS_YB); const float* Y1 = Y0 + (size_t)MT * 512;
    const float* GB = (const float*)(F.ws + WS_GB); const float* BON = (const float*)(F.ws + WS_BON); bf16_t* MIX = (bf16_t*)(F.ws + WS_MIX);
    const int c = F.tid; const float lg = F.in[I_LNG][l * 512 + c], lb = F.in[I_LNB][l * 512 + c];
    for (int item = blockIdx.x; item < MT / 32; item += F.G)
        for (int tok = 0; tok < 32; ++tok) { const size_t m = (size_t)item * 32 + tok;
            const float y = Y0[m * 512 + c] + Y1[m * 512 + c];
            const float mean = wave_sum(y) * (1.0f / 64.0f), dl = y - mean, var = wave_sum(dl * dl) * (1.0f / 64.0f);
            const float yn = dl * rsqrtf(var + GN_EPS) * lg + lb;
            MIX[m * DM + 1536 + c] = f2bf((yn + BON[m * 512 + c]) * GB[m * 512 + c]); }
}

constexpr int NPHASE = 2 + 9 * DEPTH;
#ifndef PH_MASK
#define PH_MASK 0xffff
#endif
#ifndef USE_CG_SYNC
#define USE_CG_SYNC 0
#endif
#ifndef REP_MASK
#define REP_MASK 0
#endif
#if ONE_LAUNCH && USE_CG_SYNC
#define GRID_BAR() cg::this_grid().sync()
#elif ONE_LAUNCH
#define GRID_BAR() xcd_barrier(F.bar)
#else
#define GRID_BAR() do {} while (0)
#endif
#define NREP(bit) ((REP_MASK & (bit)) ? 2 : 1)
#define IN(k) (lo <= (k) && (k) < hi)
#define SEAM(k) do { if (IN(k) && IN((k) + 1)) GRID_BAR(); } while (0)
template <int L> __device__ __forceinline__ void layer_phases(Frame& F, const int lo, const int hi) {
    constexpr int l = L, pb = 2 + 9 * L;
    if (IN(pb + 0) && (PH_MASK & 4)) {
        pg8::Gemm g{(const bf16_t*)(F.ws + WS_HB), (const bf16_t*)(F.ws + WS_WIN + l * SZ_WIN), MT, DINP, DM}; pg8::StaticOrder S; S.init(MT, DINP, F.G, (int)blockIdx.x);
        pg8::EpiBf16 E{(bf16_t*)(F.ws + WS_PROJ), DINP};
        for (int rep = 0; rep < NREP(4); ++rep) pg8::gemm_phase<pg8::EpiBf16, pg8::StaticOrder, true, true>(F.lds, g, S, E);
    } SEAM(pb + 0);
    if (IN(pb + 1) && (PH_MASK & 8)) { for (int rep = 0; rep < NREP(8); ++rep) p2_prepass(F, l); } SEAM(pb + 1);
    if (IN(pb + 2) && (PH_MASK & 16)) { for (int rep = 0; rep < NREP(16); ++rep) mixer_phase(F, l, rep); } SEAM(pb + 2);
    if (IN(pb + 3) && (PH_MASK & 32)) { for (int rep = 0; rep < NREP(32); ++rep) rwkv_combine(F, l); } SEAM(pb + 3);
    if (IN(pb + 4) && (PH_MASK & 64)) {
        pg8::Gemm g{(const bf16_t*)(F.ws + WS_MIX), (const bf16_t*)(F.ws + WS_WOUT + l * SZ_WOUT), MT, DM, DM}; pg8::StaticOrder S; S.init(MT, DM, F.G, (int)blockIdx.x);
        pg8::EpiF32 E{(float*)(F.ws + WS_OB), DM};
        for (int rep = 0; rep < NREP(64); ++rep) pg8::gemm_phase<pg8::EpiF32, pg8::StaticOrder, true, true>(F.lds, g, S, E);
    } SEAM(pb + 4);
    if (IN(pb + 5) && (PH_MASK & 128)) { rowpassA(F, l); } SEAM(pb + 5);
    if (IN(pb + 6) && (PH_MASK & 256)) {
        pg8::Gemm g{(const bf16_t*)(F.ws + WS_HB), (const bf16_t*)(F.ws + WS_WGU + l * SZ_WGU), MT, 2 * DFF, DM}; pg8::StaticOrder S; S.init(MT, 2 * DFF, F.G, (int)blockIdx.x);
        pg8::EpiSwiGLU E{(bf16_t*)(F.ws + WS_HID), DFF};
        for (int rep = 0; rep < NREP(256); ++rep) pg8::gemm_phase<pg8::EpiSwiGLU, pg8::StaticOrder, true, true>(F.lds, g, S, E);
    } SEAM(pb + 6);
    if (IN(pb + 7) && (PH_MASK & 512)) {
        pg8::Gemm g{(const bf16_t*)(F.ws + WS_HID), (const bf16_t*)(F.ws + WS_WDN + l * SZ_WDN), MT, DM, DFF}; pg8::StaticOrder S; S.init(MT, DM, F.G, (int)blockIdx.x);
        pg8::EpiF32 E{(float*)(F.ws + WS_OB), DM};
        for (int rep = 0; rep < NREP(512); ++rep) pg8::gemm_phase<pg8::EpiF32, pg8::StaticOrder, true, true>(F.lds, g, S, E);
    } SEAM(pb + 7);
    if (IN(pb + 8) && (PH_MASK & 1024)) { rowpassB(F, l); } SEAM(pb + 8);
}
__global__ void __launch_bounds__(NTHREADS, 2) hybrid_fwd(Args args) {
    extern __shared__ __attribute__((aligned(16))) unsigned char lds[];
    Frame F;
    F.lds = (LAS unsigned char*)lds; F.ldsg = lds; F.in = args.in; F.out = args.out; F.ws = args.ws;
    F.tid = threadIdx.x; F.lane = F.tid & 63; F.wave = __builtin_amdgcn_readfirstlane(F.tid >> 6); F.G = gridDim.x;
    const int lo = args.ph_lo, hi = args.ph_hi;
    if (F.tid < 32) ((LAS unsigned*)(F.lds + MISC_OFF))[F.tid] = 0u;
    __syncthreads();
#if ONE_LAUNCH && !USE_CG_SYNC
    F.bar = xcd_barrier_post((unsigned*)(F.ws + WS_CTL) + CW_BAR, (volatile LAS unsigned*)(F.lds + MISC_OFF) + 8);
#endif
    if (IN(0) && (PH_MASK & 1)) { for (int rep = 0; rep < NREP(1); ++rep) p0_prologue(F); } SEAM(0);
    if (IN(1) && (PH_MASK & 2)) { for (int rep = 0; rep < NREP(2); ++rep) rowpass0(F); } SEAM(1);
    layer_phases<0>(F, lo, hi);
    layer_phases<1>(F, lo, hi);
}
#undef IN
#undef SEAM

extern "C" void kernel_launch(void* const* d_in, const int* in_sizes, int n_in, void* d_out, int out_size, void* d_ws, size_t ws_size, hipStream_t stream) {
    static int grid = 0;
    if (grid == 0) {
        if (n_in != N_IN || (size_t)out_size != OUT_TOTAL || ws_size < WS_END) { fprintf(stderr, "kernel_launch: unexpected shapes: n_in %d out %d ws %zu (need %zu)\n", n_in, out_size, ws_size, (size_t)WS_END); grid = -1; return; }
        int dev = 0, cus = 0, per_cu = 0;
        if (hipGetDevice(&dev) != hipSuccess || hipDeviceGetAttribute(&cus, hipDeviceAttributeMultiprocessorCount, dev) != hipSuccess) { grid = -1; return; }
        if (hipFuncSetAttribute((const void*)hybrid_fwd, hipFuncAttributeMaxDynamicSharedMemorySize, LDS_BYTES) != hipSuccess) { fprintf(stderr, "kernel_launch: hipFuncSetAttribute failed\n"); grid = -1; return; }
        if (hipOccupancyMaxActiveBlocksPerMultiprocessor(&per_cu, (const void*)hybrid_fwd, NTHREADS, LDS_BYTES) != hipSuccess || per_cu < 1) { fprintf(stderr, "kernel_launch: occupancy query says %d blocks per CU\n", per_cu); (void)hipGetLastError(); grid = -1; return; }
        grid = cus;
    }
    if (grid < 0) return;
    (void)hipMemsetAsync((char*)d_ws + WS_CTL, 0, CTL_BYTES, stream);
    Args a{};
    for (int i = 0; i < N_IN; ++i) a.in[i] = (const float*)d_in[i];
    a.out = (float*)d_out; a.ws = (unsigned char*)d_ws;
#if ONE_LAUNCH
    a.ph_lo = 0; a.ph_hi = NPHASE;
    void* kargs[] = {&a};
    const hipError_t e = hipLaunchCooperativeKernel((const void*)hybrid_fwd, dim3(grid), dim3(NTHREADS), kargs, LDS_BYTES, stream);
    if (e != hipSuccess) fprintf(stderr, "kernel_launch: cooperative launch failed: %s (grid %d)\n", hipGetErrorString(e), grid);
#else
    for (int ph = 0; ph < NPHASE; ++ph) {
        a.ph_lo = ph; a.ph_hi = ph + 1;
        hipLaunchKernelGGL(hybrid_fwd, dim3(grid), dim3(NTHREADS), LDS_BYTES, stream, a);
    }
    const hipError_t le = hipPeekAtLastError();
    if (le != hipSuccess) fprintf(stderr, "kernel_launch: launch failed: %s\n", hipGetErrorName(le));
#endif
}
```

```cpp
#include <hip/hip_runtime.h>
#include <hip/hip_bf16.h>
#include <hip/hip_cooperative_groups.h>
#include <cstdio>
#include <cstdint>
#include <cmath>
namespace cg = cooperative_groups;
#ifndef ONE_LAUNCH
#define ONE_LAUNCH 1
#endif
namespace pg8 {
#define PG8_LAS __attribute__((address_space(3)))
typedef unsigned short bf16_t;
typedef short bf16x8 __attribute__((ext_vector_type(8)));
typedef float f32x4 __attribute__((ext_vector_type(4)));
typedef unsigned u32x4 __attribute__((ext_vector_type(4)));
constexpr int BM = 256, BK = 64, HALF = 128, HTB = HALF * BK * 2  , STAGE_BYTES = 8 * HTB, NXCD = 8, WGM = 8;

__host__ __device__ __forceinline__ int lds_byte(int r, int c) { const int st = (r >> 4) * 2 + (c >> 5), rr = r & 15, cc = c & 31, ob = rr * 64 + cc * 2; return st * 1024 + (ob ^ (((ob >> 9) & 1) << 5)); }
__host__ __device__ __forceinline__ void stage_rc(int b, int& R, int& C) { const int st = b / 1024, sb = b % 1024, swz = sb ^ (((sb >> 9) & 1) << 5); R = (st >> 1) * 16 + swz / 64; C = (st & 1) * 32 + (swz % 64) / 2; }
__host__ __device__ __forceinline__ int perm32(int rho) { const int n = rho >> 4, i = rho & 15; return 8 * (i >> 2) + 4 * n + (i & 3); }

struct Unit { int pm, pn; };
struct Gemm { const bf16_t* A; const bf16_t* Bt; int M, N, K; };

struct StaticOrder {
    int nM, nN, nwg, G, c;
    __host__ __device__ void init(int M, int N, int G_, int c_) { nM = M / BM; nN = N / BM; nwg = nM * nN; G = G_; c = c_; }
    __host__ __device__ bool next(int i, Unit& u) const {
        const long L = (long)i * G + c; if (L >= nwg) return false;
        int wgid = (int)L; { const int q = nwg / NXCD, r = nwg % NXCD, xcd = wgid % NXCD, off = wgid / NXCD; wgid = (xcd < r ? xcd * (q + 1) : r * (q + 1) + (xcd - r) * q) + off; }
        const int nig = WGM * nN, gid = wgid / nig, fm = gid * WGM, gsz = (nM - fm) < WGM ? (nM - fm) : WGM;
        u.pm = fm + ((wgid % nig) % gsz); u.pn = (wgid % nig) / gsz; return true;
    }
    __device__ __forceinline__ void a_ready(const Unit&) const {}
    __device__ __forceinline__ void done(const Unit&) const {}
};

__device__ __forceinline__ unsigned cvt_pk_bf16(float lo, float hi) { unsigned r; asm volatile("v_cvt_pk_bf16_f32 %0, %1, %2" : "=v"(r) : "v"(lo), "v"(hi)); return r; }
struct EpiBf16 {
    static constexpr bool PERM = true, AFTER_DRAIN = false;
    bf16_t* O; int ldc;
    __device__ __forceinline__ void operator()(const f32x4 (&acc)[2][2][4][2], const Unit& u, int wr, int wc, int fr, int fq) const {
        const int row0 = u.pm * BM + wr * 64 + fr; const int col0 = u.pn * BM + wc * 32 + 8 * fq;
#pragma unroll
        for (int ai = 0; ai < 2; ++ai)
#pragma unroll
            for (int m = 0; m < 4; ++m) { bf16_t* rowp = O + (size_t)(row0 + ai * HALF + m * 16) * ldc + col0;
#pragma unroll
                for (int bj = 0; bj < 2; ++bj) { const f32x4 v0 = acc[ai][bj][m][0], v1 = acc[ai][bj][m][1];
                    u32x4 w; w.x = cvt_pk_bf16(v0[0], v0[1]); w.y = cvt_pk_bf16(v0[2], v0[3]); w.z = cvt_pk_bf16(v1[0], v1[1]); w.w = cvt_pk_bf16(v1[2], v1[3]);
                    *(u32x4*)(rowp + bj * HALF) = w; } }
    }
};
struct EpiF32 {
    static constexpr bool PERM = false, AFTER_DRAIN = false;
    float* O; int ldc;
    __device__ __forceinline__ void operator()(const f32x4 (&acc)[2][2][4][2], const Unit& u, int wr, int wc, int fr, int fq) const {
        const int row0 = u.pm * BM + wr * 64 + fr; const int col0 = u.pn * BM + wc * 32 + 4 * fq;
#pragma unroll
        for (int ai = 0; ai < 2; ++ai)
#pragma unroll
            for (int m = 0; m < 4; ++m) { float* rowp = O + (size_t)(row0 + ai * HALF + m * 16) * ldc + col0;
#pragma unroll
                for (int bj = 0; bj < 2; ++bj)
#pragma unroll
                    for (int n = 0; n < 2; ++n) *(f32x4*)(rowp + bj * HALF + n * 16) = acc[ai][bj][m][n]; }
    }
};
__device__ __forceinline__ float silu_mul(float g, float u) { return g * __builtin_amdgcn_rcpf(1.0f + __expf(-g)) * u; }
struct EpiSwiGLU {
    static constexpr bool PERM = true, AFTER_DRAIN = false;
    bf16_t* O; int ldc;
    __device__ __forceinline__ void operator()(const f32x4 (&acc)[2][2][4][2], const Unit& u, int wr, int wc, int fr, int fq) const {
        const int row0 = u.pm * BM + wr * 64 + fr; const int col0 = u.pn * HALF + wc * 32 + 8 * fq;
#pragma unroll
        for (int ai = 0; ai < 2; ++ai)
#pragma unroll
            for (int m = 0; m < 4; ++m) { bf16_t* rowp = O + (size_t)(row0 + ai * HALF + m * 16) * ldc + col0;
                const f32x4 g0 = acc[ai][0][m][0], g1 = acc[ai][0][m][1], u0 = acc[ai][1][m][0], u1 = acc[ai][1][m][1];
                u32x4 w; w.x = cvt_pk_bf16(silu_mul(g0[0], u0[0]), silu_mul(g0[1], u0[1])); w.y = cvt_pk_bf16(silu_mul(g0[2], u0[2]), silu_mul(g0[3], u0[3]));
                w.z = cvt_pk_bf16(silu_mul(g1[0], u1[0]), silu_mul(g1[1], u1[1])); w.w = cvt_pk_bf16(silu_mul(g1[2], u1[2]), silu_mul(g1[3], u1[3]));
                *(u32x4*)rowp = w; }
    }
};
template <class Epi, class Sched, bool ALIGN_EPI = false, bool SP2 = false>
__device__ __forceinline__ void gemm_phase(PG8_LAS unsigned char* lds, const Gemm g, const Sched& S, const Epi& E) {
    const int tid = threadIdx.x, wid = __builtin_amdgcn_readfirstlane(tid >> 6), lane = tid & 63, wr = wid >> 2, wc = wid & 3, fr = lane & 15, fq = lane >> 4;
    const int K = g.K, nt = K / BK;
    unsigned voffA[2], voffB[2];
#pragma unroll
    for (int i = 0; i < 2; ++i) { int R, C; stage_rc(tid * 16 + i * 8192, R, C); const int Rb = Epi::PERM ? ((R & ~31) + perm32(R & 31)) : R;
        voffA[i] = (unsigned)(R * K + C) * 2u; voffB[i] = (unsigned)(Rb * K + C) * 2u; }
    const size_t kstep = (size_t)(BK * 2);
    const size_t hstep = (size_t)HALF * K * 2;
    const size_t tstep = 2 * hstep;
    const unsigned ldsw = (unsigned)wid * 1024u;
    const int aoff = lds_byte(wr * 64 + fr, fq * 8), boff = lds_byte(wc * 32 + fr, fq * 8);
#define PG8_SA(b, h) (((b) * 2 + (h)) * HTB)
#define PG8_SB(b, h) ((4 + (b) * 2 + (h)) * HTB)
#define PG8_STAGE(bufoff, gbase, voff) do { _Pragma("unroll") for (int _i = 0; _i < 2; ++_i) \
        __builtin_amdgcn_global_load_lds((const unsigned*)((const char*)(gbase) + (voff)[_i]), (PG8_LAS unsigned*)(lds + (bufoff) + ldsw + _i * 8192), 16, 0, 0); } while (0)
#define PG8_LDA(dst, b, h) do { _Pragma("unroll") for (int m = 0; m < 4; ++m) _Pragma("unroll") for (int k = 0; k < 2; ++k) dst[m][k] = *(const PG8_LAS bf16x8*)(lds + PG8_SA(b, h) + aoff + m * 2048 + k * 1024); } while (0)
#define PG8_LDB(dst, b, h) do { _Pragma("unroll") for (int n = 0; n < 2; ++n) _Pragma("unroll") for (int k = 0; k < 2; ++k) dst[n][k] = *(const PG8_LAS bf16x8*)(lds + PG8_SB(b, h) + boff + n * 2048 + k * 1024); } while (0)
#define PG8_MMA(ai, bj, At, Bt) do { __builtin_amdgcn_s_setprio(1); _Pragma("unroll") for (int m = 0; m < 4; ++m) _Pragma("unroll") for (int n = 0; n < 2; ++n) _Pragma("unroll") for (int k = 0; k < 2; ++k) \
        acc[ai][bj][m][n] = __builtin_amdgcn_mfma_f32_16x16x32_bf16(Bt[n][k], At[m][k], acc[ai][bj][m][n], 0, 0, 0); __builtin_amdgcn_s_setprio(0); } while (0)
#define PG8_WAIT_V(n) asm volatile("s_waitcnt vmcnt(" #n ")" ::: "memory")
#define PG8_WAIT_L(n) asm volatile("s_waitcnt lgkmcnt(" #n ")" ::: "memory")
#define PG8_BAR __builtin_amdgcn_s_barrier()
#define PG8_SCHED __builtin_amdgcn_sched_barrier(0)
    Unit cur, nxt; int ui = 0;
    if (!S.next(0, cur)) return;
    f32x4 acc[2][2][4][2];
#pragma unroll
    for (int a = 0; a < 2; ++a)
#pragma unroll
        for (int b = 0; b < 2; ++b)
#pragma unroll
            for (int m = 0; m < 4; ++m)
#pragma unroll
                for (int n = 0; n < 2; ++n) acc[a][b][m][n] = (f32x4){0.f, 0.f, 0.f, 0.f};
    bf16x8 At[4][2], B0[2][2], B1[2][2];
    const char* cA = (const char*)g.A + (size_t)cur.pm * tstep; const char* cB = (const char*)g.Bt + (size_t)cur.pn * tstep;
    S.a_ready(cur);
    if constexpr (SP2) {
        PG8_STAGE(PG8_SB(0, 0), cB, voffB); PG8_STAGE(PG8_SB(0, 1), cB + hstep, voffB); PG8_STAGE(PG8_SA(0, 0), cA, voffA); PG8_STAGE(PG8_SA(0, 1), cA + hstep, voffA);
        if (wr == 1) PG8_BAR;
        PG8_WAIT_V(2); PG8_BAR;
        PG8_STAGE(PG8_SB(1, 0), cB + kstep, voffB); PG8_STAGE(PG8_SA(1, 0), cA + kstep, voffA); PG8_STAGE(PG8_SB(1, 1), cB + hstep + kstep, voffB);
        PG8_WAIT_V(6); PG8_BAR;
    } else {
        PG8_STAGE(PG8_SB(0, 0), cB, voffB); PG8_STAGE(PG8_SA(0, 0), cA, voffA); PG8_STAGE(PG8_SB(0, 1), cB + hstep, voffB); PG8_STAGE(PG8_SA(0, 1), cA + hstep, voffA);
        if (wr == 1) PG8_BAR;
        PG8_WAIT_V(4); PG8_BAR;
        PG8_STAGE(PG8_SB(1, 0), cB + kstep, voffB); PG8_STAGE(PG8_SA(1, 0), cA + kstep, voffA); PG8_STAGE(PG8_SB(1, 1), cB + hstep + kstep, voffB);
        PG8_WAIT_V(6); PG8_BAR;
    }
    for (;;) {
        const bool has_next = S.next(ui + 1, nxt);
        const char* nA = has_next ? (const char*)g.A + (size_t)nxt.pm * tstep : cA; const char* nB = has_next ? (const char*)g.Bt + (size_t)nxt.pn * tstep : cB;
        for (int t = 0; t < nt; t += 2) {
            const bool last = (t == nt - 2);
            const char* a1 = cA + (size_t)(t + 1) * kstep;
            const char* a2 = last ? nA : cA + (size_t)(t + 2) * kstep; const char* b2 = last ? nB : cB + (size_t)(t + 2) * kstep;
            const char* a3 = a2 + kstep; const char* b3 = b2 + kstep;
            if (last && has_next) S.a_ready(nxt);
            if constexpr (SP2) {
            PG8_LDB(B0, 0, 0); PG8_LDB(B1, 0, 1); PG8_SCHED; PG8_LDA(At, 0, 0); PG8_STAGE(PG8_SA(1, 1), a1 + hstep, voffA);
            PG8_WAIT_V(8); PG8_WAIT_L(0); PG8_BAR; PG8_MMA(0, 0, At, B0); PG8_MMA(0, 1, At, B1); PG8_BAR; PG8_SCHED;
            PG8_LDA(At, 0, 1); PG8_STAGE(PG8_SB(0, 0), b2, voffB); PG8_STAGE(PG8_SB(0, 1), b2 + hstep, voffB); PG8_STAGE(PG8_SA(0, 0), a2, voffA);
            PG8_WAIT_V(8); PG8_WAIT_L(0); PG8_BAR; PG8_MMA(1, 0, At, B0); PG8_MMA(1, 1, At, B1); PG8_BAR; PG8_SCHED;
            PG8_LDB(B0, 1, 0); PG8_LDB(B1, 1, 1); PG8_SCHED; PG8_LDA(At, 1, 0); PG8_STAGE(PG8_SA(0, 1), a2 + hstep, voffA);
            PG8_WAIT_V(8); PG8_WAIT_L(0); PG8_BAR; PG8_MMA(0, 0, At, B0); PG8_MMA(0, 1, At, B1); PG8_BAR; PG8_SCHED;
            PG8_LDA(At, 1, 1); PG8_STAGE(PG8_SB(1, 0), b3, voffB); PG8_STAGE(PG8_SB(1, 1), b3 + hstep, voffB); PG8_STAGE(PG8_SA(1, 0), a3, voffA);
            PG8_WAIT_V(8); PG8_WAIT_L(0); PG8_BAR; PG8_MMA(1, 0, At, B0); PG8_MMA(1, 1, At, B1); PG8_BAR; PG8_SCHED;
            } else {
            PG8_LDB(B0, 0, 0); PG8_SCHED; PG8_LDA(At, 0, 0); PG8_STAGE(PG8_SA(1, 1), a1 + hstep, voffA);
            PG8_WAIT_L(8); PG8_BAR; PG8_WAIT_L(0); PG8_MMA(0, 0, At, B0); PG8_BAR; PG8_SCHED;
            PG8_LDB(B1, 0, 1); PG8_STAGE(PG8_SB(0, 0), b2, voffB);
            PG8_BAR; PG8_WAIT_L(0); PG8_MMA(0, 1, At, B1); PG8_BAR;
            PG8_LDA(At, 0, 1); PG8_STAGE(PG8_SA(0, 0), a2, voffA);
            PG8_BAR; PG8_WAIT_L(0); PG8_MMA(1, 0, At, B0); PG8_BAR; PG8_SCHED;
            PG8_STAGE(PG8_SB(0, 1), b2 + hstep, voffB);
            PG8_WAIT_V(6); PG8_BAR; PG8_MMA(1, 1, At, B1); PG8_BAR;
            PG8_LDB(B0, 1, 0); PG8_SCHED; PG8_LDA(At, 1, 0); PG8_STAGE(PG8_SA(0, 1), a2 + hstep, voffA);
            PG8_WAIT_L(8); PG8_BAR; PG8_WAIT_L(0); PG8_MMA(0, 0, At, B0); PG8_BAR; PG8_SCHED;
            PG8_LDB(B1, 1, 1); PG8_STAGE(PG8_SB(1, 0), b3, voffB);
            PG8_BAR; PG8_WAIT_L(0); PG8_MMA(0, 1, At, B1); PG8_BAR;
            PG8_LDA(At, 1, 1); PG8_STAGE(PG8_SA(1, 0), a3, voffA);
            PG8_BAR; PG8_WAIT_L(0); PG8_MMA(1, 0, At, B0); PG8_BAR; PG8_SCHED;
            PG8_STAGE(PG8_SB(1, 1), b3 + hstep, voffB);
            PG8_WAIT_V(6); PG8_BAR; PG8_MMA(1, 1, At, B1); PG8_BAR;
            }
        }
        if constexpr (ALIGN_EPI) { if (wr == 0) PG8_BAR; }
        if constexpr (!Epi::AFTER_DRAIN) { E(acc, cur, wr, wc, fr, fq); S.done(cur); }
        if (!has_next) break;
#pragma unroll
        for (int a = 0; a < 2; ++a)
#pragma unroll
            for (int b = 0; b < 2; ++b)
#pragma unroll
                for (int m = 0; m < 4; ++m)
#pragma unroll
                    for (int n = 0; n < 2; ++n) acc[a][b][m][n] = (f32x4){0.f, 0.f, 0.f, 0.f};
        cur = nxt; cA = nA; cB = nB; ++ui;
        if constexpr (ALIGN_EPI) { if (wr == 1) PG8_BAR; }
    }
    PG8_WAIT_V(0);
    if constexpr (!ALIGN_EPI) { if (wr == 0) PG8_BAR; }
    PG8_BAR;
    if constexpr (Epi::AFTER_DRAIN) { E.fused(acc, cur, wr, wc, fr, fq, lds, wid, lane); S.done(cur); }
#undef PG8_SA
#undef PG8_SB
#undef PG8_STAGE
#undef PG8_LDA
#undef PG8_LDB
#undef PG8_MMA
#undef PG8_WAIT_V
#undef PG8_WAIT_L
#undef PG8_BAR
#undef PG8_SCHED
}
}
namespace attn {
using bf16 = __hip_bfloat16;
constexpr int   D = 128, NW = 8, QBLK = 32, KVBLK = 64;
constexpr float SCALE = 0.088388347648318440f;
constexpr float THR = 8.f;
constexpr int SDEPTH = 2;
constexpr int LDQ = 1024, LDK = 256, LDO = 2048;
constexpr size_t SHM_V = KVBLK * D * 2, SHM_K = KVBLK * D * 2, SHM_ATTN = 2 * SHM_V + 2 * SHM_K + NW * 64 * 4;
__device__ __forceinline__ unsigned short f2bf_rne(float f) { unsigned u = __builtin_bit_cast(unsigned, f); return (unsigned short)((u + 0x7fffu + ((u >> 16) & 1u)) >> 16); }
using bf16x8 = __attribute__((ext_vector_type(8))) short;
using s16x4  = __attribute__((ext_vector_type(4))) short;
using f32x16 = __attribute__((ext_vector_type(16))) float;
using f32x8  = __attribute__((ext_vector_type(8))) float;
using u32x4  = __attribute__((ext_vector_type(4))) unsigned;
#define KSWZ(row, colB) ((row) * 256 + ((colB) ^ (((row) & 7) << 4)))
#define SBAR() __builtin_amdgcn_sched_barrier(0)
__device__ __forceinline__ int crow(int r, int hi) { return (r & 3) + 8 * (r >> 2) + 4 * hi; }
__device__ __forceinline__ unsigned cvtpk(float lo, float hi) {
  unsigned r; asm volatile("v_cvt_pk_bf16_f32 %0, %1, %2" : "=v"(r) : "v"(lo), "v"(hi)); return r;
}
template <typename TIn> struct Stage;
template <> struct Stage<bf16>  { using T = bf16x8;
  __device__ static __forceinline__ T ld8(const bf16* p) { return *reinterpret_cast<const bf16x8*>(p); }
  __device__ static __forceinline__ bf16x8 tobf(T x) { return x; } };
template <> struct Stage<float> { using T = f32x8;
  __device__ static __forceinline__ T ld8(const float* p) { return *reinterpret_cast<const f32x8*>(p); }
  __device__ static __forceinline__ bf16x8 tobf(T x) {
    u32x4 w = {cvtpk(x[0], x[1]), cvtpk(x[2], x[3]), cvtpk(x[4], x[5]), cvtpk(x[6], x[7])}; return *reinterpret_cast<bf16x8*>(&w); } };

__device__ __forceinline__ void partialSM(f32x16& p0, f32x16& p1, float& m_reg, float& mn, float& alpha) {
  constexpr float C = SCALE * 1.4426950408889634f;
  float pmax = p0[0]; for (int r = 1; r < 16; ++r) pmax = fmaxf(pmax, p0[r]); for (int r = 0; r < 16; ++r) pmax = fmaxf(pmax, p1[r]);
  { auto rr = __builtin_amdgcn_permlane32_swap(__float_as_uint(pmax), __float_as_uint(pmax), false, false);
    pmax = fmaxf(__uint_as_float(rr[0]), __uint_as_float(rr[1])); }
  if (__builtin_expect(__all(pmax - m_reg <= THR / SCALE), 1)) { mn = m_reg; alpha = 1.f; }
  else { mn = fmaxf(m_reg, pmax); alpha = __builtin_amdgcn_exp2f((m_reg - mn) * C); m_reg = mn; }
  float mnC = -mn * C;
  for (int r = 0; r < 16; ++r) p0[r] = fmaf(p0[r], C, mnC); for (int r = 0; r < 16; ++r) p1[r] = fmaf(p1[r], C, mnC);
  for (int r = 0; r < 16; ++r) p0[r] = __builtin_amdgcn_exp2f(p0[r]);
}
__device__ __forceinline__ void finishSM(f32x16& p0, f32x16& p1, float alpha, float& l_reg, bf16x8& pa0, bf16x8& pa1, bf16x8& pa2, bf16x8& pa3) {
  for (int r = 0; r < 16; ++r) p1[r] = __builtin_amdgcn_exp2f(p1[r]);
  float ps = 0; for (int r = 0; r < 16; ++r) ps += p0[r]; for (int r = 0; r < 16; ++r) ps += p1[r];
  { auto rr = __builtin_amdgcn_permlane32_swap(__float_as_uint(ps), __float_as_uint(ps), false, false);
    ps = __uint_as_float(rr[0]) + __uint_as_float(rr[1]); }
  l_reg = l_reg * alpha + ps;
#define PK4(P, BASE, OUT) do { unsigned a0 = cvtpk(P[BASE + 0], P[BASE + 1]), a1 = cvtpk(P[BASE + 2], P[BASE + 3]);   \
    unsigned b0 = cvtpk(P[BASE + 4], P[BASE + 5]), b1 = cvtpk(P[BASE + 6], P[BASE + 7]);                              \
    auto r0 = __builtin_amdgcn_permlane32_swap(a0, b0, false, false); auto r1 = __builtin_amdgcn_permlane32_swap(a1, b1, false, false); \
    u32x4 w = {r0[0], r1[0], r0[1], r1[1]}; OUT = *reinterpret_cast<bf16x8*>(&w); } while (0)
  PK4(p0, 0, pa0); PK4(p0, 8, pa1); PK4(p1, 0, pa2); PK4(p1, 8, pa3);
#undef PK4
}
__device__ __forceinline__ void qkt(f32x16& p0, f32x16& p1, const bf16* Ks, const bf16x8* qr, int r32, int hi) {
  p0 = f32x16{}; p1 = f32x16{};
  for (int d0 = 0; d0 < 8; ++d0) { int cb = (d0 * 16 + hi * 8) * 2;
    bf16x8 b0 = *reinterpret_cast<const bf16x8*>((const char*)Ks + KSWZ(r32, cb));
    bf16x8 b1 = *reinterpret_cast<const bf16x8*>((const char*)Ks + KSWZ(32 + r32, cb));
    p0 = __builtin_amdgcn_mfma_f32_32x32x16_bf16(b0, qr[d0], p0, 0, 0, 0);
    p1 = __builtin_amdgcn_mfma_f32_32x32x16_bf16(b1, qr[d0], p1, 0, 0, 0); }
}
__device__ __forceinline__ int v_st(int k, int c) { const int kk = (k & ~0xC) | ((k & 4) << 1) | ((k & 8) >> 1); return ((kk >> 3) * 4 + (c >> 5)) * 512 + ((kk & 7) * 32 + (c & 31)) * 2; }
__device__ __forceinline__ int v_rd_base(int lane) { return ((lane & 3) << 3) | (((lane >> 2) & 3) << 6) | (((lane >> 4) & 1) << 5) | (((lane >> 5) & 1) << 8); }
constexpr int v_rd_off(int d0, int ks, int half) { return d0 * 512 + ks * 4096 + half * 2048; }
template <int OFF> __device__ __forceinline__ s16x4 tr_read(int vb) {
  s16x4 r; asm volatile("ds_read_b64_tr_b16 %0, %1 offset:%2" : "=&v"(r) : "v"(vb), "i"(OFF) : "memory"); return r;
}
template <int D0> __device__ __forceinline__ void pv_one(f32x16& od, int vb, bf16x8 pa0, bf16x8 pa1, bf16x8 pa2, bf16x8 pa3) {
  const s16x4 l0 = tr_read<v_rd_off(D0, 0, 0)>(vb), h0 = tr_read<v_rd_off(D0, 0, 1)>(vb), l1 = tr_read<v_rd_off(D0, 1, 0)>(vb), h1 = tr_read<v_rd_off(D0, 1, 1)>(vb);
  const s16x4 l2 = tr_read<v_rd_off(D0, 2, 0)>(vb), h2 = tr_read<v_rd_off(D0, 2, 1)>(vb), l3 = tr_read<v_rd_off(D0, 3, 0)>(vb), h3 = tr_read<v_rd_off(D0, 3, 1)>(vb);
  asm volatile("s_waitcnt lgkmcnt(0)" ::: "memory"); SBAR();
#define PK(L, H) (bf16x8){L[0], L[1], L[2], L[3], H[0], H[1], H[2], H[3]}
  od = __builtin_amdgcn_mfma_f32_32x32x16_bf16(pa0, PK(l0, h0), od, 0, 0, 0);
  od = __builtin_amdgcn_mfma_f32_32x32x16_bf16(pa1, PK(l1, h1), od, 0, 0, 0);
  od = __builtin_amdgcn_mfma_f32_32x32x16_bf16(pa2, PK(l2, h2), od, 0, 0, 0);
  od = __builtin_amdgcn_mfma_f32_32x32x16_bf16(pa3, PK(l3, h3), od, 0, 0, 0);
#undef PK
}
__device__ __forceinline__ void pv_d0(f32x16* o, int vb, bf16x8 pa0, bf16x8 pa1, bf16x8 pa2, bf16x8 pa3) {
  pv_one<0>(o[0], vb, pa0, pa1, pa2, pa3); pv_one<1>(o[1], vb, pa0, pa1, pa2, pa3); pv_one<2>(o[2], vb, pa0, pa1, pa2, pa3); pv_one<3>(o[3], vb, pa0, pa1, pa2, pa3);
}
template <typename TQ>
__device__ __forceinline__ void attn_dense_body(const TQ* __restrict__ Qb, const bf16* __restrict__ Kh, const bf16* __restrict__ Vh,
                                                unsigned short* __restrict__ Ob, int seq, char* lds) {
  using St = Stage<bf16>; using SQ = Stage<TQ>;
  const int tid = threadIdx.x, wid = tid >> 6, lane = tid & 63, r32 = lane & 31, hi = lane >> 5;
  bf16* V_lds = (bf16*)lds; bf16* K_lds = (bf16*)(lds + 2 * SHM_V);
  float* ws = (float*)(lds + 2 * SHM_V + 2 * SHM_K) + wid * 64; float* li_l = ws; float* al_l = ws + 32;
  float m_reg = -1e30f, l_reg = 0; f32x16 o[4] = {}; bf16x8 qr[8];
  const TQ* Qw = Qb + (long)(wid * QBLK + r32) * LDQ + hi * 8;
#pragma unroll
  for (int d0 = 0; d0 < 8; ++d0) qr[d0] = SQ::tobf(SQ::ld8(Qw + d0 * 16));
  const int sr = tid >> 4, sc = (tid & 15) * 8, vst0 = v_st(sr, sc), vst1 = v_st(32 + sr, sc);
  const int vb0 = (int)(uintptr_t)V_lds + v_rd_base(lane);
  struct { typename St::T vs0, vs1, ks0, ks1; } sr_[SDEPTH];
#define SLOAD(i, k0) do { sr_[i].vs0 = St::ld8(&Vh[(long)((k0) + sr) * LDK + sc]); sr_[i].vs1 = St::ld8(&Vh[(long)((k0) + 32 + sr) * LDK + sc]); \
    sr_[i].ks0 = St::ld8(&Kh[(long)((k0) + sr) * LDK + sc]); sr_[i].ks1 = St::ld8(&Kh[(long)((k0) + 32 + sr) * LDK + sc]); } while (0)
#define SWRITE(b, i) do { *(bf16x8*)((char*)V_lds + (b) * SHM_V + vst0) = St::tobf(sr_[i].vs0);          \
    *(bf16x8*)((char*)V_lds + (b) * SHM_V + vst1) = St::tobf(sr_[i].vs1); int kc = sc * 2;               \
    *(bf16x8*)((char*)K_lds + (b) * SHM_K + KSWZ(sr, kc)) = St::tobf(sr_[i].ks0);                       \
    *(bf16x8*)((char*)K_lds + (b) * SHM_K + KSWZ(32 + sr, kc)) = St::tobf(sr_[i].ks1); } while (0)
#define SWAIT() do { if constexpr (SDEPTH == 2) asm volatile("s_waitcnt vmcnt(4)" ::: "memory"); else asm volatile("s_waitcnt vmcnt(0)" ::: "memory"); } while (0)
#define RESC(a) do { if (__any((a) < 1.f)) { if (hi == 0) al_l[r32] = (a); asm volatile("s_waitcnt lgkmcnt(0)" ::: "memory"); \
    for (int d = 0; d < 4; ++d) for (int r = 0; r < 16; ++r) o[d][r] *= al_l[crow(r, hi)]; } } while (0)
  f32x16 pA0, pA1, pB0, pB1; float mnA, mnB, alA, alB; bf16x8 pa0, pa1, pa2, pa3; const int NT = seq / KVBLK;
  constexpr int SE = 0, SO = SDEPTH - 1;
  SLOAD(SE, 0); asm volatile("s_waitcnt vmcnt(0)" ::: "memory"); SWRITE(0, SE); __syncthreads();
  qkt(pA0, pA1, K_lds, qr, r32, hi); partialSM(pA0, pA1, m_reg, mnA, alA);
  SLOAD(SO, KVBLK); if constexpr (SDEPTH == 2) { if (2 < NT) SLOAD(SE, 2 * KVBLK); }
  SWAIT(); SWRITE(1, SO); __syncthreads();
  for (int j = 1; j + 1 < NT; j += 2) {
    SBAR(); qkt(pB0, pB1, (bf16*)((char*)K_lds + SHM_K), qr, r32, hi);
    finishSM(pA0, pA1, alA, l_reg, pa0, pa1, pa2, pa3); SBAR();
    SLOAD(SO, (j + SDEPTH) * KVBLK); SBAR();
    pv_d0(o, vb0, pa0, pa1, pa2, pa3); partialSM(pB0, pB1, m_reg, mnB, alB);
    __syncthreads(); SWAIT(); SWRITE(0, SE);
    RESC(alB); __syncthreads();
    SBAR(); qkt(pA0, pA1, K_lds, qr, r32, hi);
    finishSM(pB0, pB1, alB, l_reg, pa0, pa1, pa2, pa3); SBAR();
    if (SDEPTH == 1 || j + 3 < NT) SLOAD(SE, (j + 1 + SDEPTH) * KVBLK); SBAR();
    pv_d0(o, vb0 + (int)SHM_V, pa0, pa1, pa2, pa3); partialSM(pA0, pA1, m_reg, mnA, alA);
    __syncthreads(); SWAIT(); SWRITE(1, SO);
    RESC(alA); __syncthreads();
  }
  SBAR(); qkt(pB0, pB1, (bf16*)((char*)K_lds + SHM_K), qr, r32, hi);
  finishSM(pA0, pA1, alA, l_reg, pa0, pa1, pa2, pa3); SBAR();
  pv_d0(o, vb0, pa0, pa1, pa2, pa3); partialSM(pB0, pB1, m_reg, mnB, alB);
  __syncthreads(); RESC(alB);
  finishSM(pB0, pB1, alB, l_reg, pa0, pa1, pa2, pa3); SBAR();
  pv_d0(o, vb0 + (int)SHM_V, pa0, pa1, pa2, pa3);
  if (hi == 0) li_l[r32] = l_reg; asm volatile("s_waitcnt lgkmcnt(0)" ::: "memory");
  float rli[16];
#pragma unroll
  for (int r = 0; r < 16; ++r) rli[r] = __builtin_amdgcn_rcpf(li_l[crow(r, hi)]);
  unsigned short* Ow = Ob + (long)(wid * QBLK) * LDO;
#pragma unroll
  for (int r = 0; r < 16; ++r) { int orow = crow(r, hi);
    for (int d0 = 0; d0 < 4; ++d0) Ow[(long)orow * LDO + d0 * 32 + r32] = f2bf_rne(o[d0][r] * rli[r]); }
#undef SLOAD
#undef SWRITE
#undef SWAIT
#undef RESC
}
}
#ifndef PP_MASK
#define PP_MASK 31
#endif
#ifndef PPR_MASK
#define PPR_MASK 0
#endif
#define GAS __attribute__((address_space(1)))
#define LAS __attribute__((address_space(3)))
typedef unsigned short bf16_t;
typedef float f32x4 __attribute__((ext_vector_type(4)));
typedef float f32x2 __attribute__((ext_vector_type(2)));
typedef unsigned u32x4 __attribute__((ext_vector_type(4)));
typedef unsigned u32x2 __attribute__((ext_vector_type(2)));
typedef __bf16 bf16x2_t __attribute__((ext_vector_type(2)));

constexpr int DM = 2048, MC = 4096, MS = 4096, MT = MC + MS, DEPTH = 2;
constexpr int DIN = 4768, DINP = 4864, DFF = 5632;
constexpr int O_K = 1024, O_V = 1280, O_CB = 1536, O_CC = 2048, O_CH = 2560, O_UR = 3072;
constexpr int KVROWS = 4096 + 4 * 1280;
constexpr float EPS = 1e-6f, GN_EPS = 64e-5f;
constexpr int NWAVES = 8, NTHREADS = 512;
enum { I_XP = 0, I_XS, I_CK, I_CV, I_ST, I_C, I_CCTX, I_WADA, I_BADA, I_NG, I_WIN, I_QN, I_KN, I_CONVW, I_MU, I_W0, I_WUP, I_A0, I_AUP, I_GUP, I_KK, I_KA, I_RK, I_LNG, I_LNB, I_WOUT, I_WGATE, I_WUPF, I_WDOWN, N_IN };
constexpr size_t OUT_Y = 0, OUT_NK = (size_t)MT * DM, OUT_NV = OUT_NK + 2097152, OUT_ST = OUT_NV + 2097152, OUT_TOTAL = OUT_ST + 2097152;
constexpr size_t MiB = 1u << 20;
constexpr size_t WS_CTL = 0, CTL_BYTES = 1 * MiB;
constexpr size_t WS_WIN = 1 * MiB, SZ_WIN = 19 * MiB;
constexpr size_t WS_WOUT = WS_WIN + 2 * SZ_WIN, SZ_WOUT = 8 * MiB;
constexpr size_t WS_WGU = WS_WOUT + 2 * SZ_WOUT, SZ_WGU = 44 * MiB;
constexpr size_t WS_WDN = WS_WGU + 2 * SZ_WGU, SZ_WDN = 22 * MiB;
constexpr size_t WS_MOD = WS_WDN + 2 * SZ_WDN;
constexpr size_t WS_HB = WS_MOD + 1 * MiB;
constexpr size_t WS_MIX = WS_HB + 32 * MiB;
constexpr size_t WS_XB = WS_MIX + 32 * MiB;
constexpr size_t WS_R1 = WS_XB + 64 * MiB;
constexpr size_t WS_PROJ = WS_R1;
constexpr size_t WS_QB = WS_R1 + 76 * MiB;
constexpr size_t WS_KB = WS_R1 + 92 * MiB;
constexpr size_t WS_VB = WS_R1 + 97 * MiB;
constexpr size_t WS_SCAN = WS_R1 + 102 * MiB;
constexpr size_t WS_YB = WS_R1 + 294 * MiB;
constexpr size_t WS_OB = WS_R1;
constexpr size_t WS_HID = WS_R1 + 64 * MiB;
constexpr size_t WS_END = WS_R1 + 326 * MiB;
constexpr int CW_BAR = 4096;
constexpr int CW_QUEUE = 64;
constexpr int RING_BYTES = 131072, LDS_BYTES = 147456, MISC_OFF = LDS_BYTES - 256;

__device__ __forceinline__ float bf2f(bf16_t h) { return __uint_as_float((unsigned)h << 16); }
__device__ __forceinline__ unsigned pk2(float lo, float hi) { f32x2 v = {lo, hi}; bf16x2_t b = __builtin_convertvector(v, bf16x2_t); return __builtin_bit_cast(unsigned, b); }
__device__ __forceinline__ bf16_t f2bf(float f) { return (bf16_t)(pk2(f, 0.f) & 0xffffu); }
__device__ __forceinline__ float wave_sum(float v) {
#pragma unroll
    for (int o = 1; o < 64; o <<= 1) v += __shfl_xor(v, o);
    return v;
}
template <int CTRL> __device__ __forceinline__ float dpp_add(float x) {
    const int y = __builtin_amdgcn_update_dpp(0, __float_as_int(x), CTRL, 0xf, 0xf, false);
    return x + __int_as_float(y);
}
__device__ __forceinline__ float row16_sum(float x) {
    x = dpp_add<0x128>(x); x = dpp_add<0x124>(x); x = dpp_add<0x122>(x); x = dpp_add<0x121>(x); return x;
}
__device__ __forceinline__ float wave_sum_fast(float x) {
    x = row16_sum(x); const int xi = __float_as_int(x);
    return (__int_as_float(__builtin_amdgcn_readlane(xi, 0)) + __int_as_float(__builtin_amdgcn_readlane(xi, 16))) + (__int_as_float(__builtin_amdgcn_readlane(xi, 32)) + __int_as_float(__builtin_amdgcn_readlane(xi, 48)));
}
__device__ __forceinline__ float sigmoidf_(float x) { return 1.0f / (1.0f + __expf(-x)); }

#define XB_TMO      128
#define XB_XCNT(j)  (256  + 64 * (j))
#define XB_XSUB(j)  (1280 + 64 * (j))
#define XB_XGEN(j)  (2304 + 64 * (j))
#define XB_TOP      3328
#define XB_TOPGEN   3392
#define XCD_BAR_WORDS 3456
#define XB_SPIN_CAP (1u << 18)

__device__ __forceinline__ unsigned xb_ld(unsigned* p)              { return __hip_atomic_load(p, __ATOMIC_RELAXED, __HIP_MEMORY_SCOPE_AGENT); }
__device__ __forceinline__ unsigned xb_add(unsigned* p, unsigned v) { return __hip_atomic_fetch_add(p, v, __ATOMIC_RELAXED, __HIP_MEMORY_SCOPE_AGENT); }
__device__ __forceinline__ unsigned xb_xcc_id() { return (unsigned)__builtin_amdgcn_s_getreg((3 << 11) | 20) & 0xFu; }
#define XB_SPIN(cond, bar) do { unsigned _sp = 0; while (cond) { __builtin_amdgcn_s_sleep(1); \
    if ((++_sp & 255u) == 0u) { if (xb_ld(&(bar)[XB_TMO])) break; if (_sp > XB_SPIN_CAP) { atomicAdd(&(bar)[XB_TMO], 1u); break; } } } } while (0)

struct XcdBarrier {
    unsigned* bar; unsigned x;
    volatile LAS unsigned* st;
};

__device__ __forceinline__ XcdBarrier xcd_barrier_post(unsigned* bar, volatile LAS unsigned* st) {
    XcdBarrier b; b.bar = bar; b.x = xb_xcc_id(); b.st = st;
    if (threadIdx.x == 0) (void)xb_add(&bar[XB_XCNT(b.x)], 1u);
    return b;
}
__device__ __forceinline__ void xcd_barrier_complete(unsigned* bar, unsigned x, unsigned& nloc, unsigned& nx) {
    const unsigned G = gridDim.x * gridDim.y * gridDim.z;
    unsigned sum, cnt, mine, sp = 0u;
    for (;;) {
        sum = 0u; cnt = 0u; mine = 0u;
#pragma unroll
        for (unsigned j = 0; j < 16; ++j) { const unsigned c = xb_ld(&bar[XB_XCNT(j)]); sum += c; cnt += (c > 0u) ? 1u : 0u; mine = (j == x) ? c : mine; }
        if (sum == G) break;
        __builtin_amdgcn_s_sleep(1);
        if ((++sp & 255u) == 0u) { if (xb_ld(&bar[XB_TMO])) break; if (sp > XB_SPIN_CAP) { atomicAdd(&bar[XB_TMO], 1u); break; } }
    }
    nloc = mine > 0u ? mine : 1u; nx = cnt > 0u ? cnt : 1u;
}

__device__ __forceinline__ void xcd_barrier(const XcdBarrier& b) {
    asm volatile("s_waitcnt vmcnt(0)" ::: "memory");
    __syncthreads();
    if (threadIdx.x == 0) {
        unsigned* bar = b.bar;
        __builtin_amdgcn_s_waitcnt(0);
        unsigned nloc = b.st[0], nx = b.st[1];
        if (nloc == 0u) { xcd_barrier_complete(bar, b.x, nloc, nx); b.st[0] = nloc; b.st[1] = nx; }
        const unsigned old = xb_add(&bar[XB_XSUB(b.x)], 1u);
        const unsigned gen = old / nloc;
        if (old + 1u == (gen + 1u) * nloc) {
            __builtin_amdgcn_fence(__ATOMIC_RELEASE, "agent");
            asm volatile("s_waitcnt vmcnt(0)" ::: "memory");
            const unsigned og = xb_add(&bar[XB_TOP], 1u);
            const unsigned tg = og / nx;
            if (og + 1u == (tg + 1u) * nx) xb_add(&bar[XB_TOPGEN], 1u);
            else XB_SPIN(xb_ld(&bar[XB_TOPGEN]) == tg, bar);
            __builtin_amdgcn_fence(__ATOMIC_ACQUIRE, "agent");
            xb_add(&bar[XB_XGEN(b.x)], 1u);
            asm volatile("s_waitcnt vmcnt(0)" ::: "memory");
        } else {
            XB_SPIN(xb_ld(&bar[XB_XGEN(b.x)]) == gen, bar);
            __builtin_amdgcn_fence(__ATOMIC_ACQUIRE, "agent");
            asm volatile("s_waitcnt vmcnt(0)" ::: "memory");
        }
    }
    __syncthreads();
}


struct Args { const float* in[N_IN]; float* out; unsigned char* ws; int ph_lo, ph_hi; };
struct Frame {
    LAS unsigned char* lds; unsigned char* ldsg;
    const float* const* in; float* out; unsigned char* ws;
    int tid, lane, wave, G;
    XcdBarrier bar;
};
#define LDS_WAIT() asm volatile("s_waitcnt lgkmcnt(0)" ::: "memory")

__device__ __forceinline__ void p0_transpose_item(const float* W, int K, int N, bf16_t* WT, int kb, int nb, int rowbase, LAS float* scr, int lane) {
    const int k0 = 64 * kb, n0 = 32 * nb;
#pragma unroll 8
    for (int i = 0; i < 32; ++i) { const int kk = 2 * i + (lane >> 5); scr[kk * 33 + (lane & 31)] = W[(size_t)(k0 + kk) * N + n0 + (lane & 31)]; }
    LDS_WAIT(); asm volatile("" ::: "memory");
    const int c = lane & 7;
#pragma unroll
    for (int j = 0; j < 4; ++j) { const int n = (lane >> 3) + 8 * j; const LAS float* s = scr + (8 * c) * 33 + n;
        u32x4 o; o.x = pk2(s[0 * 33], s[1 * 33]); o.y = pk2(s[2 * 33], s[3 * 33]); o.z = pk2(s[4 * 33], s[5 * 33]); o.w = pk2(s[6 * 33], s[7 * 33]);
        *(u32x4*)(WT + (size_t)(rowbase + n) * K + k0 + 8 * c) = o; }
    LDS_WAIT(); asm volatile("" ::: "memory");
}
__device__ __forceinline__ void p0_prologue(Frame& F) {
    {
        LAS float* sc = (LAS float*)F.lds;
        LAS float* red = sc + 5 * 2048;
        for (int i = F.tid; i < 5 * 2048; i += NTHREADS) { const int v = i >> 11, k = i & 2047; const float x = v == 0 ? F.in[I_CCTX][k] : F.in[I_C][(v - 1) * 2048 + k]; sc[i] = x * sigmoidf_(x); }
        __syncthreads();
        for (int it = blockIdx.x; it < 2 * 192; it += F.G) {
            const int l = it / 192, cg_ = it % 192, col = cg_ * 64 + F.lane;
            const float* W = F.in[I_WADA] + (size_t)l * 2048 * 12288 + col;
            float acc[5] = {0.f, 0.f, 0.f, 0.f, 0.f};
            const int kbeg = F.wave * 256;
#pragma unroll 2
            for (int k = kbeg; k < kbeg + 256; k += 4) {
                const float w0 = W[(size_t)(k + 0) * 12288], w1 = W[(size_t)(k + 1) * 12288], w2 = W[(size_t)(k + 2) * 12288], w3 = W[(size_t)(k + 3) * 12288];
#pragma unroll
                for (int v = 0; v < 5; ++v) { const f32x4 s = *(const LAS f32x4*)(sc + v * 2048 + k); acc[v] += s.x * w0 + s.y * w1 + s.z * w2 + s.w * w3; }
            }
#pragma unroll
            for (int v = 0; v < 5; ++v) red[(F.wave * 5 + v) * 64 + F.lane] = acc[v];
            __syncthreads();
            if (F.tid < 320) { const int v = F.tid >> 6, c = F.tid & 63; float s = 0.f;
#pragma unroll
                for (int w = 0; w < 8; ++w) s += red[(w * 5 + v) * 64 + c];
                const int cc = cg_ * 64 + c;
                ((float*)(F.ws + WS_MOD))[(size_t)(l * 5 + v) * 12288 + cc] = s + F.in[I_BADA][l * 12288 + cc]; }
            __syncthreads();
        }
    }
    __syncthreads();
    {
        const int gt = blockIdx.x * NTHREADS + F.tid, GT = F.G * NTHREADS;
        for (int i = gt; i < 2 * 24576; i += GT) { const int l = i / 24576, r = i % 24576;
            *(u32x4*)(F.ws + WS_WIN + (size_t)l * SZ_WIN + (size_t)4768 * 2048 * 2 + (size_t)r * 16) = (u32x4){0u, 0u, 0u, 0u}; }
    }
    {
        LAS float* scr = (LAS float*)(F.lds + F.wave * 16384);
        const int gw = blockIdx.x * NWAVES + F.wave, NGW = F.G * NWAVES;
        constexpr int I_IN = 32 * 149, I_OUT = 32 * 64, I_G = 32 * 176, I_DN = 88 * 64, PER_L = I_IN + I_OUT + 2 * I_G + I_DN;
        for (int it = gw; it < 2 * PER_L; it += NGW) {
            const int l = it / PER_L; int r = it % PER_L;
            if (r < I_IN) { const int kb = r / 149, nb = r % 149;
                p0_transpose_item(F.in[I_WIN] + (size_t)l * 2048 * DIN, 2048, DIN, (bf16_t*)(F.ws + WS_WIN + l * SZ_WIN), kb, nb, 32 * nb, scr, F.lane); continue; }
            r -= I_IN;
            if (r < I_OUT) { const int kb = r / 64, nb = r % 64;
                p0_transpose_item(F.in[I_WOUT] + (size_t)l * 2048 * 2048, 2048, 2048, (bf16_t*)(F.ws + WS_WOUT + l * SZ_WOUT), kb, nb, 32 * nb, scr, F.lane); continue; }
            r -= I_OUT;
            if (r < 2 * I_G) { const int up = r >= I_G; if (up) r -= I_G; const int kb = r / 176, nb = r % 176, n0 = 32 * nb;
                p0_transpose_item(F.in[up ? I_WUPF : I_WGATE] + (size_t)l * 2048 * DFF, 2048, DFF, (bf16_t*)(F.ws + WS_WGU + l * SZ_WGU), kb, nb, (n0 >> 7) * 256 + (up ? 128 : 0) + (n0 & 127), scr, F.lane); continue; }
            r -= 2 * I_G;
            { const int kb = r / 64, nb = r % 64;
                p0_transpose_item(F.in[I_WDOWN] + (size_t)l * DFF * 2048, DFF, 2048, (bf16_t*)(F.ws + WS_WDN + l * SZ_WDN), kb, nb, 32 * nb, scr, F.lane); }
        }
    }
}

__device__ __forceinline__ const float* mod_vec(const Frame& F, int l, int m, int which) {
    const int v = m < MC ? 0 : 1 + ((m - MC) >> 10);
    return (const float*)(F.ws + WS_MOD) + (size_t)(l * 5 + v) * 12288 + which * 2048;
}
__device__ __forceinline__ const float* x_in_row(const Frame& F, int m) { return m < MC ? F.in[I_XP] + (size_t)m * DM : F.in[I_XS] + (size_t)(m - MC) * DM; }
__device__ __forceinline__ float row_ss(const f32x4 (&v)[8]) {
    float s = 0.f;
#pragma unroll
    for (int j = 0; j < 8; ++j) s += (v[j].x * v[j].x + v[j].y * v[j].y) + (v[j].z * v[j].z + v[j].w * v[j].w);
    return wave_sum(s);
}
__device__ __forceinline__ void write_h(const Frame& F, const f32x4 (&x)[8], float rs, const float* ng, const float* sc, const float* sh, bf16_t* hrow) {
#pragma unroll
    for (int j = 0; j < 8; ++j) { const int o = F.lane + 64 * j;
        const f32x4 g = ((const f32x4*)ng)[o], s = ((const f32x4*)sc)[o], b = ((const f32x4*)sh)[o];
        const f32x4 h = x[j] * rs * g * (1.0f + s) + b;
        u32x2 w; w.x = pk2(h.x, h.y); w.y = pk2(h.z, h.w); ((u32x2*)hrow)[o] = w; }
}
__device__ __forceinline__ void rowpass0(Frame& F) {
    const int gw = blockIdx.x * NWAVES + F.wave, NGW = F.G * NWAVES;
    for (int m = gw; m < MT; m += NGW) {
        const f32x4* xr = (const f32x4*)x_in_row(F, m); f32x4 x[8];
#pragma unroll
        for (int j = 0; j < 8; ++j) x[j] = xr[F.lane + 64 * j];
        const float rs = rsqrtf(row_ss(x) * (1.0f / DM) + EPS);
        write_h(F, x, rs, F.in[I_NG] + 0, mod_vec(F, 0, m, 1), mod_vec(F, 0, m, 0), (bf16_t*)(F.ws + WS_HB) + (size_t)m * DM);
    }
}
__device__ __forceinline__ void rowpassA(Frame& F, int l) {
    const int gw = blockIdx.x * NWAVES + F.wave, NGW = F.G * NWAVES;
    const float* ng = F.in[I_NG] + (size_t)l * 4 * DM;
    for (int m = gw; m < MT; m += NGW) {
        const f32x4* orow = (const f32x4*)(F.ws + WS_OB) + (size_t)m * (DM / 4);
        const f32x4* xr = l == 0 ? (const f32x4*)x_in_row(F, m) : (const f32x4*)(F.ws + WS_XB) + (size_t)m * (DM / 4);
        f32x4 o[8], x[8];
#pragma unroll
        for (int j = 0; j < 8; ++j) { o[j] = orow[F.lane + 64 * j]; x[j] = xr[F.lane + 64 * j]; }
        const float r1 = rsqrtf(row_ss(o) * (1.0f / DM) + EPS);
        const float* ga = mod_vec(F, l, m, 2);
        f32x4* xo = (f32x4*)(F.ws + WS_XB) + (size_t)m * (DM / 4);
#pragma unroll
        for (int j = 0; j < 8; ++j) { const int q = F.lane + 64 * j; x[j] = x[j] + ((const f32x4*)ga)[q] * (o[j] * r1 * ((const f32x4*)(ng + DM))[q]); xo[q] = x[j]; }
        const float r2 = rsqrtf(row_ss(x) * (1.0f / DM) + EPS);
        write_h(F, x, r2, ng + 2 * DM, mod_vec(F, l, m, 4), mod_vec(F, l, m, 3), (bf16_t*)(F.ws + WS_HB) + (size_t)m * DM);
    }
}
__device__ __forceinline__ void rowpassB(Frame& F, int l) {
    const int gw = blockIdx.x * NWAVES + F.wave, NGW = F.G * NWAVES;
    const float* ng = F.in[I_NG] + (size_t)l * 4 * DM;
    for (int m = gw; m < MT; m += NGW) {
        const f32x4* orow = (const f32x4*)(F.ws + WS_OB) + (size_t)m * (DM / 4);
        const f32x4* xr = (const f32x4*)(F.ws + WS_XB) + (size_t)m * (DM / 4);
        f32x4 o[8], x[8];
#pragma unroll
        for (int j = 0; j < 8; ++j) { o[j] = orow[F.lane + 64 * j]; x[j] = xr[F.lane + 64 * j]; }
        const float r1 = rsqrtf(row_ss(o) * (1.0f / DM) + EPS);
        const float* gf = mod_vec(F, l, m, 5);
        f32x4* xo = (l == DEPTH - 1) ? (f32x4*)(F.out + OUT_Y) + (size_t)m * (DM / 4) : (f32x4*)(F.ws + WS_XB) + (size_t)m * (DM / 4);
#pragma unroll
        for (int j = 0; j < 8; ++j) { const int q = F.lane + 64 * j; x[j] = x[j] + ((const f32x4*)gf)[q] * (o[j] * r1 * ((const f32x4*)(ng + 3 * DM))[q]); xo[q] = x[j]; }
        if (l < DEPTH - 1) {
            const float r2 = rsqrtf(row_ss(x) * (1.0f / DM) + EPS);
            write_h(F, x, r2, ng + 4 * DM, mod_vec(F, l + 1, m, 1), mod_vec(F, l + 1, m, 0), (bf16_t*)(F.ws + WS_HB) + (size_t)m * DM);
        }
    }
}

constexpr int TC_PITCH = 1696, SM_OFF = 115712, TG = 8;
__device__ __forceinline__ void p2_prepass(Frame& F, int l) {
    const bf16_t* PROJ = (const bf16_t*)(F.ws + WS_PROJ);
    bf16_t* QB = (bf16_t*)(F.ws + WS_QB); bf16_t* KB = (bf16_t*)(F.ws + WS_KB); bf16_t* VB = (bf16_t*)(F.ws + WS_VB); bf16_t* MIX = (bf16_t*)(F.ws + WS_MIX);
    float* SCAN = (float*)(F.ws + WS_SCAN);
    int tid0 = F.tid; asm volatile("" : "+v"(tid0));
    for (int pi = blockIdx.x * NTHREADS + tid0; pi < 131072; pi += F.G * NTHREADS) {
        const int e = 2 * pi, b = e >> 16, rem = e & 65535, p = rem >> 8, col = rem & 255;
        const size_t src = ((size_t)(b * 2 + l) * 256 + p) * 256 + col, dst = (size_t)(MC + b * 1280 + 1024 + p) * 256 + col;
        const f32x2 kv = *(const f32x2*)(F.in[I_CK] + src), vv = *(const f32x2*)(F.in[I_CV] + src);
        *(unsigned*)(KB + dst) = pk2(kv.x, kv.y); *(unsigned*)(VB + dst) = pk2(vv.x, vv.y);
    }
    for (int item = blockIdx.x; item < MT / 32; item += F.G) {
        asm volatile("" ::: "memory");
        int tid = F.tid; asm volatile("" : "+v"(tid)); const int lane = tid & 63;
        const int m0 = item * 32; const bool smp = m0 >= MC;
        const int sb = smp ? (m0 - MC) >> 10 : m0 >> 8, t0 = smp ? (m0 - MC) & 1023 : m0 & 255, seqlen = smp ? 1024 : 256;
        __syncthreads();
#if PP_MASK & 1
        for (int rp = 0; rp < ((PPR_MASK & 1) ? 2 : 1); ++rp) {
            LAS bf16_t* TA = (LAS bf16_t*)F.lds;
#pragma unroll
            for (int j = 0; j < 12; ++j) { const int idx = tid + 512 * j, r = idx / 192, q = idx % 192;
                *(LAS u32x4*)(TA + r * 1536 + q * 8) = *(const u32x4*)(PROJ + (size_t)(m0 + r) * DINP + q * 8); }
            __syncthreads();
            const int e1 = lane < 32 ? lane : lane + 32, e2 = e1 + 32;
            const float gq1 = F.in[I_QN][l * 128 + e1], gq2 = F.in[I_QN][l * 128 + e2], gk1 = F.in[I_KN][l * 128 + e1], gk2 = F.in[I_KN][l * 128 + e2];
            const float inv = exp2f(-(float)(2 * (lane & 31)) * (13.287712379549449f / 64.0f));
#pragma unroll 2
            for (int wi = F.wave; wi < 320; wi += NWAVES) {
                const int tok = wi / 10, j = wi % 10, t = t0 + tok;
                LAS bf16_t* p = TA + tok * 1536 + (j < 8 ? j * 128 : 1024 + (j - 8) * 128);
                const float x1 = bf2f(p[e1]), x2 = bf2f(p[e2]);
                const float rs = rsqrtf(wave_sum_fast(x1 * x1 + x2 * x2) * (1.0f / 128.0f) + EPS);
                float y1 = x1 * rs * (j < 8 ? gq1 : gk1), y2 = x2 * rs * (j < 8 ? gq2 : gk2);
                if (smp) {
                    const float pos = (float)(lane < 32 ? (t >> 6) : (t & 63));
                    float rev = pos * inv * 0.15915494309189535f; rev = rev - floorf(rev);
                    const float s = __builtin_amdgcn_sinf(rev), c = __builtin_amdgcn_cosf(rev);
                    const float o1 = y1 * c - y2 * s, o2 = y2 * c + y1 * s; y1 = o1; y2 = o2;
                }
                p[e1] = f2bf(y1); p[e2] = f2bf(y2);
            }
            __syncthreads();
#pragma unroll
            for (int j = 0; j < 8; ++j) { const int idx = tid + 512 * j, r = idx >> 7, q = idx & 127;
                *(u32x4*)(QB + (size_t)(m0 + r) * 1024 + q * 8) = *(const LAS u32x4*)(TA + r * 1536 + q * 8); }
#pragma unroll
            for (int j = 0; j < 2; ++j) { const int idx = tid + 512 * j, r = idx >> 5, q = idx & 31;
                const size_t krow = smp ? (size_t)(MC + sb * 1280 + t0 + r) : (size_t)(m0 + r);
                *(u32x4*)(KB + krow * 256 + q * 8) = *(const LAS u32x4*)(TA + r * 1536 + 1024 + q * 8);
                *(u32x4*)(VB + krow * 256 + q * 8) = *(const LAS u32x4*)(TA + r * 1536 + 1280 + q * 8); }
            if (!smp) {
#pragma unroll
                for (int j = 0; j < 4; ++j) { const int idx = tid + 512 * j, r = idx >> 6, q = idx & 63;
                    const u32x2 kk = *(const LAS u32x2*)(TA + r * 1536 + 1024 + q * 4), vv = *(const LAS u32x2*)(TA + r * 1536 + 1280 + q * 4);
                    const size_t o = ((size_t)(sb * 2 + l) * 256 + t0 + r) * 256 + q * 4;
                    *(f32x4*)(F.out + OUT_NK + o) = (f32x4){__uint_as_float(kk.x << 16), __uint_as_float(kk.x & 0xffff0000u), __uint_as_float(kk.y << 16), __uint_as_float(kk.y & 0xffff0000u)};
                    *(f32x4*)(F.out + OUT_NV + o) = (f32x4){__uint_as_float(vv.x << 16), __uint_as_float(vv.x & 0xffff0000u), __uint_as_float(vv.y << 16), __uint_as_float(vv.y & 0xffff0000u)}; }
            }
            __syncthreads();
        }
#endif
#if PP_MASK & 2
        for (int rp = 0; rp < ((PPR_MASK & 2) ? 2 : 1); ++rp) {
            LAS bf16_t* TB = (LAS bf16_t*)F.lds;
#pragma unroll
            for (int j = 0; j < 13; ++j) { const int idx = tid + 512 * j; if (idx < 34 * 192) { const int rr = idx / 192, q = idx % 192, t = t0 - 1 + rr;
                u32x4 v = {0u, 0u, 0u, 0u}; if (t >= 0 && t < seqlen) v = *(const u32x4*)(PROJ + (size_t)(m0 - 1 + rr) * DINP + O_CB + q * 8);
                *(LAS u32x4*)(TB + rr * 1536 + q * 8) = v; } }
            __syncthreads();
            const int c = tid; const float* cw = F.in[I_CONVW] + (size_t)l * 3 * 512;
            const float w0 = cw[c], w1 = cw[512 + c], w2 = cw[1024 + c];
            LAS bf16_t* TO = TB + 34 * 1536;
            float prev = bf2f(TB[512 + c]) * bf2f(TB[1024 + c]), cur = bf2f(TB[1536 + 512 + c]) * bf2f(TB[1536 + 1024 + c]);
#pragma unroll 4
            for (int tok = 0; tok < 32; ++tok) {
                const LAS bf16_t* p = TB + (tok + 2) * 1536;
                const float nxt = bf2f(p[512 + c]) * bf2f(p[1024 + c]);
                const float o = bf2f(p[-1536 + c]) * (w0 * prev + w1 * cur + w2 * nxt);
                TO[tok * 512 + c] = f2bf(o);
                prev = cur; cur = nxt;
            }
            __syncthreads();
#pragma unroll
            for (int j = 0; j < 4; ++j) { const int idx = tid + 512 * j, r = idx >> 6, q = idx & 63;
                *(u32x4*)(MIX + (size_t)(m0 + r) * DM + 1024 + q * 8) = *(const LAS u32x4*)(TO + r * 512 + q * 8); }
            __syncthreads();
        }
#endif
        LAS bf16_t* TC = (LAS bf16_t*)F.lds;
        LAS float* sm = (LAS float*)(F.lds + SM_OFF);
        const float* mu = F.in[I_MU] + (size_t)l * 1696;
#pragma unroll
        for (int j = 0; j < 15; ++j) { const int idx = tid + 512 * j; if (idx < 34 * 212) { const int rr = idx / 212, q = idx % 212, t = t0 - 1 + rr;
            u32x4 v = {0u, 0u, 0u, 0u}; if (t >= 0 && t < seqlen) v = *(const u32x4*)(PROJ + (size_t)(m0 - 1 + rr) * DINP + O_UR + q * 8);
            *(LAS u32x4*)(TC + rr * TC_PITCH + q * 8) = v; } }
        __syncthreads();
#pragma unroll 5
        for (int idx = tid; idx < 32 * 160; idx += NTHREADS) {
            const int tok = idx / 160, k = idx % 160, col = 1536 + k;
            const LAS bf16_t* p = TC + (tok + 1) * TC_PITCH + col;
            const float u = bf2f(p[0]), up = bf2f(p[-TC_PITCH]), un = bf2f(p[TC_PITCH]);
            const float us = u + mu[col] * (0.5f * (up + un) - u);
            sm[idx] = k < 32 ? tanhf(us) : (k < 64 ? us : sigmoidf_(us));
        }
        __syncthreads();
        const int c = tid, h = F.wave, i = lane;
#pragma unroll 1
        for (int half = 0; half < 32 / TG; ++half) {
            const int tb = TG * half;
            float gg[TG], dc0[TG], dc1[TG];
            {
                asm volatile("" ::: "memory");
                float wg[96];
                const float* gu = F.in[I_GUP] + (size_t)l * 96 * 512 + c;
#pragma unroll
                for (int k = 0; k < 96; ++k) { wg[k] = gu[0]; gu += 512; asm volatile("" : "+v"(gu)); }
#pragma unroll
                for (int tok = 0; tok < TG; ++tok) {
                    float g = 0.f, g2 = 0.f; const LAS float* xg = sm + (tb + tok) * 160 + 64;
#pragma unroll
                    for (int hk = 0; hk < 3; ++hk) {
                        f32x4 sv[8];
#pragma unroll
                        for (int q = 0; q < 8; ++q) sv[q] = *(const LAS f32x4*)(xg + 32 * hk + 4 * q);
                        __builtin_amdgcn_sched_barrier(0);
#pragma unroll
                        for (int q = 0; q < 8; ++q) { const f32x4 sq = sv[q]; const int k0 = 32 * hk + 4 * q; (q & 1 ? g2 : g) += sq.x * wg[k0] + sq.y * wg[k0 + 1] + sq.z * wg[k0 + 2] + sq.w * wg[k0 + 3]; }
                        __builtin_amdgcn_sched_barrier(0);
                    }
                    gg[tok] = g + g2;
                }
            }
            {
                asm volatile("" ::: "memory");
                float ww0[32], ww1[32];
                const float* wu = F.in[I_WUP] + (size_t)l * 2 * 32 * 512 + c;
#pragma unroll
                for (int k = 0; k < 32; ++k) { ww0[k] = wu[0]; ww1[k] = wu[32 * 512]; wu += 512; asm volatile("" : "+v"(wu)); }
                const float b0 = F.in[I_W0][(l * 2 + 0) * 512 + c], b1 = F.in[I_W0][(l * 2 + 1) * 512 + c];
#pragma unroll
                for (int tok = 0; tok < TG; ++tok) {
                    float z0 = b0, z1 = b1; const LAS float* xw = sm + (tb + tok) * 160;
                    f32x4 sv[8];
#pragma unroll
                    for (int q = 0; q < 8; ++q) sv[q] = *(const LAS f32x4*)(xw + 4 * q);
                    __builtin_amdgcn_sched_barrier(0);
#pragma unroll
                    for (int q = 0; q < 8; ++q) { const f32x4 sq = sv[q];
                        z0 += sq.x * ww0[4 * q] + sq.y * ww0[4 * q + 1] + sq.z * ww0[4 * q + 2] + sq.w * ww0[4 * q + 3];
                        z1 += sq.x * ww1[4 * q] + sq.y * ww1[4 * q + 1] + sq.z * ww1[4 * q + 2] + sq.w * ww1[4 * q + 3]; }
                    const float sp0 = fmaxf(-z0, 0.f) + log1pf(__expf(-fabsf(z0))), sp1 = fmaxf(-z1, 0.f) + log1pf(__expf(-fabsf(z1)));
                    dc0[tok] = __expf(-__expf(-sp0 - 0.5f)); dc1[tok] = __expf(-__expf(-sp1 - 0.5f));
                    __builtin_amdgcn_sched_barrier(0);
                }
            }
            {
                asm volatile("" ::: "memory");
                float wa0[32], wa1[32];
                const float* au = F.in[I_AUP] + (size_t)l * 2 * 32 * 512 + c;
#pragma unroll
                for (int k = 0; k < 32; ++k) { wa0[k] = au[0]; wa1[k] = au[32 * 512]; au += 512; asm volatile("" : "+v"(au)); }
                const float a0b0 = F.in[I_A0][(l * 2 + 0) * 512 + c], a0b1 = F.in[I_A0][(l * 2 + 1) * 512 + c];
                const float kkc = F.in[I_KK][l * 512 + c], kac = F.in[I_KA][l * 512 + c], rkc = F.in[I_RK][l * 512 + c];
                const float mur = mu[c], muk = mu[512 + c], muv = mu[1024 + c];
                const LAS bf16_t* pr = TC + tb * TC_PITCH + c;
                float pr_r = bf2f(pr[0]), pr_k = bf2f(pr[512]), pr_v = bf2f(pr[1024]);
                float cu_r = bf2f(pr[TC_PITCH]), cu_k = bf2f(pr[TC_PITCH + 512]), cu_v = bf2f(pr[TC_PITCH + 1024]);
#pragma unroll
                for (int tok = 0; tok < TG; ++tok) {
                    const LAS bf16_t* p = pr + (tok + 2) * TC_PITCH; const int m = m0 + tb + tok;
                    const float nx_r = bf2f(p[0]), nx_k = bf2f(p[512]), nx_v = bf2f(p[1024]);
                    const float r = cu_r + mur * (0.5f * (pr_r + nx_r) - cu_r), k = cu_k + muk * (0.5f * (pr_k + nx_k) - cu_k), v = cu_v + muv * (0.5f * (pr_v + nx_v) - cu_v);
                    pr_r = cu_r; pr_k = cu_k; pr_v = cu_v; cu_r = nx_r; cu_k = nx_k; cu_v = nx_v;
                    const float kkr = k * kkc; const float kk = kkr * rsqrtf(wave_sum_fast(kkr * kkr) + 1e-12f);
                    float za0 = a0b0, za1 = a0b1; const LAS float* xa = sm + (tb + tok) * 160 + 32;
                    f32x4 sv[8];
#pragma unroll
                    for (int q = 0; q < 8; ++q) sv[q] = *(const LAS f32x4*)(xa + 4 * q);
                    __builtin_amdgcn_sched_barrier(0);
#pragma unroll
                    for (int q = 0; q < 8; ++q) { const f32x4 sq = sv[q];
                        za0 += sq.x * wa0[4 * q] + sq.y * wa0[4 * q + 1] + sq.z * wa0[4 * q + 2] + sq.w * wa0[4 * q + 3];
                        za1 += sq.x * wa1[4 * q] + sq.y * wa1[4 * q + 1] + sq.z * wa1[4 * q + 2] + sq.w * wa1[4 * q + 3]; }
                    const float a0 = sigmoidf_(za0), a1 = sigmoidf_(za1);
                    const float kd0 = k * (1.0f + (a0 - 1.0f) * kac), kd1 = k * (1.0f + (a1 - 1.0f) * kac);
                    const float bs = wave_sum_fast(r * (kd0 + kd1) * rkc);
                    f32x4* base = (f32x4*)(SCAN + ((size_t)m * 8 + h) * 768) + i;
                    base[0] = (f32x4){r, v, kk, bs * v}; base[64] = (f32x4){dc0[tok], kd0, kk * a0, gg[tok]}; base[128] = (f32x4){dc1[tok], kd1, kk * a1, 0.f};
                    __builtin_amdgcn_sched_barrier(0);
                }
            }
        }
        __syncthreads();
    }
}

struct ScanOps { f32x4 r4a, r4b, kk4a, kk4b, w4a, w4b, kd4a, kd4b, ka4a, ka4b; float v0; };
template <int CTRL> __device__ __forceinline__ float dpp_add_q(float x) { const int y = __builtin_amdgcn_update_dpp(0, __float_as_int(x), CTRL, 0xf, 0xf, false); return x + __int_as_float(y); }
__device__ __forceinline__ float oct_sum(float x) {
    x = dpp_add_q<0xB1>(x); x = dpp_add_q<0x4E>(x); x = dpp_add_q<0x141>(x); return x;
}
__device__ __forceinline__ void scan_item(Frame& F, int l, bool smp, int b, int h, int d, int half) {
    int tid = F.tid; asm volatile("" : "+v"(tid));
    const int seqlen = smp ? 1024 : 256, seq_base = smp ? MC + b * 1024 : b * 256, nch = seqlen / 16;
    LAS float* opb = (LAS float*)F.lds;
    LAS float* ypb = opb + 2 * 6144;
    const float* SCAN = (const float*)(F.ws + WS_SCAN); float* YB = (float*)(F.ws + WS_YB) + (size_t)d * MT * 512;
#define SCAN_TOK(ci, s) (d ? seqlen - 1 - ((ci) * 16 + (s)) : (ci) * 16 + (s))
    __syncthreads();
    if (tid < 256) {
        const int p = tid >> 3, c = tid & 7, row = half * 32 + p;
        f32x4 sa_ = {0.f, 0.f, 0.f, 0.f}, sb_ = {0.f, 0.f, 0.f, 0.f};
        if (smp) { const float* S0 = F.in[I_ST] + ((((size_t)b * 2 + l) * 2 + d) * 8 + h) * 4096 + row * 64 + 8 * c; sa_ = *(const f32x4*)S0; sb_ = *(const f32x4*)(S0 + 4); }
        __syncthreads();
        for (int ci = 0; ci < nch; ++ci) {
            const LAS float* ob = opb + (ci & 1) * 6144; LAS float* yp = ypb + (ci & 1) * 4096 + p * 8 + c;
#define SC_LD(R, s_) do { const LAS float* o_ = ob + (s_) * 384 + 8 * c; R.r4a = *(const LAS f32x4*)(o_); R.r4b = *(const LAS f32x4*)(o_ + 4); R.kk4a = *(const LAS f32x4*)(o_ + 128); R.kk4b = *(const LAS f32x4*)(o_ + 132); \
                R.w4a = *(const LAS f32x4*)(o_ + 192); R.w4b = *(const LAS f32x4*)(o_ + 196); R.kd4a = *(const LAS f32x4*)(o_ + 256); R.kd4b = *(const LAS f32x4*)(o_ + 260); \
                R.ka4a = *(const LAS f32x4*)(o_ + 320); R.ka4b = *(const LAS f32x4*)(o_ + 324); R.v0 = ob[(s_) * 384 + 64 + row]; } while (0)
#define SC_STEP(R, s_) do { \
                const f32x4 t_ = sa_ * R.kk4a + sb_ * R.kk4b; float d0 = (t_.x + t_.y) + (t_.z + t_.w); \
                d0 = -oct_sum(d0); \
                sa_ = sa_ * R.w4a + (R.ka4a * d0 + R.kd4a * R.v0); sb_ = sb_ * R.w4b + (R.ka4b * d0 + R.kd4b * R.v0); \
                const f32x4 u_ = sa_ * R.r4a + sb_ * R.r4b; yp[(s_) * 256] = (u_.x + u_.y) + (u_.z + u_.w); } while (0)
            ScanOps A, B;
            SC_LD(A, 0);
#pragma unroll 2
            for (int s = 0; s < 16; s += 2) {
                SC_LD(B, s + 1); __builtin_amdgcn_sched_barrier(0);
                SC_STEP(A, s); __builtin_amdgcn_sched_barrier(0);
                if (s + 2 < 16) SC_LD(A, s + 2); __builtin_amdgcn_sched_barrier(0);
                SC_STEP(B, s + 1); __builtin_amdgcn_sched_barrier(0);
            }
#undef SC_LD
#undef SC_STEP
            __syncthreads();
        }
        if (!smp) { float* O = F.out + OUT_ST + ((((size_t)b * 2 + l) * 2 + d) * 8 + h) * 4096 + row * 64 + 8 * c; *(f32x4*)O = sa_; *(f32x4*)(O + 4) = sb_; }
        __syncthreads();
    } else {
        const int ht = tid - 256;
        const int sg2 = (ht >> 6) & 1, sst0 = ht >> 7;
        const int ssrc = (sg2 ? 1 + d : 0) * 256 + (ht & 63) * 4, sdst = 3 * sg2 * 64 + (ht & 63);
        f32x4 stg[8], stg2[8];
#define SCAN_LOAD(R, ci) do { _Pragma("unroll") for (int j = 0; j < 8; ++j) R[j] = *(const f32x4*)(SCAN + ((size_t)(seq_base + SCAN_TOK(ci, sst0 + 2 * j)) * 8 + h) * 768 + ssrc); } while (0)
#define SCAN_STORE(buf) do { _Pragma("unroll") for (int j = 0; j < 8; ++j) { LAS float* dst_ = opb + (buf) * 6144 + (sst0 + 2 * j) * 384 + sdst; dst_[0] = stg[j].x; dst_[64] = stg[j].y; dst_[128] = stg[j].z; } } while (0)
#define SCAN_YRED(ci) do { _Pragma("unroll") for (int j = 0; j < 2; ++j) { const int o_ = ht + 256 * j, s_ = o_ >> 5, rr_ = o_ & 31; const LAS f32x4* q_ = (const LAS f32x4*)(ypb + ((ci) & 1) * 4096 + o_ * 8); \
            const f32x4 t_ = q_[0] + q_[1]; YB[(size_t)(seq_base + SCAN_TOK(ci, s_)) * 512 + h * 64 + half * 32 + rr_] = (t_.x + t_.y) + (t_.z + t_.w); } } while (0)
        SCAN_LOAD(stg, 0); SCAN_STORE(0);
        if (1 < nch) SCAN_LOAD(stg, 1);
        if (2 < nch) SCAN_LOAD(stg2, 2);
        __syncthreads();
        for (int ci = 0; ci < nch; ++ci) {
            if (ci + 1 < nch) { SCAN_STORE((ci + 1) & 1);
#pragma unroll
                for (int j = 0; j < 8; ++j) stg[j] = stg2[j];
                if (ci + 3 < nch) SCAN_LOAD(stg2, ci + 3); }
            if (ci > 0) SCAN_YRED(ci - 1);
            __syncthreads();
        }
        SCAN_YRED(nch - 1);
        __syncthreads();
#undef SCAN_LOAD
#undef SCAN_STORE
#undef SCAN_YRED
    }
#undef SCAN_TOK
}

__device__ __forceinline__ void mixer_phase(Frame& F, int l, int rep) {
    unsigned* head = (unsigned*)(F.ws + WS_CTL) + CW_QUEUE + 64 * (2 * l + rep);
    volatile LAS unsigned* slot = (volatile LAS unsigned*)(F.lds + MISC_OFF);
    const bf16_t* QB = (const bf16_t*)(F.ws + WS_QB); const bf16_t* KB = (const bf16_t*)(F.ws + WS_KB); const bf16_t* VB = (const bf16_t*)(F.ws + WS_VB); bf16_t* MIX = (bf16_t*)(F.ws + WS_MIX);
    for (;;) {
        __syncthreads();
        if (F.tid == 0) slot[0] = atomicAdd(head, 1u);
        __syncthreads();
        const int item = (int)slot[0];
        if (item >= 896) break;
#if defined(TITEM)
        unsigned long long ti0_ = 0; if (l == 0 && rep == 0 && item == TITEM && F.tid == 0) ti0_ = __builtin_amdgcn_s_memrealtime();
#endif
        const bool is_scan = item < 128 || (item >= 256 && item < 768);
        if (is_scan) { const bool smp = item < 128; const int u = smp ? item : item - 256; scan_item(F, l, smp, u >> 5, (u >> 2) & 7, (u >> 1) & 1, u & 1); }
        else {
            size_t row0, kr0; int hq, seq;
            if (item < 256) { const int u = item - 128, b = u >> 5, qb = u & 3; hq = (u >> 2) & 7; row0 = (size_t)MC + b * 1024 + qb * 256; kr0 = (size_t)MC + b * 1280; seq = 1280; }
            else { const int u = item - 768, b = u >> 3; hq = u & 7; row0 = (size_t)b * 256; kr0 = row0; seq = 256; }
            attn::attn_dense_body<attn::bf16>((const attn::bf16*)(QB + row0 * 1024 + hq * 128), (const attn::bf16*)(KB + kr0 * 256 + (hq >> 2) * 128), (const attn::bf16*)(VB + kr0 * 256 + (hq >> 2) * 128), MIX + row0 * DM + hq * 128, seq, (char*)F.ldsg);
        }
#if defined(TITEM)
        if (l == 0 && rep == 0 && item == TITEM && F.tid == 0) ((volatile LAS unsigned long long*)(F.lds + MISC_OFF + 240))[0] = __builtin_amdgcn_s_memrealtime() - ti0_;
#endif
    }
}
__device__ __forceinline__ void rwkv_combine(Frame& F, int l) {
    const float* Y0 = (const float*)(F.ws + WS_YB); const float* Y1 = Y0 + (size_t)MT * 512;
    const float* SCAN = (const float*)(F.ws + WS_SCAN) + (size_t)(F.tid >> 6) * 768 + (F.tid & 63) * 4 + 3; bf16_t* MIX = (bf16_t*)(F.ws + WS_MIX);
    const int c = F.tid; const float lg = F.in[I_LNG][l * 512 + c], lb = F.in[I_LNB][l * 512 + c];
    for (int item = blockIdx.x; item < MT / 32; item += F.G) {
#pragma unroll 1
        for (int tb = 0; tb < 32; tb += 8) {
            float y[8], bo[8], gg[8];
#pragma unroll
            for (int u = 0; u < 8; ++u) { const size_t m = (size_t)item * 32 + tb + u; y[u] = Y0[m * 512 + c] + Y1[m * 512 + c]; bo[u] = SCAN[m * 8 * 768]; gg[u] = SCAN[m * 8 * 768 + 256]; }
#pragma unroll
            for (int u = 0; u < 8; ++u) { const size_t m = (size_t)item * 32 + tb + u;
                const float mean = wave_sum_fast(y[u]) * (1.0f / 64.0f), dl = y[u] - mean, var = wave_sum_fast(dl * dl) * (1.0f / 64.0f);
                const float yn = dl * rsqrtf(var + GN_EPS) * lg + lb;
                MIX[m * DM + 1536 + c] = f2bf((yn + bo[u]) * gg[u]); }
        }
    }
}

constexpr int NPHASE = 2 + 9 * DEPTH;
#ifndef PH_MASK
#define PH_MASK 0xffff
#endif
#ifndef USE_CG_SYNC
#define USE_CG_SYNC 0
#endif
#ifndef REP_MASK
#define REP_MASK 0
#endif
#if ONE_LAUNCH && USE_CG_SYNC
#define GRID_BAR() cg::this_grid().sync()
#elif ONE_LAUNCH
#define GRID_BAR() xcd_barrier(F.bar)
#else
#define GRID_BAR() do {} while (0)
#endif
#define NREP(bit) ((REP_MASK & (bit)) ? 2 : 1)
#define IN(k) (lo <= (k) && (k) < hi)
#ifndef TPROBE_MASK
#define TPROBE_MASK 0
#endif
#if TPROBE_MASK
#define STAMP(k) do { if (blockIdx.x == 0 && F.tid == 0) ((volatile LAS unsigned long long*)(F.lds + MISC_OFF + 64))[k] = __builtin_amdgcn_s_memrealtime(); } while (0)
#else
#define STAMP(k) do {} while (0)
#endif
#define SEAM(k) do { if (IN(k) && IN((k) + 1)) GRID_BAR(); STAMP((k) + 1); } while (0)
template <int L> __device__ __forceinline__ void layer_phases(Frame& F, const int lo, const int hi) {
    constexpr int l = L, pb = 2 + 9 * L;
    if (IN(pb + 0) && (PH_MASK & 4)) {
        pg8::Gemm g{(const bf16_t*)(F.ws + WS_HB), (const bf16_t*)(F.ws + WS_WIN + l * SZ_WIN), MT, DINP, DM}; pg8::StaticOrder S; S.init(MT, DINP, F.G, (int)blockIdx.x);
        pg8::EpiBf16 E{(bf16_t*)(F.ws + WS_PROJ), DINP};
        for (int rep = 0; rep < NREP(4); ++rep) pg8::gemm_phase<pg8::EpiBf16, pg8::StaticOrder, true, true>(F.lds, g, S, E);
    } SEAM(pb + 0);
    if (IN(pb + 1) && (PH_MASK & 8)) { for (int rep = 0; rep < NREP(8); ++rep) p2_prepass(F, l); } SEAM(pb + 1);
    if (IN(pb + 2) && (PH_MASK & 16)) { for (int rep = 0; rep < NREP(16); ++rep) mixer_phase(F, l, rep); } SEAM(pb + 2);
    if (IN(pb + 3) && (PH_MASK & 32)) { for (int rep = 0; rep < NREP(32); ++rep) rwkv_combine(F, l); } SEAM(pb + 3);
    if (IN(pb + 4) && (PH_MASK & 64)) {
        pg8::Gemm g{(const bf16_t*)(F.ws + WS_MIX), (const bf16_t*)(F.ws + WS_WOUT + l * SZ_WOUT), MT, DM, DM}; pg8::StaticOrder S; S.init(MT, DM, F.G, (int)blockIdx.x);
        pg8::EpiF32 E{(float*)(F.ws + WS_OB), DM};
        for (int rep = 0; rep < NREP(64); ++rep) pg8::gemm_phase<pg8::EpiF32, pg8::StaticOrder, true, true>(F.lds, g, S, E);
    } SEAM(pb + 4);
    if (IN(pb + 5) && (PH_MASK & 128)) { rowpassA(F, l); } SEAM(pb + 5);
    if (IN(pb + 6) && (PH_MASK & 256)) {
        pg8::Gemm g{(const bf16_t*)(F.ws + WS_HB), (const bf16_t*)(F.ws + WS_WGU + l * SZ_WGU), MT, 2 * DFF, DM}; pg8::StaticOrder S; S.init(MT, 2 * DFF, F.G, (int)blockIdx.x);
        pg8::EpiSwiGLU E{(bf16_t*)(F.ws + WS_HID), DFF};
        for (int rep = 0; rep < NREP(256); ++rep) pg8::gemm_phase<pg8::EpiSwiGLU, pg8::StaticOrder, true, true>(F.lds, g, S, E);
    } SEAM(pb + 6);
    if (IN(pb + 7) && (PH_MASK & 512)) {
        pg8::Gemm g{(const bf16_t*)(F.ws + WS_HID), (const bf16_t*)(F.ws + WS_WDN + l * SZ_WDN), MT, DM, DFF}; pg8::StaticOrder S; S.init(MT, DM, F.G, (int)blockIdx.x);
        pg8::EpiF32 E{(float*)(F.ws + WS_OB), DM};
        for (int rep = 0; rep < NREP(512); ++rep) pg8::gemm_phase<pg8::EpiF32, pg8::StaticOrder, true, true>(F.lds, g, S, E);
    } SEAM(pb + 7);
    if (IN(pb + 8) && (PH_MASK & 1024)) { rowpassB(F, l); } SEAM(pb + 8);
}
__global__ void __launch_bounds__(NTHREADS, 2) hybrid_fwd(Args args) {
    extern __shared__ __attribute__((aligned(16))) unsigned char lds[];
    Frame F;
    F.lds = (LAS unsigned char*)lds; F.ldsg = lds; F.in = args.in; F.out = args.out; F.ws = args.ws;
    F.tid = threadIdx.x; F.lane = F.tid & 63; F.wave = __builtin_amdgcn_readfirstlane(F.tid >> 6); F.G = gridDim.x;
    const int lo = args.ph_lo, hi = args.ph_hi;
    if (F.tid < 64) ((LAS unsigned*)(F.lds + MISC_OFF))[F.tid] = 0u;
    __syncthreads();
#if ONE_LAUNCH && !USE_CG_SYNC
    F.bar = xcd_barrier_post((unsigned*)(F.ws + WS_CTL) + CW_BAR, (volatile LAS unsigned*)(F.lds + MISC_OFF) + 8);
#endif
    STAMP(0);
    if (IN(0) && (PH_MASK & 1)) { for (int rep = 0; rep < NREP(1); ++rep) p0_prologue(F); } SEAM(0);
    if (IN(1) && (PH_MASK & 2)) { for (int rep = 0; rep < NREP(2); ++rep) rowpass0(F); } SEAM(1);
    layer_phases<0>(F, lo, hi);
    layer_phases<1>(F, lo, hi);
#if defined(TITEM)
    if (F.tid == 0) { const unsigned long long tot = ((volatile LAS unsigned long long*)(F.lds + MISC_OFF + 240))[0];
        if (tot) { const unsigned long long t0 = __builtin_amdgcn_s_memrealtime(); while (__builtin_amdgcn_s_memrealtime() - t0 < tot) __builtin_amdgcn_s_sleep(8); } }
#endif
#if TPROBE_MASK
    if (blockIdx.x == 0 && F.tid == 0) {
        volatile LAS unsigned long long* ts = (volatile LAS unsigned long long*)(F.lds + MISC_OFF + 64); unsigned long long tot = 0;
        for (int k = 0; k < NPHASE; ++k) if ((TPROBE_MASK >> k) & 1) tot += ts[k + 1] - ts[k];
        const unsigned long long t0 = __builtin_amdgcn_s_memrealtime(); while (__builtin_amdgcn_s_memrealtime() - t0 < tot) __builtin_amdgcn_s_sleep(8);
    }
#endif
}
#undef IN
#undef SEAM

extern "C" void kernel_launch(void* const* d_in, const int* in_sizes, int n_in, void* d_out, int out_size, void* d_ws, size_t ws_size, hipStream_t stream) {
    static int grid = 0;
    if (grid == 0) {
        if (n_in != N_IN || (size_t)out_size != OUT_TOTAL || ws_size < WS_END) { fprintf(stderr, "kernel_launch: unexpected shapes: n_in %d out %d ws %zu (need %zu)\n", n_in, out_size, ws_size, (size_t)WS_END); grid = -1; return; }
        int dev = 0, cus = 0, per_cu = 0;
        if (hipGetDevice(&dev) != hipSuccess || hipDeviceGetAttribute(&cus, hipDeviceAttributeMultiprocessorCount, dev) != hipSuccess) { grid = -1; return; }
        if (hipFuncSetAttribute((const void*)hybrid_fwd, hipFuncAttributeMaxDynamicSharedMemorySize, LDS_BYTES) != hipSuccess) { fprintf(stderr, "kernel_launch: hipFuncSetAttribute failed\n"); grid = -1; return; }
        if (hipOccupancyMaxActiveBlocksPerMultiprocessor(&per_cu, (const void*)hybrid_fwd, NTHREADS, LDS_BYTES) != hipSuccess || per_cu < 1) { fprintf(stderr, "kernel_launch: occupancy query says %d blocks per CU\n", per_cu); (void)hipGetLastError(); grid = -1; return; }
        grid = cus;
    }
    if (grid < 0) return;
    (void)hipMemsetAsync((char*)d_ws + WS_CTL, 0, CTL_BYTES, stream);
    Args a{};
    for (int i = 0; i < N_IN; ++i) a.in[i] = (const float*)d_in[i];
    a.out = (float*)d_out; a.ws = (unsigned char*)d_ws;
#if ONE_LAUNCH
    a.ph_lo = 0; a.ph_hi = NPHASE;
    void* kargs[] = {&a};
    const hipError_t e = hipLaunchCooperativeKernel((const void*)hybrid_fwd, dim3(grid), dim3(NTHREADS), kargs, LDS_BYTES, stream);
    if (e != hipSuccess) fprintf(stderr, "kernel_launch: cooperative launch failed: %s (grid %d)\n", hipGetErrorString(e), grid);
#else
    for (int ph = 0; ph < NPHASE; ++ph) {
        a.ph_lo = ph; a.ph_hi = ph + 1;
        hipLaunchKernelGGL(hybrid_fwd, dim3(grid), dim3(NTHREADS), LDS_BYTES, stream, a);
    }
    const hipError_t le = hipPeekAtLastError();
    if (le != hipSuccess) fprintf(stderr, "kernel_launch: launch failed: %s\n", hipGetErrorName(le));
#endif
}
```

```cpp
#include <hip/hip_runtime.h>
#include <hip/hip_bf16.h>
#include <hip/hip_cooperative_groups.h>
#include <cstdio>
#include <cstdint>
#include <cmath>
namespace cg = cooperative_groups;
#ifndef ONE_LAUNCH
#define ONE_LAUNCH 1
#endif
namespace pg8 {
#define PG8_LAS __attribute__((address_space(3)))
typedef unsigned short bf16_t;
typedef short bf16x8 __attribute__((ext_vector_type(8)));
typedef float f32x4 __attribute__((ext_vector_type(4)));
typedef unsigned u32x4 __attribute__((ext_vector_type(4)));
constexpr int BM = 256, BK = 64, HALF = 128, HTB = HALF * BK * 2  , STAGE_BYTES = 8 * HTB, NXCD = 8, WGM = 8;

__host__ __device__ __forceinline__ int lds_byte(int r, int c) { const int st = (r >> 4) * 2 + (c >> 5), rr = r & 15, cc = c & 31, ob = rr * 64 + cc * 2; return st * 1024 + (ob ^ (((ob >> 9) & 1) << 5)); }
__host__ __device__ __forceinline__ void stage_rc(int b, int& R, int& C) { const int st = b / 1024, sb = b % 1024, swz = sb ^ (((sb >> 9) & 1) << 5); R = (st >> 1) * 16 + swz / 64; C = (st & 1) * 32 + (swz % 64) / 2; }
__host__ __device__ __forceinline__ int perm32(int rho) { const int n = rho >> 4, i = rho & 15; return 8 * (i >> 2) + 4 * n + (i & 3); }

struct Unit { int pm, pn; };
struct Gemm { const bf16_t* A; const bf16_t* Bt; int M, N, K; };

struct StaticOrder {
    int nM, nN, nwg, G, c;
    __host__ __device__ void init(int M, int N, int G_, int c_) { nM = M / BM; nN = N / BM; nwg = nM * nN; G = G_; c = c_; }
    __host__ __device__ bool next(int i, Unit& u) const {
        const long L = (long)i * G + c; if (L >= nwg) return false;
        int wgid = (int)L; { const int q = nwg / NXCD, r = nwg % NXCD, xcd = wgid % NXCD, off = wgid / NXCD; wgid = (xcd < r ? xcd * (q + 1) : r * (q + 1) + (xcd - r) * q) + off; }
        const int nig = WGM * nN, gid = wgid / nig, fm = gid * WGM, gsz = (nM - fm) < WGM ? (nM - fm) : WGM;
        u.pm = fm + ((wgid % nig) % gsz); u.pn = (wgid % nig) / gsz; return true;
    }
    __device__ __forceinline__ void a_ready(const Unit&) const {}
    __device__ __forceinline__ void done(const Unit&) const {}
};

__device__ __forceinline__ unsigned cvt_pk_bf16(float lo, float hi) { unsigned r; asm volatile("v_cvt_pk_bf16_f32 %0, %1, %2" : "=v"(r) : "v"(lo), "v"(hi)); return r; }
struct EpiBf16 {
    static constexpr bool PERM = true, AFTER_DRAIN = false;
    bf16_t* O; int ldc;
    __device__ __forceinline__ void operator()(const f32x4 (&acc)[2][2][4][2], const Unit& u, int wr, int wc, int fr, int fq) const {
        const int row0 = u.pm * BM + wr * 64 + fr; const int col0 = u.pn * BM + wc * 32 + 8 * fq;
#pragma unroll
        for (int ai = 0; ai < 2; ++ai)
#pragma unroll
            for (int m = 0; m < 4; ++m) { bf16_t* rowp = O + (size_t)(row0 + ai * HALF + m * 16) * ldc + col0;
#pragma unroll
                for (int bj = 0; bj < 2; ++bj) { const f32x4 v0 = acc[ai][bj][m][0], v1 = acc[ai][bj][m][1];
                    u32x4 w; w.x = cvt_pk_bf16(v0[0], v0[1]); w.y = cvt_pk_bf16(v0[2], v0[3]); w.z = cvt_pk_bf16(v1[0], v1[1]); w.w = cvt_pk_bf16(v1[2], v1[3]);
                    *(u32x4*)(rowp + bj * HALF) = w; } }
    }
};
struct EpiF32 {
    static constexpr bool PERM = false, AFTER_DRAIN = false;
    float* O; int ldc;
    __device__ __forceinline__ void operator()(const f32x4 (&acc)[2][2][4][2], const Unit& u, int wr, int wc, int fr, int fq) const {
        const int row0 = u.pm * BM + wr * 64 + fr; const int col0 = u.pn * BM + wc * 32 + 4 * fq;
#pragma unroll
        for (int ai = 0; ai < 2; ++ai)
#pragma unroll
            for (int m = 0; m < 4; ++m) { float* rowp = O + (size_t)(row0 + ai * HALF + m * 16) * ldc + col0;
#pragma unroll
                for (int bj = 0; bj < 2; ++bj)
#pragma unroll
                    for (int n = 0; n < 2; ++n) *(f32x4*)(rowp + bj * HALF + n * 16) = acc[ai][bj][m][n]; }
    }
};
__device__ __forceinline__ float silu_mul(float g, float u) { return g * __builtin_amdgcn_rcpf(1.0f + __expf(-g)) * u; }
struct EpiSwiGLU {
    static constexpr bool PERM = true, AFTER_DRAIN = false;
    bf16_t* O; int ldc;
    __device__ __forceinline__ void operator()(const f32x4 (&acc)[2][2][4][2], const Unit& u, int wr, int wc, int fr, int fq) const {
        const int row0 = u.pm * BM + wr * 64 + fr; const int col0 = u.pn * HALF + wc * 32 + 8 * fq;
#pragma unroll
        for (int ai = 0; ai < 2; ++ai)
#pragma unroll
            for (int m = 0; m < 4; ++m) { bf16_t* rowp = O + (size_t)(row0 + ai * HALF + m * 16) * ldc + col0;
                const f32x4 g0 = acc[ai][0][m][0], g1 = acc[ai][0][m][1], u0 = acc[ai][1][m][0], u1 = acc[ai][1][m][1];
                u32x4 w; w.x = cvt_pk_bf16(silu_mul(g0[0], u0[0]), silu_mul(g0[1], u0[1])); w.y = cvt_pk_bf16(silu_mul(g0[2], u0[2]), silu_mul(g0[3], u0[3]));
                w.z = cvt_pk_bf16(silu_mul(g1[0], u1[0]), silu_mul(g1[1], u1[1])); w.w = cvt_pk_bf16(silu_mul(g1[2], u1[2]), silu_mul(g1[3], u1[3]));
                *(u32x4*)rowp = w; }
    }
};
template <class Epi, class Sched, bool ALIGN_EPI = false, bool SP2 = false>
__device__ __forceinline__ void gemm_phase(PG8_LAS unsigned char* lds, const Gemm g, const Sched& S, const Epi& E) {
    const int tid = threadIdx.x, wid = __builtin_amdgcn_readfirstlane(tid >> 6), lane = tid & 63, wr = wid >> 2, wc = wid & 3, fr = lane & 15, fq = lane >> 4;
    const int K = g.K, nt = K / BK;
    unsigned voffA[2], voffB[2];
#pragma unroll
    for (int i = 0; i < 2; ++i) { int R, C; stage_rc(tid * 16 + i * 8192, R, C); const int Rb = Epi::PERM ? ((R & ~31) + perm32(R & 31)) : R;
        voffA[i] = (unsigned)(R * K + C) * 2u; voffB[i] = (unsigned)(Rb * K + C) * 2u; }
    const size_t kstep = (size_t)(BK * 2);
    const size_t hstep = (size_t)HALF * K * 2;
    const size_t tstep = 2 * hstep;
    const unsigned ldsw = (unsigned)wid * 1024u;
    const int aoff = lds_byte(wr * 64 + fr, fq * 8), boff = lds_byte(wc * 32 + fr, fq * 8);
#define PG8_SA(b, h) (((b) * 2 + (h)) * HTB)
#define PG8_SB(b, h) ((4 + (b) * 2 + (h)) * HTB)
#define PG8_STAGE(bufoff, gbase, voff) do { _Pragma("unroll") for (int _i = 0; _i < 2; ++_i) \
        __builtin_amdgcn_global_load_lds((const unsigned*)((const char*)(gbase) + (voff)[_i]), (PG8_LAS unsigned*)(lds + (bufoff) + ldsw + _i * 8192), 16, 0, 0); } while (0)
#define PG8_LDA(dst, b, h) do { _Pragma("unroll") for (int m = 0; m < 4; ++m) _Pragma("unroll") for (int k = 0; k < 2; ++k) dst[m][k] = *(const PG8_LAS bf16x8*)(lds + PG8_SA(b, h) + aoff + m * 2048 + k * 1024); } while (0)
#define PG8_LDB(dst, b, h) do { _Pragma("unroll") for (int n = 0; n < 2; ++n) _Pragma("unroll") for (int k = 0; k < 2; ++k) dst[n][k] = *(const PG8_LAS bf16x8*)(lds + PG8_SB(b, h) + boff + n * 2048 + k * 1024); } while (0)
#define PG8_MMA(ai, bj, At, Bt) do { __builtin_amdgcn_s_setprio(1); _Pragma("unroll") for (int m = 0; m < 4; ++m) _Pragma("unroll") for (int n = 0; n < 2; ++n) _Pragma("unroll") for (int k = 0; k < 2; ++k) \
        acc[ai][bj][m][n] = __builtin_amdgcn_mfma_f32_16x16x32_bf16(Bt[n][k], At[m][k], acc[ai][bj][m][n], 0, 0, 0); __builtin_amdgcn_s_setprio(0); } while (0)
#define PG8_WAIT_V(n) asm volatile("s_waitcnt vmcnt(" #n ")" ::: "memory")
#define PG8_WAIT_L(n) asm volatile("s_waitcnt lgkmcnt(" #n ")" ::: "memory")
#define PG8_BAR __builtin_amdgcn_s_barrier()
#define PG8_SCHED __builtin_amdgcn_sched_barrier(0)
    Unit cur, nxt; int ui = 0;
    if (!S.next(0, cur)) return;
    f32x4 acc[2][2][4][2];
#pragma unroll
    for (int a = 0; a < 2; ++a)
#pragma unroll
        for (int b = 0; b < 2; ++b)
#pragma unroll
            for (int m = 0; m < 4; ++m)
#pragma unroll
                for (int n = 0; n < 2; ++n) acc[a][b][m][n] = (f32x4){0.f, 0.f, 0.f, 0.f};
    bf16x8 At[4][2], B0[2][2], B1[2][2];
    const char* cA = (const char*)g.A + (size_t)cur.pm * tstep; const char* cB = (const char*)g.Bt + (size_t)cur.pn * tstep;
    S.a_ready(cur);
    if constexpr (SP2) {
        PG8_STAGE(PG8_SB(0, 0), cB, voffB); PG8_STAGE(PG8_SB(0, 1), cB + hstep, voffB); PG8_STAGE(PG8_SA(0, 0), cA, voffA); PG8_STAGE(PG8_SA(0, 1), cA + hstep, voffA);
        if (wr == 1) PG8_BAR;
        PG8_WAIT_V(2); PG8_BAR;
        PG8_STAGE(PG8_SB(1, 0), cB + kstep, voffB); PG8_STAGE(PG8_SA(1, 0), cA + kstep, voffA); PG8_STAGE(PG8_SB(1, 1), cB + hstep + kstep, voffB);
        PG8_WAIT_V(6); PG8_BAR;
    } else {
        PG8_STAGE(PG8_SB(0, 0), cB, voffB); PG8_STAGE(PG8_SA(0, 0), cA, voffA); PG8_STAGE(PG8_SB(0, 1), cB + hstep, voffB); PG8_STAGE(PG8_SA(0, 1), cA + hstep, voffA);
        if (wr == 1) PG8_BAR;
        PG8_WAIT_V(4); PG8_BAR;
        PG8_STAGE(PG8_SB(1, 0), cB + kstep, voffB); PG8_STAGE(PG8_SA(1, 0), cA + kstep, voffA); PG8_STAGE(PG8_SB(1, 1), cB + hstep + kstep, voffB);
        PG8_WAIT_V(6); PG8_BAR;
    }
    for (;;) {
        const bool has_next = S.next(ui + 1, nxt);
        const char* nA = has_next ? (const char*)g.A + (size_t)nxt.pm * tstep : cA; const char* nB = has_next ? (const char*)g.Bt + (size_t)nxt.pn * tstep : cB;
        for (int t = 0; t < nt; t += 2) {
            const bool last = (t == nt - 2);
            const char* a1 = cA + (size_t)(t + 1) * kstep;
            const char* a2 = last ? nA : cA + (size_t)(t + 2) * kstep; const char* b2 = last ? nB : cB + (size_t)(t + 2) * kstep;
            const char* a3 = a2 + kstep; const char* b3 = b2 + kstep;
            if (last && has_next) S.a_ready(nxt);
            if constexpr (SP2) {
            PG8_LDB(B0, 0, 0); PG8_LDB(B1, 0, 1); PG8_SCHED; PG8_LDA(At, 0, 0); PG8_STAGE(PG8_SA(1, 1), a1 + hstep, voffA);
            PG8_WAIT_V(8); PG8_WAIT_L(0); PG8_BAR; PG8_MMA(0, 0, At, B0); PG8_MMA(0, 1, At, B1); PG8_BAR; PG8_SCHED;
            PG8_LDA(At, 0, 1); PG8_STAGE(PG8_SB(0, 0), b2, voffB); PG8_STAGE(PG8_SB(0, 1), b2 + hstep, voffB); PG8_STAGE(PG8_SA(0, 0), a2, voffA);
            PG8_WAIT_V(8); PG8_WAIT_L(0); PG8_BAR; PG8_MMA(1, 0, At, B0); PG8_MMA(1, 1, At, B1); PG8_BAR; PG8_SCHED;
            PG8_LDB(B0, 1, 0); PG8_LDB(B1, 1, 1); PG8_SCHED; PG8_LDA(At, 1, 0); PG8_STAGE(PG8_SA(0, 1), a2 + hstep, voffA);
            PG8_WAIT_V(8); PG8_WAIT_L(0); PG8_BAR; PG8_MMA(0, 0, At, B0); PG8_MMA(0, 1, At, B1); PG8_BAR; PG8_SCHED;
            PG8_LDA(At, 1, 1); PG8_STAGE(PG8_SB(1, 0), b3, voffB); PG8_STAGE(PG8_SB(1, 1), b3 + hstep, voffB); PG8_STAGE(PG8_SA(1, 0), a3, voffA);
            PG8_WAIT_V(8); PG8_WAIT_L(0); PG8_BAR; PG8_MMA(1, 0, At, B0); PG8_MMA(1, 1, At, B1); PG8_BAR; PG8_SCHED;
            } else {
            PG8_LDB(B0, 0, 0); PG8_SCHED; PG8_LDA(At, 0, 0); PG8_STAGE(PG8_SA(1, 1), a1 + hstep, voffA);
            PG8_WAIT_L(8); PG8_BAR; PG8_WAIT_L(0); PG8_MMA(0, 0, At, B0); PG8_BAR; PG8_SCHED;
            PG8_LDB(B1, 0, 1); PG8_STAGE(PG8_SB(0, 0), b2, voffB);
            PG8_BAR; PG8_WAIT_L(0); PG8_MMA(0, 1, At, B1); PG8_BAR;
            PG8_LDA(At, 0, 1); PG8_STAGE(PG8_SA(0, 0), a2, voffA);
            PG8_BAR; PG8_WAIT_L(0); PG8_MMA(1, 0, At, B0); PG8_BAR; PG8_SCHED;
            PG8_STAGE(PG8_SB(0, 1), b2 + hstep, voffB);
            PG8_WAIT_V(6); PG8_BAR; PG8_MMA(1, 1, At, B1); PG8_BAR;
            PG8_LDB(B0, 1, 0); PG8_SCHED; PG8_LDA(At, 1, 0); PG8_STAGE(PG8_SA(0, 1), a2 + hstep, voffA);
            PG8_WAIT_L(8); PG8_BAR; PG8_WAIT_L(0); PG8_MMA(0, 0, At, B0); PG8_BAR; PG8_SCHED;
            PG8_LDB(B1, 1, 1); PG8_STAGE(PG8_SB(1, 0), b3, voffB);
            PG8_BAR; PG8_WAIT_L(0); PG8_MMA(0, 1, At, B1); PG8_BAR;
            PG8_LDA(At, 1, 1); PG8_STAGE(PG8_SA(1, 0), a3, voffA);
            PG8_BAR; PG8_WAIT_L(0); PG8_MMA(1, 0, At, B0); PG8_BAR; PG8_SCHED;
            PG8_STAGE(PG8_SB(1, 1), b3 + hstep, voffB);
            PG8_WAIT_V(6); PG8_BAR; PG8_MMA(1, 1, At, B1); PG8_BAR;
            }
        }
        if constexpr (ALIGN_EPI) { if (wr == 0) PG8_BAR; }
        if constexpr (!Epi::AFTER_DRAIN) { E(acc, cur, wr, wc, fr, fq); S.done(cur); }
        if (!has_next) break;
#pragma unroll
        for (int a = 0; a < 2; ++a)
#pragma unroll
            for (int b = 0; b < 2; ++b)
#pragma unroll
                for (int m = 0; m < 4; ++m)
#pragma unroll
                    for (int n = 0; n < 2; ++n) acc[a][b][m][n] = (f32x4){0.f, 0.f, 0.f, 0.f};
        cur = nxt; cA = nA; cB = nB; ++ui;
        if constexpr (ALIGN_EPI) { if (wr == 1) PG8_BAR; }
    }
    PG8_WAIT_V(0);
    if constexpr (!ALIGN_EPI) { if (wr == 0) PG8_BAR; }
    PG8_BAR;
    if constexpr (Epi::AFTER_DRAIN) { E.fused(acc, cur, wr, wc, fr, fq, lds, wid, lane); S.done(cur); }
#undef PG8_SA
#undef PG8_SB
#undef PG8_STAGE
#undef PG8_LDA
#undef PG8_LDB
#undef PG8_MMA
#undef PG8_WAIT_V
#undef PG8_WAIT_L
#undef PG8_BAR
#undef PG8_SCHED
}
}
namespace attn {
using bf16 = __hip_bfloat16;
constexpr int   D = 128, NW = 8, QBLK = 32, KVBLK = 64;
constexpr float SCALE = 0.088388347648318440f;
constexpr float THR = 8.f;
constexpr int SDEPTH = 2;
constexpr int LDQ = 1024, LDK = 256, LDO = 2048;
constexpr size_t SHM_V = KVBLK * D * 2, SHM_K = KVBLK * D * 2, SHM_ATTN = 2 * SHM_V + 2 * SHM_K + NW * 64 * 4;
__device__ __forceinline__ unsigned short f2bf_rne(float f) { unsigned u = __builtin_bit_cast(unsigned, f); return (unsigned short)((u + 0x7fffu + ((u >> 16) & 1u)) >> 16); }
using bf16x8 = __attribute__((ext_vector_type(8))) short;
using s16x4  = __attribute__((ext_vector_type(4))) short;
using f32x16 = __attribute__((ext_vector_type(16))) float;
using f32x8  = __attribute__((ext_vector_type(8))) float;
using u32x4  = __attribute__((ext_vector_type(4))) unsigned;
#define KSWZ(row, colB) ((row) * 256 + ((colB) ^ (((row) & 7) << 4)))
#define SBAR() __builtin_amdgcn_sched_barrier(0)
__device__ __forceinline__ int crow(int r, int hi) { return (r & 3) + 8 * (r >> 2) + 4 * hi; }
__device__ __forceinline__ unsigned cvtpk(float lo, float hi) {
  unsigned r; asm volatile("v_cvt_pk_bf16_f32 %0, %1, %2" : "=v"(r) : "v"(lo), "v"(hi)); return r;
}
template <typename TIn> struct Stage;
template <> struct Stage<bf16>  { using T = bf16x8;
  __device__ static __forceinline__ T ld8(const bf16* p) { return *reinterpret_cast<const bf16x8*>(p); }
  __device__ static __forceinline__ bf16x8 tobf(T x) { return x; } };
template <> struct Stage<float> { using T = f32x8;
  __device__ static __forceinline__ T ld8(const float* p) { return *reinterpret_cast<const f32x8*>(p); }
  __device__ static __forceinline__ bf16x8 tobf(T x) {
    u32x4 w = {cvtpk(x[0], x[1]), cvtpk(x[2], x[3]), cvtpk(x[4], x[5]), cvtpk(x[6], x[7])}; return *reinterpret_cast<bf16x8*>(&w); } };

__device__ __forceinline__ void partialSM(f32x16& p0, f32x16& p1, float& m_reg, float& mn, float& alpha) {
  constexpr float C = SCALE * 1.4426950408889634f;
  float pmax = p0[0]; for (int r = 1; r < 16; ++r) pmax = fmaxf(pmax, p0[r]); for (int r = 0; r < 16; ++r) pmax = fmaxf(pmax, p1[r]);
  { auto rr = __builtin_amdgcn_permlane32_swap(__float_as_uint(pmax), __float_as_uint(pmax), false, false);
    pmax = fmaxf(__uint_as_float(rr[0]), __uint_as_float(rr[1])); }
  if (__builtin_expect(__all(pmax - m_reg <= THR / SCALE), 1)) { mn = m_reg; alpha = 1.f; }
  else { mn = fmaxf(m_reg, pmax); alpha = __builtin_amdgcn_exp2f((m_reg - mn) * C); m_reg = mn; }
  float mnC = -mn * C;
  for (int r = 0; r < 16; ++r) p0[r] = fmaf(p0[r], C, mnC); for (int r = 0; r < 16; ++r) p1[r] = fmaf(p1[r], C, mnC);
  for (int r = 0; r < 16; ++r) p0[r] = __builtin_amdgcn_exp2f(p0[r]);
}
__device__ __forceinline__ void finishSM(f32x16& p0, f32x16& p1, float alpha, float& l_reg, bf16x8& pa0, bf16x8& pa1, bf16x8& pa2, bf16x8& pa3) {
  for (int r = 0; r < 16; ++r) p1[r] = __builtin_amdgcn_exp2f(p1[r]);
  float ps = 0; for (int r = 0; r < 16; ++r) ps += p0[r]; for (int r = 0; r < 16; ++r) ps += p1[r];
  { auto rr = __builtin_amdgcn_permlane32_swap(__float_as_uint(ps), __float_as_uint(ps), false, false);
    ps = __uint_as_float(rr[0]) + __uint_as_float(rr[1]); }
  l_reg = l_reg * alpha + ps;
#define PK4(P, BASE, OUT) do { unsigned a0 = cvtpk(P[BASE + 0], P[BASE + 1]), a1 = cvtpk(P[BASE + 2], P[BASE + 3]);   \
    unsigned b0 = cvtpk(P[BASE + 4], P[BASE + 5]), b1 = cvtpk(P[BASE + 6], P[BASE + 7]);                              \
    auto r0 = __builtin_amdgcn_permlane32_swap(a0, b0, false, false); auto r1 = __builtin_amdgcn_permlane32_swap(a1, b1, false, false); \
    u32x4 w = {r0[0], r1[0], r0[1], r1[1]}; OUT = *reinterpret_cast<bf16x8*>(&w); } while (0)
  PK4(p0, 0, pa0); PK4(p0, 8, pa1); PK4(p1, 0, pa2); PK4(p1, 8, pa3);
#undef PK4
}
__device__ __forceinline__ void qkt(f32x16& p0, f32x16& p1, const bf16* Ks, const bf16x8* qr, int r32, int hi) {
  p0 = f32x16{}; p1 = f32x16{};
  for (int d0 = 0; d0 < 8; ++d0) { int cb = (d0 * 16 + hi * 8) * 2;
    bf16x8 b0 = *reinterpret_cast<const bf16x8*>((const char*)Ks + KSWZ(r32, cb));
    bf16x8 b1 = *reinterpret_cast<const bf16x8*>((const char*)Ks + KSWZ(32 + r32, cb));
    p0 = __builtin_amdgcn_mfma_f32_32x32x16_bf16(b0, qr[d0], p0, 0, 0, 0);
    p1 = __builtin_amdgcn_mfma_f32_32x32x16_bf16(b1, qr[d0], p1, 0, 0, 0); }
}
__device__ __forceinline__ int v_st(int k, int c) { const int kk = (k & ~0xC) | ((k & 4) << 1) | ((k & 8) >> 1); return ((kk >> 3) * 4 + (c >> 5)) * 512 + ((kk & 7) * 32 + (c & 31)) * 2; }
__device__ __forceinline__ int v_rd_base(int lane) { return ((lane & 3) << 3) | (((lane >> 2) & 3) << 6) | (((lane >> 4) & 1) << 5) | (((lane >> 5) & 1) << 8); }
constexpr int v_rd_off(int d0, int ks, int half) { return d0 * 512 + ks * 4096 + half * 2048; }
template <int OFF> __device__ __forceinline__ s16x4 tr_read(int vb) {
  s16x4 r; asm volatile("ds_read_b64_tr_b16 %0, %1 offset:%2" : "=&v"(r) : "v"(vb), "i"(OFF) : "memory"); return r;
}
template <int D0> __device__ __forceinline__ void pv_one(f32x16& od, int vb, bf16x8 pa0, bf16x8 pa1, bf16x8 pa2, bf16x8 pa3) {
  const s16x4 l0 = tr_read<v_rd_off(D0, 0, 0)>(vb), h0 = tr_read<v_rd_off(D0, 0, 1)>(vb), l1 = tr_read<v_rd_off(D0, 1, 0)>(vb), h1 = tr_read<v_rd_off(D0, 1, 1)>(vb);
  const s16x4 l2 = tr_read<v_rd_off(D0, 2, 0)>(vb), h2 = tr_read<v_rd_off(D0, 2, 1)>(vb), l3 = tr_read<v_rd_off(D0, 3, 0)>(vb), h3 = tr_read<v_rd_off(D0, 3, 1)>(vb);
  asm volatile("s_waitcnt lgkmcnt(0)" ::: "memory"); SBAR();
#define PK(L, H) (bf16x8){L[0], L[1], L[2], L[3], H[0], H[1], H[2], H[3]}
  od = __builtin_amdgcn_mfma_f32_32x32x16_bf16(pa0, PK(l0, h0), od, 0, 0, 0);
  od = __builtin_amdgcn_mfma_f32_32x32x16_bf16(pa1, PK(l1, h1), od, 0, 0, 0);
  od = __builtin_amdgcn_mfma_f32_32x32x16_bf16(pa2, PK(l2, h2), od, 0, 0, 0);
  od = __builtin_amdgcn_mfma_f32_32x32x16_bf16(pa3, PK(l3, h3), od, 0, 0, 0);
#undef PK
}
__device__ __forceinline__ void pv_d0(f32x16* o, int vb, bf16x8 pa0, bf16x8 pa1, bf16x8 pa2, bf16x8 pa3) {
  pv_one<0>(o[0], vb, pa0, pa1, pa2, pa3); pv_one<1>(o[1], vb, pa0, pa1, pa2, pa3); pv_one<2>(o[2], vb, pa0, pa1, pa2, pa3); pv_one<3>(o[3], vb, pa0, pa1, pa2, pa3);
}
template <typename TQ>
__device__ __forceinline__ void attn_dense_body(const TQ* __restrict__ Qb, const bf16* __restrict__ Kh, const bf16* __restrict__ Vh,
                                                unsigned short* __restrict__ Ob, int seq, char* lds) {
  using St = Stage<bf16>; using SQ = Stage<TQ>;
  const int tid = threadIdx.x, wid = tid >> 6, lane = tid & 63, r32 = lane & 31, hi = lane >> 5;
  bf16* V_lds = (bf16*)lds; bf16* K_lds = (bf16*)(lds + 2 * SHM_V);
  float* ws = (float*)(lds + 2 * SHM_V + 2 * SHM_K) + wid * 64; float* li_l = ws; float* al_l = ws + 32;
  float m_reg = -1e30f, l_reg = 0; f32x16 o[4] = {}; bf16x8 qr[8];
  const TQ* Qw = Qb + (long)(wid * QBLK + r32) * LDQ + hi * 8;
#pragma unroll
  for (int d0 = 0; d0 < 8; ++d0) qr[d0] = SQ::tobf(SQ::ld8(Qw + d0 * 16));
  const int sr = tid >> 4, sc = (tid & 15) * 8, vst0 = v_st(sr, sc), vst1 = v_st(32 + sr, sc);
  const int vb0 = (int)(uintptr_t)V_lds + v_rd_base(lane);
  struct { typename St::T vs0, vs1, ks0, ks1; } sr_[SDEPTH];
#define SLOAD(i, k0) do { sr_[i].vs0 = St::ld8(&Vh[(long)((k0) + sr) * LDK + sc]); sr_[i].vs1 = St::ld8(&Vh[(long)((k0) + 32 + sr) * LDK + sc]); \
    sr_[i].ks0 = St::ld8(&Kh[(long)((k0) + sr) * LDK + sc]); sr_[i].ks1 = St::ld8(&Kh[(long)((k0) + 32 + sr) * LDK + sc]); } while (0)
#define SWRITE(b, i) do { *(bf16x8*)((char*)V_lds + (b) * SHM_V + vst0) = St::tobf(sr_[i].vs0);          \
    *(bf16x8*)((char*)V_lds + (b) * SHM_V + vst1) = St::tobf(sr_[i].vs1); int kc = sc * 2;               \
    *(bf16x8*)((char*)K_lds + (b) * SHM_K + KSWZ(sr, kc)) = St::tobf(sr_[i].ks0);                       \
    *(bf16x8*)((char*)K_lds + (b) * SHM_K + KSWZ(32 + sr, kc)) = St::tobf(sr_[i].ks1); } while (0)
#define SWAIT() do { if constexpr (SDEPTH == 2) asm volatile("s_waitcnt vmcnt(4)" ::: "memory"); else asm volatile("s_waitcnt vmcnt(0)" ::: "memory"); } while (0)
#define RESC(a) do { if (__any((a) < 1.f)) { if (hi == 0) al_l[r32] = (a); asm volatile("s_waitcnt lgkmcnt(0)" ::: "memory"); \
    for (int d = 0; d < 4; ++d) for (int r = 0; r < 16; ++r) o[d][r] *= al_l[crow(r, hi)]; } } while (0)
  f32x16 pA0, pA1, pB0, pB1; float mnA, mnB, alA, alB; bf16x8 pa0, pa1, pa2, pa3; const int NT = seq / KVBLK;
  constexpr int SE = 0, SO = SDEPTH - 1;
  SLOAD(SE, 0); asm volatile("s_waitcnt vmcnt(0)" ::: "memory"); SWRITE(0, SE); __syncthreads();
  qkt(pA0, pA1, K_lds, qr, r32, hi); partialSM(pA0, pA1, m_reg, mnA, alA);
  SLOAD(SO, KVBLK); if constexpr (SDEPTH == 2) { if (2 < NT) SLOAD(SE, 2 * KVBLK); }
  SWAIT(); SWRITE(1, SO); __syncthreads();
  for (int j = 1; j + 1 < NT; j += 2) {
    SBAR(); qkt(pB0, pB1, (bf16*)((char*)K_lds + SHM_K), qr, r32, hi);
    finishSM(pA0, pA1, alA, l_reg, pa0, pa1, pa2, pa3); SBAR();
    SLOAD(SO, (j + SDEPTH) * KVBLK); SBAR();
    pv_d0(o, vb0, pa0, pa1, pa2, pa3); partialSM(pB0, pB1, m_reg, mnB, alB);
    __syncthreads(); SWAIT(); SWRITE(0, SE);
    RESC(alB); __syncthreads();
    SBAR(); qkt(pA0, pA1, K_lds, qr, r32, hi);
    finishSM(pB0, pB1, alB, l_reg, pa0, pa1, pa2, pa3); SBAR();
    if (SDEPTH == 1 || j + 3 < NT) SLOAD(SE, (j + 1 + SDEPTH) * KVBLK); SBAR();
    pv_d0(o, vb0 + (int)SHM_V, pa0, pa1, pa2, pa3); partialSM(pA0, pA1, m_reg, mnA, alA);
    __syncthreads(); SWAIT(); SWRITE(1, SO);
    RESC(alA); __syncthreads();
  }
  SBAR(); qkt(pB0, pB1, (bf16*)((char*)K_lds + SHM_K), qr, r32, hi);
  finishSM(pA0, pA1, alA, l_reg, pa0, pa1, pa2, pa3); SBAR();
  pv_d0(o, vb0, pa0, pa1, pa2, pa3); partialSM(pB0, pB1, m_reg, mnB, alB);
  __syncthreads(); RESC(alB);
  finishSM(pB0, pB1, alB, l_reg, pa0, pa1, pa2, pa3); SBAR();
  pv_d0(o, vb0 + (int)SHM_V, pa0, pa1, pa2, pa3);
  if (hi == 0) li_l[r32] = l_reg; asm volatile("s_waitcnt lgkmcnt(0)" ::: "memory");
  float rli[16];
#pragma unroll
  for (int r = 0; r < 16; ++r) rli[r] = __builtin_amdgcn_rcpf(li_l[crow(r, hi)]);
  unsigned short* Ow = Ob + (long)(wid * QBLK) * LDO;
#pragma unroll
  for (int r = 0; r < 16; ++r) { int orow = crow(r, hi);
    for (int d0 = 0; d0 < 4; ++d0) Ow[(long)orow * LDO + d0 * 32 + r32] = f2bf_rne(o[d0][r] * rli[r]); }
#undef SLOAD
#undef SWRITE
#undef SWAIT
#undef RESC
}
}
#ifndef PP_MASK
#define PP_MASK 31
#endif
#ifndef PPR_MASK
#define PPR_MASK 0
#endif
#define GAS __attribute__((address_space(1)))
#define LAS __attribute__((address_space(3)))
typedef unsigned short bf16_t;
typedef float f32x4 __attribute__((ext_vector_type(4)));
typedef float f32x2 __attribute__((ext_vector_type(2)));
typedef unsigned u32x4 __attribute__((ext_vector_type(4)));
typedef unsigned u32x2 __attribute__((ext_vector_type(2)));
typedef __bf16 bf16x2_t __attribute__((ext_vector_type(2)));

constexpr int DM = 2048, MC = 4096, MS = 4096, MT = MC + MS, DEPTH = 2;
constexpr int DIN = 4768, DINP = 4864, DFF = 5632;
constexpr int O_K = 1024, O_V = 1280, O_CB = 1536, O_CC = 2048, O_CH = 2560, O_UR = 3072;
constexpr int KVROWS = 4096 + 4 * 1280;
constexpr float EPS = 1e-6f, GN_EPS = 64e-5f;
constexpr int NWAVES = 8, NTHREADS = 512;
enum { I_XP = 0, I_XS, I_CK, I_CV, I_ST, I_C, I_CCTX, I_WADA, I_BADA, I_NG, I_WIN, I_QN, I_KN, I_CONVW, I_MU, I_W0, I_WUP, I_A0, I_AUP, I_GUP, I_KK, I_KA, I_RK, I_LNG, I_LNB, I_WOUT, I_WGATE, I_WUPF, I_WDOWN, N_IN };
constexpr size_t OUT_Y = 0, OUT_NK = (size_t)MT * DM, OUT_NV = OUT_NK + 2097152, OUT_ST = OUT_NV + 2097152, OUT_TOTAL = OUT_ST + 2097152;
constexpr size_t MiB = 1u << 20;
constexpr size_t WS_CTL = 0, CTL_BYTES = 1 * MiB;
constexpr size_t WS_WIN = 1 * MiB, SZ_WIN = 19 * MiB;
constexpr size_t WS_WOUT = WS_WIN + 2 * SZ_WIN, SZ_WOUT = 8 * MiB;
constexpr size_t WS_WGU = WS_WOUT + 2 * SZ_WOUT, SZ_WGU = 44 * MiB;
constexpr size_t WS_WDN = WS_WGU + 2 * SZ_WGU, SZ_WDN = 22 * MiB;
constexpr size_t WS_MOD = WS_WDN + 2 * SZ_WDN;
constexpr size_t WS_HB = WS_MOD + 1 * MiB;
constexpr size_t WS_MIX = WS_HB + 32 * MiB;
constexpr size_t WS_XB = WS_MIX + 32 * MiB;
constexpr size_t WS_R1 = WS_XB + 64 * MiB;
constexpr size_t WS_PROJ = WS_R1;
constexpr size_t WS_QB = WS_R1 + 76 * MiB;
constexpr size_t WS_KB = WS_R1 + 92 * MiB;
constexpr size_t WS_VB = WS_R1 + 97 * MiB;
constexpr size_t WS_SCAN = WS_R1 + 102 * MiB;
constexpr size_t WS_YB = WS_R1 + 294 * MiB;
constexpr size_t WS_OB = WS_R1;
constexpr size_t WS_HID = WS_R1 + 64 * MiB;
constexpr size_t WS_END = WS_R1 + 326 * MiB;
constexpr int CW_BAR = 4096;
constexpr int CW_CNT = 16384;
constexpr int CW_QUEUE = 64;
constexpr int RING_BYTES = 131072, LDS_BYTES = 147456, MISC_OFF = LDS_BYTES - 256;

__device__ __forceinline__ float bf2f(bf16_t h) { return __uint_as_float((unsigned)h << 16); }
__device__ __forceinline__ unsigned pk2(float lo, float hi) { f32x2 v = {lo, hi}; bf16x2_t b = __builtin_convertvector(v, bf16x2_t); return __builtin_bit_cast(unsigned, b); }
__device__ __forceinline__ bf16_t f2bf(float f) { return (bf16_t)(pk2(f, 0.f) & 0xffffu); }
__device__ __forceinline__ float wave_sum(float v) {
#pragma unroll
    for (int o = 1; o < 64; o <<= 1) v += __shfl_xor(v, o);
    return v;
}
template <int CTRL> __device__ __forceinline__ float dpp_add(float x) {
    const int y = __builtin_amdgcn_update_dpp(0, __float_as_int(x), CTRL, 0xf, 0xf, false);
    return x + __int_as_float(y);
}
__device__ __forceinline__ float row16_sum(float x) {
    x = dpp_add<0x128>(x); x = dpp_add<0x124>(x); x = dpp_add<0x122>(x); x = dpp_add<0x121>(x); return x;
}
__device__ __forceinline__ float wave_sum_fast(float x) {
    x = row16_sum(x); const int xi = __float_as_int(x);
    return (__int_as_float(__builtin_amdgcn_readlane(xi, 0)) + __int_as_float(__builtin_amdgcn_readlane(xi, 16))) + (__int_as_float(__builtin_amdgcn_readlane(xi, 32)) + __int_as_float(__builtin_amdgcn_readlane(xi, 48)));
}
__device__ __forceinline__ float sigmoidf_(float x) { return 1.0f / (1.0f + __expf(-x)); }

#define XB_TMO      128
#define XB_XCNT(j)  (256  + 64 * (j))
#define XB_XSUB(j)  (1280 + 64 * (j))
#define XB_XGEN(j)  (2304 + 64 * (j))
#define XB_TOP      3328
#define XB_TOPGEN   3392
#define XCD_BAR_WORDS 3456
#define XB_SPIN_CAP (1u << 18)

__device__ __forceinline__ unsigned xb_ld(unsigned* p)              { return __hip_atomic_load(p, __ATOMIC_RELAXED, __HIP_MEMORY_SCOPE_AGENT); }
__device__ __forceinline__ unsigned xb_add(unsigned* p, unsigned v) { return __hip_atomic_fetch_add(p, v, __ATOMIC_RELAXED, __HIP_MEMORY_SCOPE_AGENT); }
__device__ __forceinline__ unsigned xb_xcc_id() { return (unsigned)__builtin_amdgcn_s_getreg((3 << 11) | 20) & 0xFu; }
#define XB_SPIN(cond, bar) do { unsigned _sp = 0; while (cond) { __builtin_amdgcn_s_sleep(1); \
    if ((++_sp & 255u) == 0u) { if (xb_ld(&(bar)[XB_TMO])) break; if (_sp > XB_SPIN_CAP) { atomicAdd(&(bar)[XB_TMO], 1u); break; } } } } while (0)

struct XcdBarrier {
    unsigned* bar; unsigned x;
    volatile LAS unsigned* st;
};

__device__ __forceinline__ XcdBarrier xcd_barrier_post(unsigned* bar, volatile LAS unsigned* st) {
    XcdBarrier b; b.bar = bar; b.x = xb_xcc_id(); b.st = st;
    if (threadIdx.x == 0) (void)xb_add(&bar[XB_XCNT(b.x)], 1u);
    return b;
}
__device__ __forceinline__ void xcd_barrier_complete(unsigned* bar, unsigned x, unsigned& nloc, unsigned& nx) {
    const unsigned G = gridDim.x * gridDim.y * gridDim.z;
    unsigned sum, cnt, mine, sp = 0u;
    for (;;) {
        sum = 0u; cnt = 0u; mine = 0u;
#pragma unroll
        for (unsigned j = 0; j < 16; ++j) { const unsigned c = xb_ld(&bar[XB_XCNT(j)]); sum += c; cnt += (c > 0u) ? 1u : 0u; mine = (j == x) ? c : mine; }
        if (sum == G) break;
        __builtin_amdgcn_s_sleep(1);
        if ((++sp & 255u) == 0u) { if (xb_ld(&bar[XB_TMO])) break; if (sp > XB_SPIN_CAP) { atomicAdd(&bar[XB_TMO], 1u); break; } }
    }
    nloc = mine > 0u ? mine : 1u; nx = cnt > 0u ? cnt : 1u;
}

__device__ __forceinline__ void xcd_barrier(const XcdBarrier& b) {
    asm volatile("s_waitcnt vmcnt(0)" ::: "memory");
    __syncthreads();
    if (threadIdx.x == 0) {
        unsigned* bar = b.bar;
        __builtin_amdgcn_s_waitcnt(0);
        unsigned nloc = b.st[0], nx = b.st[1];
        if (nloc == 0u) { xcd_barrier_complete(bar, b.x, nloc, nx); b.st[0] = nloc; b.st[1] = nx; }
        const unsigned old = xb_add(&bar[XB_XSUB(b.x)], 1u);
        const unsigned gen = old / nloc;
        if (old + 1u == (gen + 1u) * nloc) {
            __builtin_amdgcn_fence(__ATOMIC_RELEASE, "agent");
            asm volatile("s_waitcnt vmcnt(0)" ::: "memory");
            const unsigned og = xb_add(&bar[XB_TOP], 1u);
            const unsigned tg = og / nx;
            if (og + 1u == (tg + 1u) * nx) xb_add(&bar[XB_TOPGEN], 1u);
            else XB_SPIN(xb_ld(&bar[XB_TOPGEN]) == tg, bar);
            __builtin_amdgcn_fence(__ATOMIC_ACQUIRE, "agent");
            xb_add(&bar[XB_XGEN(b.x)], 1u);
            asm volatile("s_waitcnt vmcnt(0)" ::: "memory");
        } else {
            XB_SPIN(xb_ld(&bar[XB_XGEN(b.x)]) == gen, bar);
            __builtin_amdgcn_fence(__ATOMIC_ACQUIRE, "agent");
            asm volatile("s_waitcnt vmcnt(0)" ::: "memory");
        }
    }
    __syncthreads();
}


struct Args { const float* in[N_IN]; float* out; unsigned char* ws; int ph_lo, ph_hi; };
struct Frame {
    LAS unsigned char* lds; unsigned char* ldsg;
    const float* const* in; float* out; unsigned char* ws;
    int tid, lane, wave, G;
    XcdBarrier bar;
};
#define LDS_WAIT() asm volatile("s_waitcnt lgkmcnt(0)" ::: "memory")

__device__ __forceinline__ void p0_transpose_item(const float* W, int K, int N, bf16_t* WT, int kb, int nb, int rowbase, LAS float* scr, int lane) {
    const int k0 = 64 * kb, n0 = 32 * nb;
#pragma unroll 8
    for (int i = 0; i < 32; ++i) { const int kk = 2 * i + (lane >> 5); scr[kk * 33 + (lane & 31)] = W[(size_t)(k0 + kk) * N + n0 + (lane & 31)]; }
    LDS_WAIT(); asm volatile("" ::: "memory");
    const int c = lane & 7;
#pragma unroll
    for (int j = 0; j < 4; ++j) { const int n = (lane >> 3) + 8 * j; const LAS float* s = scr + (8 * c) * 33 + n;
        u32x4 o; o.x = pk2(s[0 * 33], s[1 * 33]); o.y = pk2(s[2 * 33], s[3 * 33]); o.z = pk2(s[4 * 33], s[5 * 33]); o.w = pk2(s[6 * 33], s[7 * 33]);
        *(u32x4*)(WT + (size_t)(rowbase + n) * K + k0 + 8 * c) = o; }
    LDS_WAIT(); asm volatile("" ::: "memory");
}
__device__ __forceinline__ void p0_prologue(Frame& F) {
    {
        LAS float* sc = (LAS float*)F.lds;
        LAS float* red = sc + 5 * 2048;
        for (int i = F.tid; i < 5 * 2048; i += NTHREADS) { const int v = i >> 11, k = i & 2047; const float x = v == 0 ? F.in[I_CCTX][k] : F.in[I_C][(v - 1) * 2048 + k]; sc[i] = x * sigmoidf_(x); }
        __syncthreads();
        for (int it = blockIdx.x; it < 2 * 192; it += F.G) {
            const int l = it / 192, cg_ = it % 192, col = cg_ * 64 + F.lane;
            const float* W = F.in[I_WADA] + (size_t)l * 2048 * 12288 + col;
            float acc[5] = {0.f, 0.f, 0.f, 0.f, 0.f};
            const int kbeg = F.wave * 256;
#pragma unroll 2
            for (int k = kbeg; k < kbeg + 256; k += 4) {
                const float w0 = W[(size_t)(k + 0) * 12288], w1 = W[(size_t)(k + 1) * 12288], w2 = W[(size_t)(k + 2) * 12288], w3 = W[(size_t)(k + 3) * 12288];
#pragma unroll
                for (int v = 0; v < 5; ++v) { const f32x4 s = *(const LAS f32x4*)(sc + v * 2048 + k); acc[v] += s.x * w0 + s.y * w1 + s.z * w2 + s.w * w3; }
            }
#pragma unroll
            for (int v = 0; v < 5; ++v) red[(F.wave * 5 + v) * 64 + F.lane] = acc[v];
            __syncthreads();
            if (F.tid < 320) { const int v = F.tid >> 6, c = F.tid & 63; float s = 0.f;
#pragma unroll
                for (int w = 0; w < 8; ++w) s += red[(w * 5 + v) * 64 + c];
                const int cc = cg_ * 64 + c;
                ((float*)(F.ws + WS_MOD))[(size_t)(l * 5 + v) * 12288 + cc] = s + F.in[I_BADA][l * 12288 + cc]; }
            __syncthreads();
        }
    }
    __syncthreads();
    {
        const int gt = blockIdx.x * NTHREADS + F.tid, GT = F.G * NTHREADS;
        for (int i = gt; i < 2 * 24576; i += GT) { const int l = i / 24576, r = i % 24576;
            *(u32x4*)(F.ws + WS_WIN + (size_t)l * SZ_WIN + (size_t)4768 * 2048 * 2 + (size_t)r * 16) = (u32x4){0u, 0u, 0u, 0u}; }
    }
    {
        LAS float* scr = (LAS float*)(F.lds + F.wave * 16384);
        const int gw = blockIdx.x * NWAVES + F.wave, NGW = F.G * NWAVES;
        constexpr int I_IN = 32 * 149, I_OUT = 32 * 64, I_G = 32 * 176, I_DN = 88 * 64, PER_L = I_IN + I_OUT + 2 * I_G + I_DN;
        for (int it = gw; it < 2 * PER_L; it += NGW) {
            const int l = it / PER_L; int r = it % PER_L;
            if (r < I_IN) { const int kb = r / 149, nb = r % 149;
                p0_transpose_item(F.in[I_WIN] + (size_t)l * 2048 * DIN, 2048, DIN, (bf16_t*)(F.ws + WS_WIN + l * SZ_WIN), kb, nb, 32 * nb, scr, F.lane); continue; }
            r -= I_IN;
            if (r < I_OUT) { const int kb = r / 64, nb = r % 64;
                p0_transpose_item(F.in[I_WOUT] + (size_t)l * 2048 * 2048, 2048, 2048, (bf16_t*)(F.ws + WS_WOUT + l * SZ_WOUT), kb, nb, 32 * nb, scr, F.lane); continue; }
            r -= I_OUT;
            if (r < 2 * I_G) { const int up = r >= I_G; if (up) r -= I_G; const int kb = r / 176, nb = r % 176, n0 = 32 * nb;
                p0_transpose_item(F.in[up ? I_WUPF : I_WGATE] + (size_t)l * 2048 * DFF, 2048, DFF, (bf16_t*)(F.ws + WS_WGU + l * SZ_WGU), kb, nb, (n0 >> 7) * 256 + (up ? 128 : 0) + (n0 & 127), scr, F.lane); continue; }
            r -= 2 * I_G;
            { const int kb = r / 64, nb = r % 64;
                p0_transpose_item(F.in[I_WDOWN] + (size_t)l * DFF * 2048, DFF, 2048, (bf16_t*)(F.ws + WS_WDN + l * SZ_WDN), kb, nb, 32 * nb, scr, F.lane); }
        }
    }
}

__device__ __forceinline__ const float* mod_vec(const Frame& F, int l, int m, int which) {
    const int v = m < MC ? 0 : 1 + ((m - MC) >> 10);
    return (const float*)(F.ws + WS_MOD) + (size_t)(l * 5 + v) * 12288 + which * 2048;
}
__device__ __forceinline__ const float* x_in_row(const Frame& F, int m) { return m < MC ? F.in[I_XP] + (size_t)m * DM : F.in[I_XS] + (size_t)(m - MC) * DM; }
__device__ __forceinline__ float row_ss(const f32x4 (&v)[8]) {
    float s = 0.f;
#pragma unroll
    for (int j = 0; j < 8; ++j) s += (v[j].x * v[j].x + v[j].y * v[j].y) + (v[j].z * v[j].z + v[j].w * v[j].w);
    return wave_sum(s);
}
__device__ __forceinline__ void write_h(const Frame& F, const f32x4 (&x)[8], float rs, const float* ng, const float* sc, const float* sh, bf16_t* hrow) {
#pragma unroll
    for (int j = 0; j < 8; ++j) { const int o = F.lane + 64 * j;
        const f32x4 g = ((const f32x4*)ng)[o], s = ((const f32x4*)sc)[o], b = ((const f32x4*)sh)[o];
        const f32x4 h = x[j] * rs * g * (1.0f + s) + b;
        u32x2 w; w.x = pk2(h.x, h.y); w.y = pk2(h.z, h.w); ((u32x2*)hrow)[o] = w; }
}
__device__ __forceinline__ void rowpass0(Frame& F) {
    const int gw = blockIdx.x * NWAVES + F.wave, NGW = F.G * NWAVES;
    for (int m = gw; m < MT; m += NGW) {
        const f32x4* xr = (const f32x4*)x_in_row(F, m); f32x4 x[8];
#pragma unroll
        for (int j = 0; j < 8; ++j) x[j] = xr[F.lane + 64 * j];
        const float rs = rsqrtf(row_ss(x) * (1.0f / DM) + EPS);
        write_h(F, x, rs, F.in[I_NG] + 0, mod_vec(F, 0, m, 1), mod_vec(F, 0, m, 0), (bf16_t*)(F.ws + WS_HB) + (size_t)m * DM);
    }
}
__device__ __forceinline__ void rowpassA(Frame& F, int l) {
    const int gw = blockIdx.x * NWAVES + F.wave, NGW = F.G * NWAVES;
    const float* ng = F.in[I_NG] + (size_t)l * 4 * DM;
    for (int m = gw; m < MT; m += NGW) {
        const u32x2* orow = (const u32x2*)(F.ws + WS_OB) + (size_t)m * (DM / 4);
        const f32x4* xr = l == 0 ? (const f32x4*)x_in_row(F, m) : (const f32x4*)(F.ws + WS_XB) + (size_t)m * (DM / 4);
        f32x4 o[8], x[8];
#pragma unroll
        for (int j = 0; j < 8; ++j) { const u32x2 ob_ = orow[F.lane + 64 * j]; o[j] = (f32x4){__uint_as_float(ob_.x << 16), __uint_as_float(ob_.x & 0xffff0000u), __uint_as_float(ob_.y << 16), __uint_as_float(ob_.y & 0xffff0000u)}; x[j] = xr[F.lane + 64 * j]; }
        const float r1 = rsqrtf(row_ss(o) * (1.0f / DM) + EPS);
        const float* ga = mod_vec(F, l, m, 2);
        f32x4* xo = (f32x4*)(F.ws + WS_XB) + (size_t)m * (DM / 4);
#pragma unroll
        for (int j = 0; j < 8; ++j) { const int q = F.lane + 64 * j; x[j] = x[j] + ((const f32x4*)ga)[q] * (o[j] * r1 * ((const f32x4*)(ng + DM))[q]); xo[q] = x[j]; }
        const float r2 = rsqrtf(row_ss(x) * (1.0f / DM) + EPS);
        write_h(F, x, r2, ng + 2 * DM, mod_vec(F, l, m, 4), mod_vec(F, l, m, 3), (bf16_t*)(F.ws + WS_HB) + (size_t)m * DM);
    }
}
__device__ __forceinline__ void rowpassB(Frame& F, int l) {
    const int gw = blockIdx.x * NWAVES + F.wave, NGW = F.G * NWAVES;
    const float* ng = F.in[I_NG] + (size_t)l * 4 * DM;
    for (int m = gw; m < MT; m += NGW) {
        const u32x2* orow = (const u32x2*)(F.ws + WS_OB) + (size_t)m * (DM / 4);
        const f32x4* xr = (const f32x4*)(F.ws + WS_XB) + (size_t)m * (DM / 4);
        f32x4 o[8], x[8];
#pragma unroll
        for (int j = 0; j < 8; ++j) { const u32x2 ob_ = orow[F.lane + 64 * j]; o[j] = (f32x4){__uint_as_float(ob_.x << 16), __uint_as_float(ob_.x & 0xffff0000u), __uint_as_float(ob_.y << 16), __uint_as_float(ob_.y & 0xffff0000u)}; x[j] = xr[F.lane + 64 * j]; }
        const float r1 = rsqrtf(row_ss(o) * (1.0f / DM) + EPS);
        const float* gf = mod_vec(F, l, m, 5);
        f32x4* xo = (l == DEPTH - 1) ? (f32x4*)(F.out + OUT_Y) + (size_t)m * (DM / 4) : (f32x4*)(F.ws + WS_XB) + (size_t)m * (DM / 4);
#pragma unroll
        for (int j = 0; j < 8; ++j) { const int q = F.lane + 64 * j; x[j] = x[j] + ((const f32x4*)gf)[q] * (o[j] * r1 * ((const f32x4*)(ng + 3 * DM))[q]); xo[q] = x[j]; }
        if (l < DEPTH - 1) {
            const float r2 = rsqrtf(row_ss(x) * (1.0f / DM) + EPS);
            write_h(F, x, r2, ng + 4 * DM, mod_vec(F, l + 1, m, 1), mod_vec(F, l + 1, m, 0), (bf16_t*)(F.ws + WS_HB) + (size_t)m * DM);
        }
    }
}

constexpr int TC_PITCH = 1696, SM_OFF = 115712, TG = 8;
__device__ __forceinline__ void p2_prepass(Frame& F, int l) {
    const bf16_t* PROJ = (const bf16_t*)(F.ws + WS_PROJ);
    bf16_t* QB = (bf16_t*)(F.ws + WS_QB); bf16_t* KB = (bf16_t*)(F.ws + WS_KB); bf16_t* VB = (bf16_t*)(F.ws + WS_VB); bf16_t* MIX = (bf16_t*)(F.ws + WS_MIX);
    float* SCAN = (float*)(F.ws + WS_SCAN);
    int tid0 = F.tid; asm volatile("" : "+v"(tid0));
    for (int pi = blockIdx.x * NTHREADS + tid0; pi < 131072; pi += F.G * NTHREADS) {
        const int e = 2 * pi, b = e >> 16, rem = e & 65535, p = rem >> 8, col = rem & 255;
        const size_t src = ((size_t)(b * 2 + l) * 256 + p) * 256 + col, dst = (size_t)(MC + b * 1280 + 1024 + p) * 256 + col;
        const f32x2 kv = *(const f32x2*)(F.in[I_CK] + src), vv = *(const f32x2*)(F.in[I_CV] + src);
        *(unsigned*)(KB + dst) = pk2(kv.x, kv.y); *(unsigned*)(VB + dst) = pk2(vv.x, vv.y);
    }
    for (int item = blockIdx.x; item < MT / 32; item += F.G) {
        asm volatile("" ::: "memory");
        int tid = F.tid; asm volatile("" : "+v"(tid)); const int lane = tid & 63;
        const int m0 = item * 32; const bool smp = m0 >= MC;
        const int sb = smp ? (m0 - MC) >> 10 : m0 >> 8, t0 = smp ? (m0 - MC) & 1023 : m0 & 255, seqlen = smp ? 1024 : 256;
        __syncthreads();
#if PP_MASK & 1
        for (int rp = 0; rp < ((PPR_MASK & 1) ? 2 : 1); ++rp) {
            LAS bf16_t* TA = (LAS bf16_t*)F.lds;
#pragma unroll
            for (int j = 0; j < 12; ++j) { const int idx = tid + 512 * j, r = idx / 192, q = idx % 192;
                *(LAS u32x4*)(TA + r * 1536 + q * 8) = *(const u32x4*)(PROJ + (size_t)(m0 + r) * DINP + q * 8); }
            __syncthreads();
            const int e1 = lane < 32 ? lane : lane + 32, e2 = e1 + 32;
            const float gq1 = F.in[I_QN][l * 128 + e1], gq2 = F.in[I_QN][l * 128 + e2], gk1 = F.in[I_KN][l * 128 + e1], gk2 = F.in[I_KN][l * 128 + e2];
            const float inv = exp2f(-(float)(2 * (lane & 31)) * (13.287712379549449f / 64.0f));
#pragma unroll 2
            for (int wi = F.wave; wi < 320; wi += NWAVES) {
                const int tok = wi / 10, j = wi % 10, t = t0 + tok;
                LAS bf16_t* p = TA + tok * 1536 + (j < 8 ? j * 128 : 1024 + (j - 8) * 128);
                const float x1 = bf2f(p[e1]), x2 = bf2f(p[e2]);
                const float rs = rsqrtf(wave_sum_fast(x1 * x1 + x2 * x2) * (1.0f / 128.0f) + EPS);
                float y1 = x1 * rs * (j < 8 ? gq1 : gk1), y2 = x2 * rs * (j < 8 ? gq2 : gk2);
                if (smp) {
                    const float pos = (float)(lane < 32 ? (t >> 6) : (t & 63));
                    float rev = pos * inv * 0.15915494309189535f; rev = rev - floorf(rev);
                    const float s = __builtin_amdgcn_sinf(rev), c = __builtin_amdgcn_cosf(rev);
                    const float o1 = y1 * c - y2 * s, o2 = y2 * c + y1 * s; y1 = o1; y2 = o2;
                }
                p[e1] = f2bf(y1); p[e2] = f2bf(y2);
            }
            __syncthreads();
#pragma unroll
            for (int j = 0; j < 8; ++j) { const int idx = tid + 512 * j, r = idx >> 7, q = idx & 127;
                *(u32x4*)(QB + (size_t)(m0 + r) * 1024 + q * 8) = *(const LAS u32x4*)(TA + r * 1536 + q * 8); }
#pragma unroll
            for (int j = 0; j < 2; ++j) { const int idx = tid + 512 * j, r = idx >> 5, q = idx & 31;
                const size_t krow = smp ? (size_t)(MC + sb * 1280 + t0 + r) : (size_t)(m0 + r);
                *(u32x4*)(KB + krow * 256 + q * 8) = *(const LAS u32x4*)(TA + r * 1536 + 1024 + q * 8);
                *(u32x4*)(VB + krow * 256 + q * 8) = *(const LAS u32x4*)(TA + r * 1536 + 1280 + q * 8); }
            if (!smp) {
#pragma unroll
                for (int j = 0; j < 4; ++j) { const int idx = tid + 512 * j, r = idx >> 6, q = idx & 63;
                    const u32x2 kk = *(const LAS u32x2*)(TA + r * 1536 + 1024 + q * 4), vv = *(const LAS u32x2*)(TA + r * 1536 + 1280 + q * 4);
                    const size_t o = ((size_t)(sb * 2 + l) * 256 + t0 + r) * 256 + q * 4;
                    *(f32x4*)(F.out + OUT_NK + o) = (f32x4){__uint_as_float(kk.x << 16), __uint_as_float(kk.x & 0xffff0000u), __uint_as_float(kk.y << 16), __uint_as_float(kk.y & 0xffff0000u)};
                    *(f32x4*)(F.out + OUT_NV + o) = (f32x4){__uint_as_float(vv.x << 16), __uint_as_float(vv.x & 0xffff0000u), __uint_as_float(vv.y << 16), __uint_as_float(vv.y & 0xffff0000u)}; }
            }
            __syncthreads();
        }
#endif
#if PP_MASK & 2
        for (int rp = 0; rp < ((PPR_MASK & 2) ? 2 : 1); ++rp) {
            LAS bf16_t* TB = (LAS bf16_t*)F.lds;
#pragma unroll
            for (int j = 0; j < 13; ++j) { const int idx = tid + 512 * j; if (idx < 34 * 192) { const int rr = idx / 192, q = idx % 192, t = t0 - 1 + rr;
                u32x4 v = {0u, 0u, 0u, 0u}; if (t >= 0 && t < seqlen) v = *(const u32x4*)(PROJ + (size_t)(m0 - 1 + rr) * DINP + O_CB + q * 8);
                *(LAS u32x4*)(TB + rr * 1536 + q * 8) = v; } }
            __syncthreads();
            const int c = tid; const float* cw = F.in[I_CONVW] + (size_t)l * 3 * 512;
            const float w0 = cw[c], w1 = cw[512 + c], w2 = cw[1024 + c];
            LAS bf16_t* TO = TB + 34 * 1536;
            float prev = bf2f(TB[512 + c]) * bf2f(TB[1024 + c]), cur = bf2f(TB[1536 + 512 + c]) * bf2f(TB[1536 + 1024 + c]);
#pragma unroll 4
            for (int tok = 0; tok < 32; ++tok) {
                const LAS bf16_t* p = TB + (tok + 2) * 1536;
                const float nxt = bf2f(p[512 + c]) * bf2f(p[1024 + c]);
                const float o = bf2f(p[-1536 + c]) * (w0 * prev + w1 * cur + w2 * nxt);
                TO[tok * 512 + c] = f2bf(o);
                prev = cur; cur = nxt;
            }
            __syncthreads();
#pragma unroll
            for (int j = 0; j < 4; ++j) { const int idx = tid + 512 * j, r = idx >> 6, q = idx & 63;
                *(u32x4*)(MIX + (size_t)(m0 + r) * DM + 1024 + q * 8) = *(const LAS u32x4*)(TO + r * 512 + q * 8); }
            __syncthreads();
        }
#endif
        LAS bf16_t* TC = (LAS bf16_t*)F.lds;
        LAS float* sm = (LAS float*)(F.lds + SM_OFF);
        const float* mu = F.in[I_MU] + (size_t)l * 1696;
#pragma unroll
        for (int j = 0; j < 15; ++j) { const int idx = tid + 512 * j; if (idx < 34 * 212) { const int rr = idx / 212, q = idx % 212, t = t0 - 1 + rr;
            u32x4 v = {0u, 0u, 0u, 0u}; if (t >= 0 && t < seqlen) v = *(const u32x4*)(PROJ + (size_t)(m0 - 1 + rr) * DINP + O_UR + q * 8);
            *(LAS u32x4*)(TC + rr * TC_PITCH + q * 8) = v; } }
        __syncthreads();
#pragma unroll 5
        for (int idx = tid; idx < 32 * 160; idx += NTHREADS) {
            const int tok = idx / 160, k = idx % 160, col = 1536 + k;
            const LAS bf16_t* p = TC + (tok + 1) * TC_PITCH + col;
            const float u = bf2f(p[0]), up = bf2f(p[-TC_PITCH]), un = bf2f(p[TC_PITCH]);
            const float us = u + mu[col] * (0.5f * (up + un) - u);
            sm[idx] = k < 32 ? tanhf(us) : (k < 64 ? us : sigmoidf_(us));
        }
        __syncthreads();
        const int c = tid, h = F.wave, i = lane;
#pragma unroll 1
        for (int half = 0; half < 32 / TG; ++half) {
            const int tb = TG * half;
            float gg[TG], dc0[TG], dc1[TG];
            {
                asm volatile("" ::: "memory");
                float wg[96];
                const float* gu = F.in[I_GUP] + (size_t)l * 96 * 512 + c;
#pragma unroll
                for (int k = 0; k < 96; ++k) { wg[k] = gu[0]; gu += 512; asm volatile("" : "+v"(gu)); }
#pragma unroll
                for (int tok = 0; tok < TG; ++tok) {
                    float g = 0.f, g2 = 0.f; const LAS float* xg = sm + (tb + tok) * 160 + 64;
#pragma unroll
                    for (int hk = 0; hk < 3; ++hk) {
                        f32x4 sv[8];
#pragma unroll
                        for (int q = 0; q < 8; ++q) sv[q] = *(const LAS f32x4*)(xg + 32 * hk + 4 * q);
                        __builtin_amdgcn_sched_barrier(0);
#pragma unroll
                        for (int q = 0; q < 8; ++q) { const f32x4 sq = sv[q]; const int k0 = 32 * hk + 4 * q; (q & 1 ? g2 : g) += sq.x * wg[k0] + sq.y * wg[k0 + 1] + sq.z * wg[k0 + 2] + sq.w * wg[k0 + 3]; }
                        __builtin_amdgcn_sched_barrier(0);
                    }
                    gg[tok] = g + g2;
                }
            }
            {
                asm volatile("" ::: "memory");
                float ww0[32], ww1[32];
                const float* wu = F.in[I_WUP] + (size_t)l * 2 * 32 * 512 + c;
#pragma unroll
                for (int k = 0; k < 32; ++k) { ww0[k] = wu[0]; ww1[k] = wu[32 * 512]; wu += 512; asm volatile("" : "+v"(wu)); }
                const float b0 = F.in[I_W0][(l * 2 + 0) * 512 + c], b1 = F.in[I_W0][(l * 2 + 1) * 512 + c];
#pragma unroll
                for (int tok = 0; tok < TG; ++tok) {
                    float z0 = b0, z1 = b1; const LAS float* xw = sm + (tb + tok) * 160;
                    f32x4 sv[8];
#pragma unroll
                    for (int q = 0; q < 8; ++q) sv[q] = *(const LAS f32x4*)(xw + 4 * q);
                    __builtin_amdgcn_sched_barrier(0);
#pragma unroll
                    for (int q = 0; q < 8; ++q) { const f32x4 sq = sv[q];
                        z0 += sq.x * ww0[4 * q] + sq.y * ww0[4 * q + 1] + sq.z * ww0[4 * q + 2] + sq.w * ww0[4 * q + 3];
                        z1 += sq.x * ww1[4 * q] + sq.y * ww1[4 * q + 1] + sq.z * ww1[4 * q + 2] + sq.w * ww1[4 * q + 3]; }
                    const float sp0 = fmaxf(-z0, 0.f) + log1pf(__expf(-fabsf(z0))), sp1 = fmaxf(-z1, 0.f) + log1pf(__expf(-fabsf(z1)));
                    dc0[tok] = __expf(-__expf(-sp0 - 0.5f)); dc1[tok] = __expf(-__expf(-sp1 - 0.5f));
                    __builtin_amdgcn_sched_barrier(0);
                }
            }
            {
                asm volatile("" ::: "memory");
                float wa0[32], wa1[32];
                const float* au = F.in[I_AUP] + (size_t)l * 2 * 32 * 512 + c;
#pragma unroll
                for (int k = 0; k < 32; ++k) { wa0[k] = au[0]; wa1[k] = au[32 * 512]; au += 512; asm volatile("" : "+v"(au)); }
                const float a0b0 = F.in[I_A0][(l * 2 + 0) * 512 + c], a0b1 = F.in[I_A0][(l * 2 + 1) * 512 + c];
                const float kkc = F.in[I_KK][l * 512 + c], kac = F.in[I_KA][l * 512 + c], rkc = F.in[I_RK][l * 512 + c];
                const float mur = mu[c], muk = mu[512 + c], muv = mu[1024 + c];
                const LAS bf16_t* pr = TC + tb * TC_PITCH + c;
                float pr_r = bf2f(pr[0]), pr_k = bf2f(pr[512]), pr_v = bf2f(pr[1024]);
                float cu_r = bf2f(pr[TC_PITCH]), cu_k = bf2f(pr[TC_PITCH + 512]), cu_v = bf2f(pr[TC_PITCH + 1024]);
#pragma unroll
                for (int tok = 0; tok < TG; ++tok) {
                    const LAS bf16_t* p = pr + (tok + 2) * TC_PITCH; const int m = m0 + tb + tok;
                    const float nx_r = bf2f(p[0]), nx_k = bf2f(p[512]), nx_v = bf2f(p[1024]);
                    const float r = cu_r + mur * (0.5f * (pr_r + nx_r) - cu_r), k = cu_k + muk * (0.5f * (pr_k + nx_k) - cu_k), v = cu_v + muv * (0.5f * (pr_v + nx_v) - cu_v);
                    pr_r = cu_r; pr_k = cu_k; pr_v = cu_v; cu_r = nx_r; cu_k = nx_k; cu_v = nx_v;
                    const float kkr = k * kkc; const float kk = kkr * rsqrtf(wave_sum_fast(kkr * kkr) + 1e-12f);
                    float za0 = a0b0, za1 = a0b1; const LAS float* xa = sm + (tb + tok) * 160 + 32;
                    f32x4 sv[8];
#pragma unroll
                    for (int q = 0; q < 8; ++q) sv[q] = *(const LAS f32x4*)(xa + 4 * q);
                    __builtin_amdgcn_sched_barrier(0);
#pragma unroll
                    for (int q = 0; q < 8; ++q) { const f32x4 sq = sv[q];
                        za0 += sq.x * wa0[4 * q] + sq.y * wa0[4 * q + 1] + sq.z * wa0[4 * q + 2] + sq.w * wa0[4 * q + 3];
                        za1 += sq.x * wa1[4 * q] + sq.y * wa1[4 * q + 1] + sq.z * wa1[4 * q + 2] + sq.w * wa1[4 * q + 3]; }
                    const float a0 = sigmoidf_(za0), a1 = sigmoidf_(za1);
                    const float kd0 = k * (1.0f + (a0 - 1.0f) * kac), kd1 = k * (1.0f + (a1 - 1.0f) * kac);
                    const float bs = wave_sum_fast(r * (kd0 + kd1) * rkc);
                    f32x4* base = (f32x4*)(SCAN + ((size_t)m * 8 + h) * 768) + i;
                    base[0] = (f32x4){r, v, kk, bs * v}; base[64] = (f32x4){dc0[tok], kd0, kk * a0, gg[tok]}; base[128] = (f32x4){dc1[tok], kd1, kk * a1, 0.f};
                    __builtin_amdgcn_sched_barrier(0);
                }
            }
        }
        __syncthreads();
    }
}

__device__ __forceinline__ float fma_s(float a, float b, float c) { float r; asm("v_fma_f32 %0, %1, %2, %3" : "=v"(r) : "v"(a), "v"(b), "v"(c)); return r; }
__device__ __forceinline__ float mul_s(float a, float b) { float r; asm("v_mul_f32_e32 %0, %1, %2" : "=v"(r) : "v"(a), "v"(b)); return r; }
struct ScanOps { f32x4 r4a, r4b, kk4a, kk4b, w4a, w4b, kd4a, kd4b, ka4a, ka4b; float v0; };
template <int CTRL> __device__ __forceinline__ float dpp_add_q(float x) { const int y = __builtin_amdgcn_update_dpp(0, __float_as_int(x), CTRL, 0xf, 0xf, false); return x + __int_as_float(y); }
__device__ __forceinline__ float oct_sum(float x) {
    x = dpp_add_q<0xB1>(x); x = dpp_add_q<0x4E>(x); x = dpp_add_q<0x141>(x); return x;
}
__device__ __forceinline__ void scan_item(Frame& F, int l, bool smp, int b, int h, int d, int half) {
    int tid = F.tid; asm volatile("" : "+v"(tid));
    const int seqlen = smp ? 1024 : 256, seq_base = smp ? MC + b * 1024 : b * 256, nch = seqlen / 16;
    LAS float* opb = (LAS float*)F.lds;
    LAS float* ypb = opb + 2 * 6144;
    const float* SCAN = (const float*)(F.ws + WS_SCAN); float* YB = (float*)(F.ws + WS_YB) + (size_t)d * MT * 512;
#define SCAN_TOK(ci, s) (d ? seqlen - 1 - ((ci) * 16 + (s)) : (ci) * 16 + (s))
    __syncthreads();
    if (tid < 256) {
        const int p = tid >> 3, c = tid & 7, row = half * 32 + p;
        f32x4 sa_ = {0.f, 0.f, 0.f, 0.f}, sb_ = {0.f, 0.f, 0.f, 0.f};
        if (smp) { const float* S0 = F.in[I_ST] + ((((size_t)b * 2 + l) * 2 + d) * 8 + h) * 4096 + row * 64 + 8 * c; sa_ = *(const f32x4*)S0; sb_ = *(const f32x4*)(S0 + 4); }
        __syncthreads();
        for (int ci = 0; ci < nch; ++ci) {
            const LAS float* ob = opb + (ci & 1) * 6144; LAS float* yp = ypb + (ci & 1) * 4096 + p * 8 + c;
#define SC_LD(R, s_) do { const LAS float* o_ = ob + (s_) * 384 + 8 * c; R.r4a = *(const LAS f32x4*)(o_); R.r4b = *(const LAS f32x4*)(o_ + 4); R.kk4a = *(const LAS f32x4*)(o_ + 128); R.kk4b = *(const LAS f32x4*)(o_ + 132); \
                R.w4a = *(const LAS f32x4*)(o_ + 192); R.w4b = *(const LAS f32x4*)(o_ + 196); R.kd4a = *(const LAS f32x4*)(o_ + 256); R.kd4b = *(const LAS f32x4*)(o_ + 260); \
                R.ka4a = *(const LAS f32x4*)(o_ + 320); R.ka4b = *(const LAS f32x4*)(o_ + 324); R.v0 = ob[(s_) * 384 + 64 + row]; } while (0)
#define SC_STEP(R, s_) do { \
                const f32x4 t_ = sa_ * R.kk4a + sb_ * R.kk4b; float d0 = (t_.x + t_.y) + (t_.z + t_.w); \
                d0 = -oct_sum(d0); \
                sa_ = sa_ * R.w4a + (R.ka4a * d0 + R.kd4a * R.v0); sb_ = sb_ * R.w4b + (R.ka4b * d0 + R.kd4b * R.v0); \
                const f32x4 u_ = sa_ * R.r4a + sb_ * R.r4b; yp[(s_) * 256] = (u_.x + u_.y) + (u_.z + u_.w); } while (0)
            ScanOps A, B;
            SC_LD(A, 0);
#pragma unroll 2
            for (int s = 0; s < 16; s += 2) {
                SC_LD(B, s + 1); __builtin_amdgcn_sched_barrier(0);
                SC_STEP(A, s); __builtin_amdgcn_sched_barrier(0);
                if (s + 2 < 16) SC_LD(A, s + 2); __builtin_amdgcn_sched_barrier(0);
                SC_STEP(B, s + 1); __builtin_amdgcn_sched_barrier(0);
            }
#undef SC_LD
#undef SC_STEP
            __syncthreads();
        }
        if (!smp) { float* O = F.out + OUT_ST + ((((size_t)b * 2 + l) * 2 + d) * 8 + h) * 4096 + row * 64 + 8 * c; *(f32x4*)O = sa_; *(f32x4*)(O + 4) = sb_; }
        __syncthreads();
    } else {
        const int ht = tid - 256;
        const int sg2 = (ht >> 6) & 1, sst0 = ht >> 7;
        const int ssrc = (sg2 ? 1 + d : 0) * 256 + (ht & 63) * 4, sdst = 3 * sg2 * 64 + (ht & 63);
        f32x4 stg[8], stg2[8];
#define SCAN_LOAD(R, ci) do { _Pragma("unroll") for (int j = 0; j < 8; ++j) R[j] = *(const f32x4*)(SCAN + ((size_t)(seq_base + SCAN_TOK(ci, sst0 + 2 * j)) * 8 + h) * 768 + ssrc); } while (0)
#define SCAN_STORE(buf) do { _Pragma("unroll") for (int j = 0; j < 8; ++j) { LAS float* dst_ = opb + (buf) * 6144 + (sst0 + 2 * j) * 384 + sdst; dst_[0] = stg[j].x; dst_[64] = stg[j].y; dst_[128] = stg[j].z; } } while (0)
#define SCAN_YRED(ci) do { _Pragma("unroll") for (int j = 0; j < 2; ++j) { const int o_ = ht + 256 * j, s_ = o_ >> 5, rr_ = o_ & 31; const LAS f32x4* q_ = (const LAS f32x4*)(ypb + ((ci) & 1) * 4096 + o_ * 8); \
            const f32x4 t_ = q_[0] + q_[1]; YB[(size_t)(seq_base + SCAN_TOK(ci, s_)) * 512 + h * 64 + half * 32 + rr_] = (t_.x + t_.y) + (t_.z + t_.w); } } while (0)
        SCAN_LOAD(stg, 0); SCAN_STORE(0);
        if (1 < nch) SCAN_LOAD(stg, 1);
        if (2 < nch) SCAN_LOAD(stg2, 2);
        __syncthreads();
        for (int ci = 0; ci < nch; ++ci) {
            if (ci + 1 < nch) { SCAN_STORE((ci + 1) & 1);
#pragma unroll
                for (int j = 0; j < 8; ++j) stg[j] = stg2[j];
                if (ci + 3 < nch) SCAN_LOAD(stg2, ci + 3); }
            if (ci > 0) SCAN_YRED(ci - 1);
            __syncthreads();
        }
        SCAN_YRED(nch - 1);
        __syncthreads();
#undef SCAN_LOAD
#undef SCAN_STORE
#undef SCAN_YRED
    }
#undef SCAN_TOK
}

__device__ __forceinline__ void scan_item_dual(Frame& F, int l, bool smp, int b, int h, int d) {
    int tid = F.tid; asm volatile("" : "+v"(tid));
    const int seqlen = smp ? 1024 : 256, seq_base = smp ? MC + b * 1024 : b * 256, nch = seqlen / 16;
    LAS float* opb = (LAS float*)F.lds;
    LAS float* ypb = opb + 2 * 6144;
    const float* SCAN = (const float*)(F.ws + WS_SCAN); float* YB = (float*)(F.ws + WS_YB) + (size_t)d * MT * 512;
#define SCAN_TOK(ci, s) (d ? seqlen - 1 - ((ci) * 16 + (s)) : (ci) * 16 + (s))
    const int row = tid >> 3, c = tid & 7;
    f32x4 sa_ = {0.f, 0.f, 0.f, 0.f}, sb_ = {0.f, 0.f, 0.f, 0.f};
    if (smp) { const float* S0 = F.in[I_ST] + ((((size_t)b * 2 + l) * 2 + d) * 8 + h) * 4096 + row * 64 + 8 * c; sa_ = *(const f32x4*)S0; sb_ = *(const f32x4*)(S0 + 4); }
    const int sg2 = (tid >> 6) & 1, sst0 = tid >> 7;
    const int ssrc = (sg2 ? 1 + d : 0) * 256 + (tid & 63) * 4, sdst = 3 * sg2 * 64 + (tid & 63);
    f32x4 stg[4], stg2[4];
#define SCAN_LOAD(R, ci) do { _Pragma("unroll") for (int j = 0; j < 4; ++j) R[j] = *(const f32x4*)(SCAN + ((size_t)(seq_base + SCAN_TOK(ci, sst0 + 4 * j)) * 8 + h) * 768 + ssrc); } while (0)
#define SCAN_STORE(buf) do { _Pragma("unroll") for (int j = 0; j < 4; ++j) { LAS float* dst_ = opb + (buf) * 6144 + (sst0 + 4 * j) * 384 + sdst; dst_[0] = stg[j].x; dst_[64] = stg[j].y; dst_[128] = stg[j].z; } } while (0)
    __syncthreads();
    SCAN_LOAD(stg, 0); SCAN_STORE(0);
    if (1 < nch) SCAN_LOAD(stg, 1);
    if (2 < nch) SCAN_LOAD(stg2, 2);
    __syncthreads();
    for (int ci = 0; ci < nch; ++ci) {
        const LAS float* ob = opb + (ci & 1) * 6144; LAS float* yp = ypb + row * 8 + c;
#define SC_LD(R, s_) do { const LAS float* o_ = ob + (s_) * 384 + 8 * c; R.r4a = *(const LAS f32x4*)(o_); R.r4b = *(const LAS f32x4*)(o_ + 4); R.kk4a = *(const LAS f32x4*)(o_ + 128); R.kk4b = *(const LAS f32x4*)(o_ + 132); \
            R.w4a = *(const LAS f32x4*)(o_ + 192); R.w4b = *(const LAS f32x4*)(o_ + 196); R.kd4a = *(const LAS f32x4*)(o_ + 256); R.kd4b = *(const LAS f32x4*)(o_ + 260); \
            R.ka4a = *(const LAS f32x4*)(o_ + 320); R.ka4b = *(const LAS f32x4*)(o_ + 324); R.v0 = ob[(s_) * 384 + 64 + row]; } while (0)
#define SC_STEP(R, s_) do { \
            const f32x4 t_ = sa_ * R.kk4a + sb_ * R.kk4b; float d0 = (t_.x + t_.y) + (t_.z + t_.w); \
            d0 = -oct_sum(d0); \
            sa_ = sa_ * R.w4a + (R.ka4a * d0 + R.kd4a * R.v0); sb_ = sb_ * R.w4b + (R.ka4b * d0 + R.kd4b * R.v0); \
            const f32x4 u_ = sa_ * R.r4a + sb_ * R.r4b; yp[(s_) * 512] = (u_.x + u_.y) + (u_.z + u_.w); } while (0)
        ScanOps A, B;
        SC_LD(A, 0);
#pragma unroll 2
        for (int s = 0; s < 16; s += 2) {
            SC_LD(B, s + 1); __builtin_amdgcn_sched_barrier(0);
            SC_STEP(A, s); __builtin_amdgcn_sched_barrier(0);
            if (s + 2 < 16) SC_LD(A, s + 2); __builtin_amdgcn_sched_barrier(0);
            SC_STEP(B, s + 1); __builtin_amdgcn_sched_barrier(0);
        }
#undef SC_LD
#undef SC_STEP
        __syncthreads();
#pragma unroll
        for (int j = 0; j < 2; ++j) { const int o_ = tid + 512 * j, s_ = o_ >> 6, rr_ = o_ & 63; const LAS f32x4* q_ = (const LAS f32x4*)(ypb + o_ * 8);
            const f32x4 t_ = q_[0] + q_[1]; YB[(size_t)(seq_base + SCAN_TOK(ci, s_)) * 512 + h * 64 + rr_] = (t_.x + t_.y) + (t_.z + t_.w); }
        if (ci + 1 < nch) { SCAN_STORE((ci + 1) & 1);
#pragma unroll
            for (int j = 0; j < 4; ++j) stg[j] = stg2[j];
            if (ci + 3 < nch) SCAN_LOAD(stg2, ci + 3); }
        __syncthreads();
    }
    if (!smp) { float* O = F.out + OUT_ST + ((((size_t)b * 2 + l) * 2 + d) * 8 + h) * 4096 + row * 64 + 8 * c; *(f32x4*)O = sa_; *(f32x4*)(O + 4) = sb_; }
#undef SCAN_TOK
#undef SCAN_LOAD
#undef SCAN_STORE
}

__device__ __forceinline__ void rwkv_combine_bh(Frame& F, int l, bool smp, int b, int h) {
    const int seqlen = smp ? 1024 : 256, seq_base = smp ? MC + b * 1024 : b * 256;
    const float* Y0 = (const float*)(F.ws + WS_YB) + h * 64 + F.lane; const float* Y1 = Y0 + (size_t)MT * 512;
    const float* SC = (const float*)(F.ws + WS_SCAN) + (size_t)h * 768 + F.lane * 4 + 3; bf16_t* MIX = (bf16_t*)(F.ws + WS_MIX) + 1536 + h * 64 + F.lane;
    const float lg = F.in[I_LNG][l * 512 + h * 64 + F.lane], lb = F.in[I_LNB][l * 512 + h * 64 + F.lane];
#pragma unroll 1
    for (int t0 = F.wave * 16; t0 < seqlen; t0 += 128) {
        float y0[16], y1[16], bo[16], gg[16];
#pragma unroll
        for (int u = 0; u < 16; ++u) { const size_t m = (size_t)(seq_base + t0 + u); y0[u] = Y0[m * 512]; y1[u] = Y1[m * 512]; bo[u] = SC[m * 8 * 768]; gg[u] = SC[m * 8 * 768 + 256]; }
#pragma unroll
        for (int u = 0; u < 16; ++u) { const size_t m = (size_t)(seq_base + t0 + u); const float y = y0[u] + y1[u];
            const float mean = wave_sum_fast(y) * (1.0f / 64.0f), dl = y - mean, var = wave_sum_fast(dl * dl) * (1.0f / 64.0f);
            const float yn = dl * rsqrtf(var + GN_EPS) * lg + lb;
            MIX[m * DM] = f2bf((yn + bo[u]) * gg[u]); }
    }
}

__device__ __forceinline__ void mixer_phase(Frame& F, int l, int rep) {
    unsigned* head = (unsigned*)(F.ws + WS_CTL) + CW_QUEUE + 64 * (2 * l + rep);
    unsigned* cnt = (unsigned*)(F.ws + WS_CTL) + CW_CNT + 64 * 160 * (2 * l + rep);
    volatile LAS unsigned* slot = (volatile LAS unsigned*)(F.lds + MISC_OFF);
    const bf16_t* QB = (const bf16_t*)(F.ws + WS_QB); const bf16_t* KB = (const bf16_t*)(F.ws + WS_KB); const bf16_t* VB = (const bf16_t*)(F.ws + WS_VB); bf16_t* MIX = (bf16_t*)(F.ws + WS_MIX);
    for (;;) {
        __syncthreads();
        if (F.tid == 0) slot[0] = atomicAdd(head, 1u);
        __syncthreads();
        const int item = (int)slot[0];
        if (item >= 640) break;
#if defined(TITEM)
        unsigned long long ti0_ = 0; if (l == 0 && rep == 0 && item == TITEM && F.tid == 0) ti0_ = __builtin_amdgcn_s_memrealtime();
#endif
        const bool is_scan = item < 384;
        if (is_scan) { const bool smp = item < 128; int sb_, sh_; unsigned inc_;
            if (smp) { const int u = item; sb_ = u >> 5; sh_ = (u >> 2) & 7; inc_ = 1u; scan_item(F, l, true, sb_, sh_, (u >> 1) & 1, u & 1); }
            else { const int u = item - 128; sb_ = u >> 4; sh_ = (u >> 1) & 7; inc_ = 2u; scan_item_dual(F, l, false, sb_, sh_, u & 1); }
            asm volatile("s_waitcnt vmcnt(0)" ::: "memory"); __syncthreads();
            if (F.tid == 0) { __builtin_amdgcn_fence(__ATOMIC_RELEASE, "agent"); asm volatile("s_waitcnt vmcnt(0)" ::: "memory");
                slot[1] = __hip_atomic_fetch_add(cnt + 64 * ((smp ? 0 : 32) + sb_ * 8 + sh_), inc_, __ATOMIC_RELAXED, __HIP_MEMORY_SCOPE_AGENT) + inc_; }
            __syncthreads();
            if (slot[1] == 4u) {
                if (F.tid == 0) { __builtin_amdgcn_fence(__ATOMIC_ACQUIRE, "agent"); asm volatile("s_waitcnt vmcnt(0)" ::: "memory"); }
                __syncthreads();
                rwkv_combine_bh(F, l, smp, sb_, sh_);
            }
        }
        else {
            size_t row0, kr0; int hq, seq;
            if (item < 512) { const int u = item - 384, b = u >> 5, qb = u & 3; hq = (u >> 2) & 7; row0 = (size_t)MC + b * 1024 + qb * 256; kr0 = (size_t)MC + b * 1280; seq = 1280; }
            else { const int u = item - 512, b = u >> 3; hq = u & 7; row0 = (size_t)b * 256; kr0 = row0; seq = 256; }
            attn::attn_dense_body<attn::bf16>((const attn::bf16*)(QB + row0 * 1024 + hq * 128), (const attn::bf16*)(KB + kr0 * 256 + (hq >> 2) * 128), (const attn::bf16*)(VB + kr0 * 256 + (hq >> 2) * 128), MIX + row0 * DM + hq * 128, seq, (char*)F.ldsg);
        }
#if defined(TITEM)
        if (l == 0 && rep == 0 && item == TITEM && F.tid == 0) ((volatile LAS unsigned long long*)(F.lds + MISC_OFF + 240))[0] = __builtin_amdgcn_s_memrealtime() - ti0_;
#endif
    }
#if defined(TQUIET)
    if (l == 0 && rep == 0 && blockIdx.x == 0) { __syncthreads(); unsigned long long tq0_ = __builtin_amdgcn_s_memrealtime(); scan_item(F, l, true, 0, 0, 0, 0);
        if (F.tid == 0) ((volatile LAS unsigned long long*)(F.lds + MISC_OFF + 240))[0] = __builtin_amdgcn_s_memrealtime() - tq0_; }
#endif
}
constexpr int NPHASE = 2 + 8 * DEPTH;
#ifndef PH_MASK
#define PH_MASK 0xffff
#endif
#ifndef USE_CG_SYNC
#define USE_CG_SYNC 0
#endif
#ifndef REP_MASK
#define REP_MASK 0
#endif
#if ONE_LAUNCH && USE_CG_SYNC
#define GRID_BAR() cg::this_grid().sync()
#elif ONE_LAUNCH
#define GRID_BAR() xcd_barrier(F.bar)
#else
#define GRID_BAR() do {} while (0)
#endif
#define NREP(bit) ((REP_MASK & (bit)) ? 2 : 1)
#define IN(k) (lo <= (k) && (k) < hi)
#ifndef TPROBE_MASK
#define TPROBE_MASK 0
#endif
#if TPROBE_MASK
#define STAMP(k) do { if (blockIdx.x == 0 && F.tid == 0) ((volatile LAS unsigned long long*)(F.lds + MISC_OFF + 64))[k] = __builtin_amdgcn_s_memrealtime(); } while (0)
#else
#define STAMP(k) do {} while (0)
#endif
#define SEAM(k) do { if (IN(k) && IN((k) + 1)) GRID_BAR(); STAMP((k) + 1); } while (0)
template <int L> __device__ __forceinline__ void layer_phases(Frame& F, const int lo, const int hi) {
    constexpr int l = L, pb = 2 + 8 * L;
    if (IN(pb + 0) && (PH_MASK & 4)) {
        pg8::Gemm g{(const bf16_t*)(F.ws + WS_HB), (const bf16_t*)(F.ws + WS_WIN + l * SZ_WIN), MT, DINP, DM}; pg8::StaticOrder S; S.init(MT, DINP, F.G, (int)blockIdx.x);
        pg8::EpiBf16 E{(bf16_t*)(F.ws + WS_PROJ), DINP};
        for (int rep = 0; rep < NREP(4); ++rep) pg8::gemm_phase<pg8::EpiBf16, pg8::StaticOrder, true, true>(F.lds, g, S, E);
    } SEAM(pb + 0);
    if (IN(pb + 1) && (PH_MASK & 8)) { for (int rep = 0; rep < NREP(8); ++rep) p2_prepass(F, l); } SEAM(pb + 1);
    if (IN(pb + 2) && (PH_MASK & 16)) { for (int rep = 0; rep < NREP(16); ++rep) mixer_phase(F, l, rep); } SEAM(pb + 2);
    if (IN(pb + 3) && (PH_MASK & 64)) {
        pg8::Gemm g{(const bf16_t*)(F.ws + WS_MIX), (const bf16_t*)(F.ws + WS_WOUT + l * SZ_WOUT), MT, DM, DM}; pg8::StaticOrder S; S.init(MT, DM, F.G, (int)blockIdx.x);
        pg8::EpiBf16 E{(bf16_t*)(F.ws + WS_OB), DM};
        for (int rep = 0; rep < NREP(64); ++rep) pg8::gemm_phase<pg8::EpiBf16, pg8::StaticOrder, true, true>(F.lds, g, S, E);
    } SEAM(pb + 3);
    if (IN(pb + 4) && (PH_MASK & 128)) { rowpassA(F, l); } SEAM(pb + 4);
    if (IN(pb + 5) && (PH_MASK & 256)) {
        pg8::Gemm g{(const bf16_t*)(F.ws + WS_HB), (const bf16_t*)(F.ws + WS_WGU + l * SZ_WGU), MT, 2 * DFF, DM}; pg8::StaticOrder S; S.init(MT, 2 * DFF, F.G, (int)blockIdx.x);
        pg8::EpiSwiGLU E{(bf16_t*)(F.ws + WS_HID), DFF};
        for (int rep = 0; rep < NREP(256); ++rep) pg8::gemm_phase<pg8::EpiSwiGLU, pg8::StaticOrder, true, true>(F.lds, g, S, E);
    } SEAM(pb + 5);
    if (IN(pb + 6) && (PH_MASK & 512)) {
        pg8::Gemm g{(const bf16_t*)(F.ws + WS_HID), (const bf16_t*)(F.ws + WS_WDN + l * SZ_WDN), MT, DM, DFF}; pg8::StaticOrder S; S.init(MT, DM, F.G, (int)blockIdx.x);
        pg8::EpiBf16 E{(bf16_t*)(F.ws + WS_OB), DM};
        for (int rep = 0; rep < NREP(512); ++rep) pg8::gemm_phase<pg8::EpiBf16, pg8::StaticOrder, true, true>(F.lds, g, S, E);
    } SEAM(pb + 6);
    if (IN(pb + 7) && (PH_MASK & 1024)) { rowpassB(F, l); } SEAM(pb + 7);
}
__global__ void __launch_bounds__(NTHREADS, 2) hybrid_fwd(Args args) {
    extern __shared__ __attribute__((aligned(16))) unsigned char lds[];
    Frame F;
    F.lds = (LAS unsigned char*)lds; F.ldsg = lds; F.in = args.in; F.out = args.out; F.ws = args.ws;
    F.tid = threadIdx.x; F.lane = F.tid & 63; F.wave = __builtin_amdgcn_readfirstlane(F.tid >> 6); F.G = gridDim.x;
    const int lo = args.ph_lo, hi = args.ph_hi;
    if (F.tid < 64) ((LAS unsigned*)(F.lds + MISC_OFF))[F.tid] = 0u;
    __syncthreads();
#if ONE_LAUNCH && !USE_CG_SYNC
    F.bar = xcd_barrier_post((unsigned*)(F.ws + WS_CTL) + CW_BAR, (volatile LAS unsigned*)(F.lds + MISC_OFF) + 8);
#endif
    STAMP(0);
    if (IN(0) && (PH_MASK & 1)) { for (int rep = 0; rep < NREP(1); ++rep) p0_prologue(F); } SEAM(0);
    if (IN(1) && (PH_MASK & 2)) { for (int rep = 0; rep < NREP(2); ++rep) rowpass0(F); } SEAM(1);
    layer_phases<0>(F, lo, hi);
    layer_phases<1>(F, lo, hi);
#if defined(TITEM) || defined(TQUIET)
    if (F.tid == 0) { const unsigned long long tot = ((volatile LAS unsigned long long*)(F.lds + MISC_OFF + 240))[0];
        if (tot) { const unsigned long long t0 = __builtin_amdgcn_s_memrealtime(); while (__builtin_amdgcn_s_memrealtime() - t0 < tot) __builtin_amdgcn_s_sleep(8); } }
#endif
#if TPROBE_MASK
    if (blockIdx.x == 0 && F.tid == 0) {
        volatile LAS unsigned long long* ts = (volatile LAS unsigned long long*)(F.lds + MISC_OFF + 64); unsigned long long tot = 0;
        for (int k = 0; k < NPHASE; ++k) if ((TPROBE_MASK >> k) & 1) tot += ts[k + 1] - ts[k];
        const unsigned long long t0 = __builtin_amdgcn_s_memrealtime(); while (__builtin_amdgcn_s_memrealtime() - t0 < tot) __builtin_amdgcn_s_sleep(8);
    }
#endif
}
#undef IN
#undef SEAM

extern "C" void kernel_launch(void* const* d_in, const int* in_sizes, int n_in, void* d_out, int out_size, void* d_ws, size_t ws_size, hipStream_t stream) {
    static int grid = 0;
    if (grid == 0) {
        if (n_in != N_IN || (size_t)out_size != OUT_TOTAL || ws_size < WS_END) { fprintf(stderr, "kernel_launch: unexpected shapes: n_in %d out %d ws %zu (need %zu)\n", n_in, out_size, ws_size, (size_t)WS_END); grid = -1; return; }
        int dev = 0, cus = 0, per_cu = 0;
        if (hipGetDevice(&dev) != hipSuccess || hipDeviceGetAttribute(&cus, hipDeviceAttributeMultiprocessorCount, dev) != hipSuccess) { grid = -1; return; }
        if (hipFuncSetAttribute((const void*)hybrid_fwd, hipFuncAttributeMaxDynamicSharedMemorySize, LDS_BYTES) != hipSuccess) { fprintf(stderr, "kernel_launch: hipFuncSetAttribute failed\n"); grid = -1; return; }
        if (hipOccupancyMaxActiveBlocksPerMultiprocessor(&per_cu, (const void*)hybrid_fwd, NTHREADS, LDS_BYTES) != hipSuccess || per_cu < 1) { fprintf(stderr, "kernel_launch: occupancy query says %d blocks per CU\n", per_cu); (void)hipGetLastError(); grid = -1; return; }
        grid = cus;
    }
    if (grid < 0) return;
    (void)hipMemsetAsync((char*)d_ws + WS_CTL, 0, CTL_BYTES, stream);
    Args a{};
    for (int i = 0; i < N_IN; ++i) a.in[i] = (const float*)d_in[i];
    a.out = (float*)d_out; a.ws = (unsigned char*)d_ws;
#if ONE_LAUNCH
    a.ph_lo = 0; a.ph_hi = NPHASE;
    void* kargs[] = {&a};
    const hipError_t e = hipLaunchCooperativeKernel((const void*)hybrid_fwd, dim3(grid), dim3(NTHREADS), kargs, LDS_BYTES, stream);
    if (e != hipSuccess) fprintf(stderr, "kernel_launch: cooperative launch failed: %s (grid %d)\n", hipGetErrorString(e), grid);
#else
    for (int ph = 0; ph < NPHASE; ++ph) {
        a.ph_lo = ph; a.ph_hi = ph + 1;
        hipLaunchKernelGGL(hybrid_fwd, dim3(grid), dim3(NTHREADS), LDS_BYTES, stream, a);
    }
    const hipError_t le = hipPeekAtLastError();
    if (le != hipSuccess) fprintf(stderr, "kernel_launch: launch failed: %s\n", hipGetErrorName(le));
#endif
}
```

```cpp
#include <hip/hip_runtime.h>
#include <hip/hip_bf16.h>
#include <hip/hip_cooperative_groups.h>
#include <cstdio>
#include <cstdint>
#include <cmath>
namespace cg = cooperative_groups;
#ifndef ONE_LAUNCH
#define ONE_LAUNCH 1
#endif
namespace pg8 {
#define PG8_LAS __attribute__((address_space(3)))
typedef unsigned short bf16_t;
typedef short bf16x8 __attribute__((ext_vector_type(8)));
typedef float f32x4 __attribute__((ext_vector_type(4)));
typedef unsigned u32x4 __attribute__((ext_vector_type(4)));
constexpr int BM = 256, BK = 64, HALF = 128, HTB = HALF * BK * 2  , STAGE_BYTES = 8 * HTB, NXCD = 8, WGM = 8;

__host__ __device__ __forceinline__ int lds_byte(int r, int c) { const int st = (r >> 4) * 2 + (c >> 5), rr = r & 15, cc = c & 31, ob = rr * 64 + cc * 2; return st * 1024 + (ob ^ (((ob >> 9) & 1) << 5)); }
__host__ __device__ __forceinline__ void stage_rc(int b, int& R, int& C) { const int st = b / 1024, sb = b % 1024, swz = sb ^ (((sb >> 9) & 1) << 5); R = (st >> 1) * 16 + swz / 64; C = (st & 1) * 32 + (swz % 64) / 2; }
__host__ __device__ __forceinline__ int perm32(int rho) { const int n = rho >> 4, i = rho & 15; return 8 * (i >> 2) + 4 * n + (i & 3); }

struct Unit { int pm, pn; };
struct Gemm { const bf16_t* A; const bf16_t* Bt; int M, N, K; };

struct StaticOrder {
    int nM, nN, nwg, G, c;
    __host__ __device__ void init(int M, int N, int G_, int c_) { nM = M / BM; nN = N / BM; nwg = nM * nN; G = G_; c = c_; }
    __host__ __device__ bool next(int i, Unit& u) const {
        const long L = (long)i * G + c; if (L >= nwg) return false;
        int wgid = (int)L; { const int q = nwg / NXCD, r = nwg % NXCD, xcd = wgid % NXCD, off = wgid / NXCD; wgid = (xcd < r ? xcd * (q + 1) : r * (q + 1) + (xcd - r) * q) + off; }
        const int nig = WGM * nN, gid = wgid / nig, fm = gid * WGM, gsz = (nM - fm) < WGM ? (nM - fm) : WGM;
        u.pm = fm + ((wgid % nig) % gsz); u.pn = (wgid % nig) / gsz; return true;
    }
    __device__ __forceinline__ void a_ready(const Unit&) const {}
    __device__ __forceinline__ void done(const Unit&) const {}
};

__device__ __forceinline__ unsigned cvt_pk_bf16(float lo, float hi) { unsigned r; asm volatile("v_cvt_pk_bf16_f32 %0, %1, %2" : "=v"(r) : "v"(lo), "v"(hi)); return r; }
struct EpiBf16 {
    static constexpr bool PERM = true, AFTER_DRAIN = false;
    bf16_t* O; int ldc;
    __device__ __forceinline__ void operator()(const f32x4 (&acc)[2][2][4][2], const Unit& u, int wr, int wc, int fr, int fq) const {
        const int row0 = u.pm * BM + wr * 64 + fr; const int col0 = u.pn * BM + wc * 32 + 8 * fq;
#pragma unroll
        for (int ai = 0; ai < 2; ++ai)
#pragma unroll
            for (int m = 0; m < 4; ++m) { bf16_t* rowp = O + (size_t)(row0 + ai * HALF + m * 16) * ldc + col0;
#pragma unroll
                for (int bj = 0; bj < 2; ++bj) { const f32x4 v0 = acc[ai][bj][m][0], v1 = acc[ai][bj][m][1];
                    u32x4 w; w.x = cvt_pk_bf16(v0[0], v0[1]); w.y = cvt_pk_bf16(v0[2], v0[3]); w.z = cvt_pk_bf16(v1[0], v1[1]); w.w = cvt_pk_bf16(v1[2], v1[3]);
                    *(u32x4*)(rowp + bj * HALF) = w; } }
    }
};
struct EpiF32 {
    static constexpr bool PERM = false, AFTER_DRAIN = false;
    float* O; int ldc;
    __device__ __forceinline__ void operator()(const f32x4 (&acc)[2][2][4][2], const Unit& u, int wr, int wc, int fr, int fq) const {
        const int row0 = u.pm * BM + wr * 64 + fr; const int col0 = u.pn * BM + wc * 32 + 4 * fq;
#pragma unroll
        for (int ai = 0; ai < 2; ++ai)
#pragma unroll
            for (int m = 0; m < 4; ++m) { float* rowp = O + (size_t)(row0 + ai * HALF + m * 16) * ldc + col0;
#pragma unroll
                for (int bj = 0; bj < 2; ++bj)
#pragma unroll
                    for (int n = 0; n < 2; ++n) *(f32x4*)(rowp + bj * HALF + n * 16) = acc[ai][bj][m][n]; }
    }
};
__device__ __forceinline__ float silu_mul(float g, float u) { return g * __builtin_amdgcn_rcpf(1.0f + __expf(-g)) * u; }
struct EpiSwiGLU {
    static constexpr bool PERM = true, AFTER_DRAIN = false;
    bf16_t* O; int ldc;
    __device__ __forceinline__ void operator()(const f32x4 (&acc)[2][2][4][2], const Unit& u, int wr, int wc, int fr, int fq) const {
        const int row0 = u.pm * BM + wr * 64 + fr; const int col0 = u.pn * HALF + wc * 32 + 8 * fq;
#pragma unroll
        for (int ai = 0; ai < 2; ++ai)
#pragma unroll
            for (int m = 0; m < 4; ++m) { bf16_t* rowp = O + (size_t)(row0 + ai * HALF + m * 16) * ldc + col0;
                const f32x4 g0 = acc[ai][0][m][0], g1 = acc[ai][0][m][1], u0 = acc[ai][1][m][0], u1 = acc[ai][1][m][1];
                u32x4 w; w.x = cvt_pk_bf16(silu_mul(g0[0], u0[0]), silu_mul(g0[1], u0[1])); w.y = cvt_pk_bf16(silu_mul(g0[2], u0[2]), silu_mul(g0[3], u0[3]));
                w.z = cvt_pk_bf16(silu_mul(g1[0], u1[0]), silu_mul(g1[1], u1[1])); w.w = cvt_pk_bf16(silu_mul(g1[2], u1[2]), silu_mul(g1[3], u1[3]));
                *(u32x4*)rowp = w; }
    }
};
template <class Epi, class Sched, bool ALIGN_EPI = false, bool SP2 = false>
__device__ __forceinline__ void gemm_phase(PG8_LAS unsigned char* lds, const Gemm g, const Sched& S, const Epi& E) {
    const int tid = threadIdx.x, wid = __builtin_amdgcn_readfirstlane(tid >> 6), lane = tid & 63, wr = wid >> 2, wc = wid & 3, fr = lane & 15, fq = lane >> 4;
    const int K = g.K, nt = K / BK;
    unsigned voffA[2], voffB[2];
#pragma unroll
    for (int i = 0; i < 2; ++i) { int R, C; stage_rc(tid * 16 + i * 8192, R, C); const int Rb = Epi::PERM ? ((R & ~31) + perm32(R & 31)) : R;
        voffA[i] = (unsigned)(R * K + C) * 2u; voffB[i] = (unsigned)(Rb * K + C) * 2u; }
    const size_t kstep = (size_t)(BK * 2);
    const size_t hstep = (size_t)HALF * K * 2;
    const size_t tstep = 2 * hstep;
    const unsigned ldsw = (unsigned)wid * 1024u;
    const int aoff = lds_byte(wr * 64 + fr, fq * 8), boff = lds_byte(wc * 32 + fr, fq * 8);
#define PG8_SA(b, h) (((b) * 2 + (h)) * HTB)
#define PG8_SB(b, h) ((4 + (b) * 2 + (h)) * HTB)
#define PG8_STAGE(bufoff, gbase, voff) do { _Pragma("unroll") for (int _i = 0; _i < 2; ++_i) \
        __builtin_amdgcn_global_load_lds((const unsigned*)((const char*)(gbase) + (voff)[_i]), (PG8_LAS unsigned*)(lds + (bufoff) + ldsw + _i * 8192), 16, 0, 0); } while (0)
#define PG8_LDA(dst, b, h) do { _Pragma("unroll") for (int m = 0; m < 4; ++m) _Pragma("unroll") for (int k = 0; k < 2; ++k) dst[m][k] = *(const PG8_LAS bf16x8*)(lds + PG8_SA(b, h) + aoff + m * 2048 + k * 1024); } while (0)
#define PG8_LDB(dst, b, h) do { _Pragma("unroll") for (int n = 0; n < 2; ++n) _Pragma("unroll") for (int k = 0; k < 2; ++k) dst[n][k] = *(const PG8_LAS bf16x8*)(lds + PG8_SB(b, h) + boff + n * 2048 + k * 1024); } while (0)
#define PG8_MMA(ai, bj, At, Bt) do { __builtin_amdgcn_s_setprio(1); _Pragma("unroll") for (int m = 0; m < 4; ++m) _Pragma("unroll") for (int n = 0; n < 2; ++n) _Pragma("unroll") for (int k = 0; k < 2; ++k) \
        acc[ai][bj][m][n] = __builtin_amdgcn_mfma_f32_16x16x32_bf16(Bt[n][k], At[m][k], acc[ai][bj][m][n], 0, 0, 0); __builtin_amdgcn_s_setprio(0); } while (0)
#define PG8_WAIT_V(n) asm volatile("s_waitcnt vmcnt(" #n ")" ::: "memory")
#define PG8_WAIT_L(n) asm volatile("s_waitcnt lgkmcnt(" #n ")" ::: "memory")
#define PG8_BAR __builtin_amdgcn_s_barrier()
#define PG8_SCHED __builtin_amdgcn_sched_barrier(0)
    Unit cur, nxt; int ui = 0;
    if (!S.next(0, cur)) return;
    f32x4 acc[2][2][4][2];
#pragma unroll
    for (int a = 0; a < 2; ++a)
#pragma unroll
        for (int b = 0; b < 2; ++b)
#pragma unroll
            for (int m = 0; m < 4; ++m)
#pragma unroll
                for (int n = 0; n < 2; ++n) acc[a][b][m][n] = (f32x4){0.f, 0.f, 0.f, 0.f};
    bf16x8 At[4][2], B0[2][2], B1[2][2];
    const char* cA = (const char*)g.A + (size_t)cur.pm * tstep; const char* cB = (const char*)g.Bt + (size_t)cur.pn * tstep;
    S.a_ready(cur);
    if constexpr (SP2) {
        PG8_STAGE(PG8_SB(0, 0), cB, voffB); PG8_STAGE(PG8_SB(0, 1), cB + hstep, voffB); PG8_STAGE(PG8_SA(0, 0), cA, voffA); PG8_STAGE(PG8_SA(0, 1), cA + hstep, voffA);
        if (wr == 1) PG8_BAR;
        PG8_WAIT_V(2); PG8_BAR;
        PG8_STAGE(PG8_SB(1, 0), cB + kstep, voffB); PG8_STAGE(PG8_SA(1, 0), cA + kstep, voffA); PG8_STAGE(PG8_SB(1, 1), cB + hstep + kstep, voffB);
        PG8_WAIT_V(6); PG8_BAR;
    } else {
        PG8_STAGE(PG8_SB(0, 0), cB, voffB); PG8_STAGE(PG8_SA(0, 0), cA, voffA); PG8_STAGE(PG8_SB(0, 1), cB + hstep, voffB); PG8_STAGE(PG8_SA(0, 1), cA + hstep, voffA);
        if (wr == 1) PG8_BAR;
        PG8_WAIT_V(4); PG8_BAR;
        PG8_STAGE(PG8_SB(1, 0), cB + kstep, voffB); PG8_STAGE(PG8_SA(1, 0), cA + kstep, voffA); PG8_STAGE(PG8_SB(1, 1), cB + hstep + kstep, voffB);
        PG8_WAIT_V(6); PG8_BAR;
    }
    for (;;) {
        const bool has_next = S.next(ui + 1, nxt);
        const char* nA = has_next ? (const char*)g.A + (size_t)nxt.pm * tstep : cA; const char* nB = has_next ? (const char*)g.Bt + (size_t)nxt.pn * tstep : cB;
        for (int t = 0; t < nt; t += 2) {
            const bool last = (t == nt - 2);
            const char* a1 = cA + (size_t)(t + 1) * kstep;
            const char* a2 = last ? nA : cA + (size_t)(t + 2) * kstep; const char* b2 = last ? nB : cB + (size_t)(t + 2) * kstep;
            const char* a3 = a2 + kstep; const char* b3 = b2 + kstep;
            if (last && has_next) S.a_ready(nxt);
            if constexpr (SP2) {
            PG8_LDB(B0, 0, 0); PG8_LDB(B1, 0, 1); PG8_SCHED; PG8_LDA(At, 0, 0); PG8_STAGE(PG8_SA(1, 1), a1 + hstep, voffA);
            PG8_WAIT_V(8); PG8_WAIT_L(0); PG8_BAR; PG8_MMA(0, 0, At, B0); PG8_MMA(0, 1, At, B1); PG8_BAR; PG8_SCHED;
            PG8_LDA(At, 0, 1); PG8_STAGE(PG8_SB(0, 0), b2, voffB); PG8_STAGE(PG8_SB(0, 1), b2 + hstep, voffB); PG8_STAGE(PG8_SA(0, 0), a2, voffA);
            PG8_WAIT_V(8); PG8_WAIT_L(0); PG8_BAR; PG8_MMA(1, 0, At, B0); PG8_MMA(1, 1, At, B1); PG8_BAR; PG8_SCHED;
            PG8_LDB(B0, 1, 0); PG8_LDB(B1, 1, 1); PG8_SCHED; PG8_LDA(At, 1, 0); PG8_STAGE(PG8_SA(0, 1), a2 + hstep, voffA);
            PG8_WAIT_V(8); PG8_WAIT_L(0); PG8_BAR; PG8_MMA(0, 0, At, B0); PG8_MMA(0, 1, At, B1); PG8_BAR; PG8_SCHED;
            PG8_LDA(At, 1, 1); PG8_STAGE(PG8_SB(1, 0), b3, voffB); PG8_STAGE(PG8_SB(1, 1), b3 + hstep, voffB); PG8_STAGE(PG8_SA(1, 0), a3, voffA);
            PG8_WAIT_V(8); PG8_WAIT_L(0); PG8_BAR; PG8_MMA(1, 0, At, B0); PG8_MMA(1, 1, At, B1); PG8_BAR; PG8_SCHED;
            } else {
            PG8_LDB(B0, 0, 0); PG8_SCHED; PG8_LDA(At, 0, 0); PG8_STAGE(PG8_SA(1, 1), a1 + hstep, voffA);
            PG8_WAIT_L(8); PG8_BAR; PG8_WAIT_L(0); PG8_MMA(0, 0, At, B0); PG8_BAR; PG8_SCHED;
            PG8_LDB(B1, 0, 1); PG8_STAGE(PG8_SB(0, 0), b2, voffB);
            PG8_BAR; PG8_WAIT_L(0); PG8_MMA(0, 1, At, B1); PG8_BAR;
            PG8_LDA(At, 0, 1); PG8_STAGE(PG8_SA(0, 0), a2, voffA);
            PG8_BAR; PG8_WAIT_L(0); PG8_MMA(1, 0, At, B0); PG8_BAR; PG8_SCHED;
            PG8_STAGE(PG8_SB(0, 1), b2 + hstep, voffB);
            PG8_WAIT_V(6); PG8_BAR; PG8_MMA(1, 1, At, B1); PG8_BAR;
            PG8_LDB(B0, 1, 0); PG8_SCHED; PG8_LDA(At, 1, 0); PG8_STAGE(PG8_SA(0, 1), a2 + hstep, voffA);
            PG8_WAIT_L(8); PG8_BAR; PG8_WAIT_L(0); PG8_MMA(0, 0, At, B0); PG8_BAR; PG8_SCHED;
            PG8_LDB(B1, 1, 1); PG8_STAGE(PG8_SB(1, 0), b3, voffB);
            PG8_BAR; PG8_WAIT_L(0); PG8_MMA(0, 1, At, B1); PG8_BAR;
            PG8_LDA(At, 1, 1); PG8_STAGE(PG8_SA(1, 0), a3, voffA);
            PG8_BAR; PG8_WAIT_L(0); PG8_MMA(1, 0, At, B0); PG8_BAR; PG8_SCHED;
            PG8_STAGE(PG8_SB(1, 1), b3 + hstep, voffB);
            PG8_WAIT_V(6); PG8_BAR; PG8_MMA(1, 1, At, B1); PG8_BAR;
            }
        }
        if constexpr (ALIGN_EPI) { if (wr == 0) PG8_BAR; }
        if constexpr (!Epi::AFTER_DRAIN) { E(acc, cur, wr, wc, fr, fq); S.done(cur); }
        if (!has_next) break;
#pragma unroll
        for (int a = 0; a < 2; ++a)
#pragma unroll
            for (int b = 0; b < 2; ++b)
#pragma unroll
                for (int m = 0; m < 4; ++m)
#pragma unroll
                    for (int n = 0; n < 2; ++n) acc[a][b][m][n] = (f32x4){0.f, 0.f, 0.f, 0.f};
        cur = nxt; cA = nA; cB = nB; ++ui;
        if constexpr (ALIGN_EPI) { if (wr == 1) PG8_BAR; }
    }
    PG8_WAIT_V(0);
    if constexpr (!ALIGN_EPI) { if (wr == 0) PG8_BAR; }
    PG8_BAR;
    if constexpr (Epi::AFTER_DRAIN) { E.fused(acc, cur, wr, wc, fr, fq, lds, wid, lane); S.done(cur); }
#undef PG8_SA
#undef PG8_SB
#undef PG8_STAGE
#undef PG8_LDA
#undef PG8_LDB
#undef PG8_MMA
#undef PG8_WAIT_V
#undef PG8_WAIT_L
#undef PG8_BAR
#undef PG8_SCHED
}
}
namespace attn {
using bf16 = __hip_bfloat16;
constexpr int   D = 128, NW = 8, QBLK = 32, KVBLK = 64;
constexpr float SCALE = 0.088388347648318440f;
constexpr float THR = 8.f;
constexpr int SDEPTH = 2;
constexpr int LDQ = 1024, LDK = 256, LDO = 2048;
constexpr size_t SHM_V = KVBLK * D * 2, SHM_K = KVBLK * D * 2, SHM_ATTN = 2 * SHM_V + 2 * SHM_K + NW * 64 * 4;
__device__ __forceinline__ unsigned short f2bf_rne(float f) { unsigned u = __builtin_bit_cast(unsigned, f); return (unsigned short)((u + 0x7fffu + ((u >> 16) & 1u)) >> 16); }
using bf16x8 = __attribute__((ext_vector_type(8))) short;
using s16x4  = __attribute__((ext_vector_type(4))) short;
using f32x16 = __attribute__((ext_vector_type(16))) float;
using f32x8  = __attribute__((ext_vector_type(8))) float;
using u32x4  = __attribute__((ext_vector_type(4))) unsigned;
#define KSWZ(row, colB) ((row) * 256 + ((colB) ^ (((row) & 7) << 4)))
#define SBAR() __builtin_amdgcn_sched_barrier(0)
__device__ __forceinline__ int crow(int r, int hi) { return (r & 3) + 8 * (r >> 2) + 4 * hi; }
__device__ __forceinline__ unsigned cvtpk(float lo, float hi) {
  unsigned r; asm volatile("v_cvt_pk_bf16_f32 %0, %1, %2" : "=v"(r) : "v"(lo), "v"(hi)); return r;
}
template <typename TIn> struct Stage;
template <> struct Stage<bf16>  { using T = bf16x8;
  __device__ static __forceinline__ T ld8(const bf16* p) { return *reinterpret_cast<const bf16x8*>(p); }
  __device__ static __forceinline__ bf16x8 tobf(T x) { return x; } };
template <> struct Stage<float> { using T = f32x8;
  __device__ static __forceinline__ T ld8(const float* p) { return *reinterpret_cast<const f32x8*>(p); }
  __device__ static __forceinline__ bf16x8 tobf(T x) {
    u32x4 w = {cvtpk(x[0], x[1]), cvtpk(x[2], x[3]), cvtpk(x[4], x[5]), cvtpk(x[6], x[7])}; return *reinterpret_cast<bf16x8*>(&w); } };

__device__ __forceinline__ void partialSM(f32x16& p0, f32x16& p1, float& m_reg, float& mn, float& alpha) {
  constexpr float C = SCALE * 1.4426950408889634f;
  float pmax = p0[0]; for (int r = 1; r < 16; ++r) pmax = fmaxf(pmax, p0[r]); for (int r = 0; r < 16; ++r) pmax = fmaxf(pmax, p1[r]);
  { auto rr = __builtin_amdgcn_permlane32_swap(__float_as_uint(pmax), __float_as_uint(pmax), false, false);
    pmax = fmaxf(__uint_as_float(rr[0]), __uint_as_float(rr[1])); }
  if (__builtin_expect(__all(pmax - m_reg <= THR / SCALE), 1)) { mn = m_reg; alpha = 1.f; }
  else { mn = fmaxf(m_reg, pmax); alpha = __builtin_amdgcn_exp2f((m_reg - mn) * C); m_reg = mn; }
  float mnC = -mn * C;
  for (int r = 0; r < 16; ++r) p0[r] = fmaf(p0[r], C, mnC); for (int r = 0; r < 16; ++r) p1[r] = fmaf(p1[r], C, mnC);
  for (int r = 0; r < 16; ++r) p0[r] = __builtin_amdgcn_exp2f(p0[r]);
}
__device__ __forceinline__ void finishSM(f32x16& p0, f32x16& p1, float alpha, float& l_reg, bf16x8& pa0, bf16x8& pa1, bf16x8& pa2, bf16x8& pa3) {
  for (int r = 0; r < 16; ++r) p1[r] = __builtin_amdgcn_exp2f(p1[r]);
  float ps = 0; for (int r = 0; r < 16; ++r) ps += p0[r]; for (int r = 0; r < 16; ++r) ps += p1[r];
  { auto rr = __builtin_amdgcn_permlane32_swap(__float_as_uint(ps), __float_as_uint(ps), false, false);
    ps = __uint_as_float(rr[0]) + __uint_as_float(rr[1]); }
  l_reg = l_reg * alpha + ps;
#define PK4(P, BASE, OUT) do { unsigned a0 = cvtpk(P[BASE + 0], P[BASE + 1]), a1 = cvtpk(P[BASE + 2], P[BASE + 3]);   \
    unsigned b0 = cvtpk(P[BASE + 4], P[BASE + 5]), b1 = cvtpk(P[BASE + 6], P[BASE + 7]);                              \
    auto r0 = __builtin_amdgcn_permlane32_swap(a0, b0, false, false); auto r1 = __builtin_amdgcn_permlane32_swap(a1, b1, false, false); \
    u32x4 w = {r0[0], r1[0], r0[1], r1[1]}; OUT = *reinterpret_cast<bf16x8*>(&w); } while (0)
  PK4(p0, 0, pa0); PK4(p0, 8, pa1); PK4(p1, 0, pa2); PK4(p1, 8, pa3);
#undef PK4
}
__device__ __forceinline__ void qkt(f32x16& p0, f32x16& p1, const bf16* Ks, const bf16x8* qr, int r32, int hi) {
  p0 = f32x16{}; p1 = f32x16{};
  for (int d0 = 0; d0 < 8; ++d0) { int cb = (d0 * 16 + hi * 8) * 2;
    bf16x8 b0 = *reinterpret_cast<const bf16x8*>((const char*)Ks + KSWZ(r32, cb));
    bf16x8 b1 = *reinterpret_cast<const bf16x8*>((const char*)Ks + KSWZ(32 + r32, cb));
    p0 = __builtin_amdgcn_mfma_f32_32x32x16_bf16(b0, qr[d0], p0, 0, 0, 0);
    p1 = __builtin_amdgcn_mfma_f32_32x32x16_bf16(b1, qr[d0], p1, 0, 0, 0); }
}
__device__ __forceinline__ int v_st(int k, int c) { const int kk = (k & ~0xC) | ((k & 4) << 1) | ((k & 8) >> 1); return ((kk >> 3) * 4 + (c >> 5)) * 512 + ((kk & 7) * 32 + (c & 31)) * 2; }
__device__ __forceinline__ int v_rd_base(int lane) { return ((lane & 3) << 3) | (((lane >> 2) & 3) << 6) | (((lane >> 4) & 1) << 5) | (((lane >> 5) & 1) << 8); }
constexpr int v_rd_off(int d0, int ks, int half) { return d0 * 512 + ks * 4096 + half * 2048; }
template <int OFF> __device__ __forceinline__ s16x4 tr_read(int vb) {
  s16x4 r; asm volatile("ds_read_b64_tr_b16 %0, %1 offset:%2" : "=&v"(r) : "v"(vb), "i"(OFF) : "memory"); return r;
}
template <int D0> __device__ __forceinline__ void pv_one(f32x16& od, int vb, bf16x8 pa0, bf16x8 pa1, bf16x8 pa2, bf16x8 pa3) {
  const s16x4 l0 = tr_read<v_rd_off(D0, 0, 0)>(vb), h0 = tr_read<v_rd_off(D0, 0, 1)>(vb), l1 = tr_read<v_rd_off(D0, 1, 0)>(vb), h1 = tr_read<v_rd_off(D0, 1, 1)>(vb);
  const s16x4 l2 = tr_read<v_rd_off(D0, 2, 0)>(vb), h2 = tr_read<v_rd_off(D0, 2, 1)>(vb), l3 = tr_read<v_rd_off(D0, 3, 0)>(vb), h3 = tr_read<v_rd_off(D0, 3, 1)>(vb);
  asm volatile("s_waitcnt lgkmcnt(0)" ::: "memory"); SBAR();
#define PK(L, H) (bf16x8){L[0], L[1], L[2], L[3], H[0], H[1], H[2], H[3]}
  od = __builtin_amdgcn_mfma_f32_32x32x16_bf16(pa0, PK(l0, h0), od, 0, 0, 0);
  od = __builtin_amdgcn_mfma_f32_32x32x16_bf16(pa1, PK(l1, h1), od, 0, 0, 0);
  od = __builtin_amdgcn_mfma_f32_32x32x16_bf16(pa2, PK(l2, h2), od, 0, 0, 0);
  od = __builtin_amdgcn_mfma_f32_32x32x16_bf16(pa3, PK(l3, h3), od, 0, 0, 0);
#undef PK
}
__device__ __forceinline__ void pv_d0(f32x16* o, int vb, bf16x8 pa0, bf16x8 pa1, bf16x8 pa2, bf16x8 pa3) {
  pv_one<0>(o[0], vb, pa0, pa1, pa2, pa3); pv_one<1>(o[1], vb, pa0, pa1, pa2, pa3); pv_one<2>(o[2], vb, pa0, pa1, pa2, pa3); pv_one<3>(o[3], vb, pa0, pa1, pa2, pa3);
}
template <typename TQ>
__device__ __forceinline__ void attn_dense_body(const TQ* __restrict__ Qb, const bf16* __restrict__ Kh, const bf16* __restrict__ Vh,
                                                unsigned short* __restrict__ Ob, int seq, char* lds) {
  using St = Stage<bf16>; using SQ = Stage<TQ>;
  const int tid = threadIdx.x, wid = tid >> 6, lane = tid & 63, r32 = lane & 31, hi = lane >> 5;
  bf16* V_lds = (bf16*)lds; bf16* K_lds = (bf16*)(lds + 2 * SHM_V);
  float* ws = (float*)(lds + 2 * SHM_V + 2 * SHM_K) + wid * 64; float* li_l = ws; float* al_l = ws + 32;
  float m_reg = -1e30f, l_reg = 0; f32x16 o[4] = {}; bf16x8 qr[8];
  const TQ* Qw = Qb + (long)(wid * QBLK + r32) * LDQ + hi * 8;
#pragma unroll
  for (int d0 = 0; d0 < 8; ++d0) qr[d0] = SQ::tobf(SQ::ld8(Qw + d0 * 16));
  const int sr = tid >> 4, sc = (tid & 15) * 8, vst0 = v_st(sr, sc), vst1 = v_st(32 + sr, sc);
  const int vb0 = (int)(uintptr_t)V_lds + v_rd_base(lane);
  struct { typename St::T vs0, vs1, ks0, ks1; } sr_[SDEPTH];
#define SLOAD(i, k0) do { sr_[i].vs0 = St::ld8(&Vh[(long)((k0) + sr) * LDK + sc]); sr_[i].vs1 = St::ld8(&Vh[(long)((k0) + 32 + sr) * LDK + sc]); \
    sr_[i].ks0 = St::ld8(&Kh[(long)((k0) + sr) * LDK + sc]); sr_[i].ks1 = St::ld8(&Kh[(long)((k0) + 32 + sr) * LDK + sc]); } while (0)
#define SWRITE(b, i) do { *(bf16x8*)((char*)V_lds + (b) * SHM_V + vst0) = St::tobf(sr_[i].vs0);          \
    *(bf16x8*)((char*)V_lds + (b) * SHM_V + vst1) = St::tobf(sr_[i].vs1); int kc = sc * 2;               \
    *(bf16x8*)((char*)K_lds + (b) * SHM_K + KSWZ(sr, kc)) = St::tobf(sr_[i].ks0);                       \
    *(bf16x8*)((char*)K_lds + (b) * SHM_K + KSWZ(32 + sr, kc)) = St::tobf(sr_[i].ks1); } while (0)
#define SWAIT() do { if constexpr (SDEPTH == 2) asm volatile("s_waitcnt vmcnt(4)" ::: "memory"); else asm volatile("s_waitcnt vmcnt(0)" ::: "memory"); } while (0)
#define RESC(a) do { if (__any((a) < 1.f)) { if (hi == 0) al_l[r32] = (a); asm volatile("s_waitcnt lgkmcnt(0)" ::: "memory"); \
    for (int d = 0; d < 4; ++d) for (int r = 0; r < 16; ++r) o[d][r] *= al_l[crow(r, hi)]; } } while (0)
  f32x16 pA0, pA1, pB0, pB1; float mnA, mnB, alA, alB; bf16x8 pa0, pa1, pa2, pa3; const int NT = seq / KVBLK;
  constexpr int SE = 0, SO = SDEPTH - 1;
  SLOAD(SE, 0); asm volatile("s_waitcnt vmcnt(0)" ::: "memory"); SWRITE(0, SE); __syncthreads();
  qkt(pA0, pA1, K_lds, qr, r32, hi); partialSM(pA0, pA1, m_reg, mnA, alA);
  SLOAD(SO, KVBLK); if constexpr (SDEPTH == 2) { if (2 < NT) SLOAD(SE, 2 * KVBLK); }
  SWAIT(); SWRITE(1, SO); __syncthreads();
  for (int j = 1; j + 1 < NT; j += 2) {
    SBAR(); qkt(pB0, pB1, (bf16*)((char*)K_lds + SHM_K), qr, r32, hi);
    finishSM(pA0, pA1, alA, l_reg, pa0, pa1, pa2, pa3); SBAR();
    SLOAD(SO, (j + SDEPTH) * KVBLK); SBAR();
    pv_d0(o, vb0, pa0, pa1, pa2, pa3); partialSM(pB0, pB1, m_reg, mnB, alB);
    __syncthreads(); SWAIT(); SWRITE(0, SE);
    RESC(alB); __syncthreads();
    SBAR(); qkt(pA0, pA1, K_lds, qr, r32, hi);
    finishSM(pB0, pB1, alB, l_reg, pa0, pa1, pa2, pa3); SBAR();
    if (SDEPTH == 1 || j + 3 < NT) SLOAD(SE, (j + 1 + SDEPTH) * KVBLK); SBAR();
    pv_d0(o, vb0 + (int)SHM_V, pa0, pa1, pa2, pa3); partialSM(pA0, pA1, m_reg, mnA, alA);
    __syncthreads(); SWAIT(); SWRITE(1, SO);
    RESC(alA); __syncthreads();
  }
  SBAR(); qkt(pB0, pB1, (bf16*)((char*)K_lds + SHM_K), qr, r32, hi);
  finishSM(pA0, pA1, alA, l_reg, pa0, pa1, pa2, pa3); SBAR();
  pv_d0(o, vb0, pa0, pa1, pa2, pa3); partialSM(pB0, pB1, m_reg, mnB, alB);
  __syncthreads(); RESC(alB);
  finishSM(pB0, pB1, alB, l_reg, pa0, pa1, pa2, pa3); SBAR();
  pv_d0(o, vb0 + (int)SHM_V, pa0, pa1, pa2, pa3);
  if (hi == 0) li_l[r32] = l_reg; asm volatile("s_waitcnt lgkmcnt(0)" ::: "memory");
  float rli[16];
#pragma unroll
  for (int r = 0; r < 16; ++r) rli[r] = __builtin_amdgcn_rcpf(li_l[crow(r, hi)]);
  unsigned short* Ow = Ob + (long)(wid * QBLK) * LDO;
#pragma unroll
  for (int r = 0; r < 16; ++r) { int orow = crow(r, hi);
    for (int d0 = 0; d0 < 4; ++d0) Ow[(long)orow * LDO + d0 * 32 + r32] = f2bf_rne(o[d0][r] * rli[r]); }
#undef SLOAD
#undef SWRITE
#undef SWAIT
#undef RESC
}
}
#ifndef PP_MASK
#define PP_MASK 31
#endif
#ifndef PPR_MASK
#define PPR_MASK 0
#endif
#define GAS __attribute__((address_space(1)))
#define LAS __attribute__((address_space(3)))
typedef unsigned short bf16_t;
typedef float f32x4 __attribute__((ext_vector_type(4)));
typedef float f32x2 __attribute__((ext_vector_type(2)));
typedef unsigned u32x4 __attribute__((ext_vector_type(4)));
typedef unsigned u32x2 __attribute__((ext_vector_type(2)));
typedef __bf16 bf16x2_t __attribute__((ext_vector_type(2)));

constexpr int DM = 2048, MC = 4096, MS = 4096, MT = MC + MS, DEPTH = 2;
constexpr int DIN = 4768, DINP = 4864, DFF = 5632;
constexpr int O_K = 1024, O_V = 1280, O_CB = 1536, O_CC = 2048, O_CH = 2560, O_UR = 3072;
constexpr int KVROWS = 4096 + 4 * 1280;
constexpr float EPS = 1e-6f, GN_EPS = 64e-5f;
constexpr int NWAVES = 8, NTHREADS = 512;
enum { I_XP = 0, I_XS, I_CK, I_CV, I_ST, I_C, I_CCTX, I_WADA, I_BADA, I_NG, I_WIN, I_QN, I_KN, I_CONVW, I_MU, I_W0, I_WUP, I_A0, I_AUP, I_GUP, I_KK, I_KA, I_RK, I_LNG, I_LNB, I_WOUT, I_WGATE, I_WUPF, I_WDOWN, N_IN };
constexpr size_t OUT_Y = 0, OUT_NK = (size_t)MT * DM, OUT_NV = OUT_NK + 2097152, OUT_ST = OUT_NV + 2097152, OUT_TOTAL = OUT_ST + 2097152;
constexpr size_t MiB = 1u << 20;
constexpr size_t WS_CTL = 0, CTL_BYTES = 1 * MiB;
constexpr size_t WS_WIN = 1 * MiB, SZ_WIN = 19 * MiB;
constexpr size_t WS_WOUT = WS_WIN + 2 * SZ_WIN, SZ_WOUT = 8 * MiB;
constexpr size_t WS_WGU = WS_WOUT + 2 * SZ_WOUT, SZ_WGU = 44 * MiB;
constexpr size_t WS_WDN = WS_WGU + 2 * SZ_WGU, SZ_WDN = 22 * MiB;
constexpr size_t WS_MOD = WS_WDN + 2 * SZ_WDN;
constexpr size_t WS_W4 = WS_MOD + 1 * MiB;
constexpr size_t WS_HB = WS_W4 + 1 * MiB;
constexpr size_t WS_MIX = WS_HB + 32 * MiB;
constexpr size_t WS_XB = WS_MIX + 32 * MiB;
constexpr size_t WS_R1 = WS_XB + 64 * MiB;
constexpr size_t WS_PROJ = WS_R1;
constexpr size_t WS_QB = WS_R1 + 76 * MiB;
constexpr size_t WS_KB = WS_R1 + 92 * MiB;
constexpr size_t WS_VB = WS_R1 + 97 * MiB;
constexpr size_t WS_SCAN = WS_R1 + 102 * MiB;
constexpr size_t WS_YB = WS_R1 + 294 * MiB;
constexpr size_t WS_OB = WS_R1;
constexpr size_t WS_HID = WS_R1 + 64 * MiB;
constexpr size_t WS_END = WS_R1 + 326 * MiB;
constexpr int CW_BAR = 4096;
constexpr int CW_CNT = 16384;
constexpr int CW_QUEUE = 64;
constexpr int RING_BYTES = 131072, LDS_BYTES = 147456, MISC_OFF = LDS_BYTES - 256;

__device__ __forceinline__ float bf2f(bf16_t h) { return __uint_as_float((unsigned)h << 16); }
__device__ __forceinline__ unsigned pk2(float lo, float hi) { f32x2 v = {lo, hi}; bf16x2_t b = __builtin_convertvector(v, bf16x2_t); return __builtin_bit_cast(unsigned, b); }
__device__ __forceinline__ bf16_t f2bf(float f) { return (bf16_t)(pk2(f, 0.f) & 0xffffu); }
__device__ __forceinline__ float wave_sum(float v) {
#pragma unroll
    for (int o = 1; o < 64; o <<= 1) v += __shfl_xor(v, o);
    return v;
}
template <int CTRL> __device__ __forceinline__ float dpp_add(float x) {
    const int y = __builtin_amdgcn_update_dpp(0, __float_as_int(x), CTRL, 0xf, 0xf, false);
    return x + __int_as_float(y);
}
__device__ __forceinline__ float row16_sum(float x) {
    x = dpp_add<0x128>(x); x = dpp_add<0x124>(x); x = dpp_add<0x122>(x); x = dpp_add<0x121>(x); return x;
}
__device__ __forceinline__ float wave_sum_fast(float x) {
    x = row16_sum(x); const int xi = __float_as_int(x);
    return (__int_as_float(__builtin_amdgcn_readlane(xi, 0)) + __int_as_float(__builtin_amdgcn_readlane(xi, 16))) + (__int_as_float(__builtin_amdgcn_readlane(xi, 32)) + __int_as_float(__builtin_amdgcn_readlane(xi, 48)));
}
__device__ __forceinline__ float sigmoidf_(float x) { return 1.0f / (1.0f + __expf(-x)); }

#define XB_TMO      128
#define XB_XCNT(j)  (256  + 64 * (j))
#define XB_XSUB(j)  (1280 + 64 * (j))
#define XB_XGEN(j)  (2304 + 64 * (j))
#define XB_TOP      3328
#define XB_TOPGEN   3392
#define XCD_BAR_WORDS 3456
#define XB_SPIN_CAP (1u << 18)

__device__ __forceinline__ unsigned xb_ld(unsigned* p)              { return __hip_atomic_load(p, __ATOMIC_RELAXED, __HIP_MEMORY_SCOPE_AGENT); }
__device__ __forceinline__ unsigned xb_add(unsigned* p, unsigned v) { return __hip_atomic_fetch_add(p, v, __ATOMIC_RELAXED, __HIP_MEMORY_SCOPE_AGENT); }
__device__ __forceinline__ unsigned xb_xcc_id() { return (unsigned)__builtin_amdgcn_s_getreg((3 << 11) | 20) & 0xFu; }
#define XB_SPIN(cond, bar) do { unsigned _sp = 0; while (cond) { __builtin_amdgcn_s_sleep(1); \
    if ((++_sp & 255u) == 0u) { if (xb_ld(&(bar)[XB_TMO])) break; if (_sp > XB_SPIN_CAP) { atomicAdd(&(bar)[XB_TMO], 1u); break; } } } } while (0)

struct XcdBarrier {
    unsigned* bar; unsigned x;
    volatile LAS unsigned* st;
};

__device__ __forceinline__ XcdBarrier xcd_barrier_post(unsigned* bar, volatile LAS unsigned* st) {
    XcdBarrier b; b.bar = bar; b.x = xb_xcc_id(); b.st = st;
    if (threadIdx.x == 0) (void)xb_add(&bar[XB_XCNT(b.x)], 1u);
    return b;
}
__device__ __forceinline__ void xcd_barrier_complete(unsigned* bar, unsigned x, unsigned& nloc, unsigned& nx) {
    const unsigned G = gridDim.x * gridDim.y * gridDim.z;
    unsigned sum, cnt, mine, sp = 0u;
    for (;;) {
        sum = 0u; cnt = 0u; mine = 0u;
#pragma unroll
        for (unsigned j = 0; j < 16; ++j) { const unsigned c = xb_ld(&bar[XB_XCNT(j)]); sum += c; cnt += (c > 0u) ? 1u : 0u; mine = (j == x) ? c : mine; }
        if (sum == G) break;
        __builtin_amdgcn_s_sleep(1);
        if ((++sp & 255u) == 0u) { if (xb_ld(&bar[XB_TMO])) break; if (sp > XB_SPIN_CAP) { atomicAdd(&bar[XB_TMO], 1u); break; } }
    }
    nloc = mine > 0u ? mine : 1u; nx = cnt > 0u ? cnt : 1u;
}

__device__ __forceinline__ void xcd_barrier(const XcdBarrier& b) {
    asm volatile("s_waitcnt vmcnt(0)" ::: "memory");
    __syncthreads();
    if (threadIdx.x == 0) {
        unsigned* bar = b.bar;
        __builtin_amdgcn_s_waitcnt(0);
        unsigned nloc = b.st[0], nx = b.st[1];
        if (nloc == 0u) { xcd_barrier_complete(bar, b.x, nloc, nx); b.st[0] = nloc; b.st[1] = nx; }
        const unsigned old = xb_add(&bar[XB_XSUB(b.x)], 1u);
        const unsigned gen = old / nloc;
        if (old + 1u == (gen + 1u) * nloc) {
            __builtin_amdgcn_fence(__ATOMIC_RELEASE, "agent");
            asm volatile("s_waitcnt vmcnt(0)" ::: "memory");
            const unsigned og = xb_add(&bar[XB_TOP], 1u);
            const unsigned tg = og / nx;
            if (og + 1u == (tg + 1u) * nx) xb_add(&bar[XB_TOPGEN], 1u);
            else XB_SPIN(xb_ld(&bar[XB_TOPGEN]) == tg, bar);
            __builtin_amdgcn_fence(__ATOMIC_ACQUIRE, "agent");
            xb_add(&bar[XB_XGEN(b.x)], 1u);
            asm volatile("s_waitcnt vmcnt(0)" ::: "memory");
        } else {
            XB_SPIN(xb_ld(&bar[XB_XGEN(b.x)]) == gen, bar);
            __builtin_amdgcn_fence(__ATOMIC_ACQUIRE, "agent");
            asm volatile("s_waitcnt vmcnt(0)" ::: "memory");
        }
    }
    __syncthreads();
}


struct Args { const float* in[N_IN]; float* out; unsigned char* ws; int ph_lo, ph_hi; };
struct Frame {
    LAS unsigned char* lds; unsigned char* ldsg;
    const float* const* in; float* out; unsigned char* ws;
    int tid, lane, wave, G;
    XcdBarrier bar;
};
#define LDS_WAIT() asm volatile("s_waitcnt lgkmcnt(0)" ::: "memory")
#if defined(TSUB)
#define TS_BEGIN() unsigned long long ts_t0_ = __builtin_amdgcn_s_memrealtime()
#define TS_MARK(r) do { const unsigned long long ts_t1_ = __builtin_amdgcn_s_memrealtime(); if ((r) == TSUB && blockIdx.x == TSBLK && F.tid == 0) ((volatile LAS unsigned long long*)(F.lds + MISC_OFF + 240))[0] += ts_t1_ - ts_t0_; ts_t0_ = __builtin_amdgcn_s_memrealtime(); } while (0)
#else
#define TS_BEGIN() do {} while (0)
#define TS_MARK(r) do {} while (0)
#endif

__device__ __forceinline__ void p0_transpose_item(const float* W, int K, int N, bf16_t* WT, int kb, int nb, int rowbase, LAS float* scr, int lane) {
    const int k0 = 64 * kb, n0 = 32 * nb;
#pragma unroll 8
    for (int i = 0; i < 32; ++i) { const int kk = 2 * i + (lane >> 5); scr[kk * 33 + (lane & 31)] = W[(size_t)(k0 + kk) * N + n0 + (lane & 31)]; }
    LDS_WAIT(); asm volatile("" ::: "memory");
    const int c = lane & 7;
#pragma unroll
    for (int j = 0; j < 4; ++j) { const int n = (lane >> 3) + 8 * j; const LAS float* s = scr + (8 * c) * 33 + n;
        u32x4 o; o.x = pk2(s[0 * 33], s[1 * 33]); o.y = pk2(s[2 * 33], s[3 * 33]); o.z = pk2(s[4 * 33], s[5 * 33]); o.w = pk2(s[6 * 33], s[7 * 33]);
        *(u32x4*)(WT + (size_t)(rowbase + n) * K + k0 + 8 * c) = o; }
    LDS_WAIT(); asm volatile("" ::: "memory");
}
__device__ __forceinline__ void p0_prologue(Frame& F) {
    {
        LAS float* sc = (LAS float*)F.lds;
        LAS float* red = sc + 5 * 2048;
        for (int i = F.tid; i < 5 * 2048; i += NTHREADS) { const int v = i >> 11, k = i & 2047; const float x = v == 0 ? F.in[I_CCTX][k] : F.in[I_C][(v - 1) * 2048 + k]; sc[i] = x * sigmoidf_(x); }
        __syncthreads();
        for (int it = blockIdx.x; it < 2 * 192; it += F.G) {
            const int l = it / 192, cg_ = it % 192, col = cg_ * 64 + F.lane;
            const float* W = F.in[I_WADA] + (size_t)l * 2048 * 12288 + col;
            float acc[5] = {0.f, 0.f, 0.f, 0.f, 0.f};
            const int kbeg = F.wave * 256;
#pragma unroll 2
            for (int k = kbeg; k < kbeg + 256; k += 4) {
                const float w0 = W[(size_t)(k + 0) * 12288], w1 = W[(size_t)(k + 1) * 12288], w2 = W[(size_t)(k + 2) * 12288], w3 = W[(size_t)(k + 3) * 12288];
#pragma unroll
                for (int v = 0; v < 5; ++v) { const f32x4 s = *(const LAS f32x4*)(sc + v * 2048 + k); acc[v] += s.x * w0 + s.y * w1 + s.z * w2 + s.w * w3; }
            }
#pragma unroll
            for (int v = 0; v < 5; ++v) red[(F.wave * 5 + v) * 64 + F.lane] = acc[v];
            __syncthreads();
            if (F.tid < 320) { const int v = F.tid >> 6, c = F.tid & 63; float s = 0.f;
#pragma unroll
                for (int w = 0; w < 8; ++w) s += red[(w * 5 + v) * 64 + c];
                const int cc = cg_ * 64 + c;
                ((float*)(F.ws + WS_MOD))[(size_t)(l * 5 + v) * 12288 + cc] = s + F.in[I_BADA][l * 12288 + cc]; }
            __syncthreads();
        }
    }
    __syncthreads();
    {
        const int gt = blockIdx.x * NTHREADS + F.tid, GT = F.G * NTHREADS;
        for (int i = gt; i < 2 * 224 * 512; i += GT) { const int l = i / (224 * 512), r = i % (224 * 512), k = r >> 9, c = r & 511;
            const float v = k < 96 ? F.in[I_GUP][((size_t)l * 96 + k) * 512 + c] : (k < 160 ? F.in[I_WUP][((size_t)l * 64 + (k - 96)) * 512 + c] : F.in[I_AUP][((size_t)l * 64 + (k - 160)) * 512 + c]);
            ((float*)(F.ws + WS_W4))[((size_t)l * 56 + (k >> 2)) * 2048 + c * 4 + (k & 3)] = v; }
    }
    {
        const int gt = blockIdx.x * NTHREADS + F.tid, GT = F.G * NTHREADS;
        for (int i = gt; i < 2 * 24576; i += GT) { const int l = i / 24576, r = i % 24576;
            *(u32x4*)(F.ws + WS_WIN + (size_t)l * SZ_WIN + (size_t)4768 * 2048 * 2 + (size_t)r * 16) = (u32x4){0u, 0u, 0u, 0u}; }
    }
    {
        LAS float* scr = (LAS float*)(F.lds + F.wave * 16384);
        const int gw = blockIdx.x * NWAVES + F.wave, NGW = F.G * NWAVES;
        constexpr int I_IN = 32 * 149, I_OUT = 32 * 64, I_G = 32 * 176, I_DN = 88 * 64, PER_L = I_IN + I_OUT + 2 * I_G + I_DN;
        for (int it = gw; it < 2 * PER_L; it += NGW) {
            const int l = it / PER_L; int r = it % PER_L;
            if (r < I_IN) { const int kb = r / 149, nb = r % 149;
                p0_transpose_item(F.in[I_WIN] + (size_t)l * 2048 * DIN, 2048, DIN, (bf16_t*)(F.ws + WS_WIN + l * SZ_WIN), kb, nb, 32 * nb, scr, F.lane); continue; }
            r -= I_IN;
            if (r < I_OUT) { const int kb = r / 64, nb = r % 64;
                p0_transpose_item(F.in[I_WOUT] + (size_t)l * 2048 * 2048, 2048, 2048, (bf16_t*)(F.ws + WS_WOUT + l * SZ_WOUT), kb, nb, 32 * nb, scr, F.lane); continue; }
            r -= I_OUT;
            if (r < 2 * I_G) { const int up = r >= I_G; if (up) r -= I_G; const int kb = r / 176, nb = r % 176, n0 = 32 * nb;
                p0_transpose_item(F.in[up ? I_WUPF : I_WGATE] + (size_t)l * 2048 * DFF, 2048, DFF, (bf16_t*)(F.ws + WS_WGU + l * SZ_WGU), kb, nb, (n0 >> 7) * 256 + (up ? 128 : 0) + (n0 & 127), scr, F.lane); continue; }
            r -= 2 * I_G;
            { const int kb = r / 64, nb = r % 64;
                p0_transpose_item(F.in[I_WDOWN] + (size_t)l * DFF * 2048, DFF, 2048, (bf16_t*)(F.ws + WS_WDN + l * SZ_WDN), kb, nb, 32 * nb, scr, F.lane); }
        }
    }
}

__device__ __forceinline__ const float* mod_vec(const Frame& F, int l, int m, int which) {
    const int v = m < MC ? 0 : 1 + ((m - MC) >> 10);
    return (const float*)(F.ws + WS_MOD) + (size_t)(l * 5 + v) * 12288 + which * 2048;
}
__device__ __forceinline__ const float* x_in_row(const Frame& F, int m) { return m < MC ? F.in[I_XP] + (size_t)m * DM : F.in[I_XS] + (size_t)(m - MC) * DM; }
__device__ __forceinline__ float row_ss(const f32x4 (&v)[8]) {
    float s = 0.f;
#pragma unroll
    for (int j = 0; j < 8; ++j) s += (v[j].x * v[j].x + v[j].y * v[j].y) + (v[j].z * v[j].z + v[j].w * v[j].w);
    return wave_sum(s);
}
__device__ __forceinline__ void write_h(const Frame& F, const f32x4 (&x)[8], float rs, const float* ng, const float* sc, const float* sh, bf16_t* hrow) {
#pragma unroll
    for (int j = 0; j < 8; ++j) { const int o = F.lane + 64 * j;
        const f32x4 g = ((const f32x4*)ng)[o], s = ((const f32x4*)sc)[o], b = ((const f32x4*)sh)[o];
        const f32x4 h = x[j] * rs * g * (1.0f + s) + b;
        u32x2 w; w.x = pk2(h.x, h.y); w.y = pk2(h.z, h.w); ((u32x2*)hrow)[o] = w; }
}
__device__ __forceinline__ void rowpass0(Frame& F) {
    const int gw = blockIdx.x * NWAVES + F.wave, NGW = F.G * NWAVES;
    for (int m = gw; m < MT; m += NGW) {
        const f32x4* xr = (const f32x4*)x_in_row(F, m); f32x4 x[8];
#pragma unroll
        for (int j = 0; j < 8; ++j) x[j] = xr[F.lane + 64 * j];
        const float rs = rsqrtf(row_ss(x) * (1.0f / DM) + EPS);
        write_h(F, x, rs, F.in[I_NG] + 0, mod_vec(F, 0, m, 1), mod_vec(F, 0, m, 0), (bf16_t*)(F.ws + WS_HB) + (size_t)m * DM);
    }
}
__device__ __forceinline__ f32x4 ld_bf4(const u32x2* p) { const u32x2 v = *p; return (f32x4){__uint_as_float(v.x << 16), __uint_as_float(v.x & 0xffff0000u), __uint_as_float(v.y << 16), __uint_as_float(v.y & 0xffff0000u)}; }
__device__ __forceinline__ void st_bf4(u32x2* p, f32x4 v) { u32x2 w; w.x = pk2(v.x, v.y); w.y = pk2(v.z, v.w); *p = w; }
__device__ __forceinline__ void rowpassA(Frame& F, int l) {
    const int gw = blockIdx.x * NWAVES + F.wave, NGW = F.G * NWAVES;
    const float* ng = F.in[I_NG] + (size_t)l * 4 * DM;
    for (int m = gw; m < MT; m += NGW) {
        const u32x2* orow = (const u32x2*)(F.ws + WS_OB) + (size_t)m * (DM / 4);
        const f32x4* xr = (const f32x4*)x_in_row(F, m); const u32x2* xb = (const u32x2*)(F.ws + WS_XB) + (size_t)m * (DM / 4);
        f32x4 o[8], x[8];
#pragma unroll
        for (int j = 0; j < 8; ++j) { o[j] = ld_bf4(orow + F.lane + 64 * j); x[j] = l == 0 ? xr[F.lane + 64 * j] : ld_bf4(xb + F.lane + 64 * j); }
        const float r1 = rsqrtf(row_ss(o) * (1.0f / DM) + EPS);
        const float* ga = mod_vec(F, l, m, 2);
        u32x2* xo = (u32x2*)(F.ws + WS_XB) + (size_t)m * (DM / 4);
#pragma unroll
        for (int j = 0; j < 8; ++j) { const int q = F.lane + 64 * j; x[j] = x[j] + ((const f32x4*)ga)[q] * (o[j] * r1 * ((const f32x4*)(ng + DM))[q]); st_bf4(xo + q, x[j]); }
        const float r2 = rsqrtf(row_ss(x) * (1.0f / DM) + EPS);
        write_h(F, x, r2, ng + 2 * DM, mod_vec(F, l, m, 4), mod_vec(F, l, m, 3), (bf16_t*)(F.ws + WS_HB) + (size_t)m * DM);
    }
}
__device__ __forceinline__ void rowpassB(Frame& F, int l) {
    const int gw = blockIdx.x * NWAVES + F.wave, NGW = F.G * NWAVES;
    const float* ng = F.in[I_NG] + (size_t)l * 4 * DM;
    for (int m = gw; m < MT; m += NGW) {
        const u32x2* orow = (const u32x2*)(F.ws + WS_OB) + (size_t)m * (DM / 4);
        const u32x2* xb = (const u32x2*)(F.ws + WS_XB) + (size_t)m * (DM / 4);
        f32x4 o[8], x[8];
#pragma unroll
        for (int j = 0; j < 8; ++j) { o[j] = ld_bf4(orow + F.lane + 64 * j); x[j] = ld_bf4(xb + F.lane + 64 * j); }
        const float r1 = rsqrtf(row_ss(o) * (1.0f / DM) + EPS);
        const float* gf = mod_vec(F, l, m, 5);
        f32x4* xof = (f32x4*)(F.out + OUT_Y) + (size_t)m * (DM / 4); u32x2* xo = (u32x2*)(F.ws + WS_XB) + (size_t)m * (DM / 4);
#pragma unroll
        for (int j = 0; j < 8; ++j) { const int q = F.lane + 64 * j; x[j] = x[j] + ((const f32x4*)gf)[q] * (o[j] * r1 * ((const f32x4*)(ng + 3 * DM))[q]); if (l == DEPTH - 1) xof[q] = x[j]; else st_bf4(xo + q, x[j]); }
        if (l < DEPTH - 1) {
            const float r2 = rsqrtf(row_ss(x) * (1.0f / DM) + EPS);
            write_h(F, x, r2, ng + 4 * DM, mod_vec(F, l + 1, m, 1), mod_vec(F, l + 1, m, 0), (bf16_t*)(F.ws + WS_HB) + (size_t)m * DM);
        }
    }
}

constexpr int TC_PITCH = 1696, SM_OFF = 115712, TG = 8;
__device__ __forceinline__ void p2_prepass(Frame& F, int l) {
    const bf16_t* PROJ = (const bf16_t*)(F.ws + WS_PROJ);
    bf16_t* QB = (bf16_t*)(F.ws + WS_QB); bf16_t* KB = (bf16_t*)(F.ws + WS_KB); bf16_t* VB = (bf16_t*)(F.ws + WS_VB); bf16_t* MIX = (bf16_t*)(F.ws + WS_MIX);
    float* SCAN = (float*)(F.ws + WS_SCAN);
    int tid0 = F.tid; asm volatile("" : "+v"(tid0));
    for (int pi = blockIdx.x * NTHREADS + tid0; pi < 131072; pi += F.G * NTHREADS) {
        const int e = 2 * pi, b = e >> 16, rem = e & 65535, p = rem >> 8, col = rem & 255;
        const size_t src = ((size_t)(b * 2 + l) * 256 + p) * 256 + col, dst = (size_t)(MC + b * 1280 + 1024 + p) * 256 + col;
        const f32x2 kv = *(const f32x2*)(F.in[I_CK] + src), vv = *(const f32x2*)(F.in[I_CV] + src);
        *(unsigned*)(KB + dst) = pk2(kv.x, kv.y); *(unsigned*)(VB + dst) = pk2(vv.x, vv.y);
    }
    for (int item = blockIdx.x; item < MT / 32; item += F.G) {
        asm volatile("" ::: "memory");
        int tid = F.tid; asm volatile("" : "+v"(tid)); const int lane = tid & 63;
        const int m0 = item * 32; const bool smp = m0 >= MC;
        const int sb = smp ? (m0 - MC) >> 10 : m0 >> 8, t0 = smp ? (m0 - MC) & 1023 : m0 & 255, seqlen = smp ? 1024 : 256;
        __syncthreads();
        TS_BEGIN();
#if PP_MASK & 1
        for (int rp = 0; rp < ((PPR_MASK & 1) ? 2 : 1); ++rp) {
            LAS bf16_t* TA = (LAS bf16_t*)F.lds;
#pragma unroll
            for (int j = 0; j < 12; ++j) { const int idx = tid + 512 * j, r = idx / 192, q = idx % 192;
                *(LAS u32x4*)(TA + r * 1536 + q * 8) = *(const u32x4*)(PROJ + (size_t)(m0 + r) * DINP + q * 8); }
            __syncthreads();
            const int e1 = lane < 32 ? lane : lane + 32, e2 = e1 + 32;
            const float gq1 = F.in[I_QN][l * 128 + e1], gq2 = F.in[I_QN][l * 128 + e2], gk1 = F.in[I_KN][l * 128 + e1], gk2 = F.in[I_KN][l * 128 + e2];
            const float inv = exp2f(-(float)(2 * (lane & 31)) * (13.287712379549449f / 64.0f));
#pragma unroll 2
            for (int wi = F.wave; wi < 320; wi += NWAVES) {
                const int tok = wi / 10, j = wi % 10, t = t0 + tok;
                LAS bf16_t* p = TA + tok * 1536 + (j < 8 ? j * 128 : 1024 + (j - 8) * 128);
                const float x1 = bf2f(p[e1]), x2 = bf2f(p[e2]);
                const float rs = rsqrtf(wave_sum_fast(x1 * x1 + x2 * x2) * (1.0f / 128.0f) + EPS);
                float y1 = x1 * rs * (j < 8 ? gq1 : gk1), y2 = x2 * rs * (j < 8 ? gq2 : gk2);
                if (smp) {
                    const float pos = (float)(lane < 32 ? (t >> 6) : (t & 63));
                    float rev = pos * inv * 0.15915494309189535f; rev = rev - floorf(rev);
                    const float s = __builtin_amdgcn_sinf(rev), c = __builtin_amdgcn_cosf(rev);
                    const float o1 = y1 * c - y2 * s, o2 = y2 * c + y1 * s; y1 = o1; y2 = o2;
                }
                p[e1] = f2bf(y1); p[e2] = f2bf(y2);
            }
            __syncthreads();
#pragma unroll
            for (int j = 0; j < 8; ++j) { const int idx = tid + 512 * j, r = idx >> 7, q = idx & 127;
                *(u32x4*)(QB + (size_t)(m0 + r) * 1024 + q * 8) = *(const LAS u32x4*)(TA + r * 1536 + q * 8); }
#pragma unroll
            for (int j = 0; j < 2; ++j) { const int idx = tid + 512 * j, r = idx >> 5, q = idx & 31;
                const size_t krow = smp ? (size_t)(MC + sb * 1280 + t0 + r) : (size_t)(m0 + r);
                *(u32x4*)(KB + krow * 256 + q * 8) = *(const LAS u32x4*)(TA + r * 1536 + 1024 + q * 8);
                *(u32x4*)(VB + krow * 256 + q * 8) = *(const LAS u32x4*)(TA + r * 1536 + 1280 + q * 8); }
            if (!smp) {
#pragma unroll
                for (int j = 0; j < 4; ++j) { const int idx = tid + 512 * j, r = idx >> 6, q = idx & 63;
                    const u32x2 kk = *(const LAS u32x2*)(TA + r * 1536 + 1024 + q * 4), vv = *(const LAS u32x2*)(TA + r * 1536 + 1280 + q * 4);
                    const size_t o = ((size_t)(sb * 2 + l) * 256 + t0 + r) * 256 + q * 4;
                    *(f32x4*)(F.out + OUT_NK + o) = (f32x4){__uint_as_float(kk.x << 16), __uint_as_float(kk.x & 0xffff0000u), __uint_as_float(kk.y << 16), __uint_as_float(kk.y & 0xffff0000u)};
                    *(f32x4*)(F.out + OUT_NV + o) = (f32x4){__uint_as_float(vv.x << 16), __uint_as_float(vv.x & 0xffff0000u), __uint_as_float(vv.y << 16), __uint_as_float(vv.y & 0xffff0000u)}; }
            }
            __syncthreads();
        }
#endif
        TS_MARK(0);
#if PP_MASK & 2
        for (int rp = 0; rp < ((PPR_MASK & 2) ? 2 : 1); ++rp) {
            LAS bf16_t* TB = (LAS bf16_t*)F.lds;
#pragma unroll
            for (int j = 0; j < 13; ++j) { const int idx = tid + 512 * j; if (idx < 34 * 192) { const int rr = idx / 192, q = idx % 192, t = t0 - 1 + rr;
                u32x4 v = {0u, 0u, 0u, 0u}; if (t >= 0 && t < seqlen) v = *(const u32x4*)(PROJ + (size_t)(m0 - 1 + rr) * DINP + O_CB + q * 8);
                *(LAS u32x4*)(TB + rr * 1536 + q * 8) = v; } }
            __syncthreads();
            const int c = tid; const float* cw = F.in[I_CONVW] + (size_t)l * 3 * 512;
            const float w0 = cw[c], w1 = cw[512 + c], w2 = cw[1024 + c];
            LAS bf16_t* TO = TB + 34 * 1536;
            float prev = bf2f(TB[512 + c]) * bf2f(TB[1024 + c]), cur = bf2f(TB[1536 + 512 + c]) * bf2f(TB[1536 + 1024 + c]);
#pragma unroll 4
            for (int tok = 0; tok < 32; ++tok) {
                const LAS bf16_t* p = TB + (tok + 2) * 1536;
                const float nxt = bf2f(p[512 + c]) * bf2f(p[1024 + c]);
                const float o = bf2f(p[-1536 + c]) * (w0 * prev + w1 * cur + w2 * nxt);
                TO[tok * 512 + c] = f2bf(o);
                prev = cur; cur = nxt;
            }
            __syncthreads();
#pragma unroll
            for (int j = 0; j < 4; ++j) { const int idx = tid + 512 * j, r = idx >> 6, q = idx & 63;
                *(u32x4*)(MIX + (size_t)(m0 + r) * DM + 1024 + q * 8) = *(const LAS u32x4*)(TO + r * 512 + q * 8); }
            __syncthreads();
        }
#endif
        TS_MARK(1);
        LAS bf16_t* TC = (LAS bf16_t*)F.lds;
        LAS float* sm = (LAS float*)(F.lds + SM_OFF);
        const float* mu = F.in[I_MU] + (size_t)l * 1696;
#pragma unroll
        for (int j = 0; j < 15; ++j) { const int idx = tid + 512 * j; if (idx < 34 * 212) { const int rr = idx / 212, q = idx % 212, t = t0 - 1 + rr;
            u32x4 v = {0u, 0u, 0u, 0u}; if (t >= 0 && t < seqlen) v = *(const u32x4*)(PROJ + (size_t)(m0 - 1 + rr) * DINP + O_UR + q * 8);
            *(LAS u32x4*)(TC + rr * TC_PITCH + q * 8) = v; } }
        __syncthreads();
#pragma unroll 5
        for (int idx = tid; idx < 32 * 160; idx += NTHREADS) {
            const int tok = idx / 160, k = idx % 160, col = 1536 + k;
            const LAS bf16_t* p = TC + (tok + 1) * TC_PITCH + col;
            const float u = bf2f(p[0]), up = bf2f(p[-TC_PITCH]), un = bf2f(p[TC_PITCH]);
            const float us = u + mu[col] * (0.5f * (up + un) - u);
            sm[idx] = k < 32 ? (1.0f - 2.0f / (1.0f + __expf(2.0f * us))) : (k < 64 ? us : sigmoidf_(us));
        }
        __syncthreads();
        const int c = tid, h = F.wave, i = lane;
        TS_MARK(2);
#pragma unroll 1
        for (int half = 0; half < 32 / TG; ++half) {
            const int tb = TG * half;
            float gg[TG], dc0[TG], dc1[TG];
            {
                asm volatile("" ::: "memory");
                float wg[96];
                const f32x4* w4 = (const f32x4*)(F.ws + WS_W4) + (size_t)l * 56 * 512 + c;
#pragma unroll
                for (int k4 = 0; k4 < 24; ++k4) { const f32x4 t = w4[0]; w4 += 512; asm volatile("" : "+v"(w4)); wg[4 * k4] = t.x; wg[4 * k4 + 1] = t.y; wg[4 * k4 + 2] = t.z; wg[4 * k4 + 3] = t.w; }
#pragma unroll
                for (int tok = 0; tok < TG; ++tok) {
                    float g = 0.f, g2 = 0.f; const LAS float* xg = sm + (tb + tok) * 160 + 64;
#pragma unroll
                    for (int hk = 0; hk < 3; ++hk) {
                        f32x4 sv[8];
#pragma unroll
                        for (int q = 0; q < 8; ++q) sv[q] = *(const LAS f32x4*)(xg + 32 * hk + 4 * q);
                        __builtin_amdgcn_sched_barrier(0);
#pragma unroll
                        for (int q = 0; q < 8; ++q) { const f32x4 sq = sv[q]; const int k0 = 32 * hk + 4 * q; (q & 1 ? g2 : g) += sq.x * wg[k0] + sq.y * wg[k0 + 1] + sq.z * wg[k0 + 2] + sq.w * wg[k0 + 3]; }
                        __builtin_amdgcn_sched_barrier(0);
                    }
                    gg[tok] = g + g2;
                }
            }
            {
                asm volatile("" ::: "memory");
                float ww0[32], ww1[32];
                const f32x4* w4 = (const f32x4*)(F.ws + WS_W4) + ((size_t)l * 56 + 24) * 512 + c;
#pragma unroll
                for (int k4 = 0; k4 < 8; ++k4) { const f32x4 t = w4[0], u = w4[8 * 512]; w4 += 512; asm volatile("" : "+v"(w4));
                    ww0[4 * k4] = t.x; ww0[4 * k4 + 1] = t.y; ww0[4 * k4 + 2] = t.z; ww0[4 * k4 + 3] = t.w; ww1[4 * k4] = u.x; ww1[4 * k4 + 1] = u.y; ww1[4 * k4 + 2] = u.z; ww1[4 * k4 + 3] = u.w; }
                const float b0 = F.in[I_W0][(l * 2 + 0) * 512 + c], b1 = F.in[I_W0][(l * 2 + 1) * 512 + c];
#pragma unroll
                for (int tok = 0; tok < TG; ++tok) {
                    float z0 = b0, z1 = b1; const LAS float* xw = sm + (tb + tok) * 160;
                    f32x4 sv[8];
#pragma unroll
                    for (int q = 0; q < 8; ++q) sv[q] = *(const LAS f32x4*)(xw + 4 * q);
                    __builtin_amdgcn_sched_barrier(0);
#pragma unroll
                    for (int q = 0; q < 8; ++q) { const f32x4 sq = sv[q];
                        z0 += sq.x * ww0[4 * q] + sq.y * ww0[4 * q + 1] + sq.z * ww0[4 * q + 2] + sq.w * ww0[4 * q + 3];
                        z1 += sq.x * ww1[4 * q] + sq.y * ww1[4 * q + 1] + sq.z * ww1[4 * q + 2] + sq.w * ww1[4 * q + 3]; }
                    const float sp0 = fmaxf(-z0, 0.f) + __logf(1.0f + __expf(-fabsf(z0))), sp1 = fmaxf(-z1, 0.f) + __logf(1.0f + __expf(-fabsf(z1)));
                    dc0[tok] = __expf(-__expf(-sp0 - 0.5f)); dc1[tok] = __expf(-__expf(-sp1 - 0.5f));
                    __builtin_amdgcn_sched_barrier(0);
                }
            }
            {
                asm volatile("" ::: "memory");
                float wa0[32], wa1[32];
                const f32x4* w4 = (const f32x4*)(F.ws + WS_W4) + ((size_t)l * 56 + 40) * 512 + c;
#pragma unroll
                for (int k4 = 0; k4 < 8; ++k4) { const f32x4 t = w4[0], u = w4[8 * 512]; w4 += 512; asm volatile("" : "+v"(w4));
                    wa0[4 * k4] = t.x; wa0[4 * k4 + 1] = t.y; wa0[4 * k4 + 2] = t.z; wa0[4 * k4 + 3] = t.w; wa1[4 * k4] = u.x; wa1[4 * k4 + 1] = u.y; wa1[4 * k4 + 2] = u.z; wa1[4 * k4 + 3] = u.w; }
                const float a0b0 = F.in[I_A0][(l * 2 + 0) * 512 + c], a0b1 = F.in[I_A0][(l * 2 + 1) * 512 + c];
                const float kkc = F.in[I_KK][l * 512 + c], kac = F.in[I_KA][l * 512 + c], rkc = F.in[I_RK][l * 512 + c];
                const float mur = mu[c], muk = mu[512 + c], muv = mu[1024 + c];
                const LAS bf16_t* pr = TC + tb * TC_PITCH + c;
                float pr_r = bf2f(pr[0]), pr_k = bf2f(pr[512]), pr_v = bf2f(pr[1024]);
                float cu_r = bf2f(pr[TC_PITCH]), cu_k = bf2f(pr[TC_PITCH + 512]), cu_v = bf2f(pr[TC_PITCH + 1024]);
#pragma unroll
                for (int tok = 0; tok < TG; ++tok) {
                    const LAS bf16_t* p = pr + (tok + 2) * TC_PITCH; const int m = m0 + tb + tok;
                    const float nx_r = bf2f(p[0]), nx_k = bf2f(p[512]), nx_v = bf2f(p[1024]);
                    const float r = cu_r + mur * (0.5f * (pr_r + nx_r) - cu_r), k = cu_k + muk * (0.5f * (pr_k + nx_k) - cu_k), v = cu_v + muv * (0.5f * (pr_v + nx_v) - cu_v);
                    pr_r = cu_r; pr_k = cu_k; pr_v = cu_v; cu_r = nx_r; cu_k = nx_k; cu_v = nx_v;
                    const float kkr = k * kkc; const float kk = kkr * rsqrtf(wave_sum_fast(kkr * kkr) + 1e-12f);
                    float za0 = a0b0, za1 = a0b1; const LAS float* xa = sm + (tb + tok) * 160 + 32;
                    f32x4 sv[8];
#pragma unroll
                    for (int q = 0; q < 8; ++q) sv[q] = *(const LAS f32x4*)(xa + 4 * q);
                    __builtin_amdgcn_sched_barrier(0);
#pragma unroll
                    for (int q = 0; q < 8; ++q) { const f32x4 sq = sv[q];
                        za0 += sq.x * wa0[4 * q] + sq.y * wa0[4 * q + 1] + sq.z * wa0[4 * q + 2] + sq.w * wa0[4 * q + 3];
                        za1 += sq.x * wa1[4 * q] + sq.y * wa1[4 * q + 1] + sq.z * wa1[4 * q + 2] + sq.w * wa1[4 * q + 3]; }
                    const float a0 = sigmoidf_(za0), a1 = sigmoidf_(za1);
                    const float kd0 = k * (1.0f + (a0 - 1.0f) * kac), kd1 = k * (1.0f + (a1 - 1.0f) * kac);
                    const float bs = wave_sum_fast(r * (kd0 + kd1) * rkc);
                    f32x4* base = (f32x4*)(SCAN + ((size_t)m * 8 + h) * 768) + i;
                    base[0] = (f32x4){r, v, kk, bs * v}; base[64] = (f32x4){dc0[tok], kd0, kk * a0, gg[tok]}; base[128] = (f32x4){dc1[tok], kd1, kk * a1, 0.f};
                    __builtin_amdgcn_sched_barrier(0);
                }
            }
            TS_MARK(5);
        }
        __syncthreads();
    }
}

__device__ __forceinline__ float fma_s(float a, float b, float c) { float r; asm("v_fma_f32 %0, %1, %2, %3" : "=v"(r) : "v"(a), "v"(b), "v"(c)); return r; }
__device__ __forceinline__ float mul_s(float a, float b) { float r; asm("v_mul_f32_e32 %0, %1, %2" : "=v"(r) : "v"(a), "v"(b)); return r; }
struct ScanOps { f32x4 r4a, r4b, kk4a, kk4b, w4a, w4b, kd4a, kd4b, ka4a, ka4b; float v0; };
template <int CTRL> __device__ __forceinline__ float dpp_add_q(float x) { const int y = __builtin_amdgcn_update_dpp(0, __float_as_int(x), CTRL, 0xf, 0xf, false); return x + __int_as_float(y); }
__device__ __forceinline__ float oct_sum(float x) {
    x = dpp_add_q<0xB1>(x); x = dpp_add_q<0x4E>(x); x = dpp_add_q<0x141>(x); return x;
}
__device__ __forceinline__ void scan_item(Frame& F, int l, bool smp, int b, int h, int d, int half) {
    int tid = F.tid; asm volatile("" : "+v"(tid));
    const int seqlen = smp ? 1024 : 256, seq_base = smp ? MC + b * 1024 : b * 256, nch = seqlen / 16;
    LAS float* opb = (LAS float*)F.lds;
    LAS float* ypb = opb + 2 * 6144;
    const float* SCAN = (const float*)(F.ws + WS_SCAN); float* YB = (float*)(F.ws + WS_YB) + (size_t)d * MT * 512;
#define SCAN_TOK(ci, s) (d ? seqlen - 1 - ((ci) * 16 + (s)) : (ci) * 16 + (s))
    __syncthreads();
    if (tid < 256) {
        const int p = tid >> 3, c = tid & 7, row = half * 32 + p;
        f32x4 sa_ = {0.f, 0.f, 0.f, 0.f}, sb_ = {0.f, 0.f, 0.f, 0.f};
        if (smp) { const float* S0 = F.in[I_ST] + ((((size_t)b * 2 + l) * 2 + d) * 8 + h) * 4096 + row * 64 + 8 * c; sa_ = *(const f32x4*)S0; sb_ = *(const f32x4*)(S0 + 4); }
        __syncthreads();
        for (int ci = 0; ci < nch; ++ci) {
            const LAS float* ob = opb + (ci & 1) * 6144; LAS float* yp = ypb + (ci & 1) * 4096 + p * 8 + c;
#define SC_LD(R, s_) do { const LAS float* o_ = ob + (s_) * 384 + 8 * c; R.r4a = *(const LAS f32x4*)(o_); R.r4b = *(const LAS f32x4*)(o_ + 4); R.kk4a = *(const LAS f32x4*)(o_ + 128); R.kk4b = *(const LAS f32x4*)(o_ + 132); \
                R.w4a = *(const LAS f32x4*)(o_ + 192); R.w4b = *(const LAS f32x4*)(o_ + 196); R.kd4a = *(const LAS f32x4*)(o_ + 256); R.kd4b = *(const LAS f32x4*)(o_ + 260); \
                R.ka4a = *(const LAS f32x4*)(o_ + 320); R.ka4b = *(const LAS f32x4*)(o_ + 324); R.v0 = ob[(s_) * 384 + 64 + row]; } while (0)
#define SC_STEP(R, s_) do { \
                const f32x4 t_ = sa_ * R.kk4a + sb_ * R.kk4b; float d0 = (t_.x + t_.y) + (t_.z + t_.w); \
                d0 = -oct_sum(d0); \
                sa_ = sa_ * R.w4a + (R.ka4a * d0 + R.kd4a * R.v0); sb_ = sb_ * R.w4b + (R.ka4b * d0 + R.kd4b * R.v0); \
                const f32x4 u_ = sa_ * R.r4a + sb_ * R.r4b; yp[(s_) * 256] = (u_.x + u_.y) + (u_.z + u_.w); } while (0)
            ScanOps A, B;
            SC_LD(A, 0);
#pragma unroll 2
            for (int s = 0; s < 16; s += 2) {
                SC_LD(B, s + 1); __builtin_amdgcn_sched_barrier(0);
                SC_STEP(A, s); __builtin_amdgcn_sched_barrier(0);
                if (s + 2 < 16) SC_LD(A, s + 2); __builtin_amdgcn_sched_barrier(0);
                SC_STEP(B, s + 1); __builtin_amdgcn_sched_barrier(0);
            }
#undef SC_LD
#undef SC_STEP
            __syncthreads();
        }
        if (!smp) { float* O = F.out + OUT_ST + ((((size_t)b * 2 + l) * 2 + d) * 8 + h) * 4096 + row * 64 + 8 * c; *(f32x4*)O = sa_; *(f32x4*)(O + 4) = sb_; }
        __syncthreads();
    } else {
        const int ht = tid - 256;
        const int sg2 = (ht >> 6) & 1, sst0 = ht >> 7;
        const int ssrc = (sg2 ? 1 + d : 0) * 256 + (ht & 63) * 4, sdst = 3 * sg2 * 64 + (ht & 63);
        f32x4 stg[8], stg2[8];
#define SCAN_LOAD(R, ci) do { _Pragma("unroll") for (int j = 0; j < 8; ++j) R[j] = *(const f32x4*)(SCAN + ((size_t)(seq_base + SCAN_TOK(ci, sst0 + 2 * j)) * 8 + h) * 768 + ssrc); } while (0)
#define SCAN_STORE(buf) do { _Pragma("unroll") for (int j = 0; j < 8; ++j) { LAS float* dst_ = opb + (buf) * 6144 + (sst0 + 2 * j) * 384 + sdst; dst_[0] = stg[j].x; dst_[64] = stg[j].y; dst_[128] = stg[j].z; } } while (0)
#define SCAN_YRED(ci) do { _Pragma("unroll") for (int j = 0; j < 2; ++j) { const int o_ = ht + 256 * j, s_ = o_ >> 5, rr_ = o_ & 31; const LAS f32x4* q_ = (const LAS f32x4*)(ypb + ((ci) & 1) * 4096 + o_ * 8); \
            const f32x4 t_ = q_[0] + q_[1]; YB[(size_t)(seq_base + SCAN_TOK(ci, s_)) * 512 + h * 64 + half * 32 + rr_] = (t_.x + t_.y) + (t_.z + t_.w); } } while (0)
        SCAN_LOAD(stg, 0); SCAN_STORE(0);
        if (1 < nch) SCAN_LOAD(stg, 1);
        if (2 < nch) SCAN_LOAD(stg2, 2);
        __syncthreads();
        for (int ci = 0; ci < nch; ++ci) {
            if (ci + 1 < nch) { SCAN_STORE((ci + 1) & 1);
#pragma unroll
                for (int j = 0; j < 8; ++j) stg[j] = stg2[j];
                if (ci + 3 < nch) SCAN_LOAD(stg2, ci + 3); }
            if (ci > 0) SCAN_YRED(ci - 1);
            __syncthreads();
        }
        SCAN_YRED(nch - 1);
        __syncthreads();
#undef SCAN_LOAD
#undef SCAN_STORE
#undef SCAN_YRED
    }
#undef SCAN_TOK
}

__device__ __forceinline__ void scan_item_dual(Frame& F, int l, bool smp, int b, int h, int d) {
    int tid = F.tid; asm volatile("" : "+v"(tid));
    const int seqlen = smp ? 1024 : 256, seq_base = smp ? MC + b * 1024 : b * 256, nch = seqlen / 16;
    LAS float* opb = (LAS float*)F.lds;
    LAS float* ypb = opb + 2 * 6144;
    const float* SCAN = (const float*)(F.ws + WS_SCAN); float* YB = (float*)(F.ws + WS_YB) + (size_t)d * MT * 512;
#define SCAN_TOK(ci, s) (d ? seqlen - 1 - ((ci) * 16 + (s)) : (ci) * 16 + (s))
    const int row = tid >> 3, c = tid & 7;
    f32x4 sa_ = {0.f, 0.f, 0.f, 0.f}, sb_ = {0.f, 0.f, 0.f, 0.f};
    if (smp) { const float* S0 = F.in[I_ST] + ((((size_t)b * 2 + l) * 2 + d) * 8 + h) * 4096 + row * 64 + 8 * c; sa_ = *(const f32x4*)S0; sb_ = *(const f32x4*)(S0 + 4); }
    const int sg2 = (tid >> 6) & 1, sst0 = tid >> 7;
    const int ssrc = (sg2 ? 1 + d : 0) * 256 + (tid & 63) * 4, sdst = 3 * sg2 * 64 + (tid & 63);
    f32x4 stg[4], stg2[4];
#define SCAN_LOAD(R, ci) do { _Pragma("unroll") for (int j = 0; j < 4; ++j) R[j] = *(const f32x4*)(SCAN + ((size_t)(seq_base + SCAN_TOK(ci, sst0 + 4 * j)) * 8 + h) * 768 + ssrc); } while (0)
#define SCAN_STORE(buf) do { _Pragma("unroll") for (int j = 0; j < 4; ++j) { LAS float* dst_ = opb + (buf) * 6144 + (sst0 + 4 * j) * 384 + sdst; dst_[0] = stg[j].x; dst_[64] = stg[j].y; dst_[128] = stg[j].z; } } while (0)
    __syncthreads();
    SCAN_LOAD(stg, 0); SCAN_STORE(0);
    if (1 < nch) SCAN_LOAD(stg, 1);
    if (2 < nch) SCAN_LOAD(stg2, 2);
    __syncthreads();
    for (int ci = 0; ci < nch; ++ci) {
        const LAS float* ob = opb + (ci & 1) * 6144; LAS float* yp = ypb + row * 8 + c;
#define SC_LD(R, s_) do { const LAS float* o_ = ob + (s_) * 384 + 8 * c; R.r4a = *(const LAS f32x4*)(o_); R.r4b = *(const LAS f32x4*)(o_ + 4); R.kk4a = *(const LAS f32x4*)(o_ + 128); R.kk4b = *(const LAS f32x4*)(o_ + 132); \
            R.w4a = *(const LAS f32x4*)(o_ + 192); R.w4b = *(const LAS f32x4*)(o_ + 196); R.kd4a = *(const LAS f32x4*)(o_ + 256); R.kd4b = *(const LAS f32x4*)(o_ + 260); \
            R.ka4a = *(const LAS f32x4*)(o_ + 320); R.ka4b = *(const LAS f32x4*)(o_ + 324); R.v0 = ob[(s_) * 384 + 64 + row]; } while (0)
#define SC_STEP(R, s_) do { \
            const f32x4 t_ = sa_ * R.kk4a + sb_ * R.kk4b; float d0 = (t_.x + t_.y) + (t_.z + t_.w); \
            d0 = -oct_sum(d0); \
            sa_ = sa_ * R.w4a + (R.ka4a * d0 + R.kd4a * R.v0); sb_ = sb_ * R.w4b + (R.ka4b * d0 + R.kd4b * R.v0); \
            const f32x4 u_ = sa_ * R.r4a + sb_ * R.r4b; yp[(s_) * 512] = (u_.x + u_.y) + (u_.z + u_.w); } while (0)
        ScanOps A, B;
        SC_LD(A, 0);
#pragma unroll 2
        for (int s = 0; s < 16; s += 2) {
            SC_LD(B, s + 1); __builtin_amdgcn_sched_barrier(0);
            SC_STEP(A, s); __builtin_amdgcn_sched_barrier(0);
            if (s + 2 < 16) SC_LD(A, s + 2); __builtin_amdgcn_sched_barrier(0);
            SC_STEP(B, s + 1); __builtin_amdgcn_sched_barrier(0);
        }
#undef SC_LD
#undef SC_STEP
        __syncthreads();
#pragma unroll
        for (int j = 0; j < 2; ++j) { const int o_ = tid + 512 * j, s_ = o_ >> 6, rr_ = o_ & 63; const LAS f32x4* q_ = (const LAS f32x4*)(ypb + o_ * 8);
            const f32x4 t_ = q_[0] + q_[1]; YB[(size_t)(seq_base + SCAN_TOK(ci, s_)) * 512 + h * 64 + rr_] = (t_.x + t_.y) + (t_.z + t_.w); }
        if (ci + 1 < nch) { SCAN_STORE((ci + 1) & 1);
#pragma unroll
            for (int j = 0; j < 4; ++j) stg[j] = stg2[j];
            if (ci + 3 < nch) SCAN_LOAD(stg2, ci + 3); }
        __syncthreads();
    }
    if (!smp) { float* O = F.out + OUT_ST + ((((size_t)b * 2 + l) * 2 + d) * 8 + h) * 4096 + row * 64 + 8 * c; *(f32x4*)O = sa_; *(f32x4*)(O + 4) = sb_; }
#undef SCAN_TOK
#undef SCAN_LOAD
#undef SCAN_STORE
}

__device__ __forceinline__ void rwkv_combine_bh(Frame& F, int l, bool smp, int b, int h) {
    const int seqlen = smp ? 1024 : 256, seq_base = smp ? MC + b * 1024 : b * 256;
    const float* Y0 = (const float*)(F.ws + WS_YB) + h * 64 + F.lane; const float* Y1 = Y0 + (size_t)MT * 512;
    const float* SC = (const float*)(F.ws + WS_SCAN) + (size_t)h * 768 + F.lane * 4 + 3; bf16_t* MIX = (bf16_t*)(F.ws + WS_MIX) + 1536 + h * 64 + F.lane;
    const float lg = F.in[I_LNG][l * 512 + h * 64 + F.lane], lb = F.in[I_LNB][l * 512 + h * 64 + F.lane];
#pragma unroll 1
    for (int t0 = F.wave * 16; t0 < seqlen; t0 += 128) {
        float y0[16], y1[16], bo[16], gg[16];
#pragma unroll
        for (int u = 0; u < 16; ++u) { const size_t m = (size_t)(seq_base + t0 + u); y0[u] = Y0[m * 512]; y1[u] = Y1[m * 512]; bo[u] = SC[m * 8 * 768]; gg[u] = SC[m * 8 * 768 + 256]; }
#pragma unroll
        for (int u = 0; u < 16; ++u) { const size_t m = (size_t)(seq_base + t0 + u); const float y = y0[u] + y1[u];
            const float mean = wave_sum_fast(y) * (1.0f / 64.0f), dl = y - mean, var = wave_sum_fast(dl * dl) * (1.0f / 64.0f);
            const float yn = dl * rsqrtf(var + GN_EPS) * lg + lb;
            MIX[m * DM] = f2bf((yn + bo[u]) * gg[u]); }
    }
}

__device__ __forceinline__ void mixer_phase(Frame& F, int l, int rep) {
    unsigned* head = (unsigned*)(F.ws + WS_CTL) + CW_QUEUE + 64 * (2 * l + rep);
    unsigned* cnt = (unsigned*)(F.ws + WS_CTL) + CW_CNT + 64 * 160 * (2 * l + rep);
    volatile LAS unsigned* slot = (volatile LAS unsigned*)(F.lds + MISC_OFF);
    const bf16_t* QB = (const bf16_t*)(F.ws + WS_QB); const bf16_t* KB = (const bf16_t*)(F.ws + WS_KB); const bf16_t* VB = (const bf16_t*)(F.ws + WS_VB); bf16_t* MIX = (bf16_t*)(F.ws + WS_MIX);
    for (;;) {
        __syncthreads();
        if (F.tid == 0) slot[0] = atomicAdd(head, 1u);
        __syncthreads();
        const int item = (int)slot[0];
        if (item >= 640) break;
#if defined(TITEM)
        unsigned long long ti0_ = 0; if (l == 0 && rep == 0 && item == TITEM && F.tid == 0) ti0_ = __builtin_amdgcn_s_memrealtime();
#endif
        const bool is_scan = item < 384;
        if (is_scan) { const bool smp = item < 128; int sb_, sh_; unsigned inc_;
            if (smp) { const int u = item; sb_ = u >> 5; sh_ = (u >> 2) & 7; inc_ = 1u; scan_item(F, l, true, sb_, sh_, (u >> 1) & 1, u & 1); }
            else { const int u = item - 128; sb_ = u >> 4; sh_ = (u >> 1) & 7; inc_ = 2u; scan_item_dual(F, l, false, sb_, sh_, u & 1); }
            asm volatile("s_waitcnt vmcnt(0)" ::: "memory"); __syncthreads();
            if (F.tid == 0) { __builtin_amdgcn_fence(__ATOMIC_RELEASE, "agent"); asm volatile("s_waitcnt vmcnt(0)" ::: "memory");
                slot[1] = __hip_atomic_fetch_add(cnt + 64 * ((smp ? 0 : 32) + sb_ * 8 + sh_), inc_, __ATOMIC_RELAXED, __HIP_MEMORY_SCOPE_AGENT) + inc_; }
            __syncthreads();
            if (slot[1] == 4u) {
                if (F.tid == 0) { __builtin_amdgcn_fence(__ATOMIC_ACQUIRE, "agent"); asm volatile("s_waitcnt vmcnt(0)" ::: "memory"); }
                __syncthreads();
                rwkv_combine_bh(F, l, smp, sb_, sh_);
            }
        }
        else {
            size_t row0, kr0; int hq, seq;
            if (item < 512) { const int u = item - 384, b = u >> 5, qb = u & 3; hq = (u >> 2) & 7; row0 = (size_t)MC + b * 1024 + qb * 256; kr0 = (size_t)MC + b * 1280; seq = 1280; }
            else { const int u = item - 512, b = u >> 3; hq = u & 7; row0 = (size_t)b * 256; kr0 = row0; seq = 256; }
            attn::attn_dense_body<attn::bf16>((const attn::bf16*)(QB + row0 * 1024 + hq * 128), (const attn::bf16*)(KB + kr0 * 256 + (hq >> 2) * 128), (const attn::bf16*)(VB + kr0 * 256 + (hq >> 2) * 128), MIX + row0 * DM + hq * 128, seq, (char*)F.ldsg);
        }
#if defined(TITEM)
        if (l == 0 && rep == 0 && item == TITEM && F.tid == 0) ((volatile LAS unsigned long long*)(F.lds + MISC_OFF + 240))[0] = __builtin_amdgcn_s_memrealtime() - ti0_;
#endif
    }
#if defined(TQUIET)
    if (l == 0 && rep == 0 && blockIdx.x == 0) { __syncthreads(); unsigned long long tq0_ = __builtin_amdgcn_s_memrealtime(); scan_item(F, l, true, 0, 0, 0, 0);
        if (F.tid == 0) ((volatile LAS unsigned long long*)(F.lds + MISC_OFF + 240))[0] = __builtin_amdgcn_s_memrealtime() - tq0_; }
#endif
}
constexpr int NPHASE = 2 + 8 * DEPTH;
#ifndef PH_MASK
#define PH_MASK 0xffff
#endif
#ifndef USE_CG_SYNC
#define USE_CG_SYNC 0
#endif
#ifndef REP_MASK
#define REP_MASK 0
#endif
#if ONE_LAUNCH && USE_CG_SYNC
#define GRID_BAR() cg::this_grid().sync()
#elif ONE_LAUNCH
#define GRID_BAR() xcd_barrier(F.bar)
#else
#define GRID_BAR() do {} while (0)
#endif
#define NREP(bit) ((REP_MASK & (bit)) ? 2 : 1)
#define IN(k) (lo <= (k) && (k) < hi)
#ifndef TPROBE_MASK
#define TPROBE_MASK 0
#endif
#if TPROBE_MASK
#define STAMP(k) do { if (blockIdx.x == 0 && F.tid == 0) ((volatile LAS unsigned long long*)(F.lds + MISC_OFF + 64))[k] = __builtin_amdgcn_s_memrealtime(); } while (0)
#else
#define STAMP(k) do {} while (0)
#endif
#define SEAM(k) do { if (IN(k) && IN((k) + 1)) GRID_BAR(); STAMP((k) + 1); } while (0)
template <int L> __device__ __forceinline__ void layer_phases(Frame& F, const int lo, const int hi) {
    constexpr int l = L, pb = 2 + 8 * L;
    if (IN(pb + 0) && (PH_MASK & 4)) {
        pg8::Gemm g{(const bf16_t*)(F.ws + WS_HB), (const bf16_t*)(F.ws + WS_WIN + l * SZ_WIN), MT, DINP, DM}; pg8::StaticOrder S; S.init(MT, DINP, F.G, (int)blockIdx.x);
        pg8::EpiBf16 E{(bf16_t*)(F.ws + WS_PROJ), DINP};
        for (int rep = 0; rep < NREP(4); ++rep) pg8::gemm_phase<pg8::EpiBf16, pg8::StaticOrder, true, true>(F.lds, g, S, E);
    } SEAM(pb + 0);
    if (IN(pb + 1) && (PH_MASK & 8)) { for (int rep = 0; rep < NREP(8); ++rep) p2_prepass(F, l); } SEAM(pb + 1);
    if (IN(pb + 2) && (PH_MASK & 16)) { for (int rep = 0; rep < NREP(16); ++rep) mixer_phase(F, l, rep); } SEAM(pb + 2);
    if (IN(pb + 3) && (PH_MASK & 64)) {
        pg8::Gemm g{(const bf16_t*)(F.ws + WS_MIX), (const bf16_t*)(F.ws + WS_WOUT + l * SZ_WOUT), MT, DM, DM}; pg8::StaticOrder S; S.init(MT, DM, F.G, (int)blockIdx.x);
        pg8::EpiBf16 E{(bf16_t*)(F.ws + WS_OB), DM};
        for (int rep = 0; rep < NREP(64); ++rep) pg8::gemm_phase<pg8::EpiBf16, pg8::StaticOrder, true, true>(F.lds, g, S, E);
    } SEAM(pb + 3);
    if (IN(pb + 4) && (PH_MASK & 128)) { rowpassA(F, l); } SEAM(pb + 4);
    if (IN(pb + 5) && (PH_MASK & 256)) {
        pg8::Gemm g{(const bf16_t*)(F.ws + WS_HB), (const bf16_t*)(F.ws + WS_WGU + l * SZ_WGU), MT, 2 * DFF, DM}; pg8::StaticOrder S; S.init(MT, 2 * DFF, F.G, (int)blockIdx.x);
        pg8::EpiSwiGLU E{(bf16_t*)(F.ws + WS_HID), DFF};
        for (int rep = 0; rep < NREP(256); ++rep) pg8::gemm_phase<pg8::EpiSwiGLU, pg8::StaticOrder, true, true>(F.lds, g, S, E);
    } SEAM(pb + 5);
    if (IN(pb + 6) && (PH_MASK & 512)) {
        pg8::Gemm g{(const bf16_t*)(F.ws + WS_HID), (const bf16_t*)(F.ws + WS_WDN + l * SZ_WDN), MT, DM, DFF}; pg8::StaticOrder S; S.init(MT, DM, F.G, (int)blockIdx.x);
        pg8::EpiBf16 E{(bf16_t*)(F.ws + WS_OB), DM};
        for (int rep = 0; rep < NREP(512); ++rep) pg8::gemm_phase<pg8::EpiBf16, pg8::StaticOrder, true, true>(F.lds, g, S, E);
    } SEAM(pb + 6);
    if (IN(pb + 7) && (PH_MASK & 1024)) { rowpassB(F, l); } SEAM(pb + 7);
}
__global__ void __launch_bounds__(NTHREADS, 2) hybrid_fwd(Args args) {
    extern __shared__ __attribute__((aligned(16))) unsigned char lds[];
    Frame F;
    F.lds = (LAS unsigned char*)lds; F.ldsg = lds; F.in = args.in; F.out = args.out; F.ws = args.ws;
    F.tid = threadIdx.x; F.lane = F.tid & 63; F.wave = __builtin_amdgcn_readfirstlane(F.tid >> 6); F.G = gridDim.x;
    const int lo = args.ph_lo, hi = args.ph_hi;
    if (F.tid < 64) ((LAS unsigned*)(F.lds + MISC_OFF))[F.tid] = 0u;
    __syncthreads();
#if ONE_LAUNCH && !USE_CG_SYNC
    F.bar = xcd_barrier_post((unsigned*)(F.ws + WS_CTL) + CW_BAR, (volatile LAS unsigned*)(F.lds + MISC_OFF) + 8);
#endif
    STAMP(0);
    if (IN(0) && (PH_MASK & 1)) { for (int rep = 0; rep < NREP(1); ++rep) p0_prologue(F); } SEAM(0);
    if (IN(1) && (PH_MASK & 2)) { for (int rep = 0; rep < NREP(2); ++rep) rowpass0(F); } SEAM(1);
    layer_phases<0>(F, lo, hi);
    layer_phases<1>(F, lo, hi);
#if defined(TITEM) || defined(TQUIET) || defined(TSUB)
    if (F.tid == 0) { const unsigned long long tot = ((volatile LAS unsigned long long*)(F.lds + MISC_OFF + 240))[0];
        if (tot) { const unsigned long long t0 = __builtin_amdgcn_s_memrealtime(); while (__builtin_amdgcn_s_memrealtime() - t0 < tot) __builtin_amdgcn_s_sleep(8); } }
#endif
#if TPROBE_MASK
    if (blockIdx.x == 0 && F.tid == 0) {
        volatile LAS unsigned long long* ts = (volatile LAS unsigned long long*)(F.lds + MISC_OFF + 64); unsigned long long tot = 0;
        for (int k = 0; k < NPHASE; ++k) if ((TPROBE_MASK >> k) & 1) tot += ts[k + 1] - ts[k];
        const unsigned long long t0 = __builtin_amdgcn_s_memrealtime(); while (__builtin_amdgcn_s_memrealtime() - t0 < tot) __builtin_amdgcn_s_sleep(8);
    }
#endif
}
#undef IN
#undef SEAM

extern "C" void kernel_launch(void* const* d_in, const int* in_sizes, int n_in, void* d_out, int out_size, void* d_ws, size_t ws_size, hipStream_t stream) {
    static int grid = 0;
    if (grid == 0) {
        if (n_in != N_IN || (size_t)out_size != OUT_TOTAL || ws_size < WS_END) { fprintf(stderr, "kernel_launch: unexpected shapes: n_in %d out %d ws %zu (need %zu)\n", n_in, out_size, ws_size, (size_t)WS_END); grid = -1; return; }
        int dev = 0, cus = 0, per_cu = 0;
        if (hipGetDevice(&dev) != hipSuccess || hipDeviceGetAttribute(&cus, hipDeviceAttributeMultiprocessorCount, dev) != hipSuccess) { grid = -1; return; }
        if (hipFuncSetAttribute((const void*)hybrid_fwd, hipFuncAttributeMaxDynamicSharedMemorySize, LDS_BYTES) != hipSuccess) { fprintf(stderr, "kernel_launch: hipFuncSetAttribute failed\n"); grid = -1; return; }
        if (hipOccupancyMaxActiveBlocksPerMultiprocessor(&per_cu, (const void*)hybrid_fwd, NTHREADS, LDS_BYTES) != hipSuccess || per_cu < 1) { fprintf(stderr, "kernel_launch: occupancy query says %d blocks per CU\n", per_cu); (void)hipGetLastError(); grid = -1; return; }
        grid = cus;
    }
    if (grid < 0) return;
    (void)hipMemsetAsync((char*)d_ws + WS_CTL, 0, CTL_BYTES, stream);
    Args a{};
    for (int i = 0; i < N_IN; ++i) a.in[i] = (const float*)d_in[i];
    a.out = (float*)d_out; a.ws = (unsigned char*)d_ws;
#if ONE_LAUNCH
    a.ph_lo = 0; a.ph_hi = NPHASE;
    void* kargs[] = {&a};
    const hipError_t e = hipLaunchCooperativeKernel((const void*)hybrid_fwd, dim3(grid), dim3(NTHREADS), kargs, LDS_BYTES, stream);
    if (e != hipSuccess) fprintf(stderr, "kernel_launch: cooperative launch failed: %s (grid %d)\n", hipGetErrorString(e), grid);
#else
    for (int ph = 0; ph < NPHASE; ++ph) {
        a.ph_lo = ph; a.ph_hi = ph + 1;
        hipLaunchKernelGGL(hybrid_fwd, dim3(grid), dim3(NTHREADS), LDS_BYTES, stream, a);
    }
    const hipError_t le = hipPeekAtLastError();
    if (le != hipSuccess) fprintf(stderr, "kernel_launch: launch failed: %s\n", hipGetErrorName(le));
#endif
}
```

```cpp
#include <hip/hip_runtime.h>
#include <hip/hip_bf16.h>
#include <hip/hip_cooperative_groups.h>
#include <cstdio>
#include <cstdint>
#include <cmath>
namespace cg = cooperative_groups;
#ifndef ONE_LAUNCH
#define ONE_LAUNCH 1
#endif
namespace pg8 {
#define PG8_LAS __attribute__((address_space(3)))
typedef unsigned short bf16_t;
typedef short bf16x8 __attribute__((ext_vector_type(8)));
typedef float f32x4 __attribute__((ext_vector_type(4)));
typedef unsigned u32x4 __attribute__((ext_vector_type(4)));
constexpr int BM = 256, BK = 64, HALF = 128, HTB = HALF * BK * 2  , STAGE_BYTES = 8 * HTB, NXCD = 8, WGM = 8;

__host__ __device__ __forceinline__ int lds_byte(int r, int c) { const int st = (r >> 4) * 2 + (c >> 5), rr = r & 15, cc = c & 31, ob = rr * 64 + cc * 2; return st * 1024 + (ob ^ (((ob >> 9) & 1) << 5)); }
__host__ __device__ __forceinline__ void stage_rc(int b, int& R, int& C) { const int st = b / 1024, sb = b % 1024, swz = sb ^ (((sb >> 9) & 1) << 5); R = (st >> 1) * 16 + swz / 64; C = (st & 1) * 32 + (swz % 64) / 2; }
__host__ __device__ __forceinline__ int perm32(int rho) { const int n = rho >> 4, i = rho & 15; return 8 * (i >> 2) + 4 * n + (i & 3); }

struct Unit { int pm, pn; };
struct Gemm { const bf16_t* A; const bf16_t* Bt; int M, N, K; };

struct StaticOrder {
    int nM, nN, nwg, G, c;
    __host__ __device__ void init(int M, int N, int G_, int c_) { nM = M / BM; nN = N / BM; nwg = nM * nN; G = G_; c = c_; }
    __host__ __device__ bool next(int i, Unit& u) const {
        const long L = (long)i * G + c; if (L >= nwg) return false;
        int wgid = (int)L; { const int q = nwg / NXCD, r = nwg % NXCD, xcd = wgid % NXCD, off = wgid / NXCD; wgid = (xcd < r ? xcd * (q + 1) : r * (q + 1) + (xcd - r) * q) + off; }
        const int nig = WGM * nN, gid = wgid / nig, fm = gid * WGM, gsz = (nM - fm) < WGM ? (nM - fm) : WGM;
        u.pm = fm + ((wgid % nig) % gsz); u.pn = (wgid % nig) / gsz; return true;
    }
    __device__ __forceinline__ void a_ready(const Unit&) const {}
    __device__ __forceinline__ void done(const Unit&) const {}
};

__device__ __forceinline__ unsigned cvt_pk_bf16(float lo, float hi) { unsigned r; asm volatile("v_cvt_pk_bf16_f32 %0, %1, %2" : "=v"(r) : "v"(lo), "v"(hi)); return r; }
struct EpiBf16 {
    static constexpr bool PERM = true, AFTER_DRAIN = false;
    bf16_t* O; int ldc;
    __device__ __forceinline__ void operator()(const f32x4 (&acc)[2][2][4][2], const Unit& u, int wr, int wc, int fr, int fq) const {
        const int row0 = u.pm * BM + wr * 64 + fr; const int col0 = u.pn * BM + wc * 32 + 8 * fq;
#pragma unroll
        for (int ai = 0; ai < 2; ++ai)
#pragma unroll
            for (int m = 0; m < 4; ++m) { bf16_t* rowp = O + (size_t)(row0 + ai * HALF + m * 16) * ldc + col0;
#pragma unroll
                for (int bj = 0; bj < 2; ++bj) { const f32x4 v0 = acc[ai][bj][m][0], v1 = acc[ai][bj][m][1];
                    u32x4 w; w.x = cvt_pk_bf16(v0[0], v0[1]); w.y = cvt_pk_bf16(v0[2], v0[3]); w.z = cvt_pk_bf16(v1[0], v1[1]); w.w = cvt_pk_bf16(v1[2], v1[3]);
                    *(u32x4*)(rowp + bj * HALF) = w; } }
    }
};
struct EpiF32 {
    static constexpr bool PERM = false, AFTER_DRAIN = false;
    float* O; int ldc;
    __device__ __forceinline__ void operator()(const f32x4 (&acc)[2][2][4][2], const Unit& u, int wr, int wc, int fr, int fq) const {
        const int row0 = u.pm * BM + wr * 64 + fr; const int col0 = u.pn * BM + wc * 32 + 4 * fq;
#pragma unroll
        for (int ai = 0; ai < 2; ++ai)
#pragma unroll
            for (int m = 0; m < 4; ++m) { float* rowp = O + (size_t)(row0 + ai * HALF + m * 16) * ldc + col0;
#pragma unroll
                for (int bj = 0; bj < 2; ++bj)
#pragma unroll
                    for (int n = 0; n < 2; ++n) *(f32x4*)(rowp + bj * HALF + n * 16) = acc[ai][bj][m][n]; }
    }
};
__device__ __forceinline__ float silu_mul(float g, float u) { return g * __builtin_amdgcn_rcpf(1.0f + __expf(-g)) * u; }
struct EpiSwiGLU {
    static constexpr bool PERM = true, AFTER_DRAIN = false;
    bf16_t* O; int ldc;
    __device__ __forceinline__ void operator()(const f32x4 (&acc)[2][2][4][2], const Unit& u, int wr, int wc, int fr, int fq) const {
        const int row0 = u.pm * BM + wr * 64 + fr; const int col0 = u.pn * HALF + wc * 32 + 8 * fq;
#pragma unroll
        for (int ai = 0; ai < 2; ++ai)
#pragma unroll
            for (int m = 0; m < 4; ++m) { bf16_t* rowp = O + (size_t)(row0 + ai * HALF + m * 16) * ldc + col0;
                const f32x4 g0 = acc[ai][0][m][0], g1 = acc[ai][0][m][1], u0 = acc[ai][1][m][0], u1 = acc[ai][1][m][1];
                u32x4 w; w.x = cvt_pk_bf16(silu_mul(g0[0], u0[0]), silu_mul(g0[1], u0[1])); w.y = cvt_pk_bf16(silu_mul(g0[2], u0[2]), silu_mul(g0[3], u0[3]));
                w.z = cvt_pk_bf16(silu_mul(g1[0], u1[0]), silu_mul(g1[1], u1[1])); w.w = cvt_pk_bf16(silu_mul(g1[2], u1[2]), silu_mul(g1[3], u1[3]));
                *(u32x4*)rowp = w; }
    }
};
template <class Epi, class Sched, bool ALIGN_EPI = false, bool SP2 = false>
__device__ __forceinline__ void gemm_phase(PG8_LAS unsigned char* lds, const Gemm g, const Sched& S, const Epi& E) {
    const int tid = threadIdx.x, wid = __builtin_amdgcn_readfirstlane(tid >> 6), lane = tid & 63, wr = wid >> 2, wc = wid & 3, fr = lane & 15, fq = lane >> 4;
    const int K = g.K, nt = K / BK;
    unsigned voffA[2], voffB[2];
#pragma unroll
    for (int i = 0; i < 2; ++i) { int R, C; stage_rc(tid * 16 + i * 8192, R, C); const int Rb = Epi::PERM ? ((R & ~31) + perm32(R & 31)) : R;
        voffA[i] = (unsigned)(R * K + C) * 2u; voffB[i] = (unsigned)(Rb * K + C) * 2u; }
    const size_t kstep = (size_t)(BK * 2);
    const size_t hstep = (size_t)HALF * K * 2;
    const size_t tstep = 2 * hstep;
    const unsigned ldsw = (unsigned)wid * 1024u;
    const int aoff = lds_byte(wr * 64 + fr, fq * 8), boff = lds_byte(wc * 32 + fr, fq * 8);
#define PG8_SA(b, h) (((b) * 2 + (h)) * HTB)
#define PG8_SB(b, h) ((4 + (b) * 2 + (h)) * HTB)
#define PG8_STAGE(bufoff, gbase, voff) do { _Pragma("unroll") for (int _i = 0; _i < 2; ++_i) \
        __builtin_amdgcn_global_load_lds((const unsigned*)((const char*)(gbase) + (voff)[_i]), (PG8_LAS unsigned*)(lds + (bufoff) + ldsw + _i * 8192), 16, 0, 0); } while (0)
#define PG8_LDA(dst, b, h) do { _Pragma("unroll") for (int m = 0; m < 4; ++m) _Pragma("unroll") for (int k = 0; k < 2; ++k) dst[m][k] = *(const PG8_LAS bf16x8*)(lds + PG8_SA(b, h) + aoff + m * 2048 + k * 1024); } while (0)
#define PG8_LDB(dst, b, h) do { _Pragma("unroll") for (int n = 0; n < 2; ++n) _Pragma("unroll") for (int k = 0; k < 2; ++k) dst[n][k] = *(const PG8_LAS bf16x8*)(lds + PG8_SB(b, h) + boff + n * 2048 + k * 1024); } while (0)
#define PG8_MMA(ai, bj, At, Bt) do { __builtin_amdgcn_s_setprio(1); _Pragma("unroll") for (int m = 0; m < 4; ++m) _Pragma("unroll") for (int n = 0; n < 2; ++n) _Pragma("unroll") for (int k = 0; k < 2; ++k) \
        acc[ai][bj][m][n] = __builtin_amdgcn_mfma_f32_16x16x32_bf16(Bt[n][k], At[m][k], acc[ai][bj][m][n], 0, 0, 0); __builtin_amdgcn_s_setprio(0); } while (0)
#define PG8_WAIT_V(n) asm volatile("s_waitcnt vmcnt(" #n ")" ::: "memory")
#define PG8_WAIT_L(n) asm volatile("s_waitcnt lgkmcnt(" #n ")" ::: "memory")
#define PG8_BAR __builtin_amdgcn_s_barrier()
#define PG8_SCHED __builtin_amdgcn_sched_barrier(0)
    Unit cur, nxt; int ui = 0;
    if (!S.next(0, cur)) return;
    f32x4 acc[2][2][4][2];
#pragma unroll
    for (int a = 0; a < 2; ++a)
#pragma unroll
        for (int b = 0; b < 2; ++b)
#pragma unroll
            for (int m = 0; m < 4; ++m)
#pragma unroll
                for (int n = 0; n < 2; ++n) acc[a][b][m][n] = (f32x4){0.f, 0.f, 0.f, 0.f};
    bf16x8 At[4][2], B0[2][2], B1[2][2];
    const char* cA = (const char*)g.A + (size_t)cur.pm * tstep; const char* cB = (const char*)g.Bt + (size_t)cur.pn * tstep;
    S.a_ready(cur);
    if constexpr (SP2) {
        PG8_STAGE(PG8_SB(0, 0), cB, voffB); PG8_STAGE(PG8_SB(0, 1), cB + hstep, voffB); PG8_STAGE(PG8_SA(0, 0), cA, voffA); PG8_STAGE(PG8_SA(0, 1), cA + hstep, voffA);
        if (wr == 1) PG8_BAR;
        PG8_WAIT_V(2); PG8_BAR;
        PG8_STAGE(PG8_SB(1, 0), cB + kstep, voffB); PG8_STAGE(PG8_SA(1, 0), cA + kstep, voffA); PG8_STAGE(PG8_SB(1, 1), cB + hstep + kstep, voffB);
        PG8_WAIT_V(6); PG8_BAR;
    } else {
        PG8_STAGE(PG8_SB(0, 0), cB, voffB); PG8_STAGE(PG8_SA(0, 0), cA, voffA); PG8_STAGE(PG8_SB(0, 1), cB + hstep, voffB); PG8_STAGE(PG8_SA(0, 1), cA + hstep, voffA);
        if (wr == 1) PG8_BAR;
        PG8_WAIT_V(4); PG8_BAR;
        PG8_STAGE(PG8_SB(1, 0), cB + kstep, voffB); PG8_STAGE(PG8_SA(1, 0), cA + kstep, voffA); PG8_STAGE(PG8_SB(1, 1), cB + hstep + kstep, voffB);
        PG8_WAIT_V(6); PG8_BAR;
    }
    for (;;) {
        const bool has_next = S.next(ui + 1, nxt);
        const char* nA = has_next ? (const char*)g.A + (size_t)nxt.pm * tstep : cA; const char* nB = has_next ? (const char*)g.Bt + (size_t)nxt.pn * tstep : cB;
        for (int t = 0; t < nt; t += 2) {
            const bool last = (t == nt - 2);
            const char* a1 = cA + (size_t)(t + 1) * kstep;
            const char* a2 = last ? nA : cA + (size_t)(t + 2) * kstep; const char* b2 = last ? nB : cB + (size_t)(t + 2) * kstep;
            const char* a3 = a2 + kstep; const char* b3 = b2 + kstep;
            if (last && has_next) S.a_ready(nxt);
            if constexpr (SP2) {
            PG8_LDB(B0, 0, 0); PG8_LDB(B1, 0, 1); PG8_SCHED; PG8_LDA(At, 0, 0); PG8_STAGE(PG8_SA(1, 1), a1 + hstep, voffA);
            PG8_WAIT_V(8); PG8_WAIT_L(0); PG8_BAR; PG8_MMA(0, 0, At, B0); PG8_MMA(0, 1, At, B1); PG8_BAR; PG8_SCHED;
            PG8_LDA(At, 0, 1); PG8_STAGE(PG8_SB(0, 0), b2, voffB); PG8_STAGE(PG8_SB(0, 1), b2 + hstep, voffB); PG8_STAGE(PG8_SA(0, 0), a2, voffA);
            PG8_WAIT_V(8); PG8_WAIT_L(0); PG8_BAR; PG8_MMA(1, 0, At, B0); PG8_MMA(1, 1, At, B1); PG8_BAR; PG8_SCHED;
            PG8_LDB(B0, 1, 0); PG8_LDB(B1, 1, 1); PG8_SCHED; PG8_LDA(At, 1, 0); PG8_STAGE(PG8_SA(0, 1), a2 + hstep, voffA);
            PG8_WAIT_V(8); PG8_WAIT_L(0); PG8_BAR; PG8_MMA(0, 0, At, B0); PG8_MMA(0, 1, At, B1); PG8_BAR; PG8_SCHED;
            PG8_LDA(At, 1, 1); PG8_STAGE(PG8_SB(1, 0), b3, voffB); PG8_STAGE(PG8_SB(1, 1), b3 + hstep, voffB); PG8_STAGE(PG8_SA(1, 0), a3, voffA);
            PG8_WAIT_V(8); PG8_WAIT_L(0); PG8_BAR; PG8_MMA(1, 0, At, B0); PG8_MMA(1, 1, At, B1); PG8_BAR; PG8_SCHED;
            } else {
            PG8_LDB(B0, 0, 0); PG8_SCHED; PG8_LDA(At, 0, 0); PG8_STAGE(PG8_SA(1, 1), a1 + hstep, voffA);
            PG8_WAIT_L(8); PG8_BAR; PG8_WAIT_L(0); PG8_MMA(0, 0, At, B0); PG8_BAR; PG8_SCHED;
            PG8_LDB(B1, 0, 1); PG8_STAGE(PG8_SB(0, 0), b2, voffB);
            PG8_BAR; PG8_WAIT_L(0); PG8_MMA(0, 1, At, B1); PG8_BAR;
            PG8_LDA(At, 0, 1); PG8_STAGE(PG8_SA(0, 0), a2, voffA);
            PG8_BAR; PG8_WAIT_L(0); PG8_MMA(1, 0, At, B0); PG8_BAR; PG8_SCHED;
            PG8_STAGE(PG8_SB(0, 1), b2 + hstep, voffB);
            PG8_WAIT_V(6); PG8_BAR; PG8_MMA(1, 1, At, B1); PG8_BAR;
            PG8_LDB(B0, 1, 0); PG8_SCHED; PG8_LDA(At, 1, 0); PG8_STAGE(PG8_SA(0, 1), a2 + hstep, voffA);
            PG8_WAIT_L(8); PG8_BAR; PG8_WAIT_L(0); PG8_MMA(0, 0, At, B0); PG8_BAR; PG8_SCHED;
            PG8_LDB(B1, 1, 1); PG8_STAGE(PG8_SB(1, 0), b3, voffB);
            PG8_BAR; PG8_WAIT_L(0); PG8_MMA(0, 1, At, B1); PG8_BAR;
            PG8_LDA(At, 1, 1); PG8_STAGE(PG8_SA(1, 0), a3, voffA);
            PG8_BAR; PG8_WAIT_L(0); PG8_MMA(1, 0, At, B0); PG8_BAR; PG8_SCHED;
            PG8_STAGE(PG8_SB(1, 1), b3 + hstep, voffB);
            PG8_WAIT_V(6); PG8_BAR; PG8_MMA(1, 1, At, B1); PG8_BAR;
            }
        }
        if constexpr (ALIGN_EPI) { if (wr == 0) PG8_BAR; }
        if constexpr (!Epi::AFTER_DRAIN) { E(acc, cur, wr, wc, fr, fq); S.done(cur); }
        if (!has_next) break;
#pragma unroll
        for (int a = 0; a < 2; ++a)
#pragma unroll
            for (int b = 0; b < 2; ++b)
#pragma unroll
                for (int m = 0; m < 4; ++m)
#pragma unroll
                    for (int n = 0; n < 2; ++n) acc[a][b][m][n] = (f32x4){0.f, 0.f, 0.f, 0.f};
        cur = nxt; cA = nA; cB = nB; ++ui;
        if constexpr (ALIGN_EPI) { if (wr == 1) PG8_BAR; }
    }
    PG8_WAIT_V(0);
    if constexpr (!ALIGN_EPI) { if (wr == 0) PG8_BAR; }
    PG8_BAR;
    if constexpr (Epi::AFTER_DRAIN) { E.fused(acc, cur, wr, wc, fr, fq, lds, wid, lane); S.done(cur); }
#undef PG8_SA
#undef PG8_SB
#undef PG8_STAGE
#undef PG8_LDA
#undef PG8_LDB
#undef PG8_MMA
#undef PG8_WAIT_V
#undef PG8_WAIT_L
#undef PG8_BAR
#undef PG8_SCHED
}
}
namespace attn {
using bf16 = __hip_bfloat16;
constexpr int   D = 128, NW = 8, QBLK = 32, KVBLK = 64;
constexpr float SCALE = 0.088388347648318440f;
constexpr float THR = 8.f;
constexpr int SDEPTH = 2;
constexpr int LDQ = 1024, LDK = 256, LDO = 2048;
constexpr size_t SHM_V = KVBLK * D * 2, SHM_K = KVBLK * D * 2, SHM_ATTN = 2 * SHM_V + 2 * SHM_K + NW * 64 * 4;
__device__ __forceinline__ unsigned short f2bf_rne(float f) { unsigned u = __builtin_bit_cast(unsigned, f); return (unsigned short)((u + 0x7fffu + ((u >> 16) & 1u)) >> 16); }
using bf16x8 = __attribute__((ext_vector_type(8))) short;
using s16x4  = __attribute__((ext_vector_type(4))) short;
using f32x16 = __attribute__((ext_vector_type(16))) float;
using f32x8  = __attribute__((ext_vector_type(8))) float;
using u32x4  = __attribute__((ext_vector_type(4))) unsigned;
#define KSWZ(row, colB) ((row) * 256 + ((colB) ^ (((row) & 7) << 4)))
#define SBAR() __builtin_amdgcn_sched_barrier(0)
__device__ __forceinline__ int crow(int r, int hi) { return (r & 3) + 8 * (r >> 2) + 4 * hi; }
__device__ __forceinline__ unsigned cvtpk(float lo, float hi) {
  unsigned r; asm volatile("v_cvt_pk_bf16_f32 %0, %1, %2" : "=v"(r) : "v"(lo), "v"(hi)); return r;
}
template <typename TIn> struct Stage;
template <> struct Stage<bf16>  { using T = bf16x8;
  __device__ static __forceinline__ T ld8(const bf16* p) { return *reinterpret_cast<const bf16x8*>(p); }
  __device__ static __forceinline__ bf16x8 tobf(T x) { return x; } };
template <> struct Stage<float> { using T = f32x8;
  __device__ static __forceinline__ T ld8(const float* p) { return *reinterpret_cast<const f32x8*>(p); }
  __device__ static __forceinline__ bf16x8 tobf(T x) {
    u32x4 w = {cvtpk(x[0], x[1]), cvtpk(x[2], x[3]), cvtpk(x[4], x[5]), cvtpk(x[6], x[7])}; return *reinterpret_cast<bf16x8*>(&w); } };

__device__ __forceinline__ void partialSM(f32x16& p0, f32x16& p1, float& m_reg, float& mn, float& alpha) {
  constexpr float C = SCALE * 1.4426950408889634f;
  float pmax = p0[0]; for (int r = 1; r < 16; ++r) pmax = fmaxf(pmax, p0[r]); for (int r = 0; r < 16; ++r) pmax = fmaxf(pmax, p1[r]);
  { auto rr = __builtin_amdgcn_permlane32_swap(__float_as_uint(pmax), __float_as_uint(pmax), false, false);
    pmax = fmaxf(__uint_as_float(rr[0]), __uint_as_float(rr[1])); }
  if (__builtin_expect(__all(pmax - m_reg <= THR / SCALE), 1)) { mn = m_reg; alpha = 1.f; }
  else { mn = fmaxf(m_reg, pmax); alpha = __builtin_amdgcn_exp2f((m_reg - mn) * C); m_reg = mn; }
  float mnC = -mn * C;
  for (int r = 0; r < 16; ++r) p0[r] = fmaf(p0[r], C, mnC); for (int r = 0; r < 16; ++r) p1[r] = fmaf(p1[r], C, mnC);
  for (int r = 0; r < 16; ++r) p0[r] = __builtin_amdgcn_exp2f(p0[r]);
}
__device__ __forceinline__ void finishSM(f32x16& p0, f32x16& p1, float alpha, float& l_reg, bf16x8& pa0, bf16x8& pa1, bf16x8& pa2, bf16x8& pa3) {
  for (int r = 0; r < 16; ++r) p1[r] = __builtin_amdgcn_exp2f(p1[r]);
  float ps = 0; for (int r = 0; r < 16; ++r) ps += p0[r]; for (int r = 0; r < 16; ++r) ps += p1[r];
  { auto rr = __builtin_amdgcn_permlane32_swap(__float_as_uint(ps), __float_as_uint(ps), false, false);
    ps = __uint_as_float(rr[0]) + __uint_as_float(rr[1]); }
  l_reg = l_reg * alpha + ps;
#define PK4(P, BASE, OUT) do { unsigned a0 = cvtpk(P[BASE + 0], P[BASE + 1]), a1 = cvtpk(P[BASE + 2], P[BASE + 3]);   \
    unsigned b0 = cvtpk(P[BASE + 4], P[BASE + 5]), b1 = cvtpk(P[BASE + 6], P[BASE + 7]);                              \
    auto r0 = __builtin_amdgcn_permlane32_swap(a0, b0, false, false); auto r1 = __builtin_amdgcn_permlane32_swap(a1, b1, false, false); \
    u32x4 w = {r0[0], r1[0], r0[1], r1[1]}; OUT = *reinterpret_cast<bf16x8*>(&w); } while (0)
  PK4(p0, 0, pa0); PK4(p0, 8, pa1); PK4(p1, 0, pa2); PK4(p1, 8, pa3);
#undef PK4
}
__device__ __forceinline__ void qkt(f32x16& p0, f32x16& p1, const bf16* Ks, const bf16x8* qr, int r32, int hi) {
  p0 = f32x16{}; p1 = f32x16{};
  for (int d0 = 0; d0 < 8; ++d0) { int cb = (d0 * 16 + hi * 8) * 2;
    bf16x8 b0 = *reinterpret_cast<const bf16x8*>((const char*)Ks + KSWZ(r32, cb));
    bf16x8 b1 = *reinterpret_cast<const bf16x8*>((const char*)Ks + KSWZ(32 + r32, cb));
    p0 = __builtin_amdgcn_mfma_f32_32x32x16_bf16(b0, qr[d0], p0, 0, 0, 0);
    p1 = __builtin_amdgcn_mfma_f32_32x32x16_bf16(b1, qr[d0], p1, 0, 0, 0); }
}
__device__ __forceinline__ int v_st(int k, int c) { const int kk = (k & ~0xC) | ((k & 4) << 1) | ((k & 8) >> 1); return ((kk >> 3) * 4 + (c >> 5)) * 512 + ((kk & 7) * 32 + (c & 31)) * 2; }
__device__ __forceinline__ int v_rd_base(int lane) { return ((lane & 3) << 3) | (((lane >> 2) & 3) << 6) | (((lane >> 4) & 1) << 5) | (((lane >> 5) & 1) << 8); }
constexpr int v_rd_off(int d0, int ks, int half) { return d0 * 512 + ks * 4096 + half * 2048; }
template <int OFF> __device__ __forceinline__ s16x4 tr_read(int vb) {
  s16x4 r; asm volatile("ds_read_b64_tr_b16 %0, %1 offset:%2" : "=&v"(r) : "v"(vb), "i"(OFF) : "memory"); return r;
}
template <int D0> __device__ __forceinline__ void pv_one(f32x16& od, int vb, bf16x8 pa0, bf16x8 pa1, bf16x8 pa2, bf16x8 pa3) {
  const s16x4 l0 = tr_read<v_rd_off(D0, 0, 0)>(vb), h0 = tr_read<v_rd_off(D0, 0, 1)>(vb), l1 = tr_read<v_rd_off(D0, 1, 0)>(vb), h1 = tr_read<v_rd_off(D0, 1, 1)>(vb);
  const s16x4 l2 = tr_read<v_rd_off(D0, 2, 0)>(vb), h2 = tr_read<v_rd_off(D0, 2, 1)>(vb), l3 = tr_read<v_rd_off(D0, 3, 0)>(vb), h3 = tr_read<v_rd_off(D0, 3, 1)>(vb);
  asm volatile("s_waitcnt lgkmcnt(0)" ::: "memory"); SBAR();
#define PK(L, H) (bf16x8){L[0], L[1], L[2], L[3], H[0], H[1], H[2], H[3]}
  od = __builtin_amdgcn_mfma_f32_32x32x16_bf16(pa0, PK(l0, h0), od, 0, 0, 0);
  od = __builtin_amdgcn_mfma_f32_32x32x16_bf16(pa1, PK(l1, h1), od, 0, 0, 0);
  od = __builtin_amdgcn_mfma_f32_32x32x16_bf16(pa2, PK(l2, h2), od, 0, 0, 0);
  od = __builtin_amdgcn_mfma_f32_32x32x16_bf16(pa3, PK(l3, h3), od, 0, 0, 0);
#undef PK
}
__device__ __forceinline__ void pv_d0(f32x16* o, int vb, bf16x8 pa0, bf16x8 pa1, bf16x8 pa2, bf16x8 pa3) {
  pv_one<0>(o[0], vb, pa0, pa1, pa2, pa3); pv_one<1>(o[1], vb, pa0, pa1, pa2, pa3); pv_one<2>(o[2], vb, pa0, pa1, pa2, pa3); pv_one<3>(o[3], vb, pa0, pa1, pa2, pa3);
}
template <typename TQ>
__device__ __forceinline__ void attn_dense_body(const TQ* __restrict__ Qb, const bf16* __restrict__ Kh, const bf16* __restrict__ Vh,
                                                unsigned short* __restrict__ Ob, int seq, char* lds) {
  using St = Stage<bf16>; using SQ = Stage<TQ>;
  const int tid = threadIdx.x, wid = tid >> 6, lane = tid & 63, r32 = lane & 31, hi = lane >> 5;
  bf16* V_lds = (bf16*)lds; bf16* K_lds = (bf16*)(lds + 2 * SHM_V);
  float* ws = (float*)(lds + 2 * SHM_V + 2 * SHM_K) + wid * 64; float* li_l = ws; float* al_l = ws + 32;
  float m_reg = -1e30f, l_reg = 0; f32x16 o[4] = {}; bf16x8 qr[8];
  const TQ* Qw = Qb + (long)(wid * QBLK + r32) * LDQ + hi * 8;
#pragma unroll
  for (int d0 = 0; d0 < 8; ++d0) qr[d0] = SQ::tobf(SQ::ld8(Qw + d0 * 16));
  const int sr = tid >> 4, sc = (tid & 15) * 8, vst0 = v_st(sr, sc), vst1 = v_st(32 + sr, sc);
  const int vb0 = (int)(uintptr_t)V_lds + v_rd_base(lane);
  struct { typename St::T vs0, vs1, ks0, ks1; } sr_[SDEPTH];
#define SLOAD(i, k0) do { sr_[i].vs0 = St::ld8(&Vh[(long)((k0) + sr) * LDK + sc]); sr_[i].vs1 = St::ld8(&Vh[(long)((k0) + 32 + sr) * LDK + sc]); \
    sr_[i].ks0 = St::ld8(&Kh[(long)((k0) + sr) * LDK + sc]); sr_[i].ks1 = St::ld8(&Kh[(long)((k0) + 32 + sr) * LDK + sc]); } while (0)
#define SWRITE(b, i) do { *(bf16x8*)((char*)V_lds + (b) * SHM_V + vst0) = St::tobf(sr_[i].vs0);          \
    *(bf16x8*)((char*)V_lds + (b) * SHM_V + vst1) = St::tobf(sr_[i].vs1); int kc = sc * 2;               \
    *(bf16x8*)((char*)K_lds + (b) * SHM_K + KSWZ(sr, kc)) = St::tobf(sr_[i].ks0);                       \
    *(bf16x8*)((char*)K_lds + (b) * SHM_K + KSWZ(32 + sr, kc)) = St::tobf(sr_[i].ks1); } while (0)
#define SWAIT() do { if constexpr (SDEPTH == 2) asm volatile("s_waitcnt vmcnt(4)" ::: "memory"); else asm volatile("s_waitcnt vmcnt(0)" ::: "memory"); } while (0)
#define RESC(a) do { if (__any((a) < 1.f)) { if (hi == 0) al_l[r32] = (a); asm volatile("s_waitcnt lgkmcnt(0)" ::: "memory"); \
    for (int d = 0; d < 4; ++d) for (int r = 0; r < 16; ++r) o[d][r] *= al_l[crow(r, hi)]; } } while (0)
  f32x16 pA0, pA1, pB0, pB1; float mnA, mnB, alA, alB; bf16x8 pa0, pa1, pa2, pa3; const int NT = seq / KVBLK;
  constexpr int SE = 0, SO = SDEPTH - 1;
  SLOAD(SE, 0); asm volatile("s_waitcnt vmcnt(0)" ::: "memory"); SWRITE(0, SE); __syncthreads();
  qkt(pA0, pA1, K_lds, qr, r32, hi); partialSM(pA0, pA1, m_reg, mnA, alA);
  SLOAD(SO, KVBLK); if constexpr (SDEPTH == 2) { if (2 < NT) SLOAD(SE, 2 * KVBLK); }
  SWAIT(); SWRITE(1, SO); __syncthreads();
  for (int j = 1; j + 1 < NT; j += 2) {
    SBAR(); qkt(pB0, pB1, (bf16*)((char*)K_lds + SHM_K), qr, r32, hi);
    finishSM(pA0, pA1, alA, l_reg, pa0, pa1, pa2, pa3); SBAR();
    SLOAD(SO, (j + SDEPTH) * KVBLK); SBAR();
    pv_d0(o, vb0, pa0, pa1, pa2, pa3); partialSM(pB0, pB1, m_reg, mnB, alB);
    __syncthreads(); SWAIT(); SWRITE(0, SE);
    RESC(alB); __syncthreads();
    SBAR(); qkt(pA0, pA1, K_lds, qr, r32, hi);
    finishSM(pB0, pB1, alB, l_reg, pa0, pa1, pa2, pa3); SBAR();
    if (SDEPTH == 1 || j + 3 < NT) SLOAD(SE, (j + 1 + SDEPTH) * KVBLK); SBAR();
    pv_d0(o, vb0 + (int)SHM_V, pa0, pa1, pa2, pa3); partialSM(pA0, pA1, m_reg, mnA, alA);
    __syncthreads(); SWAIT(); SWRITE(1, SO);
    RESC(alA); __syncthreads();
  }
  SBAR(); qkt(pB0, pB1, (bf16*)((char*)K_lds + SHM_K), qr, r32, hi);
  finishSM(pA0, pA1, alA, l_reg, pa0, pa1, pa2, pa3); SBAR();
  pv_d0(o, vb0, pa0, pa1, pa2, pa3); partialSM(pB0, pB1, m_reg, mnB, alB);
  __syncthreads(); RESC(alB);
  finishSM(pB0, pB1, alB, l_reg, pa0, pa1, pa2, pa3); SBAR();
  pv_d0(o, vb0 + (int)SHM_V, pa0, pa1, pa2, pa3);
  if (hi == 0) li_l[r32] = l_reg; asm volatile("s_waitcnt lgkmcnt(0)" ::: "memory");
  float rli[16];
#pragma unroll
  for (int r = 0; r < 16; ++r) rli[r] = __builtin_amdgcn_rcpf(li_l[crow(r, hi)]);
  unsigned short* Ow = Ob + (long)(wid * QBLK) * LDO;
#pragma unroll
  for (int r = 0; r < 16; ++r) { int orow = crow(r, hi);
    for (int d0 = 0; d0 < 4; ++d0) Ow[(long)orow * LDO + d0 * 32 + r32] = f2bf_rne(o[d0][r] * rli[r]); }
#undef SLOAD
#undef SWRITE
#undef SWAIT
#undef RESC
}
}
#ifndef PP_MASK
#define PP_MASK 31
#endif
#ifndef PPR_MASK
#define PPR_MASK 0
#endif
#define GAS __attribute__((address_space(1)))
#define LAS __attribute__((address_space(3)))
typedef unsigned short bf16_t;
typedef float f32x4 __attribute__((ext_vector_type(4)));
typedef float f32x2 __attribute__((ext_vector_type(2)));
typedef unsigned u32x4 __attribute__((ext_vector_type(4)));
typedef unsigned u32x2 __attribute__((ext_vector_type(2)));
typedef __bf16 bf16x2_t __attribute__((ext_vector_type(2)));

constexpr int DM = 2048, MC = 4096, MS = 4096, MT = MC + MS, DEPTH = 2;
constexpr int DIN = 4768, DINP = 4864, DFF = 5632;
constexpr int O_K = 1024, O_V = 1280, O_CB = 1536, O_CC = 2048, O_CH = 2560, O_UR = 3072;
constexpr int KVROWS = 4096 + 4 * 1280;
constexpr float EPS = 1e-6f, GN_EPS = 64e-5f;
constexpr int NWAVES = 8, NTHREADS = 512;
enum { I_XP = 0, I_XS, I_CK, I_CV, I_ST, I_C, I_CCTX, I_WADA, I_BADA, I_NG, I_WIN, I_QN, I_KN, I_CONVW, I_MU, I_W0, I_WUP, I_A0, I_AUP, I_GUP, I_KK, I_KA, I_RK, I_LNG, I_LNB, I_WOUT, I_WGATE, I_WUPF, I_WDOWN, N_IN };
constexpr size_t OUT_Y = 0, OUT_NK = (size_t)MT * DM, OUT_NV = OUT_NK + 2097152, OUT_ST = OUT_NV + 2097152, OUT_TOTAL = OUT_ST + 2097152;
constexpr size_t MiB = 1u << 20;
constexpr size_t WS_CTL = 0, CTL_BYTES = 1 * MiB, CTL_ZERO_BYTES = 256 * 1024;
constexpr size_t WS_WIN = 1 * MiB, SZ_WIN = 19 * MiB;
constexpr size_t WS_WOUT = WS_WIN + 2 * SZ_WIN, SZ_WOUT = 8 * MiB;
constexpr size_t WS_WGU = WS_WOUT + 2 * SZ_WOUT, SZ_WGU = 44 * MiB;
constexpr size_t WS_WDN = WS_WGU + 2 * SZ_WGU, SZ_WDN = 22 * MiB;
constexpr size_t WS_MOD = WS_WDN + 2 * SZ_WDN;
constexpr size_t WS_W4 = WS_MOD + 1 * MiB;
constexpr size_t WS_HB = WS_W4 + 1 * MiB;
constexpr size_t WS_MIX = WS_HB + 32 * MiB;
constexpr size_t WS_XB = WS_MIX + 32 * MiB;
constexpr size_t WS_R1 = WS_XB + 64 * MiB;
constexpr size_t WS_PROJ = WS_R1;
constexpr size_t WS_QB = WS_R1 + 76 * MiB;
constexpr size_t WS_KB = WS_R1 + 92 * MiB;
constexpr size_t WS_VB = WS_R1 + 97 * MiB;
constexpr size_t WS_SCAN = WS_R1 + 102 * MiB;
constexpr size_t WS_YB = WS_R1 + 294 * MiB;
constexpr size_t WS_OB = WS_R1;
constexpr size_t WS_HID = WS_R1 + 64 * MiB;
constexpr size_t WS_END = WS_R1 + 326 * MiB;
constexpr int CW_BAR = 4096;
constexpr int CW_CNT = 16384;
constexpr int CW_QUEUE = 64;
constexpr int RING_BYTES = 131072, LDS_BYTES = 147456, MISC_OFF = LDS_BYTES - 256;

__device__ __forceinline__ float bf2f(bf16_t h) { return __uint_as_float((unsigned)h << 16); }
__device__ __forceinline__ unsigned pk2(float lo, float hi) { f32x2 v = {lo, hi}; bf16x2_t b = __builtin_convertvector(v, bf16x2_t); return __builtin_bit_cast(unsigned, b); }
__device__ __forceinline__ bf16_t f2bf(float f) { return (bf16_t)(pk2(f, 0.f) & 0xffffu); }
__device__ __forceinline__ float wave_sum(float v) {
#pragma unroll
    for (int o = 1; o < 64; o <<= 1) v += __shfl_xor(v, o);
    return v;
}
template <int CTRL> __device__ __forceinline__ float dpp_add(float x) {
    const int y = __builtin_amdgcn_update_dpp(0, __float_as_int(x), CTRL, 0xf, 0xf, false);
    return x + __int_as_float(y);
}
__device__ __forceinline__ float row16_sum(float x) {
    x = dpp_add<0x128>(x); x = dpp_add<0x124>(x); x = dpp_add<0x122>(x); x = dpp_add<0x121>(x); return x;
}
__device__ __forceinline__ float wave_sum_fast(float x) {
    x = row16_sum(x); const int xi = __float_as_int(x);
    return (__int_as_float(__builtin_amdgcn_readlane(xi, 0)) + __int_as_float(__builtin_amdgcn_readlane(xi, 16))) + (__int_as_float(__builtin_amdgcn_readlane(xi, 32)) + __int_as_float(__builtin_amdgcn_readlane(xi, 48)));
}
__device__ __forceinline__ float sigmoidf_(float x) { return 1.0f / (1.0f + __expf(-x)); }

#define XB_TMO      128
#define XB_XCNT(j)  (256  + 64 * (j))
#define XB_XSUB(j)  (1280 + 64 * (j))
#define XB_XGEN(j)  (2304 + 64 * (j))
#define XB_TOP      3328
#define XB_TOPGEN   3392
#define XCD_BAR_WORDS 3456
#define XB_SPIN_CAP (1u << 18)

__device__ __forceinline__ unsigned xb_ld(unsigned* p)              { return __hip_atomic_load(p, __ATOMIC_RELAXED, __HIP_MEMORY_SCOPE_AGENT); }
__device__ __forceinline__ unsigned xb_add(unsigned* p, unsigned v) { return __hip_atomic_fetch_add(p, v, __ATOMIC_RELAXED, __HIP_MEMORY_SCOPE_AGENT); }
__device__ __forceinline__ unsigned xb_xcc_id() { return (unsigned)__builtin_amdgcn_s_getreg((3 << 11) | 20) & 0xFu; }
#define XB_SPIN(cond, bar) do { unsigned _sp = 0; while (cond) { __builtin_amdgcn_s_sleep(1); \
    if ((++_sp & 255u) == 0u) { if (xb_ld(&(bar)[XB_TMO])) break; if (_sp > XB_SPIN_CAP) { atomicAdd(&(bar)[XB_TMO], 1u); break; } } } } while (0)

struct XcdBarrier {
    unsigned* bar; unsigned x;
    volatile LAS unsigned* st;
};

__device__ __forceinline__ XcdBarrier xcd_barrier_post(unsigned* bar, volatile LAS unsigned* st) {
    XcdBarrier b; b.bar = bar; b.x = xb_xcc_id(); b.st = st;
    if (threadIdx.x == 0) (void)xb_add(&bar[XB_XCNT(b.x)], 1u);
    return b;
}
__device__ __forceinline__ void xcd_barrier_complete(unsigned* bar, unsigned x, unsigned& nloc, unsigned& nx) {
    const unsigned G = gridDim.x * gridDim.y * gridDim.z;
    unsigned sum, cnt, mine, sp = 0u;
    for (;;) {
        sum = 0u; cnt = 0u; mine = 0u;
#pragma unroll
        for (unsigned j = 0; j < 16; ++j) { const unsigned c = xb_ld(&bar[XB_XCNT(j)]); sum += c; cnt += (c > 0u) ? 1u : 0u; mine = (j == x) ? c : mine; }
        if (sum == G) break;
        __builtin_amdgcn_s_sleep(1);
        if ((++sp & 255u) == 0u) { if (xb_ld(&bar[XB_TMO])) break; if (sp > XB_SPIN_CAP) { atomicAdd(&bar[XB_TMO], 1u); break; } }
    }
    nloc = mine > 0u ? mine : 1u; nx = cnt > 0u ? cnt : 1u;
}

__device__ __forceinline__ void xcd_barrier(const XcdBarrier& b) {
    asm volatile("s_waitcnt vmcnt(0)" ::: "memory");
    __syncthreads();
    if (threadIdx.x == 0) {
        unsigned* bar = b.bar;
        __builtin_amdgcn_s_waitcnt(0);
        unsigned nloc = b.st[0], nx = b.st[1];
        if (nloc == 0u) { xcd_barrier_complete(bar, b.x, nloc, nx); b.st[0] = nloc; b.st[1] = nx; }
        const unsigned old = xb_add(&bar[XB_XSUB(b.x)], 1u);
        const unsigned gen = old / nloc;
        if (old + 1u == (gen + 1u) * nloc) {
            __builtin_amdgcn_fence(__ATOMIC_RELEASE, "agent");
            asm volatile("s_waitcnt vmcnt(0)" ::: "memory");
            const unsigned og = xb_add(&bar[XB_TOP], 1u);
            const unsigned tg = og / nx;
            if (og + 1u == (tg + 1u) * nx) xb_add(&bar[XB_TOPGEN], 1u);
            else XB_SPIN(xb_ld(&bar[XB_TOPGEN]) == tg, bar);
            __builtin_amdgcn_fence(__ATOMIC_ACQUIRE, "agent");
            xb_add(&bar[XB_XGEN(b.x)], 1u);
            asm volatile("s_waitcnt vmcnt(0)" ::: "memory");
        } else {
            XB_SPIN(xb_ld(&bar[XB_XGEN(b.x)]) == gen, bar);
            __builtin_amdgcn_fence(__ATOMIC_ACQUIRE, "agent");
            asm volatile("s_waitcnt vmcnt(0)" ::: "memory");
        }
    }
    __syncthreads();
}


struct Args { const float* in[N_IN]; float* out; unsigned char* ws; int ph_lo, ph_hi; };
struct Frame {
    LAS unsigned char* lds; unsigned char* ldsg;
    const float* const* in; float* out; unsigned char* ws;
    int tid, lane, wave, G;
    XcdBarrier bar;
};
#define LDS_WAIT() asm volatile("s_waitcnt lgkmcnt(0)" ::: "memory")
#if defined(TSUB)
#define TS_BEGIN() unsigned long long ts_t0_ = __builtin_amdgcn_s_memrealtime()
#define TS_MARK(r) do { const unsigned long long ts_t1_ = __builtin_amdgcn_s_memrealtime(); if ((r) == TSUB && blockIdx.x == TSBLK && F.tid == 0) ((volatile LAS unsigned long long*)(F.lds + MISC_OFF + 240))[0] += ts_t1_ - ts_t0_; ts_t0_ = __builtin_amdgcn_s_memrealtime(); } while (0)
#else
#define TS_BEGIN() do {} while (0)
#define TS_MARK(r) do {} while (0)
#endif

__device__ __forceinline__ void p0_transpose_item(const float* W, int K, int N, bf16_t* WT, int kb, int nb, int rowbase, LAS float* scr, int lane) {
    const int k0 = 64 * kb, n0 = 32 * nb;
#pragma unroll 8
    for (int i = 0; i < 32; ++i) { const int kk = 2 * i + (lane >> 5); scr[kk * 33 + (lane & 31)] = W[(size_t)(k0 + kk) * N + n0 + (lane & 31)]; }
    LDS_WAIT(); asm volatile("" ::: "memory");
    const int c = lane & 7;
#pragma unroll
    for (int j = 0; j < 4; ++j) { const int n = (lane >> 3) + 8 * j; const LAS float* s = scr + (8 * c) * 33 + n;
        u32x4 o; o.x = pk2(s[0 * 33], s[1 * 33]); o.y = pk2(s[2 * 33], s[3 * 33]); o.z = pk2(s[4 * 33], s[5 * 33]); o.w = pk2(s[6 * 33], s[7 * 33]);
        *(u32x4*)(WT + (size_t)(rowbase + n) * K + k0 + 8 * c) = o; }
    LDS_WAIT(); asm volatile("" ::: "memory");
}
constexpr int CI_IN = 32 * 149, CI_OUT = 32 * 64, CI_G = 32 * 176, CI_DN = 88 * 64;
__device__ __forceinline__ void conv_item(Frame& F, int kind, int l, int r, LAS float* scr) {
    if (kind == 0) { const int kb = r / 149, nb = r % 149;
        p0_transpose_item(F.in[I_WIN] + (size_t)l * 2048 * DIN, 2048, DIN, (bf16_t*)(F.ws + WS_WIN + l * SZ_WIN), kb, nb, 32 * nb, scr, F.lane); }
    else if (kind == 1) { const int kb = r / 64, nb = r % 64;
        p0_transpose_item(F.in[I_WOUT] + (size_t)l * 2048 * 2048, 2048, 2048, (bf16_t*)(F.ws + WS_WOUT + l * SZ_WOUT), kb, nb, 32 * nb, scr, F.lane); }
    else if (kind == 2) { const int up = r >= CI_G; if (up) r -= CI_G; const int kb = r / 176, nb = r % 176, n0 = 32 * nb;
        p0_transpose_item(F.in[up ? I_WUPF : I_WGATE] + (size_t)l * 2048 * DFF, 2048, DFF, (bf16_t*)(F.ws + WS_WGU + l * SZ_WGU), kb, nb, (n0 >> 7) * 256 + (up ? 128 : 0) + (n0 & 127), scr, F.lane); }
    else { const int kb = r / 64, nb = r % 64;
        p0_transpose_item(F.in[I_WDOWN] + (size_t)l * DFF * 2048, DFF, 2048, (bf16_t*)(F.ws + WS_WDN + l * SZ_WDN), kb, nb, 32 * nb, scr, F.lane); }
}
__device__ __forceinline__ void p0_prologue(Frame& F) {
    {
        LAS float* sc = (LAS float*)F.lds;
        LAS float* red = sc + 5 * 2048;
        for (int i = F.tid; i < 5 * 2048; i += NTHREADS) { const int v = i >> 11, k = i & 2047; const float x = v == 0 ? F.in[I_CCTX][k] : F.in[I_C][(v - 1) * 2048 + k]; sc[i] = x * sigmoidf_(x); }
        __syncthreads();
        for (int it = blockIdx.x; it < 2 * 256; it += F.G) {
            const int l = it >> 8, cg_ = it & 255, col = cg_ * 48 + (F.lane < 48 ? F.lane : 47);
            const float* W = F.in[I_WADA] + (size_t)l * 2048 * 12288 + col;
            float acc[5] = {0.f, 0.f, 0.f, 0.f, 0.f};
            const int kbeg = F.wave * 256;
#pragma unroll 2
            for (int k = kbeg; k < kbeg + 256; k += 4) {
                const float w0 = W[(size_t)(k + 0) * 12288], w1 = W[(size_t)(k + 1) * 12288], w2 = W[(size_t)(k + 2) * 12288], w3 = W[(size_t)(k + 3) * 12288];
#pragma unroll
                for (int v = 0; v < 5; ++v) { const f32x4 s = *(const LAS f32x4*)(sc + v * 2048 + k); acc[v] += s.x * w0 + s.y * w1 + s.z * w2 + s.w * w3; }
            }
#pragma unroll
            for (int v = 0; v < 5; ++v) red[(F.wave * 5 + v) * 64 + F.lane] = acc[v];
            __syncthreads();
            if (F.tid < 320) { const int v = F.tid >> 6, c = F.tid & 63; float s = 0.f;
#pragma unroll
                for (int w = 0; w < 8; ++w) s += red[(w * 5 + v) * 64 + c];
                const int cc = cg_ * 48 + c;
                if (c < 48) ((float*)(F.ws + WS_MOD))[(size_t)(l * 5 + v) * 12288 + cc] = s + F.in[I_BADA][l * 12288 + cc]; }
            __syncthreads();
        }
    }
    __syncthreads();
    {
        const int gt = blockIdx.x * NTHREADS + F.tid, GT = F.G * NTHREADS;
        for (int i = gt; i < 2 * 224 * 512; i += GT) { const int l = i / (224 * 512), r = i % (224 * 512), k = r >> 9, c = r & 511;
            const float v = k < 96 ? F.in[I_GUP][((size_t)l * 96 + k) * 512 + c] : (k < 160 ? F.in[I_WUP][((size_t)l * 64 + (k - 96)) * 512 + c] : F.in[I_AUP][((size_t)l * 64 + (k - 160)) * 512 + c]);
            ((float*)(F.ws + WS_W4))[((size_t)l * 56 + (k >> 2)) * 2048 + c * 4 + (k & 3)] = v; }
    }
    {
        const int gt = blockIdx.x * NTHREADS + F.tid, GT = F.G * NTHREADS;
        for (int i = gt; i < 2 * 24576; i += GT) { const int l = i / 24576, r = i % 24576;
            *(u32x4*)(F.ws + WS_WIN + (size_t)l * SZ_WIN + (size_t)4768 * 2048 * 2 + (size_t)r * 16) = (u32x4){0u, 0u, 0u, 0u}; }
    }
    {
        LAS float* scr = (LAS float*)(F.lds + F.wave * 16384);
        const int gw = blockIdx.x * NWAVES + F.wave, NGW = F.G * NWAVES;
        for (int it = gw; it < 2 * CI_IN; it += NGW) conv_item(F, 0, it / CI_IN, it % CI_IN, scr);
    }
}
__device__ __forceinline__ void conv_side(Frame& F, int l, int first, int count, int nblk, int blk) {
    LAS float* scr = (LAS float*)(F.lds + F.wave * 16384);
    for (int it = first + blk * NWAVES + F.wave; it < first + count; it += nblk * NWAVES) {
        int r = it, kind = 1; if (r >= CI_OUT) { r -= CI_OUT; kind = 2; if (r >= 2 * CI_G) { r -= 2 * CI_G; kind = 3; } }
        conv_item(F, kind, l, r, scr);
    }
}

__device__ __forceinline__ const float* mod_vec(const Frame& F, int l, int m, int which) {
    const int v = m < MC ? 0 : 1 + ((m - MC) >> 10);
    return (const float*)(F.ws + WS_MOD) + (size_t)(l * 5 + v) * 12288 + which * 2048;
}
__device__ __forceinline__ const float* x_in_row(const Frame& F, int m) { return m < MC ? F.in[I_XP] + (size_t)m * DM : F.in[I_XS] + (size_t)(m - MC) * DM; }
__device__ __forceinline__ float row_ss(const f32x4 (&v)[8]) {
    float s = 0.f;
#pragma unroll
    for (int j = 0; j < 8; ++j) s += (v[j].x * v[j].x + v[j].y * v[j].y) + (v[j].z * v[j].z + v[j].w * v[j].w);
    return wave_sum(s);
}
__device__ __forceinline__ void write_h(const Frame& F, const f32x4 (&x)[8], float rs, const float* ng, const float* sc, const float* sh, bf16_t* hrow) {
#pragma unroll
    for (int j = 0; j < 8; ++j) { const int o = F.lane + 64 * j;
        const f32x4 g = ((const f32x4*)ng)[o], s = ((const f32x4*)sc)[o], b = ((const f32x4*)sh)[o];
        const f32x4 h = x[j] * rs * g * (1.0f + s) + b;
        u32x2 w; w.x = pk2(h.x, h.y); w.y = pk2(h.z, h.w); ((u32x2*)hrow)[o] = w; }
}
__device__ __forceinline__ void rowpass0(Frame& F) {
    const int gw = blockIdx.x * NWAVES + F.wave, NGW = F.G * NWAVES;
    for (int m = gw; m < MT; m += NGW) {
        const f32x4* xr = (const f32x4*)x_in_row(F, m); f32x4 x[8];
#pragma unroll
        for (int j = 0; j < 8; ++j) x[j] = xr[F.lane + 64 * j];
        const float rs = rsqrtf(row_ss(x) * (1.0f / DM) + EPS);
        write_h(F, x, rs, F.in[I_NG] + 0, mod_vec(F, 0, m, 1), mod_vec(F, 0, m, 0), (bf16_t*)(F.ws + WS_HB) + (size_t)m * DM);
    }
}
__device__ __forceinline__ f32x4 ld_bf4(const u32x2* p) { const u32x2 v = *p; return (f32x4){__uint_as_float(v.x << 16), __uint_as_float(v.x & 0xffff0000u), __uint_as_float(v.y << 16), __uint_as_float(v.y & 0xffff0000u)}; }
__device__ __forceinline__ void st_bf4(u32x2* p, f32x4 v) { u32x2 w; w.x = pk2(v.x, v.y); w.y = pk2(v.z, v.w); *p = w; }
__device__ __forceinline__ void rowpassA(Frame& F, int l) {
    const int gw = blockIdx.x * NWAVES + F.wave, NGW = F.G * NWAVES;
    const float* ng = F.in[I_NG] + (size_t)l * 4 * DM;
    for (int m = gw; m < MT; m += NGW) {
        const u32x2* orow = (const u32x2*)(F.ws + WS_OB) + (size_t)m * (DM / 4);
        const f32x4* xr = (const f32x4*)x_in_row(F, m); const u32x2* xb = (const u32x2*)(F.ws + WS_XB) + (size_t)m * (DM / 4);
        f32x4 o[8], x[8];
#pragma unroll
        for (int j = 0; j < 8; ++j) { o[j] = ld_bf4(orow + F.lane + 64 * j); x[j] = l == 0 ? xr[F.lane + 64 * j] : ld_bf4(xb + F.lane + 64 * j); }
        const float r1 = rsqrtf(row_ss(o) * (1.0f / DM) + EPS);
        const float* ga = mod_vec(F, l, m, 2);
        u32x2* xo = (u32x2*)(F.ws + WS_XB) + (size_t)m * (DM / 4);
#pragma unroll
        for (int j = 0; j < 8; ++j) { const int q = F.lane + 64 * j; x[j] = x[j] + ((const f32x4*)ga)[q] * (o[j] * r1 * ((const f32x4*)(ng + DM))[q]); st_bf4(xo + q, x[j]); }
        const float r2 = rsqrtf(row_ss(x) * (1.0f / DM) + EPS);
        write_h(F, x, r2, ng + 2 * DM, mod_vec(F, l, m, 4), mod_vec(F, l, m, 3), (bf16_t*)(F.ws + WS_HB) + (size_t)m * DM);
    }
}
__device__ __forceinline__ void rowpassB(Frame& F, int l) {
    const int gw = blockIdx.x * NWAVES + F.wave, NGW = F.G * NWAVES;
    const float* ng = F.in[I_NG] + (size_t)l * 4 * DM;
    for (int m = gw; m < MT; m += NGW) {
        const u32x2* orow = (const u32x2*)(F.ws + WS_OB) + (size_t)m * (DM / 4);
        const u32x2* xb = (const u32x2*)(F.ws + WS_XB) + (size_t)m * (DM / 4);
        f32x4 o[8], x[8];
#pragma unroll
        for (int j = 0; j < 8; ++j) { o[j] = ld_bf4(orow + F.lane + 64 * j); x[j] = ld_bf4(xb + F.lane + 64 * j); }
        const float r1 = rsqrtf(row_ss(o) * (1.0f / DM) + EPS);
        const float* gf = mod_vec(F, l, m, 5);
        f32x4* xof = (f32x4*)(F.out + OUT_Y) + (size_t)m * (DM / 4); u32x2* xo = (u32x2*)(F.ws + WS_XB) + (size_t)m * (DM / 4);
#pragma unroll
        for (int j = 0; j < 8; ++j) { const int q = F.lane + 64 * j; x[j] = x[j] + ((const f32x4*)gf)[q] * (o[j] * r1 * ((const f32x4*)(ng + 3 * DM))[q]); if (l == DEPTH - 1) xof[q] = x[j]; else st_bf4(xo + q, x[j]); }
        if (l < DEPTH - 1) {
            const float r2 = rsqrtf(row_ss(x) * (1.0f / DM) + EPS);
            write_h(F, x, r2, ng + 4 * DM, mod_vec(F, l + 1, m, 1), mod_vec(F, l + 1, m, 0), (bf16_t*)(F.ws + WS_HB) + (size_t)m * DM);
        }
    }
}

constexpr int TC_PITCH = 1696, SM_OFF = 115712, TG = 8;
__device__ __forceinline__ void p2_prepass(Frame& F, int l) {
    const bf16_t* PROJ = (const bf16_t*)(F.ws + WS_PROJ);
    bf16_t* QB = (bf16_t*)(F.ws + WS_QB); bf16_t* KB = (bf16_t*)(F.ws + WS_KB); bf16_t* VB = (bf16_t*)(F.ws + WS_VB); bf16_t* MIX = (bf16_t*)(F.ws + WS_MIX);
    float* SCAN = (float*)(F.ws + WS_SCAN);
    int tid0 = F.tid; asm volatile("" : "+v"(tid0));
    for (int pi = blockIdx.x * NTHREADS + tid0; pi < 131072; pi += F.G * NTHREADS) {
        const int e = 2 * pi, b = e >> 16, rem = e & 65535, p = rem >> 8, col = rem & 255;
        const size_t src = ((size_t)(b * 2 + l) * 256 + p) * 256 + col, dst = (size_t)(MC + b * 1280 + 1024 + p) * 256 + col;
        const f32x2 kv = *(const f32x2*)(F.in[I_CK] + src), vv = *(const f32x2*)(F.in[I_CV] + src);
        *(unsigned*)(KB + dst) = pk2(kv.x, kv.y); *(unsigned*)(VB + dst) = pk2(vv.x, vv.y);
    }
    for (int item = blockIdx.x; item < MT / 32; item += F.G) {
        asm volatile("" ::: "memory");
        int tid = F.tid; asm volatile("" : "+v"(tid)); const int lane = tid & 63;
        const int m0 = item * 32; const bool smp = m0 >= MC;
        const int sb = smp ? (m0 - MC) >> 10 : m0 >> 8, t0 = smp ? (m0 - MC) & 1023 : m0 & 255, seqlen = smp ? 1024 : 256;
        __syncthreads();
        TS_BEGIN();
#if PP_MASK & 1
        for (int rp = 0; rp < ((PPR_MASK & 1) ? 2 : 1); ++rp) {
            LAS bf16_t* TA = (LAS bf16_t*)F.lds;
#pragma unroll
            for (int j = 0; j < 12; ++j) { const int idx = tid + 512 * j, r = idx / 192, q = idx % 192;
                *(LAS u32x4*)(TA + r * 1536 + q * 8) = *(const u32x4*)(PROJ + (size_t)(m0 + r) * DINP + q * 8); }
            __syncthreads();
            const int e1 = lane < 32 ? lane : lane + 32, e2 = e1 + 32;
            const float gq1 = F.in[I_QN][l * 128 + e1], gq2 = F.in[I_QN][l * 128 + e2], gk1 = F.in[I_KN][l * 128 + e1], gk2 = F.in[I_KN][l * 128 + e2];
            const float inv = exp2f(-(float)(2 * (lane & 31)) * (13.287712379549449f / 64.0f));
#pragma unroll 2
            for (int wi = F.wave; wi < 320; wi += NWAVES) {
                const int tok = wi / 10, j = wi % 10, t = t0 + tok;
                LAS bf16_t* p = TA + tok * 1536 + (j < 8 ? j * 128 : 1024 + (j - 8) * 128);
                const float x1 = bf2f(p[e1]), x2 = bf2f(p[e2]);
                const float rs = rsqrtf(wave_sum_fast(x1 * x1 + x2 * x2) * (1.0f / 128.0f) + EPS);
                float y1 = x1 * rs * (j < 8 ? gq1 : gk1), y2 = x2 * rs * (j < 8 ? gq2 : gk2);
                if (smp) {
                    const float pos = (float)(lane < 32 ? (t >> 6) : (t & 63));
                    float rev = pos * inv * 0.15915494309189535f; rev = rev - floorf(rev);
                    const float s = __builtin_amdgcn_sinf(rev), c = __builtin_amdgcn_cosf(rev);
                    const float o1 = y1 * c - y2 * s, o2 = y2 * c + y1 * s; y1 = o1; y2 = o2;
                }
                p[e1] = f2bf(y1); p[e2] = f2bf(y2);
            }
            __syncthreads();
#pragma unroll
            for (int j = 0; j < 8; ++j) { const int idx = tid + 512 * j, r = idx >> 7, q = idx & 127;
                *(u32x4*)(QB + (size_t)(m0 + r) * 1024 + q * 8) = *(const LAS u32x4*)(TA + r * 1536 + q * 8); }
#pragma unroll
            for (int j = 0; j < 2; ++j) { const int idx = tid + 512 * j, r = idx >> 5, q = idx & 31;
                const size_t krow = smp ? (size_t)(MC + sb * 1280 + t0 + r) : (size_t)(m0 + r);
                *(u32x4*)(KB + krow * 256 + q * 8) = *(const LAS u32x4*)(TA + r * 1536 + 1024 + q * 8);
                *(u32x4*)(VB + krow * 256 + q * 8) = *(const LAS u32x4*)(TA + r * 1536 + 1280 + q * 8); }
            if (!smp) {
#pragma unroll
                for (int j = 0; j < 4; ++j) { const int idx = tid + 512 * j, r = idx >> 6, q = idx & 63;
                    const u32x2 kk = *(const LAS u32x2*)(TA + r * 1536 + 1024 + q * 4), vv = *(const LAS u32x2*)(TA + r * 1536 + 1280 + q * 4);
                    const size_t o = ((size_t)(sb * 2 + l) * 256 + t0 + r) * 256 + q * 4;
                    *(f32x4*)(F.out + OUT_NK + o) = (f32x4){__uint_as_float(kk.x << 16), __uint_as_float(kk.x & 0xffff0000u), __uint_as_float(kk.y << 16), __uint_as_float(kk.y & 0xffff0000u)};
                    *(f32x4*)(F.out + OUT_NV + o) = (f32x4){__uint_as_float(vv.x << 16), __uint_as_float(vv.x & 0xffff0000u), __uint_as_float(vv.y << 16), __uint_as_float(vv.y & 0xffff0000u)}; }
            }
            __syncthreads();
        }
#endif
        TS_MARK(0);
#if PP_MASK & 2
        for (int rp = 0; rp < ((PPR_MASK & 2) ? 2 : 1); ++rp) {
            LAS bf16_t* TB = (LAS bf16_t*)F.lds;
#pragma unroll
            for (int j = 0; j < 13; ++j) { const int idx = tid + 512 * j; if (idx < 34 * 192) { const int rr = idx / 192, q = idx % 192, t = t0 - 1 + rr;
                u32x4 v = {0u, 0u, 0u, 0u}; if (t >= 0 && t < seqlen) v = *(const u32x4*)(PROJ + (size_t)(m0 - 1 + rr) * DINP + O_CB + q * 8);
                *(LAS u32x4*)(TB + rr * 1536 + q * 8) = v; } }
            __syncthreads();
            const int c = tid; const float* cw = F.in[I_CONVW] + (size_t)l * 3 * 512;
            const float w0 = cw[c], w1 = cw[512 + c], w2 = cw[1024 + c];
            LAS bf16_t* TO = TB + 34 * 1536;
            float prev = bf2f(TB[512 + c]) * bf2f(TB[1024 + c]), cur = bf2f(TB[1536 + 512 + c]) * bf2f(TB[1536 + 1024 + c]);
#pragma unroll 4
            for (int tok = 0; tok < 32; ++tok) {
                const LAS bf16_t* p = TB + (tok + 2) * 1536;
                const float nxt = bf2f(p[512 + c]) * bf2f(p[1024 + c]);
                const float o = bf2f(p[-1536 + c]) * (w0 * prev + w1 * cur + w2 * nxt);
                TO[tok * 512 + c] = f2bf(o);
                prev = cur; cur = nxt;
            }
            __syncthreads();
#pragma unroll
            for (int j = 0; j < 4; ++j) { const int idx = tid + 512 * j, r = idx >> 6, q = idx & 63;
                *(u32x4*)(MIX + (size_t)(m0 + r) * DM + 1024 + q * 8) = *(const LAS u32x4*)(TO + r * 512 + q * 8); }
            __syncthreads();
        }
#endif
        TS_MARK(1);
        LAS bf16_t* TC = (LAS bf16_t*)F.lds;
        LAS float* sm = (LAS float*)(F.lds + SM_OFF);
        const float* mu = F.in[I_MU] + (size_t)l * 1696;
#pragma unroll
        for (int j = 0; j < 15; ++j) { const int idx = tid + 512 * j; if (idx < 34 * 212) { const int rr = idx / 212, q = idx % 212, t = t0 - 1 + rr;
            u32x4 v = {0u, 0u, 0u, 0u}; if (t >= 0 && t < seqlen) v = *(const u32x4*)(PROJ + (size_t)(m0 - 1 + rr) * DINP + O_UR + q * 8);
            *(LAS u32x4*)(TC + rr * TC_PITCH + q * 8) = v; } }
        __syncthreads();
#pragma unroll 5
        for (int idx = tid; idx < 32 * 160; idx += NTHREADS) {
            const int tok = idx / 160, k = idx % 160, col = 1536 + k;
            const LAS bf16_t* p = TC + (tok + 1) * TC_PITCH + col;
            const float u = bf2f(p[0]), up = bf2f(p[-TC_PITCH]), un = bf2f(p[TC_PITCH]);
            const float us = u + mu[col] * (0.5f * (up + un) - u);
            sm[idx] = k < 32 ? (1.0f - 2.0f / (1.0f + __expf(2.0f * us))) : (k < 64 ? us : sigmoidf_(us));
        }
        __syncthreads();
        const int c = tid, h = F.wave, i = lane;
        TS_MARK(2);
#pragma unroll 1
        for (int half = 0; half < 32 / TG; ++half) {
            const int tb = TG * half;
            float gg[TG], dc0[TG], dc1[TG];
            {
                asm volatile("" ::: "memory");
                float wg[96];
                const f32x4* w4 = (const f32x4*)(F.ws + WS_W4) + (size_t)l * 56 * 512 + c;
#pragma unroll
                for (int k4 = 0; k4 < 24; ++k4) { const f32x4 t = w4[0]; w4 += 512; asm volatile("" : "+v"(w4)); wg[4 * k4] = t.x; wg[4 * k4 + 1] = t.y; wg[4 * k4 + 2] = t.z; wg[4 * k4 + 3] = t.w; }
#pragma unroll
                for (int tok = 0; tok < TG; ++tok) {
                    float g = 0.f, g2 = 0.f; const LAS float* xg = sm + (tb + tok) * 160 + 64;
#pragma unroll
                    for (int hk = 0; hk < 3; ++hk) {
                        f32x4 sv[8];
#pragma unroll
                        for (int q = 0; q < 8; ++q) sv[q] = *(const LAS f32x4*)(xg + 32 * hk + 4 * q);
                        __builtin_amdgcn_sched_barrier(0);
#pragma unroll
                        for (int q = 0; q < 8; ++q) { const f32x4 sq = sv[q]; const int k0 = 32 * hk + 4 * q; (q & 1 ? g2 : g) += sq.x * wg[k0] + sq.y * wg[k0 + 1] + sq.z * wg[k0 + 2] + sq.w * wg[k0 + 3]; }
                        __builtin_amdgcn_sched_barrier(0);
                    }
                    gg[tok] = g + g2;
                }
            }
            {
                asm volatile("" ::: "memory");
                float ww0[32], ww1[32];
                const f32x4* w4 = (const f32x4*)(F.ws + WS_W4) + ((size_t)l * 56 + 24) * 512 + c;
#pragma unroll
                for (int k4 = 0; k4 < 8; ++k4) { const f32x4 t = w4[0], u = w4[8 * 512]; w4 += 512; asm volatile("" : "+v"(w4));
                    ww0[4 * k4] = t.x; ww0[4 * k4 + 1] = t.y; ww0[4 * k4 + 2] = t.z; ww0[4 * k4 + 3] = t.w; ww1[4 * k4] = u.x; ww1[4 * k4 + 1] = u.y; ww1[4 * k4 + 2] = u.z; ww1[4 * k4 + 3] = u.w; }
                const float b0 = F.in[I_W0][(l * 2 + 0) * 512 + c], b1 = F.in[I_W0][(l * 2 + 1) * 512 + c];
#pragma unroll
                for (int tok = 0; tok < TG; ++tok) {
                    float z0 = b0, z1 = b1; const LAS float* xw = sm + (tb + tok) * 160;
                    f32x4 sv[8];
#pragma unroll
                    for (int q = 0; q < 8; ++q) sv[q] = *(const LAS f32x4*)(xw + 4 * q);
                    __builtin_amdgcn_sched_barrier(0);
#pragma unroll
                    for (int q = 0; q < 8; ++q) { const f32x4 sq = sv[q];
                        z0 += sq.x * ww0[4 * q] + sq.y * ww0[4 * q + 1] + sq.z * ww0[4 * q + 2] + sq.w * ww0[4 * q + 3];
                        z1 += sq.x * ww1[4 * q] + sq.y * ww1[4 * q + 1] + sq.z * ww1[4 * q + 2] + sq.w * ww1[4 * q + 3]; }
                    const float sp0 = fmaxf(-z0, 0.f) + __logf(1.0f + __expf(-fabsf(z0))), sp1 = fmaxf(-z1, 0.f) + __logf(1.0f + __expf(-fabsf(z1)));
                    dc0[tok] = __expf(-__expf(-sp0 - 0.5f)); dc1[tok] = __expf(-__expf(-sp1 - 0.5f));
                    __builtin_amdgcn_sched_barrier(0);
                }
            }
            {
                asm volatile("" ::: "memory");
                float wa0[32], wa1[32];
                const f32x4* w4 = (const f32x4*)(F.ws + WS_W4) + ((size_t)l * 56 + 40) * 512 + c;
#pragma unroll
                for (int k4 = 0; k4 < 8; ++k4) { const f32x4 t = w4[0], u = w4[8 * 512]; w4 += 512; asm volatile("" : "+v"(w4));
                    wa0[4 * k4] = t.x; wa0[4 * k4 + 1] = t.y; wa0[4 * k4 + 2] = t.z; wa0[4 * k4 + 3] = t.w; wa1[4 * k4] = u.x; wa1[4 * k4 + 1] = u.y; wa1[4 * k4 + 2] = u.z; wa1[4 * k4 + 3] = u.w; }
                const float a0b0 = F.in[I_A0][(l * 2 + 0) * 512 + c], a0b1 = F.in[I_A0][(l * 2 + 1) * 512 + c];
                const float kkc = F.in[I_KK][l * 512 + c], kac = F.in[I_KA][l * 512 + c], rkc = F.in[I_RK][l * 512 + c];
                const float mur = mu[c], muk = mu[512 + c], muv = mu[1024 + c];
                const LAS bf16_t* pr = TC + tb * TC_PITCH + c;
                float pr_r = bf2f(pr[0]), pr_k = bf2f(pr[512]), pr_v = bf2f(pr[1024]);
                float cu_r = bf2f(pr[TC_PITCH]), cu_k = bf2f(pr[TC_PITCH + 512]), cu_v = bf2f(pr[TC_PITCH + 1024]);
#pragma unroll
                for (int tok = 0; tok < TG; ++tok) {
                    const LAS bf16_t* p = pr + (tok + 2) * TC_PITCH; const int m = m0 + tb + tok;
                    const float nx_r = bf2f(p[0]), nx_k = bf2f(p[512]), nx_v = bf2f(p[1024]);
                    const float r = cu_r + mur * (0.5f * (pr_r + nx_r) - cu_r), k = cu_k + muk * (0.5f * (pr_k + nx_k) - cu_k), v = cu_v + muv * (0.5f * (pr_v + nx_v) - cu_v);
                    pr_r = cu_r; pr_k = cu_k; pr_v = cu_v; cu_r = nx_r; cu_k = nx_k; cu_v = nx_v;
                    const float kkr = k * kkc; const float kk = kkr * rsqrtf(wave_sum_fast(kkr * kkr) + 1e-12f);
                    float za0 = a0b0, za1 = a0b1; const LAS float* xa = sm + (tb + tok) * 160 + 32;
                    f32x4 sv[8];
#pragma unroll
                    for (int q = 0; q < 8; ++q) sv[q] = *(const LAS f32x4*)(xa + 4 * q);
                    __builtin_amdgcn_sched_barrier(0);
#pragma unroll
                    for (int q = 0; q < 8; ++q) { const f32x4 sq = sv[q];
                        za0 += sq.x * wa0[4 * q] + sq.y * wa0[4 * q + 1] + sq.z * wa0[4 * q + 2] + sq.w * wa0[4 * q + 3];
                        za1 += sq.x * wa1[4 * q] + sq.y * wa1[4 * q + 1] + sq.z * wa1[4 * q + 2] + sq.w * wa1[4 * q + 3]; }
                    const float a0 = sigmoidf_(za0), a1 = sigmoidf_(za1);
                    const float kd0 = k * (1.0f + (a0 - 1.0f) * kac), kd1 = k * (1.0f + (a1 - 1.0f) * kac);
                    const float bs = wave_sum_fast(r * (kd0 + kd1) * rkc);
                    f32x4* base = (f32x4*)(SCAN + ((size_t)m * 8 + h) * 768) + i;
                    base[0] = (f32x4){r, v, kk, bs * v}; base[64] = (f32x4){dc0[tok], kd0, kk * a0, gg[tok]}; base[128] = (f32x4){dc1[tok], kd1, kk * a1, 0.f};
                    __builtin_amdgcn_sched_barrier(0);
                }
            }
            TS_MARK(5);
        }
        __syncthreads();
    }
}

__device__ __forceinline__ float fma_s(float a, float b, float c) { float r; asm("v_fma_f32 %0, %1, %2, %3" : "=v"(r) : "v"(a), "v"(b), "v"(c)); return r; }
__device__ __forceinline__ float mul_s(float a, float b) { float r; asm("v_mul_f32_e32 %0, %1, %2" : "=v"(r) : "v"(a), "v"(b)); return r; }
struct ScanOps { f32x4 r4a, r4b, kk4a, kk4b, w4a, w4b, kd4a, kd4b, ka4a, ka4b; float v0; };
template <int CTRL> __device__ __forceinline__ float dpp_add_q(float x) { const int y = __builtin_amdgcn_update_dpp(0, __float_as_int(x), CTRL, 0xf, 0xf, false); return x + __int_as_float(y); }
__device__ __forceinline__ float oct_sum(float x) {
    x = dpp_add_q<0xB1>(x); x = dpp_add_q<0x4E>(x); x = dpp_add_q<0x141>(x); return x;
}
__device__ __forceinline__ void scan_item(Frame& F, int l, bool smp, int b, int h, int d, int half) {
    int tid = F.tid; asm volatile("" : "+v"(tid));
    const int seqlen = smp ? 1024 : 256, seq_base = smp ? MC + b * 1024 : b * 256, nch = seqlen / 16;
    LAS float* opb = (LAS float*)F.lds;
    LAS float* ypb = opb + 2 * 6144;
    const float* SCAN = (const float*)(F.ws + WS_SCAN); float* YB = (float*)(F.ws + WS_YB) + (size_t)d * MT * 512;
#define SCAN_TOK(ci, s) (d ? seqlen - 1 - ((ci) * 16 + (s)) : (ci) * 16 + (s))
    __syncthreads();
    if (tid < 256) {
        const int p = tid >> 3, c = tid & 7, row = half * 32 + p;
        f32x4 sa_ = {0.f, 0.f, 0.f, 0.f}, sb_ = {0.f, 0.f, 0.f, 0.f};
        if (smp) { const float* S0 = F.in[I_ST] + ((((size_t)b * 2 + l) * 2 + d) * 8 + h) * 4096 + row * 64 + 8 * c; sa_ = *(const f32x4*)S0; sb_ = *(const f32x4*)(S0 + 4); }
        __syncthreads();
        for (int ci = 0; ci < nch; ++ci) {
            const LAS float* ob = opb + (ci & 1) * 6144; LAS float* yp = ypb + (ci & 1) * 4096 + p * 8 + c;
#define SC_LD(R, s_) do { const LAS float* o_ = ob + (s_) * 384 + 8 * c; R.r4a = *(const LAS f32x4*)(o_); R.r4b = *(const LAS f32x4*)(o_ + 4); R.kk4a = *(const LAS f32x4*)(o_ + 128); R.kk4b = *(const LAS f32x4*)(o_ + 132); \
                R.w4a = *(const LAS f32x4*)(o_ + 192); R.w4b = *(const LAS f32x4*)(o_ + 196); R.kd4a = *(const LAS f32x4*)(o_ + 256); R.kd4b = *(const LAS f32x4*)(o_ + 260); \
                R.ka4a = *(const LAS f32x4*)(o_ + 320); R.ka4b = *(const LAS f32x4*)(o_ + 324); R.v0 = ob[(s_) * 384 + 64 + row]; } while (0)
#define SC_STEP(R, s_) do { \
                const f32x4 t_ = sa_ * R.kk4a + sb_ * R.kk4b; float d0 = (t_.x + t_.y) + (t_.z + t_.w); \
                d0 = -oct_sum(d0); \
                sa_ = sa_ * R.w4a + (R.ka4a * d0 + R.kd4a * R.v0); sb_ = sb_ * R.w4b + (R.ka4b * d0 + R.kd4b * R.v0); \
                const f32x4 u_ = sa_ * R.r4a + sb_ * R.r4b; yp[(s_) * 256] = (u_.x + u_.y) + (u_.z + u_.w); } while (0)
            ScanOps A, B;
            SC_LD(A, 0);
#pragma unroll 2
            for (int s = 0; s < 16; s += 2) {
                SC_LD(B, s + 1); __builtin_amdgcn_sched_barrier(0);
                SC_STEP(A, s); __builtin_amdgcn_sched_barrier(0);
                if (s + 2 < 16) SC_LD(A, s + 2); __builtin_amdgcn_sched_barrier(0);
                SC_STEP(B, s + 1); __builtin_amdgcn_sched_barrier(0);
            }
#undef SC_LD
#undef SC_STEP
            __syncthreads();
        }
        if (!smp) { float* O = F.out + OUT_ST + ((((size_t)b * 2 + l) * 2 + d) * 8 + h) * 4096 + row * 64 + 8 * c; *(f32x4*)O = sa_; *(f32x4*)(O + 4) = sb_; }
        __syncthreads();
    } else {
        const int ht = tid - 256;
        const int sg2 = (ht >> 6) & 1, sst0 = ht >> 7;
        const int ssrc = (sg2 ? 1 + d : 0) * 256 + (ht & 63) * 4, sdst = 3 * sg2 * 64 + (ht & 63);
        f32x4 stg[8], stg2[8];
#define SCAN_LOAD(R, ci) do { _Pragma("unroll") for (int j = 0; j < 8; ++j) R[j] = *(const f32x4*)(SCAN + ((size_t)(seq_base + SCAN_TOK(ci, sst0 + 2 * j)) * 8 + h) * 768 + ssrc); } while (0)
#define SCAN_STORE(buf) do { _Pragma("unroll") for (int j = 0; j < 8; ++j) { LAS float* dst_ = opb + (buf) * 6144 + (sst0 + 2 * j) * 384 + sdst; dst_[0] = stg[j].x; dst_[64] = stg[j].y; dst_[128] = stg[j].z; } } while (0)
#define SCAN_YRED(ci) do { _Pragma("unroll") for (int j = 0; j < 2; ++j) { const int o_ = ht + 256 * j, s_ = o_ >> 5, rr_ = o_ & 31; const LAS f32x4* q_ = (const LAS f32x4*)(ypb + ((ci) & 1) * 4096 + o_ * 8); \
            const f32x4 t_ = q_[0] + q_[1]; YB[(size_t)(seq_base + SCAN_TOK(ci, s_)) * 512 + h * 64 + half * 32 + rr_] = (t_.x + t_.y) + (t_.z + t_.w); } } while (0)
        SCAN_LOAD(stg, 0); SCAN_STORE(0);
        if (1 < nch) SCAN_LOAD(stg, 1);
        if (2 < nch) SCAN_LOAD(stg2, 2);
        __syncthreads();
        for (int ci = 0; ci < nch; ++ci) {
            if (ci + 1 < nch) { SCAN_STORE((ci + 1) & 1);
#pragma unroll
                for (int j = 0; j < 8; ++j) stg[j] = stg2[j];
                if (ci + 3 < nch) SCAN_LOAD(stg2, ci + 3); }
            if (ci > 0) SCAN_YRED(ci - 1);
            __syncthreads();
        }
        SCAN_YRED(nch - 1);
        __syncthreads();
#undef SCAN_LOAD
#undef SCAN_STORE
#undef SCAN_YRED
    }
#undef SCAN_TOK
}

__device__ __forceinline__ void scan_item_dual(Frame& F, int l, bool smp, int b, int h, int d) {
    int tid = F.tid; asm volatile("" : "+v"(tid));
    const int seqlen = smp ? 1024 : 256, seq_base = smp ? MC + b * 1024 : b * 256, nch = seqlen / 16;
    LAS float* opb = (LAS float*)F.lds;
    LAS float* ypb = opb + 2 * 6144;
    const float* SCAN = (const float*)(F.ws + WS_SCAN); float* YB = (float*)(F.ws + WS_YB) + (size_t)d * MT * 512;
#define SCAN_TOK(ci, s) (d ? seqlen - 1 - ((ci) * 16 + (s)) : (ci) * 16 + (s))
    const int row = tid >> 3, c = tid & 7;
    f32x4 sa_ = {0.f, 0.f, 0.f, 0.f}, sb_ = {0.f, 0.f, 0.f, 0.f};
    if (smp) { const float* S0 = F.in[I_ST] + ((((size_t)b * 2 + l) * 2 + d) * 8 + h) * 4096 + row * 64 + 8 * c; sa_ = *(const f32x4*)S0; sb_ = *(const f32x4*)(S0 + 4); }
    const int sg2 = (tid >> 6) & 1, sst0 = tid >> 7;
    const int ssrc = (sg2 ? 1 + d : 0) * 256 + (tid & 63) * 4, sdst = 3 * sg2 * 64 + (tid & 63);
    f32x4 stg[4], stg2[4];
#define SCAN_LOAD(R, ci) do { _Pragma("unroll") for (int j = 0; j < 4; ++j) R[j] = *(const f32x4*)(SCAN + ((size_t)(seq_base + SCAN_TOK(ci, sst0 + 4 * j)) * 8 + h) * 768 + ssrc); } while (0)
#define SCAN_STORE(buf) do { _Pragma("unroll") for (int j = 0; j < 4; ++j) { LAS float* dst_ = opb + (buf) * 6144 + (sst0 + 4 * j) * 384 + sdst; dst_[0] = stg[j].x; dst_[64] = stg[j].y; dst_[128] = stg[j].z; } } while (0)
    __syncthreads();
    SCAN_LOAD(stg, 0); SCAN_STORE(0);
    if (1 < nch) SCAN_LOAD(stg, 1);
    if (2 < nch) SCAN_LOAD(stg2, 2);
    __syncthreads();
    for (int ci = 0; ci < nch; ++ci) {
        const LAS float* ob = opb + (ci & 1) * 6144; LAS float* yp = ypb + row * 8 + c;
#define SC_LD(R, s_) do { const LAS float* o_ = ob + (s_) * 384 + 8 * c; R.r4a = *(const LAS f32x4*)(o_); R.r4b = *(const LAS f32x4*)(o_ + 4); R.kk4a = *(const LAS f32x4*)(o_ + 128); R.kk4b = *(const LAS f32x4*)(o_ + 132); \
            R.w4a = *(const LAS f32x4*)(o_ + 192); R.w4b = *(const LAS f32x4*)(o_ + 196); R.kd4a = *(const LAS f32x4*)(o_ + 256); R.kd4b = *(const LAS f32x4*)(o_ + 260); \
            R.ka4a = *(const LAS f32x4*)(o_ + 320); R.ka4b = *(const LAS f32x4*)(o_ + 324); R.v0 = ob[(s_) * 384 + 64 + row]; } while (0)
#define SC_STEP(R, s_) do { \
            const f32x4 t_ = sa_ * R.kk4a + sb_ * R.kk4b; float d0 = (t_.x + t_.y) + (t_.z + t_.w); \
            d0 = -oct_sum(d0); \
            sa_ = sa_ * R.w4a + (R.ka4a * d0 + R.kd4a * R.v0); sb_ = sb_ * R.w4b + (R.ka4b * d0 + R.kd4b * R.v0); \
            const f32x4 u_ = sa_ * R.r4a + sb_ * R.r4b; yp[(s_) * 512] = (u_.x + u_.y) + (u_.z + u_.w); } while (0)
        ScanOps A, B;
        SC_LD(A, 0);
#pragma unroll 2
        for (int s = 0; s < 16; s += 2) {
            SC_LD(B, s + 1); __builtin_amdgcn_sched_barrier(0);
            SC_STEP(A, s); __builtin_amdgcn_sched_barrier(0);
            if (s + 2 < 16) SC_LD(A, s + 2); __builtin_amdgcn_sched_barrier(0);
            SC_STEP(B, s + 1); __builtin_amdgcn_sched_barrier(0);
        }
#undef SC_LD
#undef SC_STEP
        __syncthreads();
#pragma unroll
        for (int j = 0; j < 2; ++j) { const int o_ = tid + 512 * j, s_ = o_ >> 6, rr_ = o_ & 63; const LAS f32x4* q_ = (const LAS f32x4*)(ypb + o_ * 8);
            const f32x4 t_ = q_[0] + q_[1]; YB[(size_t)(seq_base + SCAN_TOK(ci, s_)) * 512 + h * 64 + rr_] = (t_.x + t_.y) + (t_.z + t_.w); }
        if (ci + 1 < nch) { SCAN_STORE((ci + 1) & 1);
#pragma unroll
            for (int j = 0; j < 4; ++j) stg[j] = stg2[j];
            if (ci + 3 < nch) SCAN_LOAD(stg2, ci + 3); }
        __syncthreads();
    }
    if (!smp) { float* O = F.out + OUT_ST + ((((size_t)b * 2 + l) * 2 + d) * 8 + h) * 4096 + row * 64 + 8 * c; *(f32x4*)O = sa_; *(f32x4*)(O + 4) = sb_; }
#undef SCAN_TOK
#undef SCAN_LOAD
#undef SCAN_STORE
}

__device__ __forceinline__ void rwkv_combine_bh(Frame& F, int l, bool smp, int b, int h) {
    const int seqlen = smp ? 1024 : 256, seq_base = smp ? MC + b * 1024 : b * 256;
    const float* Y0 = (const float*)(F.ws + WS_YB) + h * 64 + F.lane; const float* Y1 = Y0 + (size_t)MT * 512;
    const float* SC = (const float*)(F.ws + WS_SCAN) + (size_t)h * 768 + F.lane * 4 + 3; bf16_t* MIX = (bf16_t*)(F.ws + WS_MIX) + 1536 + h * 64 + F.lane;
    const float lg = F.in[I_LNG][l * 512 + h * 64 + F.lane], lb = F.in[I_LNB][l * 512 + h * 64 + F.lane];
#pragma unroll 1
    for (int t0 = F.wave * 16; t0 < seqlen; t0 += 128) {
        float y0[16], y1[16], bo[16], gg[16];
#pragma unroll
        for (int u = 0; u < 16; ++u) { const size_t m = (size_t)(seq_base + t0 + u); y0[u] = Y0[m * 512]; y1[u] = Y1[m * 512]; bo[u] = SC[m * 8 * 768]; gg[u] = SC[m * 8 * 768 + 256]; }
#pragma unroll
        for (int u = 0; u < 16; ++u) { const size_t m = (size_t)(seq_base + t0 + u); const float y = y0[u] + y1[u];
            const float mean = wave_sum_fast(y) * (1.0f / 64.0f), dl = y - mean, var = wave_sum_fast(dl * dl) * (1.0f / 64.0f);
            const float yn = dl * rsqrtf(var + GN_EPS) * lg + lb;
            MIX[m * DM] = f2bf((yn + bo[u]) * gg[u]); }
    }
}

__device__ __forceinline__ void mixer_phase(Frame& F, int l, int rep) {
    unsigned* head = (unsigned*)(F.ws + WS_CTL) + CW_QUEUE + 64 * (2 * l + rep);
    unsigned* cnt = (unsigned*)(F.ws + WS_CTL) + CW_CNT + 64 * 160 * (2 * l + rep);
    volatile LAS unsigned* slot = (volatile LAS unsigned*)(F.lds + MISC_OFF);
    const bf16_t* QB = (const bf16_t*)(F.ws + WS_QB); const bf16_t* KB = (const bf16_t*)(F.ws + WS_KB); const bf16_t* VB = (const bf16_t*)(F.ws + WS_VB); bf16_t* MIX = (bf16_t*)(F.ws + WS_MIX);
    for (;;) {
        __syncthreads();
        if (F.tid == 0) slot[0] = atomicAdd(head, 1u);
        __syncthreads();
        const int item = (int)slot[0];
        if (item >= 640) break;
#if defined(TITEM)
        unsigned long long ti0_ = 0; if (l == 0 && rep == 0 && item == TITEM && F.tid == 0) ti0_ = __builtin_amdgcn_s_memrealtime();
#endif
        const bool is_scan = item < 384;
        if (is_scan) { const bool smp = item < 128; int sb_, sh_; unsigned inc_;
            if (smp) { const int u = item; sb_ = u >> 5; sh_ = (u >> 2) & 7; inc_ = 1u; scan_item(F, l, true, sb_, sh_, (u >> 1) & 1, u & 1); }
            else { const int u = item - 128; sb_ = u >> 4; sh_ = (u >> 1) & 7; inc_ = 2u; scan_item_dual(F, l, false, sb_, sh_, u & 1); }
            asm volatile("s_waitcnt vmcnt(0)" ::: "memory"); __syncthreads();
            if (F.tid == 0) { __builtin_amdgcn_fence(__ATOMIC_RELEASE, "agent"); asm volatile("s_waitcnt vmcnt(0)" ::: "memory");
                slot[1] = __hip_atomic_fetch_add(cnt + 64 * ((smp ? 0 : 32) + sb_ * 8 + sh_), inc_, __ATOMIC_RELAXED, __HIP_MEMORY_SCOPE_AGENT) + inc_; }
            __syncthreads();
            if (slot[1] == 4u) {
                if (F.tid == 0) { __builtin_amdgcn_fence(__ATOMIC_ACQUIRE, "agent"); asm volatile("s_waitcnt vmcnt(0)" ::: "memory"); }
                __syncthreads();
                rwkv_combine_bh(F, l, smp, sb_, sh_);
            }
        }
        else {
            size_t row0, kr0; int hq, seq;
            if (item < 512) { const int u = item - 384, b = u >> 5, qb = u & 3; hq = (u >> 2) & 7; row0 = (size_t)MC + b * 1024 + qb * 256; kr0 = (size_t)MC + b * 1280; seq = 1280; }
            else { const int u = item - 512, b = u >> 3; hq = u & 7; row0 = (size_t)b * 256; kr0 = row0; seq = 256; }
            attn::attn_dense_body<attn::bf16>((const attn::bf16*)(QB + row0 * 1024 + hq * 128), (const attn::bf16*)(KB + kr0 * 256 + (hq >> 2) * 128), (const attn::bf16*)(VB + kr0 * 256 + (hq >> 2) * 128), MIX + row0 * DM + hq * 128, seq, (char*)F.ldsg);
        }
#if defined(TITEM)
        if (l == 0 && rep == 0 && item == TITEM && F.tid == 0) ((volatile LAS unsigned long long*)(F.lds + MISC_OFF + 240))[0] = __builtin_amdgcn_s_memrealtime() - ti0_;
#endif
    }
#if defined(TQUIET)
    if (l == 0 && rep == 0 && blockIdx.x == 0) { __syncthreads(); unsigned long long tq0_ = __builtin_amdgcn_s_memrealtime(); scan_item(F, l, true, 0, 0, 0, 0);
        if (F.tid == 0) ((volatile LAS unsigned long long*)(F.lds + MISC_OFF + 240))[0] = __builtin_amdgcn_s_memrealtime() - tq0_; }
#endif
}
constexpr int NPHASE = 2 + 8 * DEPTH;
#ifndef PH_MASK
#define PH_MASK 0xffff
#endif
#ifndef USE_CG_SYNC
#define USE_CG_SYNC 0
#endif
#ifndef REP_MASK
#define REP_MASK 0
#endif
#if ONE_LAUNCH && USE_CG_SYNC
#define GRID_BAR() cg::this_grid().sync()
#elif ONE_LAUNCH
#define GRID_BAR() xcd_barrier(F.bar)
#else
#define GRID_BAR() do {} while (0)
#endif
#define NREP(bit) ((REP_MASK & (bit)) ? 2 : 1)
#define IN(k) (lo <= (k) && (k) < hi)
#ifndef TPROBE_MASK
#define TPROBE_MASK 0
#endif
#if TPROBE_MASK
#define STAMP(k) do { if (blockIdx.x == 0 && F.tid == 0) ((volatile LAS unsigned long long*)(F.lds + MISC_OFF + 64))[k] = __builtin_amdgcn_s_memrealtime(); } while (0)
#else
#define STAMP(k) do {} while (0)
#endif
#define SEAM(k) do { if (IN(k) && IN((k) + 1)) GRID_BAR(); STAMP((k) + 1); } while (0)
template <int L> __device__ __forceinline__ void layer_phases(Frame& F, const int lo, const int hi) {
    constexpr int l = L, pb = 2 + 8 * L;
    if (IN(pb + 0) && (PH_MASK & 4)) {
        pg8::Gemm g{(const bf16_t*)(F.ws + WS_HB), (const bf16_t*)(F.ws + WS_WIN + l * SZ_WIN), MT, DINP, DM}; pg8::StaticOrder S; S.init(MT, DINP, F.G, (int)blockIdx.x);
        pg8::EpiBf16 E{(bf16_t*)(F.ws + WS_PROJ), DINP};
        if (F.G == 256) {
            if (blockIdx.x < 208) { S.init(MT, DINP, 208, (int)blockIdx.x); pg8::gemm_phase<pg8::EpiBf16, pg8::StaticOrder, true, true>(F.lds, g, S, E); }
            else conv_side(F, l, 0, CI_OUT + 2 * CI_G, 48, (int)blockIdx.x - 208);
        } else {
            for (int rep = 0; rep < NREP(4); ++rep) pg8::gemm_phase<pg8::EpiBf16, pg8::StaticOrder, true, true>(F.lds, g, S, E);
            conv_side(F, l, 0, CI_OUT + 2 * CI_G + CI_DN, F.G, (int)blockIdx.x);
        }
    } SEAM(pb + 0);
    if (IN(pb + 1) && (PH_MASK & 8)) { for (int rep = 0; rep < NREP(8); ++rep) p2_prepass(F, l); } SEAM(pb + 1);
    if (IN(pb + 2) && (PH_MASK & 16)) { for (int rep = 0; rep < NREP(16); ++rep) mixer_phase(F, l, rep); } SEAM(pb + 2);
    if (IN(pb + 3) && (PH_MASK & 64)) {
        pg8::Gemm g{(const bf16_t*)(F.ws + WS_MIX), (const bf16_t*)(F.ws + WS_WOUT + l * SZ_WOUT), MT, DM, DM}; pg8::StaticOrder S; S.init(MT, DM, F.G, (int)blockIdx.x);
        pg8::EpiBf16 E{(bf16_t*)(F.ws + WS_OB), DM};
        for (int rep = 0; rep < NREP(64); ++rep) pg8::gemm_phase<pg8::EpiBf16, pg8::StaticOrder, true, true>(F.lds, g, S, E);
    } SEAM(pb + 3);
    if (IN(pb + 4) && (PH_MASK & 128)) { rowpassA(F, l); } SEAM(pb + 4);
    if (IN(pb + 5) && (PH_MASK & 256)) {
        pg8::Gemm g{(const bf16_t*)(F.ws + WS_HB), (const bf16_t*)(F.ws + WS_WGU + l * SZ_WGU), MT, 2 * DFF, DM}; pg8::StaticOrder S; S.init(MT, 2 * DFF, F.G, (int)blockIdx.x);
        pg8::EpiSwiGLU E{(bf16_t*)(F.ws + WS_HID), DFF};
        if (F.G == 256) {
            if (blockIdx.x < 240) { S.init(MT, 2 * DFF, 240, (int)blockIdx.x); pg8::gemm_phase<pg8::EpiSwiGLU, pg8::StaticOrder, true, true>(F.lds, g, S, E); }
            else conv_side(F, l, CI_OUT + 2 * CI_G, CI_DN, 16, (int)blockIdx.x - 240);
        } else
        for (int rep = 0; rep < NREP(256); ++rep) pg8::gemm_phase<pg8::EpiSwiGLU, pg8::StaticOrder, true, true>(F.lds, g, S, E);
    } SEAM(pb + 5);
    if (IN(pb + 6) && (PH_MASK & 512)) {
        pg8::Gemm g{(const bf16_t*)(F.ws + WS_HID), (const bf16_t*)(F.ws + WS_WDN + l * SZ_WDN), MT, DM, DFF}; pg8::StaticOrder S; S.init(MT, DM, F.G, (int)blockIdx.x);
        pg8::EpiBf16 E{(bf16_t*)(F.ws + WS_OB), DM};
        for (int rep = 0; rep < NREP(512); ++rep) pg8::gemm_phase<pg8::EpiBf16, pg8::StaticOrder, true, true>(F.lds, g, S, E);
    } SEAM(pb + 6);
    if (IN(pb + 7) && (PH_MASK & 1024)) { rowpassB(F, l); } SEAM(pb + 7);
}
__global__ void __launch_bounds__(NTHREADS, 2) hybrid_fwd(Args args) {
    extern __shared__ __attribute__((aligned(16))) unsigned char lds[];
    Frame F;
    F.lds = (LAS unsigned char*)lds; F.ldsg = lds; F.in = args.in; F.out = args.out; F.ws = args.ws;
    F.tid = threadIdx.x; F.lane = F.tid & 63; F.wave = __builtin_amdgcn_readfirstlane(F.tid >> 6); F.G = gridDim.x;
    const int lo = args.ph_lo, hi = args.ph_hi;
    if (F.tid < 64) ((LAS unsigned*)(F.lds + MISC_OFF))[F.tid] = 0u;
    __syncthreads();
#if ONE_LAUNCH && !USE_CG_SYNC
    F.bar = xcd_barrier_post((unsigned*)(F.ws + WS_CTL) + CW_BAR, (volatile LAS unsigned*)(F.lds + MISC_OFF) + 8);
#endif
    STAMP(0);
    if (IN(0) && (PH_MASK & 1)) { for (int rep = 0; rep < NREP(1); ++rep) p0_prologue(F); } SEAM(0);
    if (IN(1) && (PH_MASK & 2)) { for (int rep = 0; rep < NREP(2); ++rep) rowpass0(F); } SEAM(1);
    layer_phases<0>(F, lo, hi);
    layer_phases<1>(F, lo, hi);
#if defined(TITEM) || defined(TQUIET) || defined(TSUB)
    if (F.tid == 0) { const unsigned long long tot = ((volatile LAS unsigned long long*)(F.lds + MISC_OFF + 240))[0];
        if (tot) { const unsigned long long t0 = __builtin_amdgcn_s_memrealtime(); while (__builtin_amdgcn_s_memrealtime() - t0 < tot) __builtin_amdgcn_s_sleep(8); } }
#endif
#if TPROBE_MASK
    if (blockIdx.x == 0 && F.tid == 0) {
        volatile LAS unsigned long long* ts = (volatile LAS unsigned long long*)(F.lds + MISC_OFF + 64); unsigned long long tot = 0;
        for (int k = 0; k < NPHASE; ++k) if ((TPROBE_MASK >> k) & 1) tot += ts[k + 1] - ts[k];
        const unsigned long long t0 = __builtin_amdgcn_s_memrealtime(); while (__builtin_amdgcn_s_memrealtime() - t0 < tot) __builtin_amdgcn_s_sleep(8);
    }
#endif
}
#undef IN
#undef SEAM

extern "C" void kernel_launch(void* const* d_in, const int* in_sizes, int n_in, void* d_out, int out_size, void* d_ws, size_t ws_size, hipStream_t stream) {
    static int grid = 0;
    if (grid == 0) {
        if (n_in != N_IN || (size_t)out_size != OUT_TOTAL || ws_size < WS_END) { fprintf(stderr, "kernel_launch: unexpected shapes: n_in %d out %d ws %zu (need %zu)\n", n_in, out_size, ws_size, (size_t)WS_END); grid = -1; return; }
        int dev = 0, cus = 0, per_cu = 0;
        if (hipGetDevice(&dev) != hipSuccess || hipDeviceGetAttribute(&cus, hipDeviceAttributeMultiprocessorCount, dev) != hipSuccess) { grid = -1; return; }
        if (hipFuncSetAttribute((const void*)hybrid_fwd, hipFuncAttributeMaxDynamicSharedMemorySize, LDS_BYTES) != hipSuccess) { fprintf(stderr, "kernel_launch: hipFuncSetAttribute failed\n"); grid = -1; return; }
        if (hipOccupancyMaxActiveBlocksPerMultiprocessor(&per_cu, (const void*)hybrid_fwd, NTHREADS, LDS_BYTES) != hipSuccess || per_cu < 1) { fprintf(stderr, "kernel_launch: occupancy query says %d blocks per CU\n", per_cu); (void)hipGetLastError(); grid = -1; return; }
        grid = cus;
    }
    if (grid < 0) return;
    (void)hipMemsetAsync((char*)d_ws + WS_CTL, 0, CTL_ZERO_BYTES, stream);
    Args a{};
    for (int i = 0; i < N_IN; ++i) a.in[i] = (const float*)d_in[i];
    a.out = (float*)d_out; a.ws = (unsigned char*)d_ws;
#if ONE_LAUNCH
    a.ph_lo = 0; a.ph_hi = NPHASE;
    void* kargs[] = {&a};
    const hipError_t e = hipLaunchCooperativeKernel((const void*)hybrid_fwd, dim3(grid), dim3(NTHREADS), kargs, LDS_BYTES, stream);
    if (e != hipSuccess) fprintf(stderr, "kernel_launch: cooperative launch failed: %s (grid %d)\n", hipGetErrorString(e), grid);
#else
    for (int ph = 0; ph < NPHASE; ++ph) {
        a.ph_lo = ph; a.ph_hi = ph + 1;
        hipLaunchKernelGGL(hybrid_fwd, dim3(grid), dim3(NTHREADS), LDS_BYTES, stream, a);
    }
    const hipError_t le = hipPeekAtLastError();
    if (le != hipSuccess) fprintf(stderr, "kernel_launch: launch failed: %s\n", hipGetErrorName(le));
#endif
}
```

```cpp
#include <hip/hip_runtime.h>
#include <hip/hip_bf16.h>
#include <hip/hip_cooperative_groups.h>
#include <cstdio>
#include <cstdint>
#include <cmath>
namespace cg = cooperative_groups;
#ifndef ONE_LAUNCH
#define ONE_LAUNCH 1
#endif
namespace pg8 {
#define PG8_LAS __attribute__((address_space(3)))
typedef unsigned short bf16_t;
typedef short bf16x8 __attribute__((ext_vector_type(8)));
typedef float f32x4 __attribute__((ext_vector_type(4)));
typedef unsigned u32x4 __attribute__((ext_vector_type(4)));
constexpr int BM = 256, BK = 64, HALF = 128, HTB = HALF * BK * 2  , STAGE_BYTES = 8 * HTB, NXCD = 8, WGM = 8;

__host__ __device__ __forceinline__ int lds_byte(int r, int c) { const int st = (r >> 4) * 2 + (c >> 5), rr = r & 15, cc = c & 31, ob = rr * 64 + cc * 2; return st * 1024 + (ob ^ (((ob >> 9) & 1) << 5)); }
__host__ __device__ __forceinline__ void stage_rc(int b, int& R, int& C) { const int st = b / 1024, sb = b % 1024, swz = sb ^ (((sb >> 9) & 1) << 5); R = (st >> 1) * 16 + swz / 64; C = (st & 1) * 32 + (swz % 64) / 2; }
__host__ __device__ __forceinline__ int perm32(int rho) { const int n = rho >> 4, i = rho & 15; return 8 * (i >> 2) + 4 * n + (i & 3); }

struct Unit { int pm, pn; };
struct Gemm { const bf16_t* A; const bf16_t* Bt; int M, N, K; };

struct StaticOrder {
    int nM, nN, nwg, G, c;
    __host__ __device__ void init(int M, int N, int G_, int c_) { nM = M / BM; nN = N / BM; nwg = nM * nN; G = G_; c = c_; }
    __host__ __device__ bool next(int i, Unit& u) const {
        const long L = (long)i * G + c; if (L >= nwg) return false;
        int wgid = (int)L; { const int q = nwg / NXCD, r = nwg % NXCD, xcd = wgid % NXCD, off = wgid / NXCD; wgid = (xcd < r ? xcd * (q + 1) : r * (q + 1) + (xcd - r) * q) + off; }
        const int nig = WGM * nN, gid = wgid / nig, fm = gid * WGM, gsz = (nM - fm) < WGM ? (nM - fm) : WGM;
        u.pm = fm + ((wgid % nig) % gsz); u.pn = (wgid % nig) / gsz; return true;
    }
    __device__ __forceinline__ void a_ready(const Unit&) const {}
    __device__ __forceinline__ void done(const Unit&) const {}
};

__device__ __forceinline__ unsigned cvt_pk_bf16(float lo, float hi) { unsigned r; asm volatile("v_cvt_pk_bf16_f32 %0, %1, %2" : "=v"(r) : "v"(lo), "v"(hi)); return r; }
struct EpiBf16 {
    static constexpr bool PERM = true, AFTER_DRAIN = false;
    bf16_t* O; int ldc;
    __device__ __forceinline__ void operator()(const f32x4 (&acc)[2][2][4][2], const Unit& u, int wr, int wc, int fr, int fq) const {
        const int row0 = u.pm * BM + wr * 64 + fr; const int col0 = u.pn * BM + wc * 32 + 8 * fq;
#pragma unroll
        for (int ai = 0; ai < 2; ++ai)
#pragma unroll
            for (int m = 0; m < 4; ++m) { bf16_t* rowp = O + (size_t)(row0 + ai * HALF + m * 16) * ldc + col0;
#pragma unroll
                for (int bj = 0; bj < 2; ++bj) { const f32x4 v0 = acc[ai][bj][m][0], v1 = acc[ai][bj][m][1];
                    u32x4 w; w.x = cvt_pk_bf16(v0[0], v0[1]); w.y = cvt_pk_bf16(v0[2], v0[3]); w.z = cvt_pk_bf16(v1[0], v1[1]); w.w = cvt_pk_bf16(v1[2], v1[3]);
                    *(u32x4*)(rowp + bj * HALF) = w; } }
    }
};
struct EpiBf16WT {
    static constexpr bool PERM = true, AFTER_DRAIN = false;
    bf16_t* O; int ldc;
    __device__ __forceinline__ void operator()(const f32x4 (&acc)[2][2][4][2], const Unit& u, int wr, int wc, int fr, int fq) const {
        const int row0 = u.pm * BM + wr * 64 + fr; const int col0 = u.pn * BM + wc * 32 + 8 * fq;
#pragma unroll
        for (int ai = 0; ai < 2; ++ai)
#pragma unroll
            for (int m = 0; m < 4; ++m) { bf16_t* rowp = O + (size_t)(row0 + ai * HALF + m * 16) * ldc + col0;
#pragma unroll
                for (int bj = 0; bj < 2; ++bj) { const f32x4 v0 = acc[ai][bj][m][0], v1 = acc[ai][bj][m][1];
                    const unsigned long long lo = (unsigned long long)cvt_pk_bf16(v0[0], v0[1]) | ((unsigned long long)cvt_pk_bf16(v0[2], v0[3]) << 32), hi = (unsigned long long)cvt_pk_bf16(v1[0], v1[1]) | ((unsigned long long)cvt_pk_bf16(v1[2], v1[3]) << 32);
                    unsigned long long* q = (unsigned long long*)(rowp + bj * HALF);
                    __hip_atomic_store(q, lo, __ATOMIC_RELAXED, __HIP_MEMORY_SCOPE_AGENT); __hip_atomic_store(q + 1, hi, __ATOMIC_RELAXED, __HIP_MEMORY_SCOPE_AGENT); } }
    }
};
struct EpiF32 {
    static constexpr bool PERM = false, AFTER_DRAIN = false;
    float* O; int ldc;
    __device__ __forceinline__ void operator()(const f32x4 (&acc)[2][2][4][2], const Unit& u, int wr, int wc, int fr, int fq) const {
        const int row0 = u.pm * BM + wr * 64 + fr; const int col0 = u.pn * BM + wc * 32 + 4 * fq;
#pragma unroll
        for (int ai = 0; ai < 2; ++ai)
#pragma unroll
            for (int m = 0; m < 4; ++m) { float* rowp = O + (size_t)(row0 + ai * HALF + m * 16) * ldc + col0;
#pragma unroll
                for (int bj = 0; bj < 2; ++bj)
#pragma unroll
                    for (int n = 0; n < 2; ++n) *(f32x4*)(rowp + bj * HALF + n * 16) = acc[ai][bj][m][n]; }
    }
};
__device__ __forceinline__ float silu_mul(float g, float u) { return g * __builtin_amdgcn_rcpf(1.0f + __expf(-g)) * u; }
struct EpiSwiGLU {
    static constexpr bool PERM = true, AFTER_DRAIN = false;
    bf16_t* O; int ldc;
    __device__ __forceinline__ void operator()(const f32x4 (&acc)[2][2][4][2], const Unit& u, int wr, int wc, int fr, int fq) const {
        const int row0 = u.pm * BM + wr * 64 + fr; const int col0 = u.pn * HALF + wc * 32 + 8 * fq;
#pragma unroll
        for (int ai = 0; ai < 2; ++ai)
#pragma unroll
            for (int m = 0; m < 4; ++m) { bf16_t* rowp = O + (size_t)(row0 + ai * HALF + m * 16) * ldc + col0;
                const f32x4 g0 = acc[ai][0][m][0], g1 = acc[ai][0][m][1], u0 = acc[ai][1][m][0], u1 = acc[ai][1][m][1];
                u32x4 w; w.x = cvt_pk_bf16(silu_mul(g0[0], u0[0]), silu_mul(g0[1], u0[1])); w.y = cvt_pk_bf16(silu_mul(g0[2], u0[2]), silu_mul(g0[3], u0[3]));
                w.z = cvt_pk_bf16(silu_mul(g1[0], u1[0]), silu_mul(g1[1], u1[1])); w.w = cvt_pk_bf16(silu_mul(g1[2], u1[2]), silu_mul(g1[3], u1[3]));
                *(u32x4*)rowp = w; }
    }
};
template <class Epi, class Sched, bool ALIGN_EPI = false, bool SP2 = false>
__device__ __forceinline__ void gemm_phase(PG8_LAS unsigned char* lds, const Gemm g, const Sched& S, const Epi& E) {
    const int tid = threadIdx.x, wid = __builtin_amdgcn_readfirstlane(tid >> 6), lane = tid & 63, wr = wid >> 2, wc = wid & 3, fr = lane & 15, fq = lane >> 4;
    const int K = g.K, nt = K / BK;
    unsigned voffA[2], voffB[2];
#pragma unroll
    for (int i = 0; i < 2; ++i) { int R, C; stage_rc(tid * 16 + i * 8192, R, C); const int Rb = Epi::PERM ? ((R & ~31) + perm32(R & 31)) : R;
        voffA[i] = (unsigned)(R * K + C) * 2u; voffB[i] = (unsigned)(Rb * K + C) * 2u; }
    const size_t kstep = (size_t)(BK * 2);
    const size_t hstep = (size_t)HALF * K * 2;
    const size_t tstep = 2 * hstep;
    const unsigned ldsw = (unsigned)wid * 1024u;
    const int aoff = lds_byte(wr * 64 + fr, fq * 8), boff = lds_byte(wc * 32 + fr, fq * 8);
#define PG8_SA(b, h) (((b) * 2 + (h)) * HTB)
#define PG8_SB(b, h) ((4 + (b) * 2 + (h)) * HTB)
#define PG8_STAGE(bufoff, gbase, voff) do { _Pragma("unroll") for (int _i = 0; _i < 2; ++_i) \
        __builtin_amdgcn_global_load_lds((const unsigned*)((const char*)(gbase) + (voff)[_i]), (PG8_LAS unsigned*)(lds + (bufoff) + ldsw + _i * 8192), 16, 0, 0); } while (0)
#define PG8_LDA(dst, b, h) do { _Pragma("unroll") for (int m = 0; m < 4; ++m) _Pragma("unroll") for (int k = 0; k < 2; ++k) dst[m][k] = *(const PG8_LAS bf16x8*)(lds + PG8_SA(b, h) + aoff + m * 2048 + k * 1024); } while (0)
#define PG8_LDB(dst, b, h) do { _Pragma("unroll") for (int n = 0; n < 2; ++n) _Pragma("unroll") for (int k = 0; k < 2; ++k) dst[n][k] = *(const PG8_LAS bf16x8*)(lds + PG8_SB(b, h) + boff + n * 2048 + k * 1024); } while (0)
#define PG8_MMA(ai, bj, At, Bt) do { __builtin_amdgcn_s_setprio(1); _Pragma("unroll") for (int m = 0; m < 4; ++m) _Pragma("unroll") for (int n = 0; n < 2; ++n) _Pragma("unroll") for (int k = 0; k < 2; ++k) \
        acc[ai][bj][m][n] = __builtin_amdgcn_mfma_f32_16x16x32_bf16(Bt[n][k], At[m][k], acc[ai][bj][m][n], 0, 0, 0); __builtin_amdgcn_s_setprio(0); } while (0)
#define PG8_WAIT_V(n) asm volatile("s_waitcnt vmcnt(" #n ")" ::: "memory")
#define PG8_WAIT_L(n) asm volatile("s_waitcnt lgkmcnt(" #n ")" ::: "memory")
#define PG8_BAR __builtin_amdgcn_s_barrier()
#define PG8_SCHED __builtin_amdgcn_sched_barrier(0)
    Unit cur, nxt; int ui = 0;
    if (!S.next(0, cur)) return;
    f32x4 acc[2][2][4][2];
#pragma unroll
    for (int a = 0; a < 2; ++a)
#pragma unroll
        for (int b = 0; b < 2; ++b)
#pragma unroll
            for (int m = 0; m < 4; ++m)
#pragma unroll
                for (int n = 0; n < 2; ++n) acc[a][b][m][n] = (f32x4){0.f, 0.f, 0.f, 0.f};
    bf16x8 At[4][2], B0[2][2], B1[2][2];
    const char* cA = (const char*)g.A + (size_t)cur.pm * tstep; const char* cB = (const char*)g.Bt + (size_t)cur.pn * tstep;
    S.a_ready(cur);
    if constexpr (SP2) {
        PG8_STAGE(PG8_SB(0, 0), cB, voffB); PG8_STAGE(PG8_SB(0, 1), cB + hstep, voffB); PG8_STAGE(PG8_SA(0, 0), cA, voffA); PG8_STAGE(PG8_SA(0, 1), cA + hstep, voffA);
        if (wr == 1) PG8_BAR;
        PG8_WAIT_V(2); PG8_BAR;
        PG8_STAGE(PG8_SB(1, 0), cB + kstep, voffB); PG8_STAGE(PG8_SA(1, 0), cA + kstep, voffA); PG8_STAGE(PG8_SB(1, 1), cB + hstep + kstep, voffB);
        PG8_WAIT_V(6); PG8_BAR;
    } else {
        PG8_STAGE(PG8_SB(0, 0), cB, voffB); PG8_STAGE(PG8_SA(0, 0), cA, voffA); PG8_STAGE(PG8_SB(0, 1), cB + hstep, voffB); PG8_STAGE(PG8_SA(0, 1), cA + hstep, voffA);
        if (wr == 1) PG8_BAR;
        PG8_WAIT_V(4); PG8_BAR;
        PG8_STAGE(PG8_SB(1, 0), cB + kstep, voffB); PG8_STAGE(PG8_SA(1, 0), cA + kstep, voffA); PG8_STAGE(PG8_SB(1, 1), cB + hstep + kstep, voffB);
        PG8_WAIT_V(6); PG8_BAR;
    }
    for (;;) {
        const bool has_next = S.next(ui + 1, nxt);
        const char* nA = has_next ? (const char*)g.A + (size_t)nxt.pm * tstep : cA; const char* nB = has_next ? (const char*)g.Bt + (size_t)nxt.pn * tstep : cB;
        for (int t = 0; t < nt; t += 2) {
            const bool last = (t == nt - 2);
            const char* a1 = cA + (size_t)(t + 1) * kstep;
            const char* a2 = last ? nA : cA + (size_t)(t + 2) * kstep; const char* b2 = last ? nB : cB + (size_t)(t + 2) * kstep;
            const char* a3 = a2 + kstep; const char* b3 = b2 + kstep;
            if (last && has_next) S.a_ready(nxt);
            if constexpr (SP2) {
            PG8_LDB(B0, 0, 0); PG8_LDB(B1, 0, 1); PG8_SCHED; PG8_LDA(At, 0, 0); PG8_STAGE(PG8_SA(1, 1), a1 + hstep, voffA);
            PG8_WAIT_V(8); PG8_WAIT_L(0); PG8_BAR; PG8_MMA(0, 0, At, B0); PG8_MMA(0, 1, At, B1); PG8_BAR; PG8_SCHED;
            PG8_LDA(At, 0, 1); PG8_STAGE(PG8_SB(0, 0), b2, voffB); PG8_STAGE(PG8_SB(0, 1), b2 + hstep, voffB); PG8_STAGE(PG8_SA(0, 0), a2, voffA);
            PG8_WAIT_V(8); PG8_WAIT_L(0); PG8_BAR; PG8_MMA(1, 0, At, B0); PG8_MMA(1, 1, At, B1); PG8_BAR; PG8_SCHED;
            PG8_LDB(B0, 1, 0); PG8_LDB(B1, 1, 1); PG8_SCHED; PG8_LDA(At, 1, 0); PG8_STAGE(PG8_SA(0, 1), a2 + hstep, voffA);
            PG8_WAIT_V(8); PG8_WAIT_L(0); PG8_BAR; PG8_MMA(0, 0, At, B0); PG8_MMA(0, 1, At, B1); PG8_BAR; PG8_SCHED;
            PG8_LDA(At, 1, 1); PG8_STAGE(PG8_SB(1, 0), b3, voffB); PG8_STAGE(PG8_SB(1, 1), b3 + hstep, voffB); PG8_STAGE(PG8_SA(1, 0), a3, voffA);
            PG8_WAIT_V(8); PG8_WAIT_L(0); PG8_BAR; PG8_MMA(1, 0, At, B0); PG8_MMA(1, 1, At, B1); PG8_BAR; PG8_SCHED;
            } else {
            PG8_LDB(B0, 0, 0); PG8_SCHED; PG8_LDA(At, 0, 0); PG8_STAGE(PG8_SA(1, 1), a1 + hstep, voffA);
            PG8_WAIT_L(8); PG8_BAR; PG8_WAIT_L(0); PG8_MMA(0, 0, At, B0); PG8_BAR; PG8_SCHED;
            PG8_LDB(B1, 0, 1); PG8_STAGE(PG8_SB(0, 0), b2, voffB);
            PG8_BAR; PG8_WAIT_L(0); PG8_MMA(0, 1, At, B1); PG8_BAR;
            PG8_LDA(At, 0, 1); PG8_STAGE(PG8_SA(0, 0), a2, voffA);
            PG8_BAR; PG8_WAIT_L(0); PG8_MMA(1, 0, At, B0); PG8_BAR; PG8_SCHED;
            PG8_STAGE(PG8_SB(0, 1), b2 + hstep, voffB);
            PG8_WAIT_V(6); PG8_BAR; PG8_MMA(1, 1, At, B1); PG8_BAR;
            PG8_LDB(B0, 1, 0); PG8_SCHED; PG8_LDA(At, 1, 0); PG8_STAGE(PG8_SA(0, 1), a2 + hstep, voffA);
            PG8_WAIT_L(8); PG8_BAR; PG8_WAIT_L(0); PG8_MMA(0, 0, At, B0); PG8_BAR; PG8_SCHED;
            PG8_LDB(B1, 1, 1); PG8_STAGE(PG8_SB(1, 0), b3, voffB);
            PG8_BAR; PG8_WAIT_L(0); PG8_MMA(0, 1, At, B1); PG8_BAR;
            PG8_LDA(At, 1, 1); PG8_STAGE(PG8_SA(1, 0), a3, voffA);
            PG8_BAR; PG8_WAIT_L(0); PG8_MMA(1, 0, At, B0); PG8_BAR; PG8_SCHED;
            PG8_STAGE(PG8_SB(1, 1), b3 + hstep, voffB);
            PG8_WAIT_V(6); PG8_BAR; PG8_MMA(1, 1, At, B1); PG8_BAR;
            }
        }
        if constexpr (ALIGN_EPI) { if (wr == 0) PG8_BAR; }
        if constexpr (!Epi::AFTER_DRAIN) { E(acc, cur, wr, wc, fr, fq); S.done(cur); }
        if (!has_next) break;
#pragma unroll
        for (int a = 0; a < 2; ++a)
#pragma unroll
            for (int b = 0; b < 2; ++b)
#pragma unroll
                for (int m = 0; m < 4; ++m)
#pragma unroll
                    for (int n = 0; n < 2; ++n) acc[a][b][m][n] = (f32x4){0.f, 0.f, 0.f, 0.f};
        cur = nxt; cA = nA; cB = nB; ++ui;
        if constexpr (ALIGN_EPI) { if (wr == 1) PG8_BAR; }
    }
    PG8_WAIT_V(0);
    if constexpr (!ALIGN_EPI) { if (wr == 0) PG8_BAR; }
    PG8_BAR;
    if constexpr (Epi::AFTER_DRAIN) { E.fused(acc, cur, wr, wc, fr, fq, lds, wid, lane); S.done(cur); }
#undef PG8_SA
#undef PG8_SB
#undef PG8_STAGE
#undef PG8_LDA
#undef PG8_LDB
#undef PG8_MMA
#undef PG8_WAIT_V
#undef PG8_WAIT_L
#undef PG8_BAR
#undef PG8_SCHED
}
}
namespace attn {
using bf16 = __hip_bfloat16;
constexpr int   D = 128, NW = 8, QBLK = 32, KVBLK = 64;
constexpr float SCALE = 0.088388347648318440f;
constexpr float THR = 8.f;
constexpr int SDEPTH = 2;
constexpr int LDQ = 1024, LDK = 256, LDO = 2048;
constexpr size_t SHM_V = KVBLK * D * 2, SHM_K = KVBLK * D * 2, SHM_ATTN = 2 * SHM_V + 2 * SHM_K + NW * 64 * 4;
__device__ __forceinline__ unsigned short f2bf_rne(float f) { unsigned u = __builtin_bit_cast(unsigned, f); return (unsigned short)((u + 0x7fffu + ((u >> 16) & 1u)) >> 16); }
using bf16x8 = __attribute__((ext_vector_type(8))) short;
using s16x4  = __attribute__((ext_vector_type(4))) short;
using f32x16 = __attribute__((ext_vector_type(16))) float;
using f32x8  = __attribute__((ext_vector_type(8))) float;
using u32x4  = __attribute__((ext_vector_type(4))) unsigned;
#define KSWZ(row, colB) ((row) * 256 + ((colB) ^ (((row) & 7) << 4)))
#define SBAR() __builtin_amdgcn_sched_barrier(0)
__device__ __forceinline__ int crow(int r, int hi) { return (r & 3) + 8 * (r >> 2) + 4 * hi; }
__device__ __forceinline__ unsigned cvtpk(float lo, float hi) {
  unsigned r; asm volatile("v_cvt_pk_bf16_f32 %0, %1, %2" : "=v"(r) : "v"(lo), "v"(hi)); return r;
}
template <typename TIn> struct Stage;
template <> struct Stage<bf16>  { using T = bf16x8;
  __device__ static __forceinline__ T ld8(const bf16* p) { return *reinterpret_cast<const bf16x8*>(p); }
  __device__ static __forceinline__ bf16x8 tobf(T x) { return x; } };
template <> struct Stage<float> { using T = f32x8;
  __device__ static __forceinline__ T ld8(const float* p) { return *reinterpret_cast<const f32x8*>(p); }
  __device__ static __forceinline__ bf16x8 tobf(T x) {
    u32x4 w = {cvtpk(x[0], x[1]), cvtpk(x[2], x[3]), cvtpk(x[4], x[5]), cvtpk(x[6], x[7])}; return *reinterpret_cast<bf16x8*>(&w); } };

__device__ __forceinline__ void partialSM(f32x16& p0, f32x16& p1, float& m_reg, float& mn, float& alpha) {
  constexpr float C = SCALE * 1.4426950408889634f;
  float pmax = p0[0]; for (int r = 1; r < 16; ++r) pmax = fmaxf(pmax, p0[r]); for (int r = 0; r < 16; ++r) pmax = fmaxf(pmax, p1[r]);
  { auto rr = __builtin_amdgcn_permlane32_swap(__float_as_uint(pmax), __float_as_uint(pmax), false, false);
    pmax = fmaxf(__uint_as_float(rr[0]), __uint_as_float(rr[1])); }
  if (__builtin_expect(__all(pmax - m_reg <= THR / SCALE), 1)) { mn = m_reg; alpha = 1.f; }
  else { mn = fmaxf(m_reg, pmax); alpha = __builtin_amdgcn_exp2f((m_reg - mn) * C); m_reg = mn; }
  float mnC = -mn * C;
  for (int r = 0; r < 16; ++r) p0[r] = fmaf(p0[r], C, mnC); for (int r = 0; r < 16; ++r) p1[r] = fmaf(p1[r], C, mnC);
  for (int r = 0; r < 16; ++r) p0[r] = __builtin_amdgcn_exp2f(p0[r]);
}
__device__ __forceinline__ void finishSM(f32x16& p0, f32x16& p1, float alpha, float& l_reg, bf16x8& pa0, bf16x8& pa1, bf16x8& pa2, bf16x8& pa3) {
  for (int r = 0; r < 16; ++r) p1[r] = __builtin_amdgcn_exp2f(p1[r]);
  float ps = 0; for (int r = 0; r < 16; ++r) ps += p0[r]; for (int r = 0; r < 16; ++r) ps += p1[r];
  { auto rr = __builtin_amdgcn_permlane32_swap(__float_as_uint(ps), __float_as_uint(ps), false, false);
    ps = __uint_as_float(rr[0]) + __uint_as_float(rr[1]); }
  l_reg = l_reg * alpha + ps;
#define PK4(P, BASE, OUT) do { unsigned a0 = cvtpk(P[BASE + 0], P[BASE + 1]), a1 = cvtpk(P[BASE + 2], P[BASE + 3]);   \
    unsigned b0 = cvtpk(P[BASE + 4], P[BASE + 5]), b1 = cvtpk(P[BASE + 6], P[BASE + 7]);                              \
    auto r0 = __builtin_amdgcn_permlane32_swap(a0, b0, false, false); auto r1 = __builtin_amdgcn_permlane32_swap(a1, b1, false, false); \
    u32x4 w = {r0[0], r1[0], r0[1], r1[1]}; OUT = *reinterpret_cast<bf16x8*>(&w); } while (0)
  PK4(p0, 0, pa0); PK4(p0, 8, pa1); PK4(p1, 0, pa2); PK4(p1, 8, pa3);
#undef PK4
}
__device__ __forceinline__ void qkt(f32x16& p0, f32x16& p1, const bf16* Ks, const bf16x8* qr, int r32, int hi) {
  p0 = f32x16{}; p1 = f32x16{};
  for (int d0 = 0; d0 < 8; ++d0) { int cb = (d0 * 16 + hi * 8) * 2;
    bf16x8 b0 = *reinterpret_cast<const bf16x8*>((const char*)Ks + KSWZ(r32, cb));
    bf16x8 b1 = *reinterpret_cast<const bf16x8*>((const char*)Ks + KSWZ(32 + r32, cb));
    p0 = __builtin_amdgcn_mfma_f32_32x32x16_bf16(b0, qr[d0], p0, 0, 0, 0);
    p1 = __builtin_amdgcn_mfma_f32_32x32x16_bf16(b1, qr[d0], p1, 0, 0, 0); }
}
__device__ __forceinline__ int v_st(int k, int c) { const int kk = (k & ~0xC) | ((k & 4) << 1) | ((k & 8) >> 1); return ((kk >> 3) * 4 + (c >> 5)) * 512 + ((kk & 7) * 32 + (c & 31)) * 2; }
__device__ __forceinline__ int v_rd_base(int lane) { return ((lane & 3) << 3) | (((lane >> 2) & 3) << 6) | (((lane >> 4) & 1) << 5) | (((lane >> 5) & 1) << 8); }
constexpr int v_rd_off(int d0, int ks, int half) { return d0 * 512 + ks * 4096 + half * 2048; }
template <int OFF> __device__ __forceinline__ s16x4 tr_read(int vb) {
  s16x4 r; asm volatile("ds_read_b64_tr_b16 %0, %1 offset:%2" : "=&v"(r) : "v"(vb), "i"(OFF) : "memory"); return r;
}
template <int D0> __device__ __forceinline__ void pv_one(f32x16& od, int vb, bf16x8 pa0, bf16x8 pa1, bf16x8 pa2, bf16x8 pa3) {
  const s16x4 l0 = tr_read<v_rd_off(D0, 0, 0)>(vb), h0 = tr_read<v_rd_off(D0, 0, 1)>(vb), l1 = tr_read<v_rd_off(D0, 1, 0)>(vb), h1 = tr_read<v_rd_off(D0, 1, 1)>(vb);
  const s16x4 l2 = tr_read<v_rd_off(D0, 2, 0)>(vb), h2 = tr_read<v_rd_off(D0, 2, 1)>(vb), l3 = tr_read<v_rd_off(D0, 3, 0)>(vb), h3 = tr_read<v_rd_off(D0, 3, 1)>(vb);
  asm volatile("s_waitcnt lgkmcnt(0)" ::: "memory"); SBAR();
#define PK(L, H) (bf16x8){L[0], L[1], L[2], L[3], H[0], H[1], H[2], H[3]}
  od = __builtin_amdgcn_mfma_f32_32x32x16_bf16(pa0, PK(l0, h0), od, 0, 0, 0);
  od = __builtin_amdgcn_mfma_f32_32x32x16_bf16(pa1, PK(l1, h1), od, 0, 0, 0);
  od = __builtin_amdgcn_mfma_f32_32x32x16_bf16(pa2, PK(l2, h2), od, 0, 0, 0);
  od = __builtin_amdgcn_mfma_f32_32x32x16_bf16(pa3, PK(l3, h3), od, 0, 0, 0);
#undef PK
}
__device__ __forceinline__ void pv_d0(f32x16* o, int vb, bf16x8 pa0, bf16x8 pa1, bf16x8 pa2, bf16x8 pa3) {
  pv_one<0>(o[0], vb, pa0, pa1, pa2, pa3); pv_one<1>(o[1], vb, pa0, pa1, pa2, pa3); pv_one<2>(o[2], vb, pa0, pa1, pa2, pa3); pv_one<3>(o[3], vb, pa0, pa1, pa2, pa3);
}
template <typename TQ>
__device__ __forceinline__ void attn_dense_body(const TQ* __restrict__ Qb, const bf16* __restrict__ Kh, const bf16* __restrict__ Vh,
                                                unsigned short* __restrict__ Ob, int seq, char* lds) {
  using St = Stage<bf16>; using SQ = Stage<TQ>;
  const int tid = threadIdx.x, wid = tid >> 6, lane = tid & 63, r32 = lane & 31, hi = lane >> 5;
  bf16* V_lds = (bf16*)lds; bf16* K_lds = (bf16*)(lds + 2 * SHM_V);
  float* ws = (float*)(lds + 2 * SHM_V + 2 * SHM_K) + wid * 64; float* li_l = ws; float* al_l = ws + 32;
  float m_reg = -1e30f, l_reg = 0; f32x16 o[4] = {}; bf16x8 qr[8];
  const TQ* Qw = Qb + (long)(wid * QBLK + r32) * LDQ + hi * 8;
#pragma unroll
  for (int d0 = 0; d0 < 8; ++d0) qr[d0] = SQ::tobf(SQ::ld8(Qw + d0 * 16));
  const int sr = tid >> 4, sc = (tid & 15) * 8, vst0 = v_st(sr, sc), vst1 = v_st(32 + sr, sc);
  const int vb0 = (int)(uintptr_t)V_lds + v_rd_base(lane);
  struct { typename St::T vs0, vs1, ks0, ks1; } sr_[SDEPTH];
#define SLOAD(i, k0) do { sr_[i].vs0 = St::ld8(&Vh[(long)((k0) + sr) * LDK + sc]); sr_[i].vs1 = St::ld8(&Vh[(long)((k0) + 32 + sr) * LDK + sc]); \
    sr_[i].ks0 = St::ld8(&Kh[(long)((k0) + sr) * LDK + sc]); sr_[i].ks1 = St::ld8(&Kh[(long)((k0) + 32 + sr) * LDK + sc]); } while (0)
#define SWRITE(b, i) do { *(bf16x8*)((char*)V_lds + (b) * SHM_V + vst0) = St::tobf(sr_[i].vs0);          \
    *(bf16x8*)((char*)V_lds + (b) * SHM_V + vst1) = St::tobf(sr_[i].vs1); int kc = sc * 2;               \
    *(bf16x8*)((char*)K_lds + (b) * SHM_K + KSWZ(sr, kc)) = St::tobf(sr_[i].ks0);                       \
    *(bf16x8*)((char*)K_lds + (b) * SHM_K + KSWZ(32 + sr, kc)) = St::tobf(sr_[i].ks1); } while (0)
#define SWAIT() do { if constexpr (SDEPTH == 2) asm volatile("s_waitcnt vmcnt(4)" ::: "memory"); else asm volatile("s_waitcnt vmcnt(0)" ::: "memory"); } while (0)
#define RESC(a) do { if (__any((a) < 1.f)) { if (hi == 0) al_l[r32] = (a); asm volatile("s_waitcnt lgkmcnt(0)" ::: "memory"); \
    for (int d = 0; d < 4; ++d) for (int r = 0; r < 16; ++r) o[d][r] *= al_l[crow(r, hi)]; } } while (0)
  f32x16 pA0, pA1, pB0, pB1; float mnA, mnB, alA, alB; bf16x8 pa0, pa1, pa2, pa3; const int NT = seq / KVBLK;
  constexpr int SE = 0, SO = SDEPTH - 1;
  SLOAD(SE, 0); asm volatile("s_waitcnt vmcnt(0)" ::: "memory"); SWRITE(0, SE); __syncthreads();
  qkt(pA0, pA1, K_lds, qr, r32, hi); partialSM(pA0, pA1, m_reg, mnA, alA);
  SLOAD(SO, KVBLK); if constexpr (SDEPTH == 2) { if (2 < NT) SLOAD(SE, 2 * KVBLK); }
  SWAIT(); SWRITE(1, SO); __syncthreads();
  for (int j = 1; j + 1 < NT; j += 2) {
    SBAR(); qkt(pB0, pB1, (bf16*)((char*)K_lds + SHM_K), qr, r32, hi);
    finishSM(pA0, pA1, alA, l_reg, pa0, pa1, pa2, pa3); SBAR();
    SLOAD(SO, (j + SDEPTH) * KVBLK); SBAR();
    pv_d0(o, vb0, pa0, pa1, pa2, pa3); partialSM(pB0, pB1, m_reg, mnB, alB);
    __syncthreads(); SWAIT(); SWRITE(0, SE);
    RESC(alB); __syncthreads();
    SBAR(); qkt(pA0, pA1, K_lds, qr, r32, hi);
    finishSM(pB0, pB1, alB, l_reg, pa0, pa1, pa2, pa3); SBAR();
    if (SDEPTH == 1 || j + 3 < NT) SLOAD(SE, (j + 1 + SDEPTH) * KVBLK); SBAR();
    pv_d0(o, vb0 + (int)SHM_V, pa0, pa1, pa2, pa3); partialSM(pA0, pA1, m_reg, mnA, alA);
    __syncthreads(); SWAIT(); SWRITE(1, SO);
    RESC(alA); __syncthreads();
  }
  SBAR(); qkt(pB0, pB1, (bf16*)((char*)K_lds + SHM_K), qr, r32, hi);
  finishSM(pA0, pA1, alA, l_reg, pa0, pa1, pa2, pa3); SBAR();
  pv_d0(o, vb0, pa0, pa1, pa2, pa3); partialSM(pB0, pB1, m_reg, mnB, alB);
  __syncthreads(); RESC(alB);
  finishSM(pB0, pB1, alB, l_reg, pa0, pa1, pa2, pa3); SBAR();
  pv_d0(o, vb0 + (int)SHM_V, pa0, pa1, pa2, pa3);
  if (hi == 0) li_l[r32] = l_reg; asm volatile("s_waitcnt lgkmcnt(0)" ::: "memory");
  float rli[16];
#pragma unroll
  for (int r = 0; r < 16; ++r) rli[r] = __builtin_amdgcn_rcpf(li_l[crow(r, hi)]);
  unsigned short* Ow = Ob + (long)(wid * QBLK) * LDO;
#pragma unroll
  for (int r = 0; r < 16; ++r) { int orow = crow(r, hi);
    for (int d0 = 0; d0 < 4; ++d0) Ow[(long)orow * LDO + d0 * 32 + r32] = f2bf_rne(o[d0][r] * rli[r]); }
#undef SLOAD
#undef SWRITE
#undef SWAIT
#undef RESC
}
}
#ifndef PP_MASK
#define PP_MASK 31
#endif
#ifndef PPR_MASK
#define PPR_MASK 0
#endif
#define GAS __attribute__((address_space(1)))
#define LAS __attribute__((address_space(3)))
typedef unsigned short bf16_t;
typedef float f32x4 __attribute__((ext_vector_type(4)));
typedef float f32x2 __attribute__((ext_vector_type(2)));
typedef unsigned u32x4 __attribute__((ext_vector_type(4)));
typedef unsigned u32x2 __attribute__((ext_vector_type(2)));
typedef __bf16 bf16x2_t __attribute__((ext_vector_type(2)));

constexpr int DM = 2048, MC = 4096, MS = 4096, MT = MC + MS, DEPTH = 2;
constexpr int DIN = 4768, DINP = 4864, DFF = 5632;
constexpr int O_K = 1024, O_V = 1280, O_CB = 1536, O_CC = 2048, O_CH = 2560, O_UR = 3072;
constexpr int KVROWS = 4096 + 4 * 1280;
constexpr float EPS = 1e-6f, GN_EPS = 64e-5f;
constexpr int NWAVES = 8, NTHREADS = 512;
enum { I_XP = 0, I_XS, I_CK, I_CV, I_ST, I_C, I_CCTX, I_WADA, I_BADA, I_NG, I_WIN, I_QN, I_KN, I_CONVW, I_MU, I_W0, I_WUP, I_A0, I_AUP, I_GUP, I_KK, I_KA, I_RK, I_LNG, I_LNB, I_WOUT, I_WGATE, I_WUPF, I_WDOWN, N_IN };
constexpr size_t OUT_Y = 0, OUT_NK = (size_t)MT * DM, OUT_NV = OUT_NK + 2097152, OUT_ST = OUT_NV + 2097152, OUT_TOTAL = OUT_ST + 2097152;
constexpr size_t MiB = 1u << 20;
constexpr size_t WS_CTL = 0, CTL_BYTES = 1 * MiB, CTL_ZERO_BYTES = 256 * 1024;
constexpr size_t WS_WIN = 1 * MiB, SZ_WIN = 19 * MiB;
constexpr size_t WS_WOUT = WS_WIN + 2 * SZ_WIN, SZ_WOUT = 8 * MiB;
constexpr size_t WS_WGU = WS_WOUT + 2 * SZ_WOUT, SZ_WGU = 44 * MiB;
constexpr size_t WS_WDN = WS_WGU + 2 * SZ_WGU, SZ_WDN = 22 * MiB;
constexpr size_t WS_MOD = WS_WDN + 2 * SZ_WDN;
constexpr size_t WS_W4 = WS_MOD + 1 * MiB;
constexpr size_t WS_HB = WS_W4 + 1 * MiB;
constexpr size_t WS_MIX = WS_HB + 32 * MiB;
constexpr size_t WS_XB = WS_MIX + 32 * MiB;
constexpr size_t WS_BG = WS_XB + 32 * MiB;
constexpr size_t WS_R1 = WS_XB + 64 * MiB;
constexpr size_t WS_PROJ = WS_R1;
constexpr size_t WS_QB = WS_R1 + 76 * MiB;
constexpr size_t WS_KB = WS_R1 + 92 * MiB;
constexpr size_t WS_VB = WS_R1 + 97 * MiB;
constexpr size_t WS_SCAN = WS_R1 + 102 * MiB;
constexpr size_t WS_YB = WS_R1 + 294 * MiB;
constexpr size_t WS_OB = WS_R1;
constexpr size_t WS_HID = WS_R1 + 64 * MiB;
constexpr size_t WS_END = WS_R1 + 326 * MiB;
constexpr int CW_BAR = 4096;
constexpr int CW_CNT = 16384;
constexpr int CW_PAN = 16384;
constexpr int CW_QUEUE = 64;
constexpr int RING_BYTES = 131072, LDS_BYTES = 147456, MISC_OFF = LDS_BYTES - 256;

__device__ __forceinline__ float bf2f(bf16_t h) { return __uint_as_float((unsigned)h << 16); }
__device__ __forceinline__ unsigned pk2(float lo, float hi) { f32x2 v = {lo, hi}; bf16x2_t b = __builtin_convertvector(v, bf16x2_t); return __builtin_bit_cast(unsigned, b); }
__device__ __forceinline__ bf16_t f2bf(float f) { return (bf16_t)(pk2(f, 0.f) & 0xffffu); }
__device__ __forceinline__ float wave_sum(float v) {
#pragma unroll
    for (int o = 1; o < 64; o <<= 1) v += __shfl_xor(v, o);
    return v;
}
template <int CTRL> __device__ __forceinline__ float dpp_add(float x) {
    const int y = __builtin_amdgcn_update_dpp(0, __float_as_int(x), CTRL, 0xf, 0xf, false);
    return x + __int_as_float(y);
}
__device__ __forceinline__ float row16_sum(float x) {
    x = dpp_add<0x128>(x); x = dpp_add<0x124>(x); x = dpp_add<0x122>(x); x = dpp_add<0x121>(x); return x;
}
__device__ __forceinline__ float wave_sum_fast(float x) {
    x = row16_sum(x); const int xi = __float_as_int(x);
    return (__int_as_float(__builtin_amdgcn_readlane(xi, 0)) + __int_as_float(__builtin_amdgcn_readlane(xi, 16))) + (__int_as_float(__builtin_amdgcn_readlane(xi, 32)) + __int_as_float(__builtin_amdgcn_readlane(xi, 48)));
}
__device__ __forceinline__ float sigmoidf_(float x) { return 1.0f / (1.0f + __expf(-x)); }

#define XB_TMO      128
#define XB_XCNT(j)  (256  + 64 * (j))
#define XB_XSUB(j)  (1280 + 64 * (j))
#define XB_XGEN(j)  (2304 + 64 * (j))
#define XB_TOP      3328
#define XB_TOPGEN   3392
#define XCD_BAR_WORDS 3456
#define XB_SPIN_CAP (1u << 18)

__device__ __forceinline__ unsigned xb_ld(unsigned* p)              { return __hip_atomic_load(p, __ATOMIC_RELAXED, __HIP_MEMORY_SCOPE_AGENT); }
__device__ __forceinline__ unsigned xb_add(unsigned* p, unsigned v) { return __hip_atomic_fetch_add(p, v, __ATOMIC_RELAXED, __HIP_MEMORY_SCOPE_AGENT); }
__device__ __forceinline__ unsigned xb_xcc_id() { return (unsigned)__builtin_amdgcn_s_getreg((3 << 11) | 20) & 0xFu; }
#define XB_SPIN(cond, bar) do { unsigned _sp = 0; while (cond) { __builtin_amdgcn_s_sleep(1); \
    if ((++_sp & 255u) == 0u) { if (xb_ld(&(bar)[XB_TMO])) break; if (_sp > XB_SPIN_CAP) { atomicAdd(&(bar)[XB_TMO], 1u); break; } } } } while (0)

struct XcdBarrier {
    unsigned* bar; unsigned x;
    volatile LAS unsigned* st;
};

__device__ __forceinline__ XcdBarrier xcd_barrier_post(unsigned* bar, volatile LAS unsigned* st) {
    XcdBarrier b; b.bar = bar; b.x = xb_xcc_id(); b.st = st;
    if (threadIdx.x == 0) (void)xb_add(&bar[XB_XCNT(b.x)], 1u);
    return b;
}
__device__ __forceinline__ void xcd_barrier_complete(unsigned* bar, unsigned x, unsigned& nloc, unsigned& nx) {
    const unsigned G = gridDim.x * gridDim.y * gridDim.z;
    unsigned sum, cnt, mine, sp = 0u;
    for (;;) {
        sum = 0u; cnt = 0u; mine = 0u;
#pragma unroll
        for (unsigned j = 0; j < 16; ++j) { const unsigned c = xb_ld(&bar[XB_XCNT(j)]); sum += c; cnt += (c > 0u) ? 1u : 0u; mine = (j == x) ? c : mine; }
        if (sum == G) break;
        __builtin_amdgcn_s_sleep(1);
        if ((++sp & 255u) == 0u) { if (xb_ld(&bar[XB_TMO])) break; if (sp > XB_SPIN_CAP) { atomicAdd(&bar[XB_TMO], 1u); break; } }
    }
    nloc = mine > 0u ? mine : 1u; nx = cnt > 0u ? cnt : 1u;
}

__device__ __forceinline__ void xcd_barrier(const XcdBarrier& b) {
    asm volatile("s_waitcnt vmcnt(0)" ::: "memory");
    __syncthreads();
    if (threadIdx.x == 0) {
        unsigned* bar = b.bar;
        __builtin_amdgcn_s_waitcnt(0);
        unsigned nloc = b.st[0], nx = b.st[1];
        if (nloc == 0u) { xcd_barrier_complete(bar, b.x, nloc, nx); b.st[0] = nloc; b.st[1] = nx; }
        const unsigned old = xb_add(&bar[XB_XSUB(b.x)], 1u);
        const unsigned gen = old / nloc;
        if (old + 1u == (gen + 1u) * nloc) {
            __builtin_amdgcn_fence(__ATOMIC_RELEASE, "agent");
            asm volatile("s_waitcnt vmcnt(0)" ::: "memory");
            const unsigned og = xb_add(&bar[XB_TOP], 1u);
            const unsigned target = (og / nx + 1u) * nx;
            if (og + 1u != target) XB_SPIN(xb_ld(&bar[XB_TOP]) < target, bar);
            xb_add(&bar[XB_XGEN(b.x)], 1u);
            __builtin_amdgcn_fence(__ATOMIC_ACQUIRE, "agent");
            asm volatile("s_waitcnt vmcnt(0)" ::: "memory");
        } else {
            XB_SPIN(xb_ld(&bar[XB_XGEN(b.x)]) == gen, bar);
            __builtin_amdgcn_fence(__ATOMIC_ACQUIRE, "agent");
            asm volatile("s_waitcnt vmcnt(0)" ::: "memory");
        }
    }
    __syncthreads();
}


struct Args { const float* in[N_IN]; float* out; unsigned char* ws; int ph_lo, ph_hi; };
struct Frame {
    LAS unsigned char* lds; unsigned char* ldsg;
    const float* const* in; float* out; unsigned char* ws;
    int tid, lane, wave, G;
    XcdBarrier bar;
};
#define LDS_WAIT() asm volatile("s_waitcnt lgkmcnt(0)" ::: "memory")
#if defined(TSUB)
#define TS_BEGIN() unsigned long long ts_t0_ = __builtin_amdgcn_s_memrealtime()
#define TS_MARK(r) do { const unsigned long long ts_t1_ = __builtin_amdgcn_s_memrealtime(); if ((r) == TSUB && blockIdx.x == TSBLK && F.tid == 0) ((volatile LAS unsigned long long*)(F.lds + MISC_OFF + 240))[0] += ts_t1_ - ts_t0_; ts_t0_ = __builtin_amdgcn_s_memrealtime(); } while (0)
#else
#define TS_BEGIN() do {} while (0)
#define TS_MARK(r) do {} while (0)
#endif

__device__ __forceinline__ void p0_transpose_item(const float* W, int K, int N, bf16_t* WT, int kb, int nb, int rowbase, LAS float* scr, int lane) {
    const int k0 = 64 * kb, n0 = 32 * nb;
#pragma unroll 8
    for (int i = 0; i < 32; ++i) { const int kk = 2 * i + (lane >> 5); scr[kk * 33 + (lane & 31)] = __builtin_nontemporal_load(W + (size_t)(k0 + kk) * N + n0 + (lane & 31)); }
    LDS_WAIT(); asm volatile("" ::: "memory");
    const int c = lane & 7;
#pragma unroll
    for (int j = 0; j < 4; ++j) { const int n = (lane >> 3) + 8 * j; const LAS float* s = scr + (8 * c) * 33 + n;
        u32x4 o; o.x = pk2(s[0 * 33], s[1 * 33]); o.y = pk2(s[2 * 33], s[3 * 33]); o.z = pk2(s[4 * 33], s[5 * 33]); o.w = pk2(s[6 * 33], s[7 * 33]);
        *(u32x4*)(WT + (size_t)(rowbase + n) * K + k0 + 8 * c) = o; }
    LDS_WAIT(); asm volatile("" ::: "memory");
}
constexpr int CI_IN = 32 * 149, CI_OUT = 32 * 64, CI_G = 32 * 176, CI_DN = 88 * 64;
__device__ __forceinline__ void conv_item(Frame& F, int kind, int l, int r, LAS float* scr) {
    if (kind == 0) { const int kb = r / 149, nb = r % 149;
        p0_transpose_item(F.in[I_WIN] + (size_t)l * 2048 * DIN, 2048, DIN, (bf16_t*)(F.ws + WS_WIN + l * SZ_WIN), kb, nb, 32 * nb, scr, F.lane); }
    else if (kind == 1) { const int kb = r / 64, nb = r % 64;
        p0_transpose_item(F.in[I_WOUT] + (size_t)l * 2048 * 2048, 2048, 2048, (bf16_t*)(F.ws + WS_WOUT + l * SZ_WOUT), kb, nb, 32 * nb, scr, F.lane); }
    else if (kind == 2) { const int up = r >= CI_G; if (up) r -= CI_G; const int kb = r / 176, nb = r % 176, n0 = 32 * nb;
        p0_transpose_item(F.in[up ? I_WUPF : I_WGATE] + (size_t)l * 2048 * DFF, 2048, DFF, (bf16_t*)(F.ws + WS_WGU + l * SZ_WGU), kb, nb, (n0 >> 7) * 256 + (up ? 128 : 0) + (n0 & 127), scr, F.lane); }
    else { const int kb = r / 64, nb = r % 64;
        p0_transpose_item(F.in[I_WDOWN] + (size_t)l * DFF * 2048, DFF, 2048, (bf16_t*)(F.ws + WS_WDN + l * SZ_WDN), kb, nb, 32 * nb, scr, F.lane); }
}
__device__ __forceinline__ void p0_prologue(Frame& F) {
    TS_BEGIN();
    {
        LAS float* sc = (LAS float*)F.lds;
        LAS float* red = sc + 5 * 2048;
        for (int i = F.tid; i < 5 * 2048; i += NTHREADS) { const int v = i >> 11, k = i & 2047; const float x = v == 0 ? F.in[I_CCTX][k] : F.in[I_C][(v - 1) * 2048 + k]; sc[i] = x * sigmoidf_(x); }
        __syncthreads();
        for (int it = blockIdx.x; it < 2 * 128; it += F.G) {
            const int l = it >> 7, cg_ = it & 127, col = cg_ * 96 + 2 * (F.lane < 48 ? F.lane : 47);
            const float* W = F.in[I_WADA] + (size_t)l * 2048 * 12288 + col;
            f32x2 acc[5];
#pragma unroll
            for (int v = 0; v < 5; ++v) acc[v] = (f32x2){0.f, 0.f};
            const int kbeg = F.wave * 256;
#pragma unroll 4
            for (int k = kbeg; k < kbeg + 256; k += 4) {
                const f32x2 w0 = __builtin_nontemporal_load((const f32x2*)(W + (size_t)(k + 0) * 12288)), w1 = __builtin_nontemporal_load((const f32x2*)(W + (size_t)(k + 1) * 12288)),
                            w2 = __builtin_nontemporal_load((const f32x2*)(W + (size_t)(k + 2) * 12288)), w3 = __builtin_nontemporal_load((const f32x2*)(W + (size_t)(k + 3) * 12288));
#pragma unroll
                for (int v = 0; v < 5; ++v) { const f32x4 s = *(const LAS f32x4*)(sc + v * 2048 + k); acc[v] += s.x * w0 + s.y * w1 + s.z * w2 + s.w * w3; }
            }
#pragma unroll
            for (int v = 0; v < 5; ++v) *(LAS f32x2*)(red + (F.wave * 5 + v) * 128 + 2 * F.lane) = acc[v];
            __syncthreads();
            if (F.tid < 480) { const int v = F.tid / 96, c = F.tid % 96; float s = 0.f;
#pragma unroll
                for (int w = 0; w < 8; ++w) s += red[(w * 5 + v) * 128 + c];
                const int cc = cg_ * 96 + c;
                ((float*)(F.ws + WS_MOD))[(size_t)(l * 5 + v) * 12288 + cc] = s + F.in[I_BADA][l * 12288 + cc]; }
            __syncthreads();
        }
    }
    __syncthreads();
    TS_MARK(10);
    {
        const int gt = blockIdx.x * NTHREADS + F.tid, GT = F.G * NTHREADS;
        for (int i = gt; i < 2 * 224 * 512; i += GT) { const int l = i / (224 * 512), r = i % (224 * 512), k = r >> 9, c = r & 511;
            const float v = k < 96 ? F.in[I_GUP][((size_t)l * 96 + k) * 512 + c] : (k < 160 ? F.in[I_WUP][((size_t)l * 64 + (k - 96)) * 512 + c] : F.in[I_AUP][((size_t)l * 64 + (k - 160)) * 512 + c]);
            ((float*)(F.ws + WS_W4))[((size_t)l * 56 + (k >> 2)) * 2048 + c * 4 + (k & 3)] = v; }
    }
    {
        const int gt = blockIdx.x * NTHREADS + F.tid, GT = F.G * NTHREADS;
        for (int i = gt; i < 2 * 24576; i += GT) { const int l = i / 24576, r = i % 24576;
            *(u32x4*)(F.ws + WS_WIN + (size_t)l * SZ_WIN + (size_t)4768 * 2048 * 2 + (size_t)r * 16) = (u32x4){0u, 0u, 0u, 0u}; }
    }
    TS_MARK(11);
    {
        LAS float* scr = (LAS float*)(F.lds + F.wave * 16384);
        const int gw = blockIdx.x * NWAVES + F.wave, NGW = F.G * NWAVES;
        for (int it = gw; it < 2 * CI_IN; it += NGW) conv_item(F, 0, it / CI_IN, it % CI_IN, scr);
    }
    TS_MARK(12);
}
__device__ __forceinline__ void conv_side(Frame& F, int l, int first, int count, int nblk, int blk) {
    LAS float* scr = (LAS float*)(F.lds + F.wave * 16384);
    for (int it = first + blk * NWAVES + F.wave; it < first + count; it += nblk * NWAVES) {
        int r = it, kind = 1; if (r >= CI_OUT) { r -= CI_OUT; kind = 2; if (r >= 2 * CI_G) { r -= 2 * CI_G; kind = 3; } }
        conv_item(F, kind, l, r, scr);
    }
}

__device__ __forceinline__ const float* mod_vec(const Frame& F, int l, int m, int which) {
    const int v = m < MC ? 0 : 1 + ((m - MC) >> 10);
    return (const float*)(F.ws + WS_MOD) + (size_t)(l * 5 + v) * 12288 + which * 2048;
}
__device__ __forceinline__ const float* x_in_row(const Frame& F, int m) { return m < MC ? F.in[I_XP] + (size_t)m * DM : F.in[I_XS] + (size_t)(m - MC) * DM; }
__device__ __forceinline__ float row_ss(const f32x4 (&v)[8]) {
    float s = 0.f;
#pragma unroll
    for (int j = 0; j < 8; ++j) s += (v[j].x * v[j].x + v[j].y * v[j].y) + (v[j].z * v[j].z + v[j].w * v[j].w);
    return wave_sum_fast(s);
}
struct RowVecL { const LAS float* l;
    __device__ __forceinline__ f32x4 at(int o) const { return *(const LAS f32x4*)(l + 4 * o); } };
__device__ __forceinline__ RowVecL row_vec(const Frame& F, int slot) { RowVecL r; r.l = (const LAS float*)F.lds + slot * 2048; return r; }
__device__ __forceinline__ void stage_vec(Frame& F, const float* g, int slot) { *(LAS f32x4*)((LAS float*)F.lds + slot * 2048 + 4 * F.tid) = ((const f32x4*)g)[F.tid]; }
__device__ __forceinline__ f32x4 stage_ld(const Frame& F, const float* g) { return ((const f32x4*)g)[F.tid]; }
__device__ __forceinline__ void stage_st(Frame& F, f32x4 v, int slot) { *(LAS f32x4*)((LAS float*)F.lds + slot * 2048 + 4 * F.tid) = v; }
__device__ __forceinline__ void write_h(const Frame& F, const f32x4 (&x)[8], float rs, RowVecL ng, RowVecL sc, RowVecL sh, bf16_t* hrow) {
#pragma unroll
    for (int j = 0; j < 8; ++j) { const int o = F.lane + 64 * j;
        const f32x4 g = ng.at(o), s = sc.at(o), b = sh.at(o);
        const f32x4 h = x[j] * rs * g * (1.0f + s) + b;
        u32x2 w; w.x = pk2(h.x, h.y); w.y = pk2(h.z, h.w); ((u32x2*)hrow)[o] = w;
        if (j & 1) __builtin_amdgcn_sched_barrier(0); }
}
__device__ __forceinline__ void rowpass0(Frame& F) {
  { const int mq = 32 * (int)blockIdx.x; if (mq >= MT) return;
    const f32x4 sv0 = stage_ld(F, F.in[I_NG] + 0), sv1 = stage_ld(F, mod_vec(F, 0, mq, 1)), sv2 = stage_ld(F, mod_vec(F, 0, mq, 0));
    for (int mb = mq + 4 * F.wave, me = mb + 4; mb < me; mb += 2) {
        int mr[2]; mr[0] = mb; mr[1] = mb + 1;
        f32x4 x[2][8];
#pragma unroll
        for (int r = 0; r < 2; ++r) { const f32x4* xr = (const f32x4*)x_in_row(F, mr[r]);
#pragma unroll
            for (int j = 0; j < 8; ++j) x[r][j] = xr[F.lane + 64 * j]; }
        if (mb == mq + 4 * F.wave) { stage_st(F, sv0, 0); stage_st(F, sv1, 1); stage_st(F, sv2, 2); __syncthreads(); }
#pragma unroll
        for (int r = 0; r < 2; ++r) { const int m = mr[r];
            const float rs = rsqrtf(row_ss(x[r]) * (1.0f / DM) + EPS);
            write_h(F, x[r], rs, row_vec(F, 0), row_vec(F, 1), row_vec(F, 2), (bf16_t*)(F.ws + WS_HB) + (size_t)m * DM); }
    }
  }
}
__device__ __forceinline__ f32x4 ld_bf4(const u32x2* p) { const u32x2 v = *p; return (f32x4){__uint_as_float(v.x << 16), __uint_as_float(v.x & 0xffff0000u), __uint_as_float(v.y << 16), __uint_as_float(v.y & 0xffff0000u)}; }
__device__ __forceinline__ void st_bf4(u32x2* p, f32x4 v) { u32x2 w; w.x = pk2(v.x, v.y); w.y = pk2(v.z, v.w); *p = w; }
__device__ __forceinline__ void rowpassA(Frame& F, int l) {
    const float* ng = F.in[I_NG] + (size_t)l * 4 * DM;
  { const int mq = 32 * (int)blockIdx.x; if (mq >= MT) return;
    const f32x4 sv0 = stage_ld(F, mod_vec(F, l, mq, 2)), sv1 = stage_ld(F, ng + DM), sv2 = stage_ld(F, ng + 2 * DM), sv3 = stage_ld(F, mod_vec(F, l, mq, 4)), sv4 = stage_ld(F, mod_vec(F, l, mq, 3));
    for (int mb = mq + 4 * F.wave, me = mb + 4; mb < me; mb += 2) {
        int mr[2]; mr[0] = mb; mr[1] = mb + 1;
        f32x4 o[2][8], x[2][8];
#pragma unroll
        for (int r = 0; r < 2; ++r) { const int m = mr[r];
            const u32x2* orow = (const u32x2*)(F.ws + WS_OB) + (size_t)m * (DM / 4);
            const f32x4* xr = (const f32x4*)x_in_row(F, m); const u32x2* xb = (const u32x2*)(F.ws + WS_XB) + (size_t)m * (DM / 4);
#pragma unroll
            for (int j = 0; j < 8; ++j) { o[r][j] = ld_bf4(orow + F.lane + 64 * j); x[r][j] = l == 0 ? xr[F.lane + 64 * j] : ld_bf4(xb + F.lane + 64 * j); } }
        if (mb == mq + 4 * F.wave) { stage_st(F, sv0, 0); stage_st(F, sv1, 1); stage_st(F, sv2, 2); stage_st(F, sv3, 3); stage_st(F, sv4, 4); __syncthreads(); }
#pragma unroll
        for (int r = 0; r < 2; ++r) { const int m = mr[r];
            const float r1 = rsqrtf(row_ss(o[r]) * (1.0f / DM) + EPS);
            const RowVecL ga = row_vec(F, 0), n1 = row_vec(F, 1);
            u32x2* xo = (u32x2*)(F.ws + WS_XB) + (size_t)m * (DM / 4);
#pragma unroll
            for (int j = 0; j < 8; ++j) { const int q = F.lane + 64 * j; x[r][j] = x[r][j] + ga.at(q) * (o[r][j] * r1 * n1.at(q)); st_bf4(xo + q, x[r][j]); if (j & 1) __builtin_amdgcn_sched_barrier(0); }
            const float r2 = rsqrtf(row_ss(x[r]) * (1.0f / DM) + EPS);
            write_h(F, x[r], r2, row_vec(F, 2), row_vec(F, 3), row_vec(F, 4), (bf16_t*)(F.ws + WS_HB) + (size_t)m * DM); }
    }
  }
}
__device__ __forceinline__ void rowpassB(Frame& F, int l) {
    const float* ng = F.in[I_NG] + (size_t)l * 4 * DM;
  { const int mq = 32 * (int)blockIdx.x; if (mq >= MT) return;
    const f32x4 sv0 = stage_ld(F, mod_vec(F, l, mq, 5)), sv1 = stage_ld(F, ng + 3 * DM);
    f32x4 sv2 = sv0, sv3 = sv0, sv4 = sv0;
    if (l < DEPTH - 1) { sv2 = stage_ld(F, ng + 4 * DM); sv3 = stage_ld(F, mod_vec(F, l + 1, mq, 1)); sv4 = stage_ld(F, mod_vec(F, l + 1, mq, 0)); }
    for (int mb = mq + 4 * F.wave, me = mb + 4; mb < me; mb += 2) {
        int mr[2]; mr[0] = mb; mr[1] = mb + 1;
        f32x4 o[2][8], x[2][8];
#pragma unroll
        for (int r = 0; r < 2; ++r) { const int m = mr[r];
            const u32x2* orow = (const u32x2*)(F.ws + WS_OB) + (size_t)m * (DM / 4);
            const u32x2* xb = (const u32x2*)(F.ws + WS_XB) + (size_t)m * (DM / 4);
#pragma unroll
            for (int j = 0; j < 8; ++j) { o[r][j] = ld_bf4(orow + F.lane + 64 * j); x[r][j] = ld_bf4(xb + F.lane + 64 * j); } }
        if (mb == mq + 4 * F.wave) { stage_st(F, sv0, 0); stage_st(F, sv1, 1); if (l < DEPTH - 1) { stage_st(F, sv2, 2); stage_st(F, sv3, 3); stage_st(F, sv4, 4); } __syncthreads(); }
#pragma unroll
        for (int r = 0; r < 2; ++r) { const int m = mr[r];
            const float r1 = rsqrtf(row_ss(o[r]) * (1.0f / DM) + EPS);
            const RowVecL gf = row_vec(F, 0), n3 = row_vec(F, 1);
            f32x4* xof = (f32x4*)(F.out + OUT_Y) + (size_t)m * (DM / 4); u32x2* xo = (u32x2*)(F.ws + WS_XB) + (size_t)m * (DM / 4);
#pragma unroll
            for (int j = 0; j < 8; ++j) { const int q = F.lane + 64 * j; x[r][j] = x[r][j] + gf.at(q) * (o[r][j] * r1 * n3.at(q)); if (l == DEPTH - 1) xof[q] = x[r][j]; else st_bf4(xo + q, x[r][j]); if (j & 1) __builtin_amdgcn_sched_barrier(0); }
            if (l < DEPTH - 1) {
                const float r2 = rsqrtf(row_ss(x[r]) * (1.0f / DM) + EPS);
                write_h(F, x[r], r2, row_vec(F, 2), row_vec(F, 3), row_vec(F, 4), (bf16_t*)(F.ws + WS_HB) + (size_t)m * DM);
            } }
    }
  }
}

constexpr int TC_PITCH = 1696, SM_OFF = 115712, TG = 8;
__device__ __forceinline__ void p2_prepass(Frame& F, int l) {
    const bf16_t* PROJ = (const bf16_t*)(F.ws + WS_PROJ);
    bf16_t* QB = (bf16_t*)(F.ws + WS_QB); bf16_t* KB = (bf16_t*)(F.ws + WS_KB); bf16_t* VB = (bf16_t*)(F.ws + WS_VB); bf16_t* MIX = (bf16_t*)(F.ws + WS_MIX);
    float* SCAN = (float*)(F.ws + WS_SCAN);
    int tid0 = F.tid; asm volatile("" : "+v"(tid0));
    for (int pi = blockIdx.x * NTHREADS + tid0; pi < 131072; pi += F.G * NTHREADS) {
        const int e = 2 * pi, b = e >> 16, rem = e & 65535, p = rem >> 8, col = rem & 255;
        const size_t src = ((size_t)(b * 2 + l) * 256 + p) * 256 + col, dst = (size_t)(MC + b * 1280 + 1024 + p) * 256 + col;
        const f32x2 kv = *(const f32x2*)(F.in[I_CK] + src), vv = *(const f32x2*)(F.in[I_CV] + src);
        *(unsigned*)(KB + dst) = pk2(kv.x, kv.y); *(unsigned*)(VB + dst) = pk2(vv.x, vv.y);
    }
    for (int item = blockIdx.x; item < MT / 32; item += F.G) {
        asm volatile("" ::: "memory");
        int tid = F.tid; asm volatile("" : "+v"(tid)); const int lane = tid & 63;
        const int m0 = item * 32; const bool smp = m0 >= MC;
        const int sb = smp ? (m0 - MC) >> 10 : m0 >> 8, t0 = smp ? (m0 - MC) & 1023 : m0 & 255, seqlen = smp ? 1024 : 256;
        __syncthreads();
        TS_BEGIN();
#if PP_MASK & 1
        for (int rp = 0; rp < ((PPR_MASK & 1) ? 2 : 1); ++rp) {
            LAS bf16_t* TA = (LAS bf16_t*)F.lds;
#pragma unroll
            for (int j = 0; j < 12; ++j) { const int idx = tid + 512 * j, r = idx / 192, q = idx % 192;
                *(LAS u32x4*)(TA + r * 1536 + q * 8) = *(const u32x4*)(PROJ + (size_t)(m0 + r) * DINP + q * 8); }
            __syncthreads();
            const int e1 = lane < 32 ? lane : lane + 32, e2 = e1 + 32;
            const float gq1 = F.in[I_QN][l * 128 + e1], gq2 = F.in[I_QN][l * 128 + e2], gk1 = F.in[I_KN][l * 128 + e1], gk2 = F.in[I_KN][l * 128 + e2];
            const float inv = exp2f(-(float)(2 * (lane & 31)) * (13.287712379549449f / 64.0f));
#pragma unroll 2
            for (int wi = F.wave; wi < 320; wi += NWAVES) {
                const int tok = wi / 10, j = wi % 10, t = t0 + tok;
                LAS bf16_t* p = TA + tok * 1536 + (j < 8 ? j * 128 : 1024 + (j - 8) * 128);
                const float x1 = bf2f(p[e1]), x2 = bf2f(p[e2]);
                const float rs = rsqrtf(wave_sum_fast(x1 * x1 + x2 * x2) * (1.0f / 128.0f) + EPS);
                float y1 = x1 * rs * (j < 8 ? gq1 : gk1), y2 = x2 * rs * (j < 8 ? gq2 : gk2);
                if (smp) {
                    const float pos = (float)(lane < 32 ? (t >> 6) : (t & 63));
                    float rev = pos * inv * 0.15915494309189535f; rev = rev - floorf(rev);
                    const float s = __builtin_amdgcn_sinf(rev), c = __builtin_amdgcn_cosf(rev);
                    const float o1 = y1 * c - y2 * s, o2 = y2 * c + y1 * s; y1 = o1; y2 = o2;
                }
                p[e1] = f2bf(y1); p[e2] = f2bf(y2);
            }
            __syncthreads();
#pragma unroll
            for (int j = 0; j < 8; ++j) { const int idx = tid + 512 * j, r = idx >> 7, q = idx & 127;
                *(u32x4*)(QB + (size_t)(m0 + r) * 1024 + q * 8) = *(const LAS u32x4*)(TA + r * 1536 + q * 8); }
#pragma unroll
            for (int j = 0; j < 2; ++j) { const int idx = tid + 512 * j, r = idx >> 5, q = idx & 31;
                const size_t krow = smp ? (size_t)(MC + sb * 1280 + t0 + r) : (size_t)(m0 + r);
                *(u32x4*)(KB + krow * 256 + q * 8) = *(const LAS u32x4*)(TA + r * 1536 + 1024 + q * 8);
                *(u32x4*)(VB + krow * 256 + q * 8) = *(const LAS u32x4*)(TA + r * 1536 + 1280 + q * 8); }
            if (!smp) {
#pragma unroll
                for (int j = 0; j < 4; ++j) { const int idx = tid + 512 * j, r = idx >> 6, q = idx & 63;
                    const u32x2 kk = *(const LAS u32x2*)(TA + r * 1536 + 1024 + q * 4), vv = *(const LAS u32x2*)(TA + r * 1536 + 1280 + q * 4);
                    const size_t o = ((size_t)(sb * 2 + l) * 256 + t0 + r) * 256 + q * 4;
                    *(f32x4*)(F.out + OUT_NK + o) = (f32x4){__uint_as_float(kk.x << 16), __uint_as_float(kk.x & 0xffff0000u), __uint_as_float(kk.y << 16), __uint_as_float(kk.y & 0xffff0000u)};
                    *(f32x4*)(F.out + OUT_NV + o) = (f32x4){__uint_as_float(vv.x << 16), __uint_as_float(vv.x & 0xffff0000u), __uint_as_float(vv.y << 16), __uint_as_float(vv.y & 0xffff0000u)}; }
            }
            __syncthreads();
        }
#endif
        TS_MARK(0);
#if PP_MASK & 2
        for (int rp = 0; rp < ((PPR_MASK & 2) ? 2 : 1); ++rp) {
            LAS bf16_t* TB = (LAS bf16_t*)F.lds;
#pragma unroll
            for (int j = 0; j < 13; ++j) { const int idx = tid + 512 * j; if (idx < 34 * 192) { const int rr = idx / 192, q = idx % 192, t = t0 - 1 + rr;
                u32x4 v = {0u, 0u, 0u, 0u}; if (t >= 0 && t < seqlen) v = *(const u32x4*)(PROJ + (size_t)(m0 - 1 + rr) * DINP + O_CB + q * 8);
                *(LAS u32x4*)(TB + rr * 1536 + q * 8) = v; } }
            __syncthreads();
            const int c = tid; const float* cw = F.in[I_CONVW] + (size_t)l * 3 * 512;
            const float w0 = cw[c], w1 = cw[512 + c], w2 = cw[1024 + c];
            LAS bf16_t* TO = TB + 34 * 1536;
            float prev = bf2f(TB[512 + c]) * bf2f(TB[1024 + c]), cur = bf2f(TB[1536 + 512 + c]) * bf2f(TB[1536 + 1024 + c]);
#pragma unroll 4
            for (int tok = 0; tok < 32; ++tok) {
                const LAS bf16_t* p = TB + (tok + 2) * 1536;
                const float nxt = bf2f(p[512 + c]) * bf2f(p[1024 + c]);
                const float o = bf2f(p[-1536 + c]) * (w0 * prev + w1 * cur + w2 * nxt);
                TO[tok * 512 + c] = f2bf(o);
                prev = cur; cur = nxt;
            }
            __syncthreads();
#pragma unroll
            for (int j = 0; j < 4; ++j) { const int idx = tid + 512 * j, r = idx >> 6, q = idx & 63;
                *(u32x4*)(MIX + (size_t)(m0 + r) * DM + 1024 + q * 8) = *(const LAS u32x4*)(TO + r * 512 + q * 8); }
            __syncthreads();
        }
#endif
        TS_MARK(1);
        LAS bf16_t* TC = (LAS bf16_t*)F.lds;
        LAS float* sm = (LAS float*)(F.lds + SM_OFF);
        const float* mu = F.in[I_MU] + (size_t)l * 1696;
#pragma unroll
        for (int j = 0; j < 15; ++j) { const int idx = tid + 512 * j; if (idx < 34 * 212) { const int rr = idx / 212, q = idx % 212, t = t0 - 1 + rr;
            u32x4 v = {0u, 0u, 0u, 0u}; if (t >= 0 && t < seqlen) v = *(const u32x4*)(PROJ + (size_t)(m0 - 1 + rr) * DINP + O_UR + q * 8);
            *(LAS u32x4*)(TC + rr * TC_PITCH + q * 8) = v; } }
        __syncthreads();
#pragma unroll 5
        for (int idx = tid; idx < 32 * 160; idx += NTHREADS) {
            const int tok = idx / 160, k = idx % 160, col = 1536 + k;
            const LAS bf16_t* p = TC + (tok + 1) * TC_PITCH + col;
            const float u = bf2f(p[0]), up = bf2f(p[-TC_PITCH]), un = bf2f(p[TC_PITCH]);
            const float us = u + mu[col] * (0.5f * (up + un) - u);
            sm[idx] = k < 32 ? (1.0f - 2.0f / (1.0f + __expf(2.0f * us))) : (k < 64 ? us : sigmoidf_(us));
        }
        __syncthreads();
        const int c = tid, h = F.wave, i = lane;
        TS_MARK(2);
#pragma unroll 1
        for (int half = 0; half < 32 / TG; ++half) {
            const int tb = TG * half;
            float gg[TG], dc0[TG], dc1[TG];
            {
                asm volatile("" ::: "memory");
                float wg[96];
                const f32x4* w4 = (const f32x4*)(F.ws + WS_W4) + (size_t)l * 56 * 512 + c;
#pragma unroll
                for (int k4 = 0; k4 < 24; ++k4) { const f32x4 t = w4[0]; w4 += 512; asm volatile("" : "+v"(w4)); wg[4 * k4] = t.x; wg[4 * k4 + 1] = t.y; wg[4 * k4 + 2] = t.z; wg[4 * k4 + 3] = t.w; }
#pragma unroll
                for (int tok = 0; tok < TG; ++tok) {
                    float g = 0.f, g2 = 0.f; const LAS float* xg = sm + (tb + tok) * 160 + 64;
#pragma unroll
                    for (int hk = 0; hk < 3; ++hk) {
                        f32x4 sv[8];
#pragma unroll
                        for (int q = 0; q < 8; ++q) sv[q] = *(const LAS f32x4*)(xg + 32 * hk + 4 * q);
                        __builtin_amdgcn_sched_barrier(0);
#pragma unroll
                        for (int q = 0; q < 8; ++q) { const f32x4 sq = sv[q]; const int k0 = 32 * hk + 4 * q; (q & 1 ? g2 : g) += sq.x * wg[k0] + sq.y * wg[k0 + 1] + sq.z * wg[k0 + 2] + sq.w * wg[k0 + 3]; }
                        __builtin_amdgcn_sched_barrier(0);
                    }
                    gg[tok] = g + g2;
                }
            }
            {
                asm volatile("" ::: "memory");
                float ww0[32], ww1[32];
                const f32x4* w4 = (const f32x4*)(F.ws + WS_W4) + ((size_t)l * 56 + 24) * 512 + c;
#pragma unroll
                for (int k4 = 0; k4 < 8; ++k4) { const f32x4 t = w4[0], u = w4[8 * 512]; w4 += 512; asm volatile("" : "+v"(w4));
                    ww0[4 * k4] = t.x; ww0[4 * k4 + 1] = t.y; ww0[4 * k4 + 2] = t.z; ww0[4 * k4 + 3] = t.w; ww1[4 * k4] = u.x; ww1[4 * k4 + 1] = u.y; ww1[4 * k4 + 2] = u.z; ww1[4 * k4 + 3] = u.w; }
                const float b0 = F.in[I_W0][(l * 2 + 0) * 512 + c], b1 = F.in[I_W0][(l * 2 + 1) * 512 + c];
#pragma unroll
                for (int tok = 0; tok < TG; ++tok) {
                    float z0 = b0, z1 = b1; const LAS float* xw = sm + (tb + tok) * 160;
                    f32x4 sv[8];
#pragma unroll
                    for (int q = 0; q < 8; ++q) sv[q] = *(const LAS f32x4*)(xw + 4 * q);
                    __builtin_amdgcn_sched_barrier(0);
#pragma unroll
                    for (int q = 0; q < 8; ++q) { const f32x4 sq = sv[q];
                        z0 += sq.x * ww0[4 * q] + sq.y * ww0[4 * q + 1] + sq.z * ww0[4 * q + 2] + sq.w * ww0[4 * q + 3];
                        z1 += sq.x * ww1[4 * q] + sq.y * ww1[4 * q + 1] + sq.z * ww1[4 * q + 2] + sq.w * ww1[4 * q + 3]; }
                    const float sp0 = fmaxf(-z0, 0.f) + __logf(1.0f + __expf(-fabsf(z0))), sp1 = fmaxf(-z1, 0.f) + __logf(1.0f + __expf(-fabsf(z1)));
                    dc0[tok] = __expf(-__expf(-sp0 - 0.5f)); dc1[tok] = __expf(-__expf(-sp1 - 0.5f));
                    __builtin_amdgcn_sched_barrier(0);
                }
            }
            {
                asm volatile("" ::: "memory");
                float wa0[32], wa1[32];
                const f32x4* w4 = (const f32x4*)(F.ws + WS_W4) + ((size_t)l * 56 + 40) * 512 + c;
#pragma unroll
                for (int k4 = 0; k4 < 8; ++k4) { const f32x4 t = w4[0], u = w4[8 * 512]; w4 += 512; asm volatile("" : "+v"(w4));
                    wa0[4 * k4] = t.x; wa0[4 * k4 + 1] = t.y; wa0[4 * k4 + 2] = t.z; wa0[4 * k4 + 3] = t.w; wa1[4 * k4] = u.x; wa1[4 * k4 + 1] = u.y; wa1[4 * k4 + 2] = u.z; wa1[4 * k4 + 3] = u.w; }
                const float a0b0 = F.in[I_A0][(l * 2 + 0) * 512 + c], a0b1 = F.in[I_A0][(l * 2 + 1) * 512 + c];
                const float kkc = F.in[I_KK][l * 512 + c], kac = F.in[I_KA][l * 512 + c], rkc = F.in[I_RK][l * 512 + c];
                const float mur = mu[c], muk = mu[512 + c], muv = mu[1024 + c];
                const LAS bf16_t* pr = TC + tb * TC_PITCH + c;
                float pr_r = bf2f(pr[0]), pr_k = bf2f(pr[512]), pr_v = bf2f(pr[1024]);
                float cu_r = bf2f(pr[TC_PITCH]), cu_k = bf2f(pr[TC_PITCH + 512]), cu_v = bf2f(pr[TC_PITCH + 1024]);
#pragma unroll
                for (int tok = 0; tok < TG; ++tok) {
                    const LAS bf16_t* p = pr + (tok + 2) * TC_PITCH; const int m = m0 + tb + tok;
                    const float nx_r = bf2f(p[0]), nx_k = bf2f(p[512]), nx_v = bf2f(p[1024]);
                    const float r = cu_r + mur * (0.5f * (pr_r + nx_r) - cu_r), k = cu_k + muk * (0.5f * (pr_k + nx_k) - cu_k), v = cu_v + muv * (0.5f * (pr_v + nx_v) - cu_v);
                    pr_r = cu_r; pr_k = cu_k; pr_v = cu_v; cu_r = nx_r; cu_k = nx_k; cu_v = nx_v;
                    const float kkr = k * kkc; const float kk = kkr * rsqrtf(wave_sum_fast(kkr * kkr) + 1e-12f);
                    float za0 = a0b0, za1 = a0b1; const LAS float* xa = sm + (tb + tok) * 160 + 32;
                    f32x4 sv[8];
#pragma unroll
                    for (int q = 0; q < 8; ++q) sv[q] = *(const LAS f32x4*)(xa + 4 * q);
                    __builtin_amdgcn_sched_barrier(0);
#pragma unroll
                    for (int q = 0; q < 8; ++q) { const f32x4 sq = sv[q];
                        za0 += sq.x * wa0[4 * q] + sq.y * wa0[4 * q + 1] + sq.z * wa0[4 * q + 2] + sq.w * wa0[4 * q + 3];
                        za1 += sq.x * wa1[4 * q] + sq.y * wa1[4 * q + 1] + sq.z * wa1[4 * q + 2] + sq.w * wa1[4 * q + 3]; }
                    const float a0 = sigmoidf_(za0), a1 = sigmoidf_(za1);
                    const float kd0 = k * (1.0f + (a0 - 1.0f) * kac), kd1 = k * (1.0f + (a1 - 1.0f) * kac);
                    const float bs = wave_sum_fast(r * (kd0 + kd1) * rkc);
                    float* base = SCAN + (size_t)((smp ? 32768 + (sb * 8 + h) * 1024 : (sb * 8 + h) * 256) + t0 + tb + tok) * 576 + 3 * i;
                    base[0] = r; base[1] = v; base[2] = kk; base[192] = dc0[tok]; base[193] = kd0; base[194] = kk * a0; base[384] = dc1[tok]; base[385] = kd1; base[386] = kk * a1;
                    ((unsigned*)(F.ws + WS_BG))[(size_t)m * 512 + c] = pk2(bs * v, gg[tok]);
                    __builtin_amdgcn_sched_barrier(0);
                }
            }
            TS_MARK(5);
        }
        __syncthreads();
    }
}

__device__ __forceinline__ float fma_s(float a, float b, float c) { float r; asm("v_fma_f32 %0, %1, %2, %3" : "=v"(r) : "v"(a), "v"(b), "v"(c)); return r; }
__device__ __forceinline__ float mul_s(float a, float b) { float r; asm("v_mul_f32_e32 %0, %1, %2" : "=v"(r) : "v"(a), "v"(b)); return r; }
struct ScanOps { f32x4 r4a, r4b, kk4a, kk4b, w4a, w4b, kd4a, kd4b, ka4a, ka4b; float v0; };
template <int CTRL> __device__ __forceinline__ float dpp_add_q(float x) { const int y = __builtin_amdgcn_update_dpp(0, __float_as_int(x), CTRL, 0xf, 0xf, false); return x + __int_as_float(y); }
__device__ __forceinline__ float oct_sum(float x) {
    x = dpp_add_q<0xB1>(x); x = dpp_add_q<0x4E>(x); x = dpp_add_q<0x141>(x); return x;
}
__device__ __forceinline__ void scan_item(Frame& F, int l, bool smp, int b, int h, int d, int half) {
    int tid = F.tid; asm volatile("" : "+v"(tid));
    const int seqlen = smp ? 1024 : 256, seq_base = smp ? MC + b * 1024 : b * 256, nch = seqlen / 16;
    LAS float* opb = (LAS float*)F.lds;
    LAS float* ypb = opb + 2 * 6144;
    const float* SCAN = (const float*)(F.ws + WS_SCAN); float* YB = (float*)(F.ws + WS_YB) + (size_t)d * MT * 512;
#define SCAN_TOK(ci, s) (d ? seqlen - 1 - ((ci) * 16 + (s)) : (ci) * 16 + (s))
    __syncthreads();
    if (tid < 256) {
        const int p = tid >> 3, c = tid & 7, row = half * 32 + p;
        f32x4 sa_ = {0.f, 0.f, 0.f, 0.f}, sb_ = {0.f, 0.f, 0.f, 0.f};
        if (smp) { const float* S0 = F.in[I_ST] + ((((size_t)b * 2 + l) * 2 + d) * 8 + h) * 4096 + row * 64 + 8 * c; sa_ = *(const f32x4*)S0; sb_ = *(const f32x4*)(S0 + 4); }
        __syncthreads();
        for (int ci = 0; ci < nch; ++ci) {
            const LAS float* ob = opb + (ci & 1) * 6144; LAS float* yp = ypb + (ci & 1) * 4096 + p * 8 + c;
#define SC_LD(R, s_) do { const LAS float* o_ = ob + (s_) * 384 + 8 * c; R.r4a = *(const LAS f32x4*)(o_); R.r4b = *(const LAS f32x4*)(o_ + 4); R.kk4a = *(const LAS f32x4*)(o_ + 128); R.kk4b = *(const LAS f32x4*)(o_ + 132); \
                R.w4a = *(const LAS f32x4*)(o_ + 192); R.w4b = *(const LAS f32x4*)(o_ + 196); R.kd4a = *(const LAS f32x4*)(o_ + 256); R.kd4b = *(const LAS f32x4*)(o_ + 260); \
                R.ka4a = *(const LAS f32x4*)(o_ + 320); R.ka4b = *(const LAS f32x4*)(o_ + 324); R.v0 = ob[(s_) * 384 + 64 + row]; } while (0)
#define SC_STEP(R, s_) do { \
                const f32x4 t_ = sa_ * R.kk4a + sb_ * R.kk4b; float d0 = (t_.x + t_.y) + (t_.z + t_.w); \
                d0 = -oct_sum(d0); \
                sa_ = sa_ * R.w4a + (R.ka4a * d0 + R.kd4a * R.v0); sb_ = sb_ * R.w4b + (R.ka4b * d0 + R.kd4b * R.v0); \
                const f32x4 u_ = sa_ * R.r4a + sb_ * R.r4b; yp[(s_) * 256] = (u_.x + u_.y) + (u_.z + u_.w); } while (0)
            ScanOps A, B;
            SC_LD(A, 0);
#pragma unroll 2
            for (int s = 0; s < 16; s += 2) {
                SC_LD(B, s + 1); __builtin_amdgcn_sched_barrier(0);
                SC_STEP(A, s); __builtin_amdgcn_sched_barrier(0);
                if (s + 2 < 16) SC_LD(A, s + 2); __builtin_amdgcn_sched_barrier(0);
                SC_STEP(B, s + 1); __builtin_amdgcn_sched_barrier(0);
            }
#undef SC_LD
#undef SC_STEP
            __syncthreads();
        }
        if (!smp) { float* O = F.out + OUT_ST + ((((size_t)b * 2 + l) * 2 + d) * 8 + h) * 4096 + row * 64 + 8 * c; *(f32x4*)O = sa_; *(f32x4*)(O + 4) = sb_; }
        __syncthreads();
    } else {
        const int ht = tid - 256;
        const int sg2 = (ht >> 6) & 1, sst0 = ht >> 7;
        const int ssrc = (sg2 ? 1 + d : 0) * 256 + (ht & 63) * 4, sdst = 3 * sg2 * 64 + (ht & 63);
        f32x4 stg[8], stg2[8];
#define SCAN_LOAD(R, ci) do { _Pragma("unroll") for (int j = 0; j < 8; ++j) R[j] = *(const f32x4*)(SCAN + ((size_t)(seq_base + SCAN_TOK(ci, sst0 + 2 * j)) * 8 + h) * 768 + ssrc); } while (0)
#define SCAN_STORE(buf) do { _Pragma("unroll") for (int j = 0; j < 8; ++j) { LAS float* dst_ = opb + (buf) * 6144 + (sst0 + 2 * j) * 384 + sdst; dst_[0] = stg[j].x; dst_[64] = stg[j].y; dst_[128] = stg[j].z; } } while (0)
#define SCAN_YRED(ci) do { _Pragma("unroll") for (int j = 0; j < 2; ++j) { const int o_ = ht + 256 * j, s_ = o_ >> 5, rr_ = o_ & 31; const LAS f32x4* q_ = (const LAS f32x4*)(ypb + ((ci) & 1) * 4096 + o_ * 8); \
            const f32x4 t_ = q_[0] + q_[1]; YB[(size_t)(seq_base + SCAN_TOK(ci, s_)) * 512 + h * 64 + half * 32 + rr_] = (t_.x + t_.y) + (t_.z + t_.w); } } while (0)
        SCAN_LOAD(stg, 0); SCAN_STORE(0);
        if (1 < nch) SCAN_LOAD(stg, 1);
        if (2 < nch) SCAN_LOAD(stg2, 2);
        __syncthreads();
        for (int ci = 0; ci < nch; ++ci) {
            if (ci + 1 < nch) { SCAN_STORE((ci + 1) & 1);
#pragma unroll
                for (int j = 0; j < 8; ++j) stg[j] = stg2[j];
                if (ci + 3 < nch) SCAN_LOAD(stg2, ci + 3); }
            if (ci > 0) SCAN_YRED(ci - 1);
            __syncthreads();
        }
        SCAN_YRED(nch - 1);
        __syncthreads();
#undef SCAN_LOAD
#undef SCAN_STORE
#undef SCAN_YRED
    }
#undef SCAN_TOK
}

__device__ __forceinline__ void scan_item_dual(Frame& F, int l, bool smp, int b, int h, int d) {
    int tid = F.tid; asm volatile("" : "+v"(tid));
    const int seqlen = smp ? 1024 : 256, seq_base = smp ? MC + b * 1024 : b * 256, nch = seqlen / 16;
    LAS float* opb = (LAS float*)F.lds;
    LAS float* ypb = opb + 2 * 6144;
    const float* SCAN = (const float*)(F.ws + WS_SCAN); float* YB = (float*)(F.ws + WS_YB) + (size_t)d * MT * 512;
#define SCAN_TOK(ci, s) (d ? seqlen - 1 - ((ci) * 16 + (s)) : (ci) * 16 + (s))
    const int row = tid >> 3, c = tid & 7;
    f32x4 sa_ = {0.f, 0.f, 0.f, 0.f}, sb_ = {0.f, 0.f, 0.f, 0.f};
    if (smp) { const float* S0 = F.in[I_ST] + ((((size_t)b * 2 + l) * 2 + d) * 8 + h) * 4096 + row * 64 + 8 * c; sa_ = *(const f32x4*)S0; sb_ = *(const f32x4*)(S0 + 4); }
    const int sg2 = (tid >> 6) & 1, sst0 = tid >> 7;
    const int ssrc = (sg2 ? 1 + d : 0) * 256 + (tid & 63) * 4, sdst = 3 * sg2 * 64 + (tid & 63);
    f32x4 stg[4], stg2[4];
#define SCAN_LOAD(R, ci) do { _Pragma("unroll") for (int j = 0; j < 4; ++j) R[j] = *(const f32x4*)(SCAN + ((size_t)(seq_base + SCAN_TOK(ci, sst0 + 4 * j)) * 8 + h) * 768 + ssrc); } while (0)
#define SCAN_STORE(buf) do { _Pragma("unroll") for (int j = 0; j < 4; ++j) { LAS float* dst_ = opb + (buf) * 6144 + (sst0 + 4 * j) * 384 + sdst; dst_[0] = stg[j].x; dst_[64] = stg[j].y; dst_[128] = stg[j].z; } } while (0)
    __syncthreads();
    SCAN_LOAD(stg, 0); SCAN_STORE(0);
    if (1 < nch) SCAN_LOAD(stg, 1);
    if (2 < nch) SCAN_LOAD(stg2, 2);
    __syncthreads();
    for (int ci = 0; ci < nch; ++ci) {
        const LAS float* ob = opb + (ci & 1) * 6144; LAS float* yp = ypb + row * 8 + c;
#define SC_LD(R, s_) do { const LAS float* o_ = ob + (s_) * 384 + 8 * c; R.r4a = *(const LAS f32x4*)(o_); R.r4b = *(const LAS f32x4*)(o_ + 4); R.kk4a = *(const LAS f32x4*)(o_ + 128); R.kk4b = *(const LAS f32x4*)(o_ + 132); \
            R.w4a = *(const LAS f32x4*)(o_ + 192); R.w4b = *(const LAS f32x4*)(o_ + 196); R.kd4a = *(const LAS f32x4*)(o_ + 256); R.kd4b = *(const LAS f32x4*)(o_ + 260); \
            R.ka4a = *(const LAS f32x4*)(o_ + 320); R.ka4b = *(const LAS f32x4*)(o_ + 324); R.v0 = ob[(s_) * 384 + 64 + row]; } while (0)
#define SC_STEP(R, s_) do { \
            const f32x4 t_ = sa_ * R.kk4a + sb_ * R.kk4b; float d0 = (t_.x + t_.y) + (t_.z + t_.w); \
            d0 = -oct_sum(d0); \
            sa_ = sa_ * R.w4a + (R.ka4a * d0 + R.kd4a * R.v0); sb_ = sb_ * R.w4b + (R.ka4b * d0 + R.kd4b * R.v0); \
            const f32x4 u_ = sa_ * R.r4a + sb_ * R.r4b; yp[(s_) * 512] = (u_.x + u_.y) + (u_.z + u_.w); } while (0)
        ScanOps A, B;
        SC_LD(A, 0);
#pragma unroll 2
        for (int s = 0; s < 16; s += 2) {
            SC_LD(B, s + 1); __builtin_amdgcn_sched_barrier(0);
            SC_STEP(A, s); __builtin_amdgcn_sched_barrier(0);
            if (s + 2 < 16) SC_LD(A, s + 2); __builtin_amdgcn_sched_barrier(0);
            SC_STEP(B, s + 1); __builtin_amdgcn_sched_barrier(0);
        }
#undef SC_LD
#undef SC_STEP
        __syncthreads();
#pragma unroll
        for (int j = 0; j < 2; ++j) { const int o_ = tid + 512 * j, s_ = o_ >> 6, rr_ = o_ & 63; const LAS f32x4* q_ = (const LAS f32x4*)(ypb + o_ * 8);
            const f32x4 t_ = q_[0] + q_[1]; YB[(size_t)(seq_base + SCAN_TOK(ci, s_)) * 512 + h * 64 + rr_] = (t_.x + t_.y) + (t_.z + t_.w); }
        if (ci + 1 < nch) { SCAN_STORE((ci + 1) & 1);
#pragma unroll
            for (int j = 0; j < 4; ++j) stg[j] = stg2[j];
            if (ci + 3 < nch) SCAN_LOAD(stg2, ci + 3); }
        __syncthreads();
    }
    if (!smp) { float* O = F.out + OUT_ST + ((((size_t)b * 2 + l) * 2 + d) * 8 + h) * 4096 + row * 64 + 8 * c; *(f32x4*)O = sa_; *(f32x4*)(O + 4) = sb_; }
#undef SCAN_TOK
#undef SCAN_LOAD
#undef SCAN_STORE
}

#if defined(TCTX)
#define TSEL (!smp)
#else
#define TSEL (smp && half == 0)
#endif
#define LDS_BARRIER() asm volatile("s_waitcnt lgkmcnt(0)\n\ts_barrier" ::: "memory")
#define MFMA4(a, b, c) __builtin_amdgcn_mfma_f32_16x16x4f32((a), (b), (c), 0, 0, 0)
constexpr int RAW_P = 448, RAW_SZ = 16 * RAW_P, RW_R = 0, RW_KK = 80, RW_KD = 160, RW_KA = 240, RW_W = 320, RW_V = 384;
constexpr int TP = 68, TB_M = 0, TB_N = 1104, TB_PT = 2208, TB_QT = 3312, TB_VT = 4416, TB_CT = 5440, TAB_SZ = 5504;
constexpr int CS_TAB = 2 * RAW_SZ, CS_PROD = CS_TAB + 3 * TAB_SZ, PROD_SZ = 1024;
constexpr int PD_NTI = 0, PD_UQ = 256, PD_WP = 512, PD_WQ = 768;
static_assert((CS_PROD + 2 * PROD_SZ) * 4 <= MISC_OFF, "chunked scan LDS");
__device__ __forceinline__ void scan_item_chunk(Frame& F, int l, bool smp, int b, int h, int d, int half) {
    typedef short bf16x8_t __attribute__((ext_vector_type(8))); typedef short bf16x4_t __attribute__((ext_vector_type(4))); typedef unsigned u32x2_t __attribute__((ext_vector_type(2)));
    int tid = F.tid; asm volatile("" : "+v"(tid));
    const int lane = tid & 63, wv = __builtin_amdgcn_readfirstlane(tid >> 6), g = lane >> 4, lo = lane & 15;
    const int seqlen = smp ? 1024 : 256, seq_base = smp ? MC + b * 1024 : b * 256, nch = seqlen / 16;
    const int seq_pr = smp ? 32768 + (b * 8 + h) * 1024 : (b * 8 + h) * 256;
    LAS float* L = (LAS float*)F.lds;
    const float* SCAN = (const float*)(F.ws + WS_SCAN); bf16_t* YB = (bf16_t*)(F.ws + WS_YB) + (size_t)d * MT * 512;
#define SCAN_TOK(ci, s) (d ? seqlen - 1 - ((ci) * 16 + (s)) : (ci) * 16 + (s))
    __syncthreads();
    const bool split = half >= 0;
    if (split ? wv < 2 : (wv & 2) == 0) {
        const int row = (split ? 32 * half : 0) + 16 * ((wv & 1) | ((wv >> 2) << 1)) + lo;
        f32x4 st[4];
#pragma unroll
        for (int jt = 0; jt < 4; ++jt) st[jt] = (f32x4){0.f, 0.f, 0.f, 0.f};
        if (smp) { const float* S0 = F.in[I_ST] + ((((size_t)b * 2 + l) * 2 + d) * 8 + h) * 4096 + row * 64 + 4 * g;
#pragma unroll
            for (int jt = 0; jt < 4; ++jt) st[jt] = *(const f32x4*)(S0 + 16 * jt); }
        LDS_BARRIER(); LDS_BARRIER(); LDS_BARRIER();
#if defined(TCH)
        unsigned long long tc0_ = __builtin_amdgcn_s_memrealtime(), tacc_ = 0;
#define TCH_MARK(r) do { const unsigned long long t1_ = __builtin_amdgcn_s_memrealtime(); if ((r) == TCH) tacc_ += t1_ - tc0_; tc0_ = t1_; } while (0)
#else
#define TCH_MARK(r) do {} while (0)
#endif
        int tb3 = 0;
#if defined(TCLK)
        const unsigned long long tclk_c0 = __builtin_amdgcn_s_memtime(), tclk_r0 = __builtin_amdgcn_s_memrealtime();
#endif
        for (int ci = 0; ci < nch; ++ci) {
            TCH_MARK(4);
            const LAS float* T = L + CS_TAB + tb3 * TAB_SZ; const LAS float* Pd = L + CS_PROD + (ci & 1) * PROD_SZ; tb3 = tb3 == 2 ? 0 : tb3 + 1;
            const LAS float* vt = T + TB_VT + row;
            f32x4 am[4], an[4]; float auq[4], ant[4], av[4];
#pragma unroll
            for (int jt = 0; jt < 4; ++jt) { am[jt] = *(const LAS f32x4*)(T + TB_M + lo * TP + 16 * jt + 4 * g); an[jt] = *(const LAS f32x4*)(T + TB_N + lo * TP + 16 * jt + 4 * g); }
#pragma unroll
            for (int kb = 0; kb < 4; ++kb) { auq[kb] = Pd[PD_UQ + (4 * g + kb) * 16 + lo]; ant[kb] = Pd[PD_NTI + (4 * g + kb) * 16 + lo]; av[kb] = vt[(4 * g + kb) * 64]; }
            __builtin_amdgcn_sched_barrier(0);
            f32x4 xa = {0.f, 0.f, 0.f, 0.f}, yt = {0.f, 0.f, 0.f, 0.f};
#pragma unroll
            for (int q = 0; q < 2; ++q) {
                const bf16x8_t bs_ = __builtin_bit_cast(bf16x8_t, (u32x4){pk2(st[2 * q][0], st[2 * q][1]), pk2(st[2 * q][2], st[2 * q][3]), pk2(st[2 * q + 1][0], st[2 * q + 1][1]), pk2(st[2 * q + 1][2], st[2 * q + 1][3])});
                xa = __builtin_amdgcn_mfma_f32_16x16x32_bf16(__builtin_bit_cast(bf16x8_t, (u32x4){pk2(am[2 * q][0], am[2 * q][1]), pk2(am[2 * q][2], am[2 * q][3]), pk2(am[2 * q + 1][0], am[2 * q + 1][1]), pk2(am[2 * q + 1][2], am[2 * q + 1][3])}), bs_, xa, 0, 0, 0);
                yt = __builtin_amdgcn_mfma_f32_16x16x32_bf16(__builtin_bit_cast(bf16x8_t, (u32x4){pk2(an[2 * q][0], an[2 * q][1]), pk2(an[2 * q][2], an[2 * q][3]), pk2(an[2 * q + 1][0], an[2 * q + 1][1]), pk2(an[2 * q + 1][2], an[2 * q + 1][3])}), bs_, yt, 0, 0, 0);
            }
            const u32x2_t pav = {pk2(av[0], av[1]), pk2(av[2], av[3])};
            xa = __builtin_amdgcn_mfma_f32_16x16x16bf16_1k(__builtin_bit_cast(bf16x4_t, (u32x2_t){pk2(auq[0], auq[1]), pk2(auq[2], auq[3])}), __builtin_bit_cast(bf16x4_t, pav), xa, 0, 0, 0);
            f32x4 sat = {0.f, 0.f, 0.f, 0.f};
#pragma unroll
            for (int kb = 0; kb < 4; ++kb) sat = MFMA4(ant[kb], xa[kb], sat);
            __builtin_amdgcn_sched_barrier(0);
            TCH_MARK(1);
            float awp[4], awq[4], apt[16], aqt[16]; f32x4 ct[4];
#pragma unroll
            for (int jt = 0; jt < 4; ++jt) {
#pragma unroll
                for (int kb = 0; kb < 4; ++kb) { apt[4 * jt + kb] = T[TB_PT + (4 * g + kb) * TP + 16 * jt + lo]; aqt[4 * jt + kb] = T[TB_QT + (4 * g + kb) * TP + 16 * jt + lo]; }
                ct[jt] = *(const LAS f32x4*)(T + TB_CT + 16 * jt + 4 * g); }
#pragma unroll
            for (int kb = 0; kb < 4; ++kb) { awp[kb] = Pd[PD_WP + (4 * g + kb) * 16 + lo]; awq[kb] = Pd[PD_WQ + (4 * g + kb) * 16 + lo]; }
            __builtin_amdgcn_sched_barrier(0);
            const bf16x8_t bsv = __builtin_bit_cast(bf16x8_t, (u32x4){pk2(sat[0], sat[1]), pk2(sat[2], sat[3]), pav[0], pav[1]});
            yt = __builtin_amdgcn_mfma_f32_16x16x32_bf16(__builtin_bit_cast(bf16x8_t, (u32x4){pk2(awp[0], awp[1]), pk2(awp[2], awp[3]), pk2(awq[0], awq[1]), pk2(awq[2], awq[3])}), bsv, yt, 0, 0, 0);
#pragma unroll
            for (int jt = 0; jt < 4; ++jt)
                st[jt] = __builtin_amdgcn_mfma_f32_16x16x32_bf16(__builtin_bit_cast(bf16x8_t, (u32x4){pk2(apt[4 * jt], apt[4 * jt + 1]), pk2(apt[4 * jt + 2], apt[4 * jt + 3]), pk2(aqt[4 * jt], aqt[4 * jt + 1]), pk2(aqt[4 * jt + 2], aqt[4 * jt + 3])}), bsv, st[jt], 0, 0, 0);
#pragma unroll
            for (int r = 0; r < 4; ++r) YB[(size_t)(seq_base + SCAN_TOK(ci, 4 * g + r)) * 512 + h * 64 + row] = f2bf(yt[r]);
#pragma unroll
            for (int jt = 0; jt < 4; ++jt) st[jt] = st[jt] * ct[jt];
            __builtin_amdgcn_sched_barrier(0);
            TCH_MARK(3);
            LDS_BARRIER();
        }
#if defined(TCH)
        if (TSEL && b == 0 && h == 0 && d == 0 && l == 0 && tid == 0) ((volatile LAS unsigned long long*)(F.lds + MISC_OFF + 240))[0] = tacc_;
#endif
#if defined(TCLK)
        if (smp && b == 0 && h == 0 && d == 0 && l == 0 && tid == 0) { const unsigned long long cyc = __builtin_amdgcn_s_memtime() - tclk_c0, rt = __builtin_amdgcn_s_memrealtime() - tclk_r0;
            ((volatile LAS unsigned long long*)(F.lds + MISC_OFF + 240))[0] = (cyc * 1000ull) / rt; }
#endif
        if (!smp) { float* O = F.out + OUT_ST + ((((size_t)b * 2 + l) * 2 + d) * 8 + h) * 4096 + row * 64 + 4 * g;
#pragma unroll
            for (int jt = 0; jt < 4; ++jt) *(f32x4*)(O + 16 * jt) = st[jt]; }
    } else if ((wv & 2) == 0) {
        for (int i = 0; i < nch + 3; ++i) LDS_BARRIER();
    } else {
        const int hw = (wv & 1) | ((wv >> 2) << 1), ht = hw * 64 + lane;
        const int sg2 = (ht >> 6) & 1, sst0 = ht >> 7;
        const int ssrc = (sg2 ? 1 + d : 0) * 192 + (ht & 63) * 3;
        const int sd0 = (sg2 ? RW_W : RW_R) + (ht & 63), sd1 = (sg2 ? RW_KD : RW_V) + (ht & 63), sd2 = (sg2 ? RW_KA : RW_KK) + (ht & 63);
        typedef float f32x3_t __attribute__((ext_vector_type(3)));
        f32x3_t sA[8], sB[8];
        const int sloff = (d ? 15 - sst0 : sst0) * 576 + ssrc;
#define SCAN_LOAD(R, ci) do { const float* cb_ = SCAN + (size_t)(seq_pr + (d ? seqlen - 16 - (ci) * 16 : (ci) * 16)) * 576; \
            _Pragma("unroll") for (int j = 0; j < 8; ++j) { const float* p_ = cb_ + (d ? -2 * j : 2 * j) * 576; R[j] = (f32x3_t){p_[sloff], p_[sloff + 1], p_[sloff + 2]}; } } while (0)
#define SCAN_STORE(R, buf) do { _Pragma("unroll") for (int j = 0; j < 8; ++j) { LAS float* dst_ = L + (buf) * RAW_SZ + (sst0 + 2 * j) * RAW_P; dst_[sd0] = R[j].x; dst_[sd1] = R[j].y; dst_[sd2] = R[j].z; } } while (0)
        const int ty = lane >> 4, cl = lane & 15;
        const int aoff = ty == 0 ? RW_KK : (ty == 1 ? RW_R : (ty == 2 ? RW_KA : RW_KD)), wsh = ty == 0 ? RAW_P : 0, toff = ty * 1104;
#define CS_TABLES(n, tbuf) do { const LAS float* R_ = L + ((n) & 1) * RAW_SZ + 16 * hw + cl; LAS float* T_ = L + CS_TAB + (tbuf) * TAB_SZ + 16 * hw + cl; \
            float w_[16], a_[16], v_[4]; \
            _Pragma("unroll") for (int t = 0; t < 16; ++t) { w_[t] = R_[RW_W + (t ? t * RAW_P - wsh : 0)]; a_[t] = R_[t * RAW_P + aoff]; } \
            _Pragma("unroll") for (int i = 0; i < 4; ++i) v_[i] = R_[(ty + 4 * i) * RAW_P + RW_V]; \
            __builtin_amdgcn_sched_barrier(0); \
            if (ty == 0) w_[0] = 1.0f; \
            if (ty >= 2) { _Pragma("unroll") for (int t = 0; t < 16; ++t) w_[t] = __builtin_amdgcn_rcpf(w_[t]); } \
            float c_ = 1.0f; \
            _Pragma("unroll") for (int t = 0; t < 16; ++t) { c_ *= w_[t]; T_[toff + t * TP] = a_[t] * c_; } \
            _Pragma("unroll") for (int i = 0; i < 4; ++i) T_[TB_VT + (ty + 4 * i) * 64] = v_[i]; \
            if (ty == 1) T_[TB_CT] = c_; } while (0)
#define PK8(a, b) __builtin_bit_cast(bf16x8_t, (u32x4){pk2((a)[0], (a)[1]), pk2((a)[2], (a)[3]), pk2((b)[0], (b)[1]), pk2((b)[2], (b)[3])})
#define PK4(z) __builtin_bit_cast(bf16x4_t, (u32x2_t){pk2((z)[0], (z)[1]), pk2((z)[2], (z)[3])})
#define MMB(za, zb) __builtin_amdgcn_mfma_f32_16x16x16bf16_1k((za), (zb), (f32x4){0.f, 0.f, 0.f, 0.f}, 0, 0, 0)
#define CS_PRODS(n, tbuf) do { const LAS float* Tq_ = L + CS_TAB + (tbuf) * TAB_SZ + lo * TP + 8 * g; LAS float* P_ = L + CS_PROD + ((n) & 1) * PROD_SZ; \
            const LAS float* A_ = Tq_ + (hw < 2 ? TB_M : TB_N); const LAS float* Bq_ = Tq_ + ((hw & 1) ? TB_QT : TB_PT); \
            const f32x4 xa0_ = *(const LAS f32x4*)A_, xa1_ = *(const LAS f32x4*)(A_ + 4), xa2_ = *(const LAS f32x4*)(A_ + 32), xa3_ = *(const LAS f32x4*)(A_ + 36); \
            const f32x4 xb0_ = *(const LAS f32x4*)Bq_, xb1_ = *(const LAS f32x4*)(Bq_ + 4), xb2_ = *(const LAS f32x4*)(Bq_ + 32), xb3_ = *(const LAS f32x4*)(Bq_ + 36); \
            __builtin_amdgcn_sched_barrier(0); \
            const bf16x8_t fa0_ = PK8(xa0_, xa1_), fa1_ = PK8(xa2_, xa3_), fb0_ = PK8(xb0_, xb1_), fb1_ = PK8(xb2_, xb3_); \
            f32x4 u_ = {0.f, 0.f, 0.f, 0.f}; \
            u_ = __builtin_amdgcn_mfma_f32_16x16x32_bf16(fa0_, fb0_, u_, 0, 0, 0); u_ = __builtin_amdgcn_mfma_f32_16x16x32_bf16(fa1_, fb1_, u_, 0, 0, 0); \
            _Pragma("unroll") for (int r = 0; r < 4; ++r) { const int t_ = 4 * g + r; const bool keep_ = hw < 2 ? (lo < t_) : (lo <= t_); u_[r] = keep_ ? u_[r] : 0.f; } \
            if (hw != 0) { *(LAS f32x4*)(P_ + (hw == 1 ? PD_UQ : (hw == 2 ? PD_WP : PD_WQ)) + lo * 16 + 4 * g) = u_; } \
            else {   \
                f32x4 z_ = {0.f, 0.f, 0.f, 0.f}; \
                z_ = __builtin_amdgcn_mfma_f32_16x16x32_bf16(fb0_, fa0_, z_, 0, 0, 0); z_ = __builtin_amdgcn_mfma_f32_16x16x32_bf16(fb1_, fa1_, z_, 0, 0, 0); \
                f32x4 s_; \
                _Pragma("unroll") for (int r = 0; r < 4; ++r) { const int t_ = 4 * g + r; z_[r] = (t_ < lo) ? z_[r] : 0.f; s_[r] = (t_ == lo ? 1.0f : 0.0f) - z_[r]; } \
                const bf16x4_t bu_ = PK4(z_), but_ = PK4(u_); \
                const f32x4 u2_ = MMB(but_, bu_), u2t_ = MMB(bu_, but_); \
                const bf16x4_t b2_ = PK4(u2_), b2t_ = PK4(u2t_); \
                const f32x4 u4_ = MMB(b2t_, b2_), u4t_ = MMB(b2_, b2t_); \
                const bf16x4_t b4t_ = PK4(u4t_); \
                s_ = __builtin_amdgcn_mfma_f32_16x16x16bf16_1k(b2t_, PK4(s_), s_, 0, 0, 0); \
                const f32x4 u8t_ = MMB(PK4(u4_), b4t_); \
                s_ = __builtin_amdgcn_mfma_f32_16x16x16bf16_1k(b4t_, PK4(s_), s_, 0, 0, 0); \
                s_ = __builtin_amdgcn_mfma_f32_16x16x16bf16_1k(PK4(u8t_), PK4(s_), s_, 0, 0, 0); \
                _Pragma("unroll") for (int r = 0; r < 4; ++r) P_[PD_NTI + (4 * g + r) * 16 + lo] = -s_[r]; } } while (0)
        SCAN_LOAD(sA, 0); SCAN_LOAD(sB, 1); SCAN_STORE(sA, 0); SCAN_LOAD(sA, 2); SCAN_STORE(sB, 1); if (3 < nch) SCAN_LOAD(sB, 3);
        LDS_BARRIER();
        CS_TABLES(0, 0); CS_TABLES(1, 1);
        LDS_BARRIER();
        CS_PRODS(0, 0); SCAN_STORE(sA, 0); if (4 < nch) SCAN_LOAD(sA, 4);
        LDS_BARRIER();
        int t1 = 1, t2 = 2;
#if defined(TCHH)
        unsigned long long th0_ = __builtin_amdgcn_s_memrealtime(), thacc_ = 0;
#define TH_MARK(r) do { const unsigned long long t1_ = __builtin_amdgcn_s_memrealtime(); if ((r) == TCHH) thacc_ += t1_ - th0_; th0_ = t1_; } while (0)
#else
#define TH_MARK(r) do {} while (0)
#endif
        for (int ci = 0; ci < nch; ci += 2) {
            TH_MARK(5);
            if (ci + 2 < nch) CS_TABLES(ci + 2, t2);
            TH_MARK(1);
            CS_PRODS(ci + 1, t1);
            TH_MARK(3);
            if (ci + 3 < nch) { SCAN_STORE(sB, 1); if (ci + 5 < nch) SCAN_LOAD(sB, ci + 5); }
            t1 = t2; t2 = t2 == 2 ? 0 : t2 + 1;
            TH_MARK(4);
            LDS_BARRIER();
            TH_MARK(5);
            if (ci + 3 < nch) CS_TABLES(ci + 3, t2);
            TH_MARK(1);
            if (ci + 2 < nch) CS_PRODS(ci + 2, t1);
            TH_MARK(3);
            if (ci + 4 < nch) { SCAN_STORE(sA, 0); if (ci + 6 < nch) SCAN_LOAD(sA, ci + 6); }
            t1 = t2; t2 = t2 == 2 ? 0 : t2 + 1;
            TH_MARK(4);
            LDS_BARRIER();
        }
#if defined(TCHH)
        if (TSEL && b == 0 && h == 0 && d == 0 && l == 0 && hw == TCHW && lane == 0) ((volatile LAS unsigned long long*)(F.lds + MISC_OFF + 240))[0] = thacc_;
#endif
#undef SCAN_LOAD
#undef SCAN_STORE
#undef CS_TABLES
#undef CS_PRODS
#undef PK8
#undef PK4
#undef MMB
    }
#undef SCAN_TOK
    __syncthreads();
}

__device__ __forceinline__ void rwkv_combine_bh(Frame& F, int l, bool smp, int b, int h) {
    const int seqlen = smp ? 1024 : 256, seq_base = smp ? MC + b * 1024 : b * 256;
    const float* Y0 = (const float*)(F.ws + WS_YB) + h * 64 + F.lane; const float* Y1 = Y0 + (size_t)MT * 512;
    const float* SC = (const float*)(F.ws + WS_SCAN) + (size_t)(smp ? 32768 + (b * 8 + h) * 1024 : (b * 8 + h) * 256) * 768 + F.lane * 4 + 3; bf16_t* MIX = (bf16_t*)(F.ws + WS_MIX) + 1536 + h * 64 + F.lane;
    const float lg = F.in[I_LNG][l * 512 + h * 64 + F.lane], lb = F.in[I_LNB][l * 512 + h * 64 + F.lane];
#pragma unroll 1
    for (int t0 = F.wave * 16; t0 < seqlen; t0 += 128) {
        float y0[16], y1[16], bo[16], gg[16];
#pragma unroll
        for (int u = 0; u < 16; ++u) { const size_t m = (size_t)(seq_base + t0 + u); y0[u] = Y0[m * 512]; y1[u] = Y1[m * 512]; bo[u] = SC[(size_t)(t0 + u) * 768]; gg[u] = SC[(size_t)(t0 + u) * 768 + 256]; }
#pragma unroll
        for (int u = 0; u < 16; ++u) { const size_t m = (size_t)(seq_base + t0 + u); const float y = y0[u] + y1[u];
            const float mean = wave_sum_fast(y) * (1.0f / 64.0f), dl = y - mean, var = wave_sum_fast(dl * dl) * (1.0f / 64.0f);
            const float yn = dl * rsqrtf(var + GN_EPS) * lg + lb;
            MIX[m * DM] = f2bf((yn + bo[u]) * gg[u]); }
    }
}

__device__ __forceinline__ void rwkv_combine_all(Frame& F, int l) {
    const int h = F.wave;
    const float lg = F.in[I_LNG][l * 512 + h * 64 + F.lane], lb = F.in[I_LNB][l * 512 + h * 64 + F.lane];
#pragma unroll 1
    for (int m0 = (int)blockIdx.x * 32; m0 < MT; m0 += F.G * 32) {
        const bf16_t* Y0 = (const bf16_t*)(F.ws + WS_YB) + (size_t)m0 * 512 + h * 64 + F.lane; const bf16_t* Y1 = Y0 + (size_t)MT * 512;
        const unsigned* BG = (const unsigned*)(F.ws + WS_BG) + (size_t)m0 * 512 + h * 64 + F.lane; bf16_t* MIX = (bf16_t*)(F.ws + WS_MIX) + (size_t)m0 * DM + 1536 + h * 64 + F.lane;
#pragma unroll 1
        for (int t0 = 0; t0 < 32; t0 += 16) {
            bf16_t y0[16], y1[16]; unsigned bg[16];
#pragma unroll
            for (int u = 0; u < 16; ++u) { y0[u] = Y0[(size_t)(t0 + u) * 512]; y1[u] = Y1[(size_t)(t0 + u) * 512]; bg[u] = BG[(size_t)(t0 + u) * 512]; }
#pragma unroll
            for (int u = 0; u < 16; ++u) { const float y = bf2f(y0[u]) + bf2f(y1[u]);
                const float mean = wave_sum_fast(y) * (1.0f / 64.0f), dl = y - mean, var = wave_sum_fast(dl * dl) * (1.0f / 64.0f);
                const float yn = dl * rsqrtf(var + GN_EPS) * lg + lb;
                __hip_atomic_store(MIX + (size_t)(t0 + u) * DM, f2bf((yn + __uint_as_float(bg[u] << 16)) * __uint_as_float(bg[u] & 0xffff0000u)), __ATOMIC_RELAXED, __HIP_MEMORY_SCOPE_AGENT); }
        }
    }
}

#ifndef SPLIT_SMP
#define SPLIT_SMP 1
#endif
constexpr int NSS = SPLIT_SMP ? 128 : 64;
__device__ __forceinline__ void mixer_phase(Frame& F, int l, int rep) {
    unsigned* head = (unsigned*)(F.ws + WS_CTL) + CW_QUEUE + 64 * (2 * l + rep);
    volatile LAS unsigned* slot = (volatile LAS unsigned*)(F.lds + MISC_OFF);
    const bf16_t* QB = (const bf16_t*)(F.ws + WS_QB); const bf16_t* KB = (const bf16_t*)(F.ws + WS_KB); const bf16_t* VB = (const bf16_t*)(F.ws + WS_VB); bf16_t* MIX = (bf16_t*)(F.ws + WS_MIX);
    for (;;) {
        __syncthreads();
        if (F.tid == 0) slot[0] = atomicAdd(head, 1u);
        __syncthreads();
        const int item = (int)slot[0];
        if (item >= NSS + 512) break;
#if defined(TITEM)
        unsigned long long ti0_ = 0; if (l == 0 && rep == 0 && item == TITEM && F.tid == 0) ti0_ = __builtin_amdgcn_s_memrealtime();
#endif
        const bool is_scan = item < NSS + 256;
        if (is_scan) { const bool smp = item < NSS; const int u = smp ? (SPLIT_SMP ? item >> 1 : item) : item - NSS, sb_ = u >> 4, sh_ = (u >> 1) & 7;
            scan_item_chunk(F, l, smp, sb_, sh_, u & 1, (smp && SPLIT_SMP) ? (item & 1) : -1);
        }
        else {
            size_t row0, kr0; int hq, seq;
            if (item < NSS + 384) { const int u = item - (NSS + 256), b = u >> 5, qb = u & 3; hq = (u >> 2) & 7; row0 = (size_t)MC + b * 1024 + qb * 256; kr0 = (size_t)MC + b * 1280; seq = 1280; }
            else { const int u = item - (NSS + 384), b = u >> 3; hq = u & 7; row0 = (size_t)b * 256; kr0 = row0; seq = 256; }
            attn::attn_dense_body<attn::bf16>((const attn::bf16*)(QB + row0 * 1024 + hq * 128), (const attn::bf16*)(KB + kr0 * 256 + (hq >> 2) * 128), (const attn::bf16*)(VB + kr0 * 256 + (hq >> 2) * 128), MIX + row0 * DM + hq * 128, seq, (char*)F.ldsg);
        }
#if defined(TITEM)
        if (l == 0 && rep == 0 && item == TITEM && F.tid == 0) ((volatile LAS unsigned long long*)(F.lds + MISC_OFF + 240))[0] = __builtin_amdgcn_s_memrealtime() - ti0_;
#endif
    }
#if defined(TQUIET)
    if (l == 0 && rep == 0 && blockIdx.x == 0) { __syncthreads(); unsigned long long tq0_ = __builtin_amdgcn_s_memrealtime(); scan_item(F, l, true, 0, 0, 0, 0);
        if (F.tid == 0) ((volatile LAS unsigned long long*)(F.lds + MISC_OFF + 240))[0] = __builtin_amdgcn_s_memrealtime() - tq0_; }
#endif
}
constexpr int NPHASE = 2 + 8 * DEPTH;
#ifndef PH_MASK
#define PH_MASK 0xffff
#endif
#ifndef USE_CG_SYNC
#define USE_CG_SYNC 0
#endif
#ifndef REP_MASK
#define REP_MASK 0
#endif
#if ONE_LAUNCH && USE_CG_SYNC
#define GRID_BAR() cg::this_grid().sync()
#elif ONE_LAUNCH
#define GRID_BAR() xcd_barrier(F.bar)
#else
#define GRID_BAR() do {} while (0)
#endif
#define NREP(bit) ((REP_MASK & (bit)) ? 2 : 1)
#define IN(k) (lo <= (k) && (k) < hi)
#ifndef TPROBE_MASK
#define TPROBE_MASK 0
#endif
#if TPROBE_MASK
#define STAMP(k) do { if (blockIdx.x == 0 && F.tid == 0) ((volatile LAS unsigned long long*)(F.lds + MISC_OFF + 64))[k] = __builtin_amdgcn_s_memrealtime(); } while (0)
#else
#define STAMP(k) do {} while (0)
#endif
#define SEAM(k) do { if (IN(k) && IN((k) + 1)) GRID_BAR(); STAMP((k) + 1); } while (0)
__device__ __forceinline__ unsigned* panel_ctr(Frame& F, int l, int which) { return (unsigned*)(F.ws + WS_CTL) + CW_PAN + 64 * (64 + (l * 2 + which) * 32); }
__device__ __forceinline__ void panel_publish(Frame& F, unsigned* ctr, int pm) {
    asm volatile("s_waitcnt vmcnt(0)" ::: "memory"); __syncthreads();
    if (F.tid == 0) (void)xb_add(ctr + 64 * pm, 1u);
}
__device__ __forceinline__ void panel_wait(Frame& F, unsigned* ctr, int pm, unsigned want) {
    if (F.tid == 0) { unsigned sp = 0u; while (xb_ld(ctr + 64 * pm) < want) { __builtin_amdgcn_s_sleep(1); if (++sp > XB_SPIN_CAP) break; }
        __builtin_amdgcn_fence(__ATOMIC_ACQUIRE, "agent"); asm volatile("s_waitcnt vmcnt(0)" ::: "memory"); }
    __syncthreads();
}
#define SEAM_HANDOFF(k) do { if (true) { if (IN(k) && IN((k) + 1)) GRID_BAR(); } STAMP((k) + 1); } while (0)
template <int L> __device__ __forceinline__ void layer_phases(Frame& F, const int lo, const int hi) {
    constexpr int l = L, pb = 2 + 8 * L;
    if (IN(pb + 0) && (PH_MASK & 4)) {
        pg8::Gemm g{(const bf16_t*)(F.ws + WS_HB), (const bf16_t*)(F.ws + WS_WIN + l * SZ_WIN), MT, DINP, DM}; pg8::StaticOrder S; S.init(MT, DINP, F.G, (int)blockIdx.x);
        pg8::EpiBf16 E{(bf16_t*)(F.ws + WS_PROJ), DINP};
        if (F.G == 256) {
            if (blockIdx.x < 204) { S.init(MT, DINP, 204, (int)blockIdx.x); pg8::gemm_phase<pg8::EpiBf16, pg8::StaticOrder, true, true>(F.lds, g, S, E); }
            else conv_side(F, l, 0, CI_OUT + 2 * CI_G, 52, (int)blockIdx.x - 204);
        } else {
            for (int rep = 0; rep < NREP(4); ++rep) pg8::gemm_phase<pg8::EpiBf16, pg8::StaticOrder, true, true>(F.lds, g, S, E);
            conv_side(F, l, 0, CI_OUT + 2 * CI_G + CI_DN, F.G, (int)blockIdx.x);
        }
    } SEAM(pb + 0);
    if (IN(pb + 1) && (PH_MASK & 8)) { for (int rep = 0; rep < NREP(8); ++rep) p2_prepass(F, l); } SEAM(pb + 1);
    if (IN(pb + 2) && (PH_MASK & 16)) { for (int rep = 0; rep < NREP(16); ++rep) mixer_phase(F, l, rep); } SEAM(pb + 2);
    if (IN(pb + 3) && (PH_MASK & 64)) {
        rwkv_combine_all(F, l);
        pg8::Gemm g{(const bf16_t*)(F.ws + WS_MIX), (const bf16_t*)(F.ws + WS_WOUT + l * SZ_WOUT), MT, DM, DM}; pg8::StaticOrder S; S.init(MT, DM, F.G, (int)blockIdx.x);
        if (F.G == 256) {
            unsigned* pan = (unsigned*)(F.ws + WS_CTL) + CW_PAN + 64 * (l * 32);
            asm volatile("s_waitcnt vmcnt(0)" ::: "memory"); __syncthreads();
            if (F.tid == 0) {
                (void)xb_add(pan + 64 * ((int)blockIdx.x >> 3), 1u);
                pg8::Unit u0; unsigned want = 0u; if (S.next(0, u0)) want = 8u;
                unsigned sp = 0u; while (want && xb_ld(pan + 64 * u0.pm) < want) { __builtin_amdgcn_s_sleep(1); if (++sp > XB_SPIN_CAP) break; }
                __builtin_amdgcn_fence(__ATOMIC_ACQUIRE, "agent"); asm volatile("s_waitcnt vmcnt(0)" ::: "memory");
            }
            __syncthreads();
        } else GRID_BAR();
        if (false) { pg8::EpiBf16WT E{(bf16_t*)(F.ws + WS_OB), DM}; pg8::gemm_phase<pg8::EpiBf16WT, pg8::StaticOrder, true, true>(F.lds, g, S, E);
            pg8::Unit u1; if (S.next(0, u1)) panel_publish(F, panel_ctr(F, l, 0), u1.pm); }
        else { pg8::EpiBf16 E{(bf16_t*)(F.ws + WS_OB), DM}; pg8::gemm_phase<pg8::EpiBf16, pg8::StaticOrder, true, true>(F.lds, g, S, E); }
    } SEAM_HANDOFF(pb + 3);
    if (IN(pb + 4) && (PH_MASK & 128)) { rowpassA(F, l); } SEAM(pb + 4);
    if (IN(pb + 5) && (PH_MASK & 256)) {
        pg8::Gemm g{(const bf16_t*)(F.ws + WS_HB), (const bf16_t*)(F.ws + WS_WGU + l * SZ_WGU), MT, 2 * DFF, DM}; pg8::StaticOrder S; S.init(MT, 2 * DFF, F.G, (int)blockIdx.x);
        pg8::EpiSwiGLU E{(bf16_t*)(F.ws + WS_HID), DFF};
        if (F.G == 256) {
            if (blockIdx.x < 240) { S.init(MT, 2 * DFF, 240, (int)blockIdx.x); pg8::gemm_phase<pg8::EpiSwiGLU, pg8::StaticOrder, true, true>(F.lds, g, S, E); }
            else conv_side(F, l, CI_OUT + 2 * CI_G, CI_DN, 16, (int)blockIdx.x - 240);
        } else
        for (int rep = 0; rep < NREP(256); ++rep) pg8::gemm_phase<pg8::EpiSwiGLU, pg8::StaticOrder, true, true>(F.lds, g, S, E);
    } SEAM(pb + 5);
    if (IN(pb + 6) && (PH_MASK & 512)) {
        pg8::Gemm g{(const bf16_t*)(F.ws + WS_HID), (const bf16_t*)(F.ws + WS_WDN + l * SZ_WDN), MT, DM, DFF}; pg8::StaticOrder S; S.init(MT, DM, F.G, (int)blockIdx.x);
        if (false) { pg8::EpiBf16WT E{(bf16_t*)(F.ws + WS_OB), DM}; pg8::gemm_phase<pg8::EpiBf16WT, pg8::StaticOrder, true, true>(F.lds, g, S, E);
            pg8::Unit u1; if (S.next(0, u1)) panel_publish(F, panel_ctr(F, l, 1), u1.pm); }
        else { pg8::EpiBf16 E{(bf16_t*)(F.ws + WS_OB), DM}; pg8::gemm_phase<pg8::EpiBf16, pg8::StaticOrder, true, true>(F.lds, g, S, E); }
    } SEAM_HANDOFF(pb + 6);
    if (IN(pb + 7) && (PH_MASK & 1024)) { rowpassB(F, l); } SEAM(pb + 7);
}
__global__ void __launch_bounds__(NTHREADS, 2) hybrid_fwd(Args args) {
    extern __shared__ __attribute__((aligned(16))) unsigned char lds[];
    Frame F;
    F.lds = (LAS unsigned char*)lds; F.ldsg = lds; F.in = args.in; F.out = args.out; F.ws = args.ws;
    F.tid = threadIdx.x; F.lane = F.tid & 63; F.wave = __builtin_amdgcn_readfirstlane(F.tid >> 6); F.G = gridDim.x;
    const int lo = args.ph_lo, hi = args.ph_hi;
    if (F.tid < 64) ((LAS unsigned*)(F.lds + MISC_OFF))[F.tid] = 0u;
    __syncthreads();
#if ONE_LAUNCH && !USE_CG_SYNC
    F.bar = xcd_barrier_post((unsigned*)(F.ws + WS_CTL) + CW_BAR, (volatile LAS unsigned*)(F.lds + MISC_OFF) + 8);
#endif
    STAMP(0);
    if (IN(0) && (PH_MASK & 1)) { for (int rep = 0; rep < NREP(1); ++rep) p0_prologue(F); } SEAM(0);
    if (IN(1) && (PH_MASK & 2)) { for (int rep = 0; rep < NREP(2); ++rep) rowpass0(F); } SEAM(1);
    layer_phases<0>(F, lo, hi);
    layer_phases<1>(F, lo, hi);
#if defined(XBAR)
#pragma unroll 1
    for (int i = 0; i < XBAR; ++i) GRID_BAR();
#endif
#if defined(TITEM) || defined(TQUIET) || defined(TSUB) || defined(TCH) || defined(TCHH) || defined(TCLK)
    if (F.tid == 0) { const unsigned long long tot = ((volatile LAS unsigned long long*)(F.lds + MISC_OFF + 240))[0];
        if (tot) { const unsigned long long t0 = __builtin_amdgcn_s_memrealtime(); while (__builtin_amdgcn_s_memrealtime() - t0 < tot) __builtin_amdgcn_s_sleep(8); } }
#endif
#if TPROBE_MASK
    if (blockIdx.x == 0 && F.tid == 0) {
        volatile LAS unsigned long long* ts = (volatile LAS unsigned long long*)(F.lds + MISC_OFF + 64); unsigned long long tot = 0;
        for (int k = 0; k < NPHASE; ++k) if ((TPROBE_MASK >> k) & 1) tot += ts[k + 1] - ts[k];
        const unsigned long long t0 = __builtin_amdgcn_s_memrealtime(); while (__builtin_amdgcn_s_memrealtime() - t0 < tot) __builtin_amdgcn_s_sleep(8);
    }
#endif
}
#undef IN
#undef SEAM

extern "C" void kernel_launch(void* const* d_in, const int* in_sizes, int n_in, void* d_out, int out_size, void* d_ws, size_t ws_size, hipStream_t stream) {
    static int grid = 0;
    if (grid == 0) {
        if (n_in != N_IN || (size_t)out_size != OUT_TOTAL || ws_size < WS_END) { fprintf(stderr, "kernel_launch: unexpected shapes: n_in %d out %d ws %zu (need %zu)\n", n_in, out_size, ws_size, (size_t)WS_END); grid = -1; return; }
        int dev = 0, cus = 0, per_cu = 0;
        if (hipGetDevice(&dev) != hipSuccess || hipDeviceGetAttribute(&cus, hipDeviceAttributeMultiprocessorCount, dev) != hipSuccess) { grid = -1; return; }
        if (hipFuncSetAttribute((const void*)hybrid_fwd, hipFuncAttributeMaxDynamicSharedMemorySize, LDS_BYTES) != hipSuccess) { fprintf(stderr, "kernel_launch: hipFuncSetAttribute failed\n"); grid = -1; return; }
        if (hipOccupancyMaxActiveBlocksPerMultiprocessor(&per_cu, (const void*)hybrid_fwd, NTHREADS, LDS_BYTES) != hipSuccess || per_cu < 1) { fprintf(stderr, "kernel_launch: occupancy query says %d blocks per CU\n", per_cu); (void)hipGetLastError(); grid = -1; return; }
        if (cus * 32 < MT) { fprintf(stderr, "kernel_launch: %d CUs: the row passes need %d workgroups\n", cus, MT / 32); grid = -1; return; }
        grid = cus;
    }
    if (grid < 0) return;
    (void)hipMemsetAsync((char*)d_ws + WS_CTL, 0, CTL_ZERO_BYTES, stream);
    Args a{};
    for (int i = 0; i < N_IN; ++i) a.in[i] = (const float*)d_in[i];
    a.out = (float*)d_out; a.ws = (unsigned char*)d_ws;
#if ONE_LAUNCH
    a.ph_lo = 0; a.ph_hi = NPHASE;
    void* kargs[] = {&a};
    const hipError_t e = hipLaunchCooperativeKernel((const void*)hybrid_fwd, dim3(grid), dim3(NTHREADS), kargs, LDS_BYTES, stream);
    if (e != hipSuccess) fprintf(stderr, "kernel_launch: cooperative launch failed: %s (grid %d)\n", hipGetErrorString(e), grid);
#else
    for (int ph = 0; ph < NPHASE; ++ph) {
        a.ph_lo = ph; a.ph_hi = ph + 1;
        hipLaunchKernelGGL(hybrid_fwd, dim3(grid), dim3(NTHREADS), LDS_BYTES, stream, a);
    }
    const hipError_t le = hipPeekAtLastError();
    if (le != hipSuccess) fprintf(stderr, "kernel_launch: launch failed: %s\n", hipGetErrorName(le));
#endif
}
```
